# Optimizing an MI355X kernel written in HIP

```python
import jax, jax.numpy as jnp
from jax import lax
import numpy as np

D_MODEL = 4096
BATCH = 4
SEQ = 4096
DEPTH = 2

MIX_WIDTH = D_MODEL
CONV_WIDTH = MIX_WIDTH // 2
CONV_GROUPS = 16
RET_WIDTH = MIX_WIDTH - CONV_WIDTH
RET_HEADS = 8
RET_HEAD_DIM = RET_WIDTH // RET_HEADS
CHUNK = 128
SHORT_CONV = 3
D_FF = 256 * ((8 * D_MODEL // 3 + 255) // 256)
ROPE_BASE = 10000.0
EPS = 1e-6
IN_COLS = 3 * CONV_WIDTH + 4 * RET_WIDTH

kernel_name = "hybrid_shortconv_retention_convffn_encoder"


def rmsnorm(x, g):
    xf = x.astype(jnp.float32)
    y = xf * lax.rsqrt(jnp.mean(xf * xf, axis=-1, keepdims=True) + EPS)
    return (y * g.astype(jnp.float32)).astype(x.dtype)


def dwconv3(x, w, b):
    xp = jnp.pad(x, ((0, 0), (1, 1), (0, 0)))
    return xp[:, :-2] * w[0] + xp[:, 1:-1] * w[1] + xp[:, 2:] * w[2] + b


def rotary(t, cos, sin):
    t1, t2 = jnp.split(t, 2, axis=-1)
    return jnp.concatenate([t1 * cos - t2 * sin, t2 * cos + t1 * sin], axis=-1)


def bidir_retention(q, k, v, log_gamma):
    b, s, h, d = q.shape
    n = s // CHUNK

    def chunks(t):
        return t.reshape(b, n, CHUNK, h, d).transpose(0, 3, 1, 2, 4)

    q, k, v = chunks(q), chunks(k), chunks(v)
    lf = log_gamma[0][:, None]
    lb = log_gamma[1][:, None]
    pos = jnp.arange(CHUNK, dtype=jnp.float32)
    rel = pos[:, None] - pos[None, :]
    dec = jnp.where(rel >= 0,
                    jnp.exp(lf[:, :, None] * jnp.maximum(rel, 0.0)),
                    jnp.exp(lb[:, :, None] * jnp.maximum(-rel, 0.0)))
    scores = jnp.einsum('bhnid,bhnjd->bhnij', q, k) * dec[None, :, None]
    o = jnp.einsum('bhnij,bhnje->bhnie', scores, v)
    wk_f = jnp.exp(lf * (CHUNK - 1 - pos))
    wk_b = jnp.exp(lb * pos)
    kv_f = jnp.einsum('bhncd,bhnce->bhnde', k * wk_f[None, :, None, :, None], v)
    kv_b = jnp.einsum('bhncd,bhnce->bhnde', k * wk_b[None, :, None, :, None], v)
    g_chunk_f = jnp.exp(lf * CHUNK)[None, :, :, None]
    g_chunk_b = jnp.exp(lb * CHUNK)[None, :, :, None]

    def step_f(state, kv):
        return state * g_chunk_f + kv, state

    def step_b(state, kv):
        return state * g_chunk_b + kv, state

    zeros = jnp.zeros(kv_f.shape[:2] + kv_f.shape[3:], kv_f.dtype)
    _, state_f = lax.scan(step_f, zeros, jnp.moveaxis(kv_f, 2, 0))
    _, state_b = lax.scan(step_b, zeros, jnp.moveaxis(kv_b, 2, 0), reverse=True)
    state_f = jnp.moveaxis(state_f, 0, 2)
    state_b = jnp.moveaxis(state_b, 0, 2)
    wq_f = jnp.exp(lf * (pos + 1.0))[None, :, None, :, None]
    wq_b = jnp.exp(lb * (CHUNK - pos))[None, :, None, :, None]
    o = o + wq_f * jnp.einsum('bhnid,bhnde->bhnie', q, state_f) \
          + wq_b * jnp.einsum('bhnid,bhnde->bhnie', q, state_b)
    return o.transpose(0, 2, 3, 1, 4).reshape(b, s, h, d)


def setup_inputs(seed: int = 0) -> dict:
    key = jax.random.key(seed)
    ks = jax.random.split(key, 18)
    f32 = jnp.float32
    nrm = lambda k, shape, scale: jax.random.normal(k, shape, f32) * scale
    base_logit = jnp.asarray(np.log(2.0 ** (5 + np.arange(RET_HEADS)) - 1.0), f32)
    return {
        "x": nrm(ks[0], (BATCH, SEQ, D_MODEL), 1.0),
        "positions": jnp.broadcast_to(jnp.arange(SEQ, dtype=jnp.int32), (BATCH, SEQ)),
        "norm1_g": 1.0 + nrm(ks[1], (DEPTH, D_MODEL), 0.02),
        "w_in": nrm(ks[2], (DEPTH, D_MODEL, IN_COLS), D_MODEL ** -0.5),
        "conv_a_w": nrm(ks[3], (DEPTH, SHORT_CONV, CONV_WIDTH), SHORT_CONV ** -0.5),
        "conv_a_b": nrm(ks[4], (DEPTH, CONV_WIDTH), 0.02),
        "beta_a": 1.0 + nrm(ks[5], (DEPTH, CONV_WIDTH), 0.02),
        "ret_decay_logit": base_logit + nrm(ks[6], (DEPTH, 2, RET_HEADS), 0.05),
        "ret_gn_g": 1.0 + nrm(ks[7], (DEPTH, RET_WIDTH), 0.02),
        "w_out": nrm(ks[8], (DEPTH, MIX_WIDTH, D_MODEL), MIX_WIDTH ** -0.5),
        "norm2_g": 1.0 + nrm(ks[9], (DEPTH, D_MODEL), 0.02),
        "w_gate": nrm(ks[10], (DEPTH, D_MODEL, D_FF), D_MODEL ** -0.5),
        "w_up": nrm(ks[11], (DEPTH, D_MODEL, D_FF), D_MODEL ** -0.5),
        "ffn_conv_w": nrm(ks[12], (DEPTH, SHORT_CONV, D_FF), SHORT_CONV ** -0.5),
        "ffn_conv_b": nrm(ks[13], (DEPTH, D_FF), 0.02),
        "w_down": nrm(ks[14], (DEPTH, D_FF, D_MODEL), D_FF ** -0.5),
        "norm_f_g": 1.0 + nrm(ks[15], (D_MODEL,), 0.02),
    }


def reference(x, positions, norm1_g, w_in, conv_a_w, conv_a_b, beta_a, ret_decay_logit,
              ret_gn_g, w_out, norm2_g, w_gate, w_up, ffn_conv_w, ffn_conv_b, w_down,
              norm_f_g):
    b, s, _ = x.shape
    half = RET_HEAD_DIM // 2
    inv_freq = ROPE_BASE ** (-jnp.arange(half, dtype=jnp.float32) / half)
    ang = positions.astype(jnp.float32)[..., None] * inv_freq
    cos = jnp.cos(ang)[:, :, None, :].astype(x.dtype)
    sin = jnp.sin(ang)[:, :, None, :].astype(x.dtype)
    split_pts = [CONV_WIDTH, 2 * CONV_WIDTH, 3 * CONV_WIDTH,
                 3 * CONV_WIDTH + RET_WIDTH, 3 * CONV_WIDTH + 2 * RET_WIDTH,
                 3 * CONV_WIDTH + 3 * RET_WIDTH]

    for l in range(DEPTH):
        h = rmsnorm(x, norm1_g[l])
        proj = h @ w_in[l]
        a_b, a_c, a_x, r_q, r_k, r_v, r_g = jnp.split(proj, split_pts, axis=-1)
        ya = a_b * dwconv3(a_c * a_x, conv_a_w[l], conv_a_b[l])
        ya = rmsnorm(ya.reshape(b, s, CONV_GROUPS, CONV_WIDTH // CONV_GROUPS),
                     jnp.ones((), jnp.float32)).reshape(b, s, CONV_WIDTH) * beta_a[l]
        q = rotary(r_q.reshape(b, s, RET_HEADS, RET_HEAD_DIM), cos, sin) * (RET_HEAD_DIM ** -0.5)
        k = rotary(r_k.reshape(b, s, RET_HEADS, RET_HEAD_DIM), cos, sin)
        v = r_v.reshape(b, s, RET_HEADS, RET_HEAD_DIM)
        log_gamma = jax.nn.log_sigmoid(ret_decay_logit[l].astype(jnp.float32))
        o = bidir_retention(q, k, v, log_gamma).astype(jnp.float32)
        mu = jnp.mean(o, axis=-1, keepdims=True)
        var = jnp.mean(jnp.square(o - mu), axis=-1, keepdims=True)
        o = ((o - mu) * lax.rsqrt(var + EPS)).reshape(b, s, RET_WIDTH) * ret_gn_g[l]
        yr = o.astype(x.dtype) * jax.nn.silu(r_g)
        y = jnp.concatenate([ya.astype(x.dtype), yr], axis=-1) @ w_out[l]
        x = x + y
        h = rmsnorm(x, norm2_g[l])
        gate = dwconv3(h @ w_gate[l], ffn_conv_w[l], ffn_conv_b[l])
        x = x + (jax.nn.silu(gate) * (h @ w_up[l])) @ w_down[l]

    return rmsnorm(x, norm_f_g)
```

```cpp
#include <hip/hip_runtime.h>
#include <cstdio>
#include <cstdint>

#ifndef PH_MASK
#define PH_MASK 0x3ff
#endif
#define PHON(k) ((PH_MASK >> (k)) & 1)
#ifndef MK_SPLIT
#define MK_SPLIT 0
#endif

namespace pg8 {
#define PG8_LAS __attribute__((address_space(3)))
typedef unsigned short bf16_t;
typedef short bf16x8 __attribute__((ext_vector_type(8)));
typedef float f32x4 __attribute__((ext_vector_type(4)));
typedef unsigned u32x4 __attribute__((ext_vector_type(4)));
constexpr int BM = 256, BK = 64, HALF = 128, HTB = HALF * BK * 2  , STAGE_BYTES = 8 * HTB, NXCD = 8, WGM = 8;

__host__ __device__ __forceinline__ int lds_byte(int r, int c) { const int st = (r >> 4) * 2 + (c >> 5), rr = r & 15, cc = c & 31, ob = rr * 64 + cc * 2; return st * 1024 + (ob ^ (((ob >> 9) & 1) << 5)); }
__host__ __device__ __forceinline__ void stage_rc(int b, int& R, int& C) { const int st = b / 1024, sb = b % 1024, swz = sb ^ (((sb >> 9) & 1) << 5); R = (st >> 1) * 16 + swz / 64; C = (st & 1) * 32 + (swz % 64) / 2; }
__host__ __device__ __forceinline__ int perm32(int rho) { const int n = rho >> 4, i = rho & 15; return 8 * (i >> 2) + 4 * n + (i & 3); }

struct Unit { int pm, pn; };
struct Gemm { const bf16_t* A; const bf16_t* Bt; int M, N, K; };

struct StaticOrder {
    int nM, nN, nwg, G, c;
    __host__ __device__ void init(int M, int N, int G_, int c_) { nM = M / BM; nN = N / BM; nwg = nM * nN; G = G_; c = c_; }
    __host__ __device__ bool next(int i, Unit& u) const {
        const long L = (long)i * G + c; if (L >= nwg) return false;
        int wgid = (int)L; { const int q = nwg / NXCD, r = nwg % NXCD, xcd = wgid % NXCD, off = wgid / NXCD; wgid = (xcd < r ? xcd * (q + 1) : r * (q + 1) + (xcd - r) * q) + off; }
        const int nig = WGM * nN, gid = wgid / nig, fm = gid * WGM, gsz = (nM - fm) < WGM ? (nM - fm) : WGM;
        u.pm = fm + ((wgid % nig) % gsz); u.pn = (wgid % nig) / gsz; return true;
    }
    __device__ __forceinline__ void a_ready(const Unit&) const {}
    __device__ __forceinline__ void done(const Unit&) const {}
};

__device__ __forceinline__ unsigned cvt_pk_bf16(float lo, float hi) { unsigned r; asm volatile("v_cvt_pk_bf16_f32 %0, %1, %2" : "=v"(r) : "v"(lo), "v"(hi)); return r; }
__device__ __forceinline__ u32x4 pack8(const f32x4 a, const f32x4 b) { u32x4 w; w.x = cvt_pk_bf16(a[0], a[1]); w.y = cvt_pk_bf16(a[2], a[3]); w.z = cvt_pk_bf16(b[0], b[1]); w.w = cvt_pk_bf16(b[2], b[3]); return w; }

struct EpiIn {
    static constexpr bool PERM = true, AFTER_DRAIN = false;
    bf16_t* O; int ldc; const float* rstd; const float* cosb; const float* sinb;
    __device__ __forceinline__ void operator()(const f32x4 (&acc)[2][2][4][2], const Unit& u, int wr, int wc, int fr, int fq) const {
        asm volatile("" : "+v"(fr), "+v"(fq));
        const int row0 = u.pm * BM + wr * 64 + fr, col0 = u.pn * BM + wc * 32 + 8 * fq, typ = u.pn >> 3;
        const bool rot = (typ == 3) || (typ == 5); const float osc = (typ == 3) ? 0.0625f : 1.0f;
#pragma unroll
        for (int ai = 0; ai < 2; ++ai)
#pragma unroll
            for (int m = 0; m < 4; ++m) { const int row = row0 + ai * HALF + m * 16; const float rs = rstd[row]; bf16_t* rowp = O + (size_t)row * ldc + col0;
                if (rot) { const float sc = rs * osc; const float* cp = cosb + (size_t)row * 128 + wc * 32 + 8 * fq; const float* sp = sinb + (size_t)row * 128 + wc * 32 + 8 * fq;
                    const f32x4 c0 = *(const f32x4*)cp, c1 = *(const f32x4*)(cp + 4), s0 = *(const f32x4*)sp, s1 = *(const f32x4*)(sp + 4);
                    const f32x4 a0 = acc[ai][0][m][0] * sc, a1 = acc[ai][0][m][1] * sc, b0 = acc[ai][1][m][0] * sc, b1 = acc[ai][1][m][1] * sc;
                    *(u32x4*)(rowp) = pack8(a0 * c0 - b0 * s0, a1 * c1 - b1 * s1);
                    *(u32x4*)(rowp + HALF) = pack8(b0 * c0 + a0 * s0, b1 * c1 + a1 * s1);
                } else {
#pragma unroll
                    for (int bj = 0; bj < 2; ++bj) *(u32x4*)(rowp + bj * HALF) = pack8(acc[ai][bj][m][0] * rs, acc[ai][bj][m][1] * rs);
                } }
    }
};
struct EpiKV {
    static constexpr bool PERM = true, AFTER_DRAIN = false;
    bf16_t* KFT; bf16_t* KBT; bf16_t* VT; int ldc; const float* rstd; const float* cosT; const float* sinT; const float* lgam;
    __device__ __forceinline__ void operator()(const f32x4 (&acc)[2][2][4][2], const Unit& u, int wr, int wc, int fr, int fq) const {
        asm volatile("" : "+v"(fr), "+v"(fq));
        const int tok0 = u.pn * BM + wc * 32 + 8 * fq;
        if (u.pm < 8) {
            const int h = u.pm; const float lf = lgam[h], lb = lgam[8 + h];
#pragma unroll
            for (int bj = 0; bj < 2; ++bj) { const int tok = tok0 + bj * HALF; const f32x4 r0 = *(const f32x4*)(rstd + tok), r1 = *(const f32x4*)(rstd + tok + 4);
                f32x4 wf0, wf1, wb0, wb1; const int cpos = wc * 32 + 8 * fq;
#pragma unroll
                for (int j = 0; j < 4; ++j) { wf0[j] = __expf(lf * (float)(127 - (cpos + j))); wf1[j] = __expf(lf * (float)(127 - (cpos + 4 + j))); wb0[j] = __expf(lb * (float)(cpos + j)); wb1[j] = __expf(lb * (float)(cpos + 4 + j)); }
#pragma unroll
                for (int m = 0; m < 4; ++m) { const int d = wr * 64 + m * 16 + fr;
                    const float* cp = cosT + (size_t)d * ldc + tok; const float* sp = sinT + (size_t)d * ldc + tok;
                    const f32x4 c0 = *(const f32x4*)cp, c1 = *(const f32x4*)(cp + 4), s0 = *(const f32x4*)sp, s1 = *(const f32x4*)(sp + 4);
                    const f32x4 a0 = acc[0][bj][m][0] * r0, a1 = acc[0][bj][m][1] * r1, b0 = acc[1][bj][m][0] * r0, b1 = acc[1][bj][m][1] * r1;
                    const f32x4 o10 = a0 * c0 - b0 * s0, o11 = a1 * c1 - b1 * s1, o20 = b0 * c0 + a0 * s0, o21 = b1 * c1 + a1 * s1;
                    const size_t off1 = (size_t)(h * 256 + d) * ldc + tok, off2 = off1 + (size_t)128 * ldc;
                    *(u32x4*)(KFT + off1) = pack8(o10 * wf0, o11 * wf1); *(u32x4*)(KFT + off2) = pack8(o20 * wf0, o21 * wf1);
                    *(u32x4*)(KBT + off1) = pack8(o10 * wb0, o11 * wb1); *(u32x4*)(KBT + off2) = pack8(o20 * wb0, o21 * wb1); } }
        } else {
            const int rowb = (u.pm - 8) * BM + wr * 64 + fr;
#pragma unroll
            for (int bj = 0; bj < 2; ++bj) { const int tok = tok0 + bj * HALF; const f32x4 r0 = *(const f32x4*)(rstd + tok), r1 = *(const f32x4*)(rstd + tok + 4);
#pragma unroll
                for (int ai = 0; ai < 2; ++ai)
#pragma unroll
                    for (int m = 0; m < 4; ++m) *(u32x4*)(VT + (size_t)(rowb + ai * HALF + m * 16) * ldc + tok) = pack8(acc[ai][bj][m][0] * r0, acc[ai][bj][m][1] * r1); }
        }
    }
};
struct EpiScale {
    static constexpr bool PERM = true, AFTER_DRAIN = false;
    bf16_t* O; int ldc; const float* rstd;
    __device__ __forceinline__ void operator()(const f32x4 (&acc)[2][2][4][2], const Unit& u, int wr, int wc, int fr, int fq) const {
        asm volatile("" : "+v"(fr), "+v"(fq));
        const int row0 = u.pm * BM + wr * 64 + fr, col0 = u.pn * BM + wc * 32 + 8 * fq;
#pragma unroll
        for (int ai = 0; ai < 2; ++ai)
#pragma unroll
            for (int m = 0; m < 4; ++m) { const int row = row0 + ai * HALF + m * 16; const float rs = rstd[row]; bf16_t* rowp = O + (size_t)row * ldc + col0;
#pragma unroll
                for (int bj = 0; bj < 2; ++bj) *(u32x4*)(rowp + bj * HALF) = pack8(acc[ai][bj][m][0] * rs, acc[ai][bj][m][1] * rs); }
    }
};
struct EpiRes {
    static constexpr bool PERM = true, AFTER_DRAIN = false;
    const float* xin; float* xout; bf16_t* xb; float* part; int ldc;
    __device__ __forceinline__ void operator()(const f32x4 (&acc)[2][2][4][2], const Unit& u, int wr, int wc, int fr, int fq) const {
        asm volatile("" : "+v"(fr), "+v"(fq));
        const int row0 = u.pm * BM + wr * 64 + fr, col0 = u.pn * BM + wc * 32 + 8 * fq;
#pragma unroll
        for (int ai = 0; ai < 2; ++ai)
#pragma unroll
            for (int m = 0; m < 4; ++m) { const int row = row0 + ai * HALF + m * 16; const size_t off = (size_t)row * ldc + col0; float ss = 0.f;
#pragma unroll
                for (int bj = 0; bj < 2; ++bj) { const f32x4 x0 = *(const f32x4*)(xin + off + bj * HALF), x1 = *(const f32x4*)(xin + off + bj * HALF + 4);
                    const f32x4 v0 = x0 + acc[ai][bj][m][0], v1 = x1 + acc[ai][bj][m][1];
                    *(f32x4*)(xout + off + bj * HALF) = v0; *(f32x4*)(xout + off + bj * HALF + 4) = v1; *(u32x4*)(xb + off + bj * HALF) = pack8(v0, v1);
                    ss += (v0[0] * v0[0] + v0[1] * v0[1]) + (v0[2] * v0[2] + v0[3] * v0[3]) + (v1[0] * v1[0] + v1[1] * v1[1]) + (v1[2] * v1[2] + v1[3] * v1[3]); }
                ss += __shfl_xor(ss, 16); ss += __shfl_xor(ss, 32);
                if (fq == 0) part[(size_t)row * 64 + u.pn * 4 + wc] = ss; }
    }
};

template <class Epi, class Sched, bool ALIGN_EPI = false, bool SP2 = false>
__device__ __forceinline__ void gemm_phase(PG8_LAS unsigned char* lds, const Gemm g, const Sched& S, const Epi& E) {
    int tid_ = threadIdx.x; asm volatile("" : "+v"(tid_));
    const int tid = tid_, wid = __builtin_amdgcn_readfirstlane(tid >> 6), lane = tid & 63, wr = wid >> 2, wc = wid & 3, fr = lane & 15, fq = lane >> 4;
    const int K = g.K, nt = K / BK;
    unsigned voffA[2], voffB[2];
#pragma unroll
    for (int i = 0; i < 2; ++i) { int R, C; stage_rc(tid * 16 + i * 8192, R, C); const int Rb = Epi::PERM ? ((R & ~31) + perm32(R & 31)) : R;
        voffA[i] = (unsigned)(R * K + C) * 2u; voffB[i] = (unsigned)(Rb * K + C) * 2u; }
    const size_t kstep = (size_t)(BK * 2);
    const size_t hstep = (size_t)HALF * K * 2;
    const size_t tstep = 2 * hstep;
    const unsigned ldsw = (unsigned)wid * 1024u;
    const int aoff = lds_byte(wr * 64 + fr, fq * 8), boff = lds_byte(wc * 32 + fr, fq * 8);
#define PG8_SA(b, h) (((b) * 2 + (h)) * HTB)
#define PG8_SB(b, h) ((4 + (b) * 2 + (h)) * HTB)
#define PG8_STAGE(bufoff, gbase, voff) do { _Pragma("unroll") for (int _i = 0; _i < 2; ++_i) \
        __builtin_amdgcn_global_load_lds((const unsigned*)((const char*)(gbase) + (voff)[_i]), (PG8_LAS unsigned*)(lds + (bufoff) + ldsw + _i * 8192), 16, 0, 0); } while (0)
#define PG8_LDA(dst, b, h) do { _Pragma("unroll") for (int m = 0; m < 4; ++m) _Pragma("unroll") for (int k = 0; k < 2; ++k) dst[m][k] = *(const PG8_LAS bf16x8*)(lds + PG8_SA(b, h) + aoff + m * 2048 + k * 1024); } while (0)
#define PG8_LDB(dst, b, h) do { _Pragma("unroll") for (int n = 0; n < 2; ++n) _Pragma("unroll") for (int k = 0; k < 2; ++k) dst[n][k] = *(const PG8_LAS bf16x8*)(lds + PG8_SB(b, h) + boff + n * 2048 + k * 1024); } while (0)
#define PG8_MMA(ai, bj, At, Bt) do { __builtin_amdgcn_s_setprio(1); _Pragma("unroll") for (int m = 0; m < 4; ++m) _Pragma("unroll") for (int n = 0; n < 2; ++n) _Pragma("unroll") for (int k = 0; k < 2; ++k) \
        acc[ai][bj][m][n] = __builtin_amdgcn_mfma_f32_16x16x32_bf16(Bt[n][k], At[m][k], acc[ai][bj][m][n], 0, 0, 0); __builtin_amdgcn_s_setprio(0); } while (0)
#define PG8_WAIT_V(n) asm volatile("s_waitcnt vmcnt(" #n ")" ::: "memory")
#define PG8_WAIT_L(n) asm volatile("s_waitcnt lgkmcnt(" #n ")" ::: "memory")
#define PG8_BAR __builtin_amdgcn_s_barrier()
#define PG8_SCHED __builtin_amdgcn_sched_barrier(0)
    Unit cur, nxt; int ui = 0;
    if (!S.next(0, cur)) return;
    f32x4 acc[2][2][4][2];
#pragma unroll
    for (int a = 0; a < 2; ++a)
#pragma unroll
        for (int b = 0; b < 2; ++b)
#pragma unroll
            for (int m = 0; m < 4; ++m)
#pragma unroll
                for (int n = 0; n < 2; ++n) acc[a][b][m][n] = (f32x4){0.f, 0.f, 0.f, 0.f};
    bf16x8 At[4][2], B0[2][2], B1[2][2];
    const char* cA = (const char*)g.A + (size_t)cur.pm * tstep; const char* cB = (const char*)g.Bt + (size_t)cur.pn * tstep;
    S.a_ready(cur);
    if constexpr (SP2) {
        PG8_STAGE(PG8_SB(0, 0), cB, voffB); PG8_STAGE(PG8_SB(0, 1), cB + hstep, voffB); PG8_STAGE(PG8_SA(0, 0), cA, voffA); PG8_STAGE(PG8_SA(0, 1), cA + hstep, voffA);
        if (wr == 1) PG8_BAR;
        PG8_WAIT_V(2); PG8_BAR;
        PG8_STAGE(PG8_SB(1, 0), cB + kstep, voffB); PG8_STAGE(PG8_SA(1, 0), cA + kstep, voffA); PG8_STAGE(PG8_SB(1, 1), cB + hstep + kstep, voffB);
        PG8_WAIT_V(6); PG8_BAR;
    } else {
        PG8_STAGE(PG8_SB(0, 0), cB, voffB); PG8_STAGE(PG8_SA(0, 0), cA, voffA); PG8_STAGE(PG8_SB(0, 1), cB + hstep, voffB); PG8_STAGE(PG8_SA(0, 1), cA + hstep, voffA);
        if (wr == 1) PG8_BAR;
        PG8_WAIT_V(4); PG8_BAR;
        PG8_STAGE(PG8_SB(1, 0), cB + kstep, voffB); PG8_STAGE(PG8_SA(1, 0), cA + kstep, voffA); PG8_STAGE(PG8_SB(1, 1), cB + hstep + kstep, voffB);
        PG8_WAIT_V(6); PG8_BAR;
    }
    for (;;) {
        const bool has_next = S.next(ui + 1, nxt);
        const char* nA = has_next ? (const char*)g.A + (size_t)nxt.pm * tstep : cA; const char* nB = has_next ? (const char*)g.Bt + (size_t)nxt.pn * tstep : cB;
        for (int t = 0; t < nt; t += 2) {
            const bool last = (t == nt - 2);
            const char* a1 = cA + (size_t)(t + 1) * kstep;
            const char* a2 = last ? nA : cA + (size_t)(t + 2) * kstep; const char* b2 = last ? nB : cB + (size_t)(t + 2) * kstep;
            const char* a3 = a2 + kstep; const char* b3 = b2 + kstep;
            if (last && has_next) S.a_ready(nxt);
            if constexpr (SP2) {
            PG8_LDB(B0, 0, 0); PG8_LDB(B1, 0, 1); PG8_SCHED; PG8_LDA(At, 0, 0); PG8_STAGE(PG8_SA(1, 1), a1 + hstep, voffA);
            PG8_WAIT_V(8); PG8_WAIT_L(0); PG8_BAR; PG8_MMA(0, 0, At, B0); PG8_MMA(0, 1, At, B1); PG8_BAR; PG8_SCHED;
            PG8_LDA(At, 0, 1); PG8_STAGE(PG8_SB(0, 0), b2, voffB); PG8_STAGE(PG8_SB(0, 1), b2 + hstep, voffB); PG8_STAGE(PG8_SA(0, 0), a2, voffA);
            PG8_WAIT_V(8); PG8_WAIT_L(0); PG8_BAR; PG8_MMA(1, 0, At, B0); PG8_MMA(1, 1, At, B1); PG8_BAR; PG8_SCHED;
            PG8_LDB(B0, 1, 0); PG8_LDB(B1, 1, 1); PG8_SCHED; PG8_LDA(At, 1, 0); PG8_STAGE(PG8_SA(0, 1), a2 + hstep, voffA);
            PG8_WAIT_V(8); PG8_WAIT_L(0); PG8_BAR; PG8_MMA(0, 0, At, B0); PG8_MMA(0, 1, At, B1); PG8_BAR; PG8_SCHED;
            PG8_LDA(At, 1, 1); PG8_STAGE(PG8_SB(1, 0), b3, voffB); PG8_STAGE(PG8_SB(1, 1), b3 + hstep, voffB); PG8_STAGE(PG8_SA(1, 0), a3, voffA);
            PG8_WAIT_V(8); PG8_WAIT_L(0); PG8_BAR; PG8_MMA(1, 0, At, B0); PG8_MMA(1, 1, At, B1); PG8_BAR; PG8_SCHED;
            } else {
            PG8_LDB(B0, 0, 0); PG8_SCHED; PG8_LDA(At, 0, 0); PG8_STAGE(PG8_SA(1, 1), a1 + hstep, voffA);
            PG8_WAIT_L(8); PG8_BAR; PG8_WAIT_L(0); PG8_MMA(0, 0, At, B0); PG8_BAR; PG8_SCHED;
            PG8_LDB(B1, 0, 1); PG8_STAGE(PG8_SB(0, 0), b2, voffB);
            PG8_BAR; PG8_WAIT_L(0); PG8_MMA(0, 1, At, B1); PG8_BAR;
            PG8_LDA(At, 0, 1); PG8_STAGE(PG8_SA(0, 0), a2, voffA);
            PG8_BAR; PG8_WAIT_L(0); PG8_MMA(1, 0, At, B0); PG8_BAR; PG8_SCHED;
            PG8_STAGE(PG8_SB(0, 1), b2 + hstep, voffB);
            PG8_WAIT_V(6); PG8_BAR; PG8_MMA(1, 1, At, B1); PG8_BAR;
            PG8_LDB(B0, 1, 0); PG8_SCHED; PG8_LDA(At, 1, 0); PG8_STAGE(PG8_SA(0, 1), a2 + hstep, voffA);
            PG8_WAIT_L(8); PG8_BAR; PG8_WAIT_L(0); PG8_MMA(0, 0, At, B0); PG8_BAR; PG8_SCHED;
            PG8_LDB(B1, 1, 1); PG8_STAGE(PG8_SB(1, 0), b3, voffB);
            PG8_BAR; PG8_WAIT_L(0); PG8_MMA(0, 1, At, B1); PG8_BAR;
            PG8_LDA(At, 1, 1); PG8_STAGE(PG8_SA(1, 0), a3, voffA);
            PG8_BAR; PG8_WAIT_L(0); PG8_MMA(1, 0, At, B0); PG8_BAR; PG8_SCHED;
            PG8_STAGE(PG8_SB(1, 1), b3 + hstep, voffB);
            PG8_WAIT_V(6); PG8_BAR; PG8_MMA(1, 1, At, B1); PG8_BAR;
            }
        }
        if constexpr (ALIGN_EPI) { if (wr == 0) PG8_BAR; }
        if constexpr (!Epi::AFTER_DRAIN) { E(acc, cur, wr, wc, fr, fq); S.done(cur); }
        if (!has_next) break;
#pragma unroll
        for (int a = 0; a < 2; ++a)
#pragma unroll
            for (int b = 0; b < 2; ++b)
#pragma unroll
                for (int m = 0; m < 4; ++m)
#pragma unroll
                    for (int n = 0; n < 2; ++n) acc[a][b][m][n] = (f32x4){0.f, 0.f, 0.f, 0.f};
        cur = nxt; cA = nA; cB = nB; ++ui;
        if constexpr (ALIGN_EPI) { if (wr == 1) PG8_BAR; }
    }
    PG8_WAIT_V(0);
    if constexpr (!ALIGN_EPI) { if (wr == 0) PG8_BAR; }
    PG8_BAR;
#undef PG8_SA
#undef PG8_SB
#undef PG8_STAGE
#undef PG8_LDA
#undef PG8_LDB
#undef PG8_MMA
#undef PG8_WAIT_V
#undef PG8_WAIT_L
#undef PG8_BAR
#undef PG8_SCHED
}
}

#ifndef PG8_SP2
#define PG8_SP2 true
#endif
#ifndef PG8_ALIGN
#define PG8_ALIGN true
#endif

constexpr int NWAVES = 8;
constexpr int BATCH = 4, SEQ = 4096, D = 4096, M = BATCH * SEQ, DEPTH = 2;
constexpr int CW = 2048, RW = 2048, RH = 8, HD = 256, CHUNK = 128, NCH = SEQ / CHUNK;
constexpr int IN_COLS = 14336, N1 = 12288  , FF = 11008, NGU = 2 * FF;
constexpr int COL_AB = 0, COL_AC = 2048, COL_AX = 4096, COL_Q = 6144, COL_G = 8192, COL_K = 10240;
constexpr float EPS = 1e-6f;

constexpr size_t MiB = 1u << 20;
constexpr size_t WS_CTL = 0, CTL_ZERO_BYTES = 1 * MiB;
constexpr size_t WS_RSTD1 = 1 * MiB;
constexpr size_t WS_RSTD2 = WS_RSTD1 + 256 * 1024;
constexpr size_t WS_LGAM = WS_RSTD2 + 256 * 1024;
constexpr size_t WS_PART = 2 * MiB;
constexpr size_t WS_COS = 6 * MiB, WS_SIN = 14 * MiB, WS_COST = 22 * MiB, WS_SINT = 30 * MiB;
constexpr size_t WS_WIN = 38 * MiB;
constexpr size_t WS_WOUT = WS_WIN + 112 * MiB;
constexpr size_t WS_WGU = WS_WOUT + 32 * MiB;
constexpr size_t WS_WDN = WS_WGU + 172 * MiB;
constexpr size_t WS_XB = WS_WDN + 86 * MiB;
constexpr size_t WS_R = WS_XB + 128 * MiB;
constexpr size_t WS_PROJ = WS_R;
constexpr size_t WS_KFT = WS_PROJ + 384 * MiB, WS_KBT = WS_KFT + 64 * MiB, WS_VT = WS_KBT + 64 * MiB;
constexpr size_t WS_SFT = WS_VT + 64 * MiB, WS_SBT = WS_SFT + 128 * MiB;
constexpr size_t WS_YCAT = WS_SBT + 128 * MiB;
constexpr size_t WS_MIX_END = WS_YCAT + 128 * MiB;
constexpr size_t WS_GU = WS_R;
constexpr size_t WS_ACT = WS_GU + 688 * MiB;
constexpr size_t WS_END = WS_ACT + 344 * MiB;
static_assert(WS_MIX_END <= WS_END, "overlay");
static_assert((size_t)M * N1 * 2 == 384 * MiB && (size_t)M * NGU * 2 == 688 * MiB && (size_t)M * FF * 2 == 344 * MiB && (size_t)IN_COLS * D * 2 == 112 * MiB && (size_t)NGU * D * 2 == 172 * MiB && (size_t)D * FF * 2 == 86 * MiB, "sizes");
constexpr int CW_BAR = 4096;

constexpr int RING_OFF = 0, RING_BYTES = 136 * 1024;
constexpr int LDSCTL_OFF = RING_BYTES, MISC_OFF = LDSCTL_OFF + 320;
constexpr int LDS_BYTES = 147456;
static_assert(MISC_OFF + 128 <= LDS_BYTES && 8 * 16640 <= RING_BYTES, "LDS map");

#define GAS __attribute__((address_space(1)))
#define LAS __attribute__((address_space(3)))
typedef unsigned short bf16;
typedef unsigned v4u __attribute__((ext_vector_type(4)));
typedef unsigned v2u __attribute__((ext_vector_type(2)));
typedef float f32x4 __attribute__((ext_vector_type(4)));
typedef float f32x16 __attribute__((ext_vector_type(16)));
typedef short bf16x8 __attribute__((ext_vector_type(8)));
typedef GAS unsigned gu32;
#define RLX_AGENT __ATOMIC_RELAXED, __HIP_MEMORY_SCOPE_AGENT
#define LDS_WAIT() asm volatile("s_waitcnt lgkmcnt(0)" ::: "memory")
#define VM_WAIT() asm volatile("s_waitcnt vmcnt(0)" ::: "memory")
__device__ __forceinline__ unsigned pk2(float lo, float hi) { return pg8::cvt_pk_bf16(lo, hi); }
__device__ __forceinline__ float bflo(unsigned w) { return __uint_as_float(w << 16); }
__device__ __forceinline__ float bfhi(unsigned w) { return __uint_as_float(w & 0xffff0000u); }
__device__ __forceinline__ void unpack8(const v4u w, float (&f)[8]) { f[0] = bflo(w.x); f[1] = bfhi(w.x); f[2] = bflo(w.y); f[3] = bfhi(w.y); f[4] = bflo(w.z); f[5] = bfhi(w.z); f[6] = bflo(w.w); f[7] = bfhi(w.w); }

#define XB_TMO      128
#define XB_XCNT(j)  (256  + 64 * (j))
#define XB_XSUB(j)  (1280 + 64 * (j))
#define XB_XGEN(j)  (2304 + 64 * (j))
#define XB_TOP      3328
#define XB_TOPGEN   3392
#define XCD_BAR_WORDS 3456
#define XB_SPIN_CAP (1u << 18)

__device__ __forceinline__ unsigned xb_ld(unsigned* p)              { return __hip_atomic_load(p, __ATOMIC_RELAXED, __HIP_MEMORY_SCOPE_AGENT); }
__device__ __forceinline__ unsigned xb_add(unsigned* p, unsigned v) { return __hip_atomic_fetch_add(p, v, __ATOMIC_RELAXED, __HIP_MEMORY_SCOPE_AGENT); }
__device__ __forceinline__ unsigned xb_xcc_id() { return (unsigned)__builtin_amdgcn_s_getreg((3 << 11) | 20) & 0xFu; }
#define XB_SPIN(cond, bar) do { unsigned _sp = 0; while (cond) { __builtin_amdgcn_s_sleep(1); \
    if ((++_sp & 255u) == 0u) { if (xb_ld(&(bar)[XB_TMO])) break; if (_sp > XB_SPIN_CAP) { atomicAdd(&(bar)[XB_TMO], 1u); break; } } } } while (0)

struct XcdBarrier {
    unsigned* bar; unsigned x;
    volatile LAS unsigned* st;
};
__device__ __forceinline__ XcdBarrier xcd_barrier_post(unsigned* bar, volatile LAS unsigned* st) {
    XcdBarrier b; b.bar = bar; b.x = xb_xcc_id(); b.st = st;
    if (threadIdx.x == 0) (void)xb_add(&bar[XB_XCNT(b.x)], 1u);
    return b;
}
__device__ __forceinline__ void xcd_barrier_complete(unsigned* bar, unsigned x, unsigned& nloc, unsigned& nx) {
    const unsigned G = gridDim.x * gridDim.y * gridDim.z;
    unsigned sum, cnt, mine, sp = 0u;
    for (;;) {
        sum = 0u; cnt = 0u; mine = 0u;
#pragma unroll
        for (unsigned j = 0; j < 16; ++j) { const unsigned c = xb_ld(&bar[XB_XCNT(j)]); sum += c; cnt += (c > 0u) ? 1u : 0u; mine = (j == x) ? c : mine; }
        if (sum == G) break;
        __builtin_amdgcn_s_sleep(1);
        if ((++sp & 255u) == 0u) { if (xb_ld(&bar[XB_TMO])) break; if (sp > XB_SPIN_CAP) { atomicAdd(&bar[XB_TMO], 1u); break; } }
    }
    nloc = mine > 0u ? mine : 1u; nx = cnt > 0u ? cnt : 1u;
}
__device__ __forceinline__ void xcd_barrier(const XcdBarrier& b) {
    asm volatile("s_waitcnt vmcnt(0)" ::: "memory");
    __syncthreads();
    if (threadIdx.x == 0) {
        unsigned* bar = b.bar;
        __builtin_amdgcn_s_waitcnt(0);
        unsigned nloc = b.st[0], nx = b.st[1];
        if (nloc == 0u) { xcd_barrier_complete(bar, b.x, nloc, nx); b.st[0] = nloc; b.st[1] = nx; }
        const unsigned old = xb_add(&bar[XB_XSUB(b.x)], 1u);
        const unsigned gen = old / nloc;
        if (old + 1u == (gen + 1u) * nloc) {
            __builtin_amdgcn_fence(__ATOMIC_RELEASE, "agent");
            asm volatile("s_waitcnt vmcnt(0)" ::: "memory");
            const unsigned og = xb_add(&bar[XB_TOP], 1u);
            const unsigned tg = og / nx;
            if (og + 1u == (tg + 1u) * nx) xb_add(&bar[XB_TOPGEN], 1u);
            else XB_SPIN(xb_ld(&bar[XB_TOPGEN]) == tg, bar);
            __builtin_amdgcn_fence(__ATOMIC_ACQUIRE, "agent");
            xb_add(&bar[XB_XGEN(b.x)], 1u);
            asm volatile("s_waitcnt vmcnt(0)" ::: "memory");
        } else {
            XB_SPIN(xb_ld(&bar[XB_XGEN(b.x)]) == gen, bar);
            __builtin_amdgcn_fence(__ATOMIC_ACQUIRE, "agent");
            asm volatile("s_waitcnt vmcnt(0)" ::: "memory");
        }
    }
    __syncthreads();
}

struct Args { const void* in[17]; float* out; unsigned char* ws; int ph_lo, ph_hi; };
static_assert(sizeof(Args) == 17 * 8 + 8 + 8 + 8, "Args has no padding");
struct Frame {
    LAS unsigned char* lds;
    int tid, lane, wave;
    int vcu, G;
    const __attribute__((address_space(4))) Args* ap;
};
#define F_x ((const float*)(const GAS float*)F.ap->in[0])
#define F_pos ((const int*)(const GAS int*)F.ap->in[1])
#define F_norm1_g ((const float*)(const GAS float*)F.ap->in[2])
#define F_w_in ((const float*)(const GAS float*)F.ap->in[3])
#define F_conv_a_w ((const float*)(const GAS float*)F.ap->in[4])
#define F_conv_a_b ((const float*)(const GAS float*)F.ap->in[5])
#define F_beta_a ((const float*)(const GAS float*)F.ap->in[6])
#define F_dlogit ((const float*)(const GAS float*)F.ap->in[7])
#define F_gn_g ((const float*)(const GAS float*)F.ap->in[8])
#define F_w_out ((const float*)(const GAS float*)F.ap->in[9])
#define F_norm2_g ((const float*)(const GAS float*)F.ap->in[10])
#define F_w_gate ((const float*)(const GAS float*)F.ap->in[11])
#define F_w_up ((const float*)(const GAS float*)F.ap->in[12])
#define F_ffn_w ((const float*)(const GAS float*)F.ap->in[13])
#define F_ffn_b ((const float*)(const GAS float*)F.ap->in[14])
#define F_w_down ((const float*)(const GAS float*)F.ap->in[15])
#define F_norm_f ((const float*)(const GAS float*)F.ap->in[16])
#define F_out ((float*)(GAS float*)F.ap->out)
#define F_rstd1 ((float*)(GAS float*)(F.ap->ws + WS_RSTD1))
#define F_rstd2 ((float*)(GAS float*)(F.ap->ws + WS_RSTD2))
#define F_lgam ((float*)(GAS float*)(F.ap->ws + WS_LGAM))
#define F_part ((float*)(GAS float*)(F.ap->ws + WS_PART))
#define F_cosb ((float*)(GAS float*)(F.ap->ws + WS_COS))
#define F_sinb ((float*)(GAS float*)(F.ap->ws + WS_SIN))
#define F_cosT ((float*)(GAS float*)(F.ap->ws + WS_COST))
#define F_sinT ((float*)(GAS float*)(F.ap->ws + WS_SINT))
#define F_WIN ((bf16*)(GAS bf16*)(F.ap->ws + WS_WIN))
#define F_WOUT ((bf16*)(GAS bf16*)(F.ap->ws + WS_WOUT))
#define F_WGU ((bf16*)(GAS bf16*)(F.ap->ws + WS_WGU))
#define F_WDN ((bf16*)(GAS bf16*)(F.ap->ws + WS_WDN))
#define F_XB ((bf16*)(GAS bf16*)(F.ap->ws + WS_XB))
#define F_PROJ ((bf16*)(GAS bf16*)(F.ap->ws + WS_PROJ))
#define F_KFT ((bf16*)(GAS bf16*)(F.ap->ws + WS_KFT))
#define F_KBT ((bf16*)(GAS bf16*)(F.ap->ws + WS_KBT))
#define F_VT ((bf16*)(GAS bf16*)(F.ap->ws + WS_VT))
#define F_SFT ((bf16*)(GAS bf16*)(F.ap->ws + WS_SFT))
#define F_SBT ((bf16*)(GAS bf16*)(F.ap->ws + WS_SBT))
#define F_YCAT ((bf16*)(GAS bf16*)(F.ap->ws + WS_YCAT))
#define F_GU ((bf16*)(GAS bf16*)(F.ap->ws + WS_GU))
#define F_ACT ((bf16*)(GAS bf16*)(F.ap->ws + WS_ACT))
__device__ __forceinline__ float wave_sum(float v) {
#pragma unroll
    for (int o = 1; o < 64; o <<= 1) v += __shfl_xor(v, o);
    return v;
}

__device__ __forceinline__ void cvt_item(const float* __restrict__ W, int N, const float* __restrict__ gain, bf16* WT, int K, int k0, int n0s, int n0d, LAS float* scr, int lane) {
    const int r4 = lane >> 4, c4 = (lane & 15) * 4;
    f32x4 v[16];
#pragma unroll
    for (int i = 0; i < 16; ++i) v[i] = *(const f32x4*)(W + (size_t)(k0 + 4 * i + r4) * N + n0s + c4);
#pragma unroll
    for (int i = 0; i < 16; ++i) { const int kk = 4 * i + r4; const float g = gain ? gain[k0 + kk] : 1.0f; LAS float* s = scr + kk * 65 + c4;
        s[0] = v[i].x * g; s[1] = v[i].y * g; s[2] = v[i].z * g; s[3] = v[i].w * g; }
    LDS_WAIT(); asm volatile("" ::: "memory");
    const int c = lane & 7;
#pragma unroll
    for (int it = 0; it < 8; ++it) { const int n = (lane >> 3) + 8 * it; const LAS float* s = scr + (8 * c) * 65 + n;
        v4u o; o.x = pk2(s[0 * 65], s[1 * 65]); o.y = pk2(s[2 * 65], s[3 * 65]); o.z = pk2(s[4 * 65], s[5 * 65]); o.w = pk2(s[6 * 65], s[7 * 65]);
        *(v4u*)(WT + (size_t)(n0d + n) * K + k0 + 8 * c) = o; }
    LDS_WAIT(); asm volatile("" ::: "memory");
}
__device__ __forceinline__ void cvt_matrix(Frame& F, const float* W, int K, int N, const float* gain, bf16* WT, int dst_row0, bool in_perm, int& it, int it_end_prev, LAS float* scr) {
    const int nnb = N / 64, nitems = (K / 64) * nnb, NGW = F.G * NWAVES;
    for (; it < it_end_prev + nitems; it += NGW) {
        const int r = it - it_end_prev, kb = r / nnb, nb = r % nnb; const int n0s = nb * 64; int n0d = dst_row0 + n0s;
        if (in_perm) { const int blk = n0s >> 11, dblk = (blk < 4) ? blk : (blk == 4 ? 5 : (blk == 5 ? 6 : 4)); n0d = dblk * 2048 + (n0s & 2047); }
        cvt_item(W, N, gain, WT, K, kb * 64, n0s, n0d, scr, F.lane);
    }
}

__device__ __forceinline__ void rstd_from_part(Frame& F, float* rstd) {
    const int gw = F.vcu * NWAVES + F.wave, NGW = F.G * NWAVES;
    for (int row = gw; row < M; row += NGW) { const float s = wave_sum(F_part[(size_t)row * 64 + F.lane]); if (F.lane == 0) rstd[row] = 1.0f / sqrtf(s * (1.0f / D) + EPS); }
}
__device__ __forceinline__ void p0_phase(Frame& F, int l) {
    LAS float* scr = (LAS float*)(F.lds + RING_OFF + F.wave * 16640);
    const int gw = F.vcu * NWAVES + F.wave, NGW = F.G * NWAVES;
    int it = gw, base = 0;
    cvt_matrix(F, F_w_in + (size_t)l * D * IN_COLS, D, IN_COLS, F_norm1_g + l * D, F_WIN, 0, true, it, base, scr); base += (D / 64) * (IN_COLS / 64);
    cvt_matrix(F, F_w_out + (size_t)l * D * D, D, D, nullptr, F_WOUT, 0, false, it, base, scr); base += (D / 64) * (D / 64);
    cvt_matrix(F, F_w_gate + (size_t)l * D * FF, D, FF, F_norm2_g + l * D, F_WGU, 0, false, it, base, scr); base += (D / 64) * (FF / 64);
    cvt_matrix(F, F_w_up + (size_t)l * D * FF, D, FF, F_norm2_g + l * D, F_WGU, FF, false, it, base, scr); base += (D / 64) * (FF / 64);
    cvt_matrix(F, F_w_down + (size_t)l * FF * D, FF, D, nullptr, F_WDN, 0, false, it, base, scr);
    if (l == 0) {
        for (int m = gw; m < M; m += NGW) { const float* xr = F_x + (size_t)m * D + 8 * F.lane; f32x4 v[16]; float ss = 0.f;
#pragma unroll
            for (int j = 0; j < 8; ++j) { v[2 * j] = *(const f32x4*)(xr + 512 * j); v[2 * j + 1] = *(const f32x4*)(xr + 512 * j + 4); }
#pragma unroll
            for (int j = 0; j < 16; ++j) ss += (v[j].x * v[j].x + v[j].y * v[j].y) + (v[j].z * v[j].z + v[j].w * v[j].w);
            ss = wave_sum(ss); if (F.lane == 0) F_rstd1[m] = 1.0f / sqrtf(ss * (1.0f / D) + EPS);
            bf16* o = F_XB + (size_t)m * D + 8 * F.lane;
#pragma unroll
            for (int j = 0; j < 8; ++j) *(v4u*)(o + 512 * j) = pg8::pack8(v[2 * j], v[2 * j + 1]); }
        { const int gt = gw * 64 + F.lane, NT = NGW * 64; const int j = gt & 127;
          const float inv = exp2f(-(float)j * (13.287712379549449f / 128.0f));
          for (int idx = gt; idx < M * 128; idx += NT) { const int m = idx >> 7; const float ang = (float)F_pos[m] * inv;
              const double a = (double)ang, k = rint(a * 0.15915494309189535), r = a - k * 6.283185307179586; const float rf = (float)r;
              const float c = cosf(rf), s = sinf(rf);
              F_cosb[idx] = c; F_sinb[idx] = s; F_cosT[(size_t)j * M + m] = c; F_sinT[(size_t)j * M + m] = s; } }
        if (blockIdx.x == 0 && F.tid < DEPTH * 2 * RH) { const float xl = F_dlogit[F.tid]; const float t = __expf(-xl);
            const float ser = t * (1.0f - t * (0.5f - t * (0.33333334f - t * (0.25f - t * 0.2f)))); F_lgam[F.tid] = -((t < 0.04f) ? ser : __logf(1.0f + t)); }
    } else rstd_from_part(F, F_rstd1);
}

__device__ __forceinline__ void mixer_a(Frame& F, int l) {
    const int gw = F.vcu * NWAVES + F.wave, NGW = F.G * NWAVES;
    for (int item = gw; item < (M / 32) * 4; item += NGW) {
        const int t0 = (item >> 2) * 32, c0 = (item & 3) * 512 + F.lane * 8;
        float w0[8], w1[8], w2[8], bb[8], be[8];
        { const float* cw = F_conv_a_w + (size_t)l * 3 * CW + c0; const float* cb = F_conv_a_b + (size_t)l * CW + c0; const float* bt = F_beta_a + (size_t)l * CW + c0;
#pragma unroll
          for (int j = 0; j < 8; ++j) { w0[j] = cw[j]; w1[j] = cw[CW + j]; w2[j] = cw[2 * CW + j]; bb[j] = cb[j]; be[j] = bt[j]; } }
        float pp[8], pc[8], pn[8];
        auto prod = [&](int t, float (&p)[8]) { const bf16* r = F_PROJ + (size_t)t * N1 + c0; float a[8], b[8]; unpack8(*(const v4u*)(r + COL_AC), a); unpack8(*(const v4u*)(r + COL_AX), b);
#pragma unroll
            for (int j = 0; j < 8; ++j) p[j] = a[j] * b[j]; };
        if ((t0 & (SEQ - 1)) == 0) {
#pragma unroll
            for (int j = 0; j < 8; ++j) pp[j] = 0.f;
        } else prod(t0 - 1, pp);
        prod(t0, pc);
        for (int t = t0; t < t0 + 32; ++t) {
            if ((t & (SEQ - 1)) == SEQ - 1) {
#pragma unroll
                for (int j = 0; j < 8; ++j) pn[j] = 0.f;
            } else prod(t + 1, pn);
            float ab[8], y[8]; unpack8(*(const v4u*)(F_PROJ + (size_t)t * N1 + COL_AB + c0), ab); float ss = 0.f;
#pragma unroll
            for (int j = 0; j < 8; ++j) { y[j] = ab[j] * (w0[j] * pp[j] + w1[j] * pc[j] + w2[j] * pn[j] + bb[j]); ss += y[j] * y[j]; }
            ss += __shfl_xor(ss, 1); ss += __shfl_xor(ss, 2); ss += __shfl_xor(ss, 4); ss += __shfl_xor(ss, 8);
            const float r = 1.0f / sqrtf(ss * (1.0f / 128.0f) + EPS);
            v4u o; o.x = pk2(y[0] * r * be[0], y[1] * r * be[1]); o.y = pk2(y[2] * r * be[2], y[3] * r * be[3]); o.z = pk2(y[4] * r * be[4], y[5] * r * be[5]); o.w = pk2(y[6] * r * be[6], y[7] * r * be[7]);
            *(v4u*)(F_YCAT + (size_t)t * D + c0) = o;
#pragma unroll
            for (int j = 0; j < 8; ++j) { pp[j] = pc[j]; pc[j] = pn[j]; }
        }
    }
}

#define MFMA32(a, b, c) __builtin_amdgcn_mfma_f32_32x32x16_bf16((a), (b), (c), 0, 0, 0)
__device__ __forceinline__ void scan_phase(Frame& F, int l) {
    const int gw = F.vcu * NWAVES + F.wave, NGW = F.G * NWAVES, li = F.lane & 31, hh = F.lane >> 5;
    for (int unit = gw; unit < BATCH * RH * 2 * 8 * 4; unit += NGW) {
        const int eq = unit & 3, dblk = (unit >> 2) & 7, dir = (unit >> 5) & 1, h = (unit >> 6) & 7, b = unit >> 9;
        const bf16* KT = (dir ? F_KBT : F_KFT) + (size_t)(h * HD + dblk * 32 + li) * M + (size_t)b * SEQ + 8 * hh;
        const bf16* VT = F_VT + (size_t)(h * HD + eq * 64 + li) * M + (size_t)b * SEQ + 8 * hh;
        bf16* ST = (dir ? F_SBT : F_SFT) + ((size_t)(b * RH + h) * NCH * HD + eq * 64 + li) * HD + dblk * 32 + 4 * hh;
        const float g128 = __expf(128.0f * F_lgam[l * 16 + dir * 8 + h]);
        f32x16 s0, s1;
#pragma unroll
        for (int r = 0; r < 16; ++r) { s0[r] = 0.f; s1[r] = 0.f; }
        for (int step = 0; step < NCH; ++step) {
            const int n = dir ? (NCH - 1 - step) : step;
            bf16* st = ST + (size_t)n * HD * HD;
#pragma unroll
            for (int g = 0; g < 4; ++g) { v2u a; a.x = pk2(s0[4 * g], s0[4 * g + 1]); a.y = pk2(s0[4 * g + 2], s0[4 * g + 3]); *(v2u*)(st + 8 * g) = a;
                v2u c; c.x = pk2(s1[4 * g], s1[4 * g + 1]); c.y = pk2(s1[4 * g + 2], s1[4 * g + 3]); *(v2u*)(st + 32 * HD + 8 * g) = c; }
#pragma unroll
            for (int r = 0; r < 16; ++r) { s0[r] *= g128; s1[r] *= g128; }
            const bf16* kt = KT + n * CHUNK; const bf16* vt = VT + n * CHUNK;
#pragma unroll
            for (int ks = 0; ks < 8; ++ks) { const bf16x8 a = *(const bf16x8*)(kt + 16 * ks), b0 = *(const bf16x8*)(vt + 16 * ks), b1 = *(const bf16x8*)(vt + (size_t)32 * M + 16 * ks);
                s0 = MFMA32(a, b0, s0); s1 = MFMA32(a, b1, s1); }
        }
    }
}

__device__ __forceinline__ void intra_phase(Frame& F, int l) {
    LAS float* red1 = (LAS float*)(F.lds + RING_OFF); LAS float* red2 = red1 + 256;
    const int w = F.wave, ib = w & 3, eh = w >> 2, li = F.lane & 31, hh = F.lane >> 5;
    const float L2E = 1.4426950408889634f;
    for (int unit = F.vcu; unit < BATCH * RH * NCH; unit += F.G) {
        const int n = unit & 31, h = (unit >> 5) & 7, b = unit >> 8;
        int i = 32 * ib + li; asm volatile("" : "+v"(i));
        const int tok0 = b * SEQ + n * CHUNK, tok = tok0 + i;
        const float lf = F_lgam[l * 16 + h], lb = F_lgam[l * 16 + 8 + h];
        const bf16* qp = F_PROJ + (size_t)tok * N1 + COL_Q + h * HD + 8 * hh;
#define QF(s) (*(const bf16x8*)(qp + 16 * (s)))
        bf16x8 pf[4][2];
        { const bf16* kp = F_PROJ + (size_t)(tok0 + li) * N1 + COL_K + h * HD + 8 * hh; const float lf2 = lf * L2E, lb2 = lb * L2E;
#pragma unroll
          for (int jt = 0; jt < 4; ++jt) {
              f32x16 sc;
#pragma unroll
              for (int r = 0; r < 16; ++r) sc[r] = 0.f;
#pragma unroll
              for (int s = 0; s < 16; ++s) { const bf16x8 a = *(const bf16x8*)(kp + (size_t)jt * 32 * N1 + 16 * s); sc = MFMA32(a, QF(s), sc); if (s == 7) asm volatile("" ::: "memory"); }
#pragma unroll
              for (int s2 = 0; s2 < 2; ++s2) {
                  float pv[8];
#pragma unroll
                  for (int jj = 0; jj < 8; ++jj) { const int r = 8 * s2 + jj; const int j = 32 * jt + (r & 3) + 8 * (r >> 2) + 4 * hh; const int dd = i - j;
                      const float e = (dd >= 0) ? lf2 * (float)dd : lb2 * (float)(-dd); pv[jj] = sc[r] * exp2f(e); }
                  v4u pw; pw.x = pk2(pv[0], pv[1]); pw.y = pk2(pv[2], pv[3]); pw.z = pk2(pv[4], pv[5]); pw.w = pk2(pv[6], pv[7]);
                  pf[jt][s2] = __builtin_bit_cast(bf16x8, pw); }
              asm volatile("" ::: "memory"); } }
        f32x16 acc[4];
#pragma unroll
        for (int et = 0; et < 4; ++et)
#pragma unroll
            for (int r = 0; r < 16; ++r) acc[et][r] = 0.f;
        const size_t sbase = ((size_t)(b * RH + h) * NCH + n) * HD * HD + (size_t)(128 * eh + li) * HD + 8 * hh;
        { const bf16* sf = F_SFT + sbase;
#pragma unroll
          for (int et = 0; et < 4; ++et) {
#pragma unroll
              for (int s = 0; s < 16; ++s) { const bf16x8 a = *(const bf16x8*)(sf + et * 32 * HD + 16 * s); acc[et] = MFMA32(a, QF(s), acc[et]); if (s == 7) asm volatile("" ::: "memory"); }
              asm volatile("" ::: "memory"); } }
        { const float ratio = __expf(lf * (float)(i + 1) - lb * (float)(CHUNK - i));
#pragma unroll
          for (int et = 0; et < 4; ++et)
#pragma unroll
              for (int r = 0; r < 16; ++r) acc[et][r] *= ratio; }
        { const bf16* sb = F_SBT + sbase;
#pragma unroll
          for (int et = 0; et < 4; ++et) {
#pragma unroll
              for (int s = 0; s < 16; ++s) { const bf16x8 a = *(const bf16x8*)(sb + et * 32 * HD + 16 * s); acc[et] = MFMA32(a, QF(s), acc[et]); if (s == 7) asm volatile("" ::: "memory"); }
              asm volatile("" ::: "memory"); } }
        { const float wb = __expf(lb * (float)(CHUNK - i));
#pragma unroll
          for (int et = 0; et < 4; ++et)
#pragma unroll
              for (int r = 0; r < 16; ++r) acc[et][r] *= wb; }
        { const bf16* vp = F_VT + (size_t)(h * HD + 128 * eh + li) * M + tok0 + 4 * hh;
#pragma unroll
          for (int et = 0; et < 4; ++et) {
#pragma unroll
              for (int jt = 0; jt < 4; ++jt)
#pragma unroll
                  for (int s2 = 0; s2 < 2; ++s2) { const bf16* vq = vp + (size_t)et * 32 * M + 32 * jt + 16 * s2;
                      const v2u lo = *(const v2u*)vq, hi = *(const v2u*)(vq + 8); v4u aw; aw.x = lo.x; aw.y = lo.y; aw.z = hi.x; aw.w = hi.y;
                      acc[et] = MFMA32(__builtin_bit_cast(bf16x8, aw), pf[jt][s2], acc[et]); }
              asm volatile("" ::: "memory"); } }
#undef QF
        float s = 0.f;
#pragma unroll
        for (int et = 0; et < 4; ++et)
#pragma unroll
            for (int r = 0; r < 16; ++r) s += acc[et][r];
        s += __shfl_xor(s, 32);
        if (hh == 0) red1[w * 32 + li] = s;
        LDS_WAIT(); __syncthreads();
        const float mean = (red1[ib * 32 + li] + red1[(ib + 4) * 32 + li]) * (1.0f / HD);
        float q = 0.f;
#pragma unroll
        for (int et = 0; et < 4; ++et)
#pragma unroll
            for (int r = 0; r < 16; ++r) { const float dlt = acc[et][r] - mean; q += dlt * dlt; }
        q += __shfl_xor(q, 32);
        if (hh == 0) red2[w * 32 + li] = q;
        LDS_WAIT(); __syncthreads();
        const float rstd = 1.0f / sqrtf((red2[ib * 32 + li] + red2[(ib + 4) * 32 + li]) * (1.0f / HD) + EPS);
        { const float* gn = F_gn_g + (size_t)l * RW + h * HD; const bf16* gp = F_PROJ + (size_t)tok * N1 + COL_G + h * HD; bf16* yp = F_YCAT + (size_t)tok * D + CW + h * HD;
#pragma unroll
          for (int et = 0; et < 4; ++et)
#pragma unroll
              for (int g = 0; g < 4; ++g) { const int e4 = 128 * eh + 32 * et + 8 * g + 4 * hh; const f32x4 gv = *(const f32x4*)(gn + e4); const v2u gw2 = *(const v2u*)(gp + e4);
                  const float gt[4] = {bflo(gw2.x), bfhi(gw2.x), bflo(gw2.y), bfhi(gw2.y)}; float y[4];
#pragma unroll
                  for (int j = 0; j < 4; ++j) { const float sg = gt[j] / (1.0f + __expf(-gt[j])); y[j] = (acc[et][4 * g + j] - mean) * rstd * gv[j] * sg; }
                  v2u o; o.x = pk2(y[0], y[1]); o.y = pk2(y[2], y[3]); *(v2u*)(yp + e4) = o; } }
    }
}

__device__ __forceinline__ void act_phase(Frame& F, int l) {
    const int gw = F.vcu * NWAVES + F.wave, NGW = F.G * NWAVES;
    for (int item = gw; item < (M / 32) * 22; item += NGW) {
        const int tb = item / 22, cg = item - tb * 22; const int t0 = tb * 32, c0 = cg * 512 + F.lane * 8;
        if (c0 >= FF) continue;
        float w0[8], w1[8], w2[8], bb[8];
        { const float* cw = F_ffn_w + (size_t)l * 3 * FF + c0; const float* cb = F_ffn_b + (size_t)l * FF + c0;
#pragma unroll
          for (int j = 0; j < 8; ++j) { w0[j] = cw[j]; w1[j] = cw[FF + j]; w2[j] = cw[2 * FF + j]; bb[j] = cb[j]; } }
        float gp[8], gc[8], gn[8];
        if ((t0 & (SEQ - 1)) == 0) {
#pragma unroll
            for (int j = 0; j < 8; ++j) gp[j] = 0.f;
        } else unpack8(*(const v4u*)(F_GU + (size_t)(t0 - 1) * NGU + c0), gp);
        unpack8(*(const v4u*)(F_GU + (size_t)t0 * NGU + c0), gc);
        for (int t = t0; t < t0 + 32; ++t) {
            if ((t & (SEQ - 1)) == SEQ - 1) {
#pragma unroll
                for (int j = 0; j < 8; ++j) gn[j] = 0.f;
            } else unpack8(*(const v4u*)(F_GU + (size_t)(t + 1) * NGU + c0), gn);
            float u[8], y[8]; unpack8(*(const v4u*)(F_GU + (size_t)t * NGU + FF + c0), u);
#pragma unroll
            for (int j = 0; j < 8; ++j) { const float z = w0[j] * gp[j] + w1[j] * gc[j] + w2[j] * gn[j] + bb[j]; y[j] = z / (1.0f + __expf(-z)) * u[j]; }
            v4u o; o.x = pk2(y[0], y[1]); o.y = pk2(y[2], y[3]); o.z = pk2(y[4], y[5]); o.w = pk2(y[6], y[7]);
            *(v4u*)(F_ACT + (size_t)t * FF + c0) = o;
#pragma unroll
            for (int j = 0; j < 8; ++j) { gp[j] = gc[j]; gc[j] = gn[j]; }
        }
    }
}

__device__ __forceinline__ void final_phase(Frame& F) {
    const int gw = F.vcu * NWAVES + F.wave, NGW = F.G * NWAVES;
    for (int m = gw; m < M; m += NGW) {
        const float s = wave_sum(F_part[(size_t)m * 64 + F.lane]); const float rs = 1.0f / sqrtf(s * (1.0f / D) + EPS);
        float* xr = F_out + (size_t)m * D + 4 * F.lane; const float* gr = F_norm_f + 4 * F.lane;
#pragma unroll
        for (int j = 0; j < 16; ++j) { const f32x4 v = *(const f32x4*)(xr + 256 * j), g = *(const f32x4*)(gr + 256 * j); *(f32x4*)(xr + 256 * j) = v * rs * g; }
    }
}

constexpr int PH_PER_LAYER = 9, N_PHASES = DEPTH * PH_PER_LAYER + 1;

__global__ void __launch_bounds__(NWAVES * 64, 2) enc_fwd(Args args) {
    extern __shared__ __attribute__((aligned(16))) unsigned char lds[];
    Frame F;
    F.lds = (LAS unsigned char*)lds;
    volatile LAS unsigned* MISC = (volatile LAS unsigned*)(F.lds + MISC_OFF);
    F.tid = threadIdx.x; F.lane = F.tid & 63; F.wave = __builtin_amdgcn_readfirstlane(F.tid >> 6);
    F.G = gridDim.x; { const int bx = blockIdx.x; F.vcu = (F.G % 8 == 0) ? (bx % 8) * (F.G / 8) + bx / 8 : bx; }
    F.ap = (const __attribute__((address_space(4))) Args*)__builtin_amdgcn_kernarg_segment_ptr();
    unsigned char* ws = args.ws;
    for (int u = F.tid; u < (LDS_BYTES - LDSCTL_OFF) / 4; u += NWAVES * 64) ((LAS unsigned*)(F.lds + LDSCTL_OFF))[u] = 0u;
    __syncthreads();
    XcdBarrier bar; bar.bar = (unsigned*)(ws + WS_CTL) + CW_BAR; bar.x = 0; bar.st = nullptr;
#if !MK_SPLIT
    bar = xcd_barrier_post((unsigned*)(ws + WS_CTL) + CW_BAR, MISC + 8);
#define GRID_BAR() xcd_barrier(bar)
#else
#define GRID_BAR() do {} while (0)
#endif
    const int lo = args.ph_lo, hi = args.ph_hi;
#define IN(k) (lo <= (k) && (k) < hi)
#define SEAM(k) do { if (IN(k) && IN((k) + 1)) GRID_BAR(); } while (0)
    using namespace pg8;
    for (int l = 0; l < DEPTH; ++l) {
        const int pb = l * PH_PER_LAYER;
#define LAUNDER() do { F.tid = threadIdx.x; asm volatile("" : "+v"(F.tid), "+s"(F.ap)); F.lane = F.tid & 63; } while (0)
        if (PHON(0) && IN(pb + 0)) { LAUNDER(); p0_phase(F, l); } SEAM(pb + 0);
        if (PHON(1) && IN(pb + 1)) { LAUNDER();
            { Gemm g{F_XB, F_WIN, M, N1, D}; StaticOrder S; S.init(M, N1, F.G, (int)blockIdx.x); EpiIn E{F_PROJ, N1, F_rstd1, F_cosb, F_sinb};
              gemm_phase<EpiIn, StaticOrder, PG8_ALIGN, PG8_SP2>(F.lds + RING_OFF, g, S, E); }
            { Gemm g{F_WIN + (size_t)COL_K * D, F_XB, 2 * RW, M, D}; StaticOrder S; S.init(2 * RW, M, F.G, (int)blockIdx.x); EpiKV E{F_KFT, F_KBT, F_VT, M, F_rstd1, F_cosT, F_sinT, F_lgam + l * 16};
              gemm_phase<EpiKV, StaticOrder, PG8_ALIGN, PG8_SP2>(F.lds + RING_OFF, g, S, E); }
        } SEAM(pb + 1);
        if (PHON(2) && IN(pb + 2)) { LAUNDER(); mixer_a(F, l); scan_phase(F, l); } SEAM(pb + 2);
        if (PHON(3) && IN(pb + 3)) { LAUNDER(); intra_phase(F, l); } SEAM(pb + 3);
        if (PHON(4) && IN(pb + 4)) { LAUNDER(); Gemm g{F_YCAT, F_WOUT, M, D, D}; StaticOrder S; S.init(M, D, F.G, (int)blockIdx.x); EpiRes E{l == 0 ? F_x : F_out, F_out, F_XB, F_part, D};
            gemm_phase<EpiRes, StaticOrder, PG8_ALIGN, PG8_SP2>(F.lds + RING_OFF, g, S, E); } SEAM(pb + 4);
        if (PHON(5) && IN(pb + 5)) { LAUNDER(); rstd_from_part(F, F_rstd2); } SEAM(pb + 5);
        if (PHON(6) && IN(pb + 6)) { LAUNDER(); Gemm g{F_XB, F_WGU, M, NGU, D}; StaticOrder S; S.init(M, NGU, F.G, (int)blockIdx.x); EpiScale E{F_GU, NGU, F_rstd2};
            gemm_phase<EpiScale, StaticOrder, PG8_ALIGN, PG8_SP2>(F.lds + RING_OFF, g, S, E); } SEAM(pb + 6);
        if (PHON(7) && IN(pb + 7)) { LAUNDER(); act_phase(F, l); } SEAM(pb + 7);
        if (PHON(8) && IN(pb + 8)) { LAUNDER(); Gemm g{F_ACT, F_WDN, M, D, FF}; StaticOrder S; S.init(M, D, F.G, (int)blockIdx.x); EpiRes E{F_out, F_out, F_XB, F_part, D};
            gemm_phase<EpiRes, StaticOrder, PG8_ALIGN, PG8_SP2>(F.lds + RING_OFF, g, S, E); } SEAM(pb + 8);
    }
    if (PHON(9) && IN(N_PHASES - 1)) { LAUNDER(); final_phase(F); }
#undef IN
#undef SEAM
}

extern "C" void kernel_launch(void* const* d_in, const int* in_sizes, int n_in, void* d_out, int out_size, void* d_ws, size_t ws_size, hipStream_t stream) {
    static int grid = 0;
    if (grid == 0) {
        if (n_in != 17 || in_sizes[0] != M * D || out_size != M * D || ws_size < WS_END) { fprintf(stderr, "kernel_launch: unexpected shapes (n_in %d, in0 %d, out %d, ws %zu < %zu?)\n", n_in, n_in > 0 ? in_sizes[0] : -1, out_size, ws_size, (size_t)WS_END); grid = -1; return; }
        int dev = 0, cus = 0, per_cu = 0;
        if (hipGetDevice(&dev) != hipSuccess || hipDeviceGetAttribute(&cus, hipDeviceAttributeMultiprocessorCount, dev) != hipSuccess) { grid = -1; return; }
        if (hipFuncSetAttribute((const void*)enc_fwd, hipFuncAttributeMaxDynamicSharedMemorySize, LDS_BYTES) != hipSuccess) { fprintf(stderr, "kernel_launch: hipFuncSetAttribute failed\n"); grid = -1; return; }
        if (hipOccupancyMaxActiveBlocksPerMultiprocessor(&per_cu, (const void*)enc_fwd, NWAVES * 64, LDS_BYTES) != hipSuccess || per_cu < 1) fprintf(stderr, "kernel_launch: occupancy query reports %d\n", per_cu);
        (void)hipGetLastError();
        grid = cus;
    }
    if (grid < 0) return;
    if (hipMemsetAsync((char*)d_ws + WS_CTL, 0, CTL_ZERO_BYTES, stream) != hipSuccess) { fprintf(stderr, "kernel_launch: memset failed\n"); return; }
    Args a{};
    for (int i = 0; i < 17; ++i) a.in[i] = d_in[i];
    a.out = (float*)d_out; a.ws = (unsigned char*)d_ws;
#if MK_SPLIT
    for (int p = 0; p < N_PHASES; ++p) { a.ph_lo = p; a.ph_hi = p + 1; hipLaunchKernelGGL(enc_fwd, dim3(grid), dim3(NWAVES * 64), LDS_BYTES, stream, a); }
#else
    a.ph_lo = 0; a.ph_hi = N_PHASES;
    hipLaunchKernelGGL(enc_fwd, dim3(grid), dim3(NWAVES * 64), LDS_BYTES, stream, a);
#endif
    const hipError_t le = hipPeekAtLastError();
    if (le != hipSuccess) fprintf(stderr, "kernel_launch: launch failed: %s\n", hipGetErrorName(le));
}
```

```cpp
#include <hip/hip_runtime.h>
#include <cstdio>
#include <cstdint>

#ifndef PH_MASK
#define PH_MASK 0x3ff
#endif
#define PHON(k) ((PH_MASK >> (k)) & 1)
#ifndef PH_REPEAT
#define PH_REPEAT 0
#endif
#define PHREP(k) (((PH_REPEAT >> (k)) & 1) ? 2 : 1)
#ifndef MK_SPLIT
#define MK_SPLIT 0
#endif

namespace pg8 {
#define PG8_LAS __attribute__((address_space(3)))
typedef unsigned short bf16_t;
typedef short bf16x8 __attribute__((ext_vector_type(8)));
typedef float f32x4 __attribute__((ext_vector_type(4)));
typedef unsigned u32x4 __attribute__((ext_vector_type(4)));
constexpr int BM = 256, BK = 64, HALF = 128, HTB = HALF * BK * 2  , STAGE_BYTES = 8 * HTB, NXCD = 8, WGM = 8;

__host__ __device__ __forceinline__ int lds_byte(int r, int c) { const int st = (r >> 4) * 2 + (c >> 5), rr = r & 15, cc = c & 31, ob = rr * 64 + cc * 2; return st * 1024 + (ob ^ (((ob >> 9) & 1) << 5)); }
__host__ __device__ __forceinline__ void stage_rc(int b, int& R, int& C) { const int st = b / 1024, sb = b % 1024, swz = sb ^ (((sb >> 9) & 1) << 5); R = (st >> 1) * 16 + swz / 64; C = (st & 1) * 32 + (swz % 64) / 2; }
__host__ __device__ __forceinline__ int perm32(int rho) { const int n = rho >> 4, i = rho & 15; return 8 * (i >> 2) + 4 * n + (i & 3); }

struct Unit { int pm, pn; };
struct Gemm { const bf16_t* A; const bf16_t* Bt; int M, N, K; };

struct StaticOrder {
    int nM, nN, nwg, G, c;
    __host__ __device__ void init(int M, int N, int G_, int c_) { nM = M / BM; nN = N / BM; nwg = nM * nN; G = G_; c = c_; }
    __host__ __device__ bool next(int i, Unit& u) const {
        const long L = (long)i * G + c; if (L >= nwg) return false;
        int wgid = (int)L; { const int q = nwg / NXCD, r = nwg % NXCD, xcd = wgid % NXCD, off = wgid / NXCD; wgid = (xcd < r ? xcd * (q + 1) : r * (q + 1) + (xcd - r) * q) + off; }
        const int nig = WGM * nN, gid = wgid / nig, fm = gid * WGM, gsz = (nM - fm) < WGM ? (nM - fm) : WGM;
        u.pm = fm + ((wgid % nig) % gsz); u.pn = (wgid % nig) / gsz; return true;
    }
    __device__ __forceinline__ void a_ready(const Unit&) const {}
    __device__ __forceinline__ void done(const Unit&) const {}
};

#ifndef PROBE_GEMM
#define PROBE_GEMM 0
#endif
struct ProbeOrder : StaticOrder {
    __host__ __device__ bool next(int i, Unit& u) const { const bool ok = StaticOrder::next(i, u); if (PROBE_GEMM == 2) { u.pm = 0; u.pn = 0; } return ok; }
};
__device__ __forceinline__ unsigned cvt_pk_bf16(float lo, float hi) { unsigned r; asm volatile("v_cvt_pk_bf16_f32 %0, %1, %2" : "=v"(r) : "v"(lo), "v"(hi)); return r; }
__device__ __forceinline__ u32x4 pack8(const f32x4 a, const f32x4 b) { u32x4 w; w.x = cvt_pk_bf16(a[0], a[1]); w.y = cvt_pk_bf16(a[2], a[3]); w.z = cvt_pk_bf16(b[0], b[1]); w.w = cvt_pk_bf16(b[2], b[3]); return w; }

struct EpiIn {
    static constexpr bool PERM = true, AFTER_DRAIN = false;
    bf16_t* O; int ldc; const float* rstd; const float* cosb; const float* sinb;
    __device__ __forceinline__ void operator()(const f32x4 (&acc)[2][2][4][2], const Unit& u, int wr, int wc, int fr, int fq) const {
        asm volatile("" : "+v"(fr), "+v"(fq));
        const int row0 = u.pm * BM + wr * 64 + fr, col0 = u.pn * BM + wc * 32 + 8 * fq, typ = u.pn >> 3;
        const bool rot = (typ == 3) || (typ == 5); const float osc = (typ == 3) ? 0.0625f : 1.0f;
#pragma unroll
        for (int ai = 0; ai < 2; ++ai)
#pragma unroll
            for (int m = 0; m < 4; ++m) { const int row = row0 + ai * HALF + m * 16; const float rs = rstd[row]; bf16_t* rowp = O + (size_t)row * ldc + col0;
                if (rot) { const float sc = rs * osc; const float* cp = cosb + (size_t)row * 128 + wc * 32 + 8 * fq; const float* sp = sinb + (size_t)row * 128 + wc * 32 + 8 * fq;
                    const f32x4 c0 = *(const f32x4*)cp, c1 = *(const f32x4*)(cp + 4), s0 = *(const f32x4*)sp, s1 = *(const f32x4*)(sp + 4);
                    const f32x4 a0 = acc[ai][0][m][0] * sc, a1 = acc[ai][0][m][1] * sc, b0 = acc[ai][1][m][0] * sc, b1 = acc[ai][1][m][1] * sc;
                    *(u32x4*)(rowp) = pack8(a0 * c0 - b0 * s0, a1 * c1 - b1 * s1);
                    *(u32x4*)(rowp + HALF) = pack8(b0 * c0 + a0 * s0, b1 * c1 + a1 * s1);
                } else {
#pragma unroll
                    for (int bj = 0; bj < 2; ++bj) *(u32x4*)(rowp + bj * HALF) = pack8(acc[ai][bj][m][0] * rs, acc[ai][bj][m][1] * rs);
                } }
    }
};
struct EpiKV {
    static constexpr bool PERM = true, AFTER_DRAIN = false;
    bf16_t* KFT; bf16_t* KBT; bf16_t* VT; int ldc; const float* rstd; const float* cosT; const float* sinT; const float* lgam;
    __device__ __forceinline__ void operator()(const f32x4 (&acc)[2][2][4][2], const Unit& u, int wr, int wc, int fr, int fq) const {
        asm volatile("" : "+v"(fr), "+v"(fq));
        const int tok0 = u.pn * BM + wc * 32 + 8 * fq;
        if (u.pm < 8) {
            const int h = u.pm; const float lf = lgam[h], lb = lgam[8 + h];
#pragma unroll
            for (int bj = 0; bj < 2; ++bj) { const int tok = tok0 + bj * HALF; const f32x4 r0 = *(const f32x4*)(rstd + tok), r1 = *(const f32x4*)(rstd + tok + 4);
                f32x4 wf0, wf1, wb0, wb1; const int cpos = wc * 32 + 8 * fq;
#pragma unroll
                for (int j = 0; j < 4; ++j) { wf0[j] = __expf(lf * (float)(127 - (cpos + j))); wf1[j] = __expf(lf * (float)(127 - (cpos + 4 + j))); wb0[j] = __expf(lb * (float)(cpos + j)); wb1[j] = __expf(lb * (float)(cpos + 4 + j)); }
#pragma unroll
                for (int m = 0; m < 4; ++m) { const int d = wr * 64 + m * 16 + fr;
                    const float* cp = cosT + (size_t)d * ldc + tok; const float* sp = sinT + (size_t)d * ldc + tok;
                    const f32x4 c0 = *(const f32x4*)cp, c1 = *(const f32x4*)(cp + 4), s0 = *(const f32x4*)sp, s1 = *(const f32x4*)(sp + 4);
                    const f32x4 a0 = acc[0][bj][m][0] * r0, a1 = acc[0][bj][m][1] * r1, b0 = acc[1][bj][m][0] * r0, b1 = acc[1][bj][m][1] * r1;
                    const f32x4 o10 = a0 * c0 - b0 * s0, o11 = a1 * c1 - b1 * s1, o20 = b0 * c0 + a0 * s0, o21 = b1 * c1 + a1 * s1;
                    const size_t off1 = (size_t)(h * 256 + d) * ldc + tok, off2 = off1 + (size_t)128 * ldc;
                    *(u32x4*)(KFT + off1) = pack8(o10 * wf0, o11 * wf1); *(u32x4*)(KFT + off2) = pack8(o20 * wf0, o21 * wf1);
                    *(u32x4*)(KBT + off1) = pack8(o10 * wb0, o11 * wb1); *(u32x4*)(KBT + off2) = pack8(o20 * wb0, o21 * wb1); } }
        } else {
            const int rowb = (u.pm - 8) * BM + wr * 64 + fr;
#pragma unroll
            for (int bj = 0; bj < 2; ++bj) { const int tok = tok0 + bj * HALF; const f32x4 r0 = *(const f32x4*)(rstd + tok), r1 = *(const f32x4*)(rstd + tok + 4);
#pragma unroll
                for (int ai = 0; ai < 2; ++ai)
#pragma unroll
                    for (int m = 0; m < 4; ++m) *(u32x4*)(VT + (size_t)(rowb + ai * HALF + m * 16) * ldc + tok) = pack8(acc[ai][bj][m][0] * r0, acc[ai][bj][m][1] * r1); }
        }
    }
};
struct EpiScale {
    static constexpr bool PERM = true, AFTER_DRAIN = false;
    bf16_t* O; int ldc; const float* rstd;
    __device__ __forceinline__ void operator()(const f32x4 (&acc)[2][2][4][2], const Unit& u, int wr, int wc, int fr, int fq) const {
        asm volatile("" : "+v"(fr), "+v"(fq));
        const int row0 = u.pm * BM + wr * 64 + fr, col0 = u.pn * BM + wc * 32 + 8 * fq;
#pragma unroll
        for (int ai = 0; ai < 2; ++ai)
#pragma unroll
            for (int m = 0; m < 4; ++m) { const int row = row0 + ai * HALF + m * 16; const float rs = rstd[row]; bf16_t* rowp = O + (size_t)row * ldc + col0;
#pragma unroll
                for (int bj = 0; bj < 2; ++bj) *(u32x4*)(rowp + bj * HALF) = pack8(acc[ai][bj][m][0] * rs, acc[ai][bj][m][1] * rs); }
    }
};
struct EpiRes {
    static constexpr bool PERM = true, AFTER_DRAIN = false;
    const float* xin; float* xout; bf16_t* xb; float* part; int ldc;
    __device__ __forceinline__ void operator()(const f32x4 (&acc)[2][2][4][2], const Unit& u, int wr, int wc, int fr, int fq) const {
        asm volatile("" : "+v"(fr), "+v"(fq));
        const int row0 = u.pm * BM + wr * 64 + fr, col0 = u.pn * BM + wc * 32 + 8 * fq;
#pragma unroll
        for (int ai = 0; ai < 2; ++ai)
#pragma unroll
            for (int m = 0; m < 4; ++m) { const int row = row0 + ai * HALF + m * 16; const size_t off = (size_t)row * ldc + col0; float ss = 0.f;
#pragma unroll
                for (int bj = 0; bj < 2; ++bj) { const f32x4 x0 = *(const f32x4*)(xin + off + bj * HALF), x1 = *(const f32x4*)(xin + off + bj * HALF + 4);
                    const f32x4 v0 = x0 + acc[ai][bj][m][0], v1 = x1 + acc[ai][bj][m][1];
                    *(f32x4*)(xout + off + bj * HALF) = v0; *(f32x4*)(xout + off + bj * HALF + 4) = v1; *(u32x4*)(xb + off + bj * HALF) = pack8(v0, v1);
                    ss += (v0[0] * v0[0] + v0[1] * v0[1]) + (v0[2] * v0[2] + v0[3] * v0[3]) + (v1[0] * v1[0] + v1[1] * v1[1]) + (v1[2] * v1[2] + v1[3] * v1[3]); }
                ss += __shfl_xor(ss, 16); ss += __shfl_xor(ss, 32);
                if (fq == 0) part[(size_t)row * 64 + u.pn * 4 + wc] = ss; }
    }
};

template <class Epi, class Sched, bool ALIGN_EPI = false, bool SP2 = false>
__device__ __forceinline__ void gemm_phase(PG8_LAS unsigned char* lds, const Gemm g, const Sched& S, const Epi& E) {
    int tid_ = threadIdx.x; asm volatile("" : "+v"(tid_));
    const int tid = tid_, wid = __builtin_amdgcn_readfirstlane(tid >> 6), lane = tid & 63, wr = wid >> 2, wc = wid & 3, fr = lane & 15, fq = lane >> 4;
    const int K = g.K, nt = K / BK;
    unsigned voffA[2], voffB[2];
#pragma unroll
    for (int i = 0; i < 2; ++i) { int R, C; stage_rc(tid * 16 + i * 8192, R, C); const int Rb = Epi::PERM ? ((R & ~31) + perm32(R & 31)) : R;
        voffA[i] = (unsigned)(R * K + C) * 2u; voffB[i] = (unsigned)(Rb * K + C) * 2u; }
    const size_t kstep = (size_t)(BK * 2);
    const size_t hstep = (size_t)HALF * K * 2;
    const size_t tstep = 2 * hstep;
    const unsigned ldsw = (unsigned)wid * 1024u;
    const int aoff = lds_byte(wr * 64 + fr, fq * 8), boff = lds_byte(wc * 32 + fr, fq * 8);
#define PG8_SA(b, h) (((b) * 2 + (h)) * HTB)
#define PG8_SB(b, h) ((4 + (b) * 2 + (h)) * HTB)
#define PG8_STAGE(bufoff, gbase, voff) do { _Pragma("unroll") for (int _i = 0; _i < 2; ++_i) \
        __builtin_amdgcn_global_load_lds((const unsigned*)((const char*)(gbase) + (voff)[_i]), (PG8_LAS unsigned*)(lds + (bufoff) + ldsw + _i * 8192), 16, 0, 0); } while (0)
#define PG8_LDA(dst, b, h) do { _Pragma("unroll") for (int m = 0; m < 4; ++m) _Pragma("unroll") for (int k = 0; k < 2; ++k) dst[m][k] = *(const PG8_LAS bf16x8*)(lds + PG8_SA(b, h) + aoff + m * 2048 + k * 1024); } while (0)
#define PG8_LDB(dst, b, h) do { _Pragma("unroll") for (int n = 0; n < 2; ++n) _Pragma("unroll") for (int k = 0; k < 2; ++k) dst[n][k] = *(const PG8_LAS bf16x8*)(lds + PG8_SB(b, h) + boff + n * 2048 + k * 1024); } while (0)
#define PG8_MMA(ai, bj, At, Bt) do { __builtin_amdgcn_s_setprio(1); _Pragma("unroll") for (int m = 0; m < 4; ++m) _Pragma("unroll") for (int n = 0; n < 2; ++n) _Pragma("unroll") for (int k = 0; k < 2; ++k) \
        acc[ai][bj][m][n] = __builtin_amdgcn_mfma_f32_16x16x32_bf16(Bt[n][k], At[m][k], acc[ai][bj][m][n], 0, 0, 0); __builtin_amdgcn_s_setprio(0); } while (0)
#define PG8_WAIT_V(n) asm volatile("s_waitcnt vmcnt(" #n ")" ::: "memory")
#define PG8_WAIT_L(n) asm volatile("s_waitcnt lgkmcnt(" #n ")" ::: "memory")
#define PG8_BAR __builtin_amdgcn_s_barrier()
#define PG8_SCHED __builtin_amdgcn_sched_barrier(0)
    Unit cur, nxt; int ui = 0;
    if (!S.next(0, cur)) return;
    f32x4 acc[2][2][4][2];
#pragma unroll
    for (int a = 0; a < 2; ++a)
#pragma unroll
        for (int b = 0; b < 2; ++b)
#pragma unroll
            for (int m = 0; m < 4; ++m)
#pragma unroll
                for (int n = 0; n < 2; ++n) acc[a][b][m][n] = (f32x4){0.f, 0.f, 0.f, 0.f};
    bf16x8 At[4][2], B0[2][2], B1[2][2];
    const char* cA = (const char*)g.A + (size_t)cur.pm * tstep; const char* cB = (const char*)g.Bt + (size_t)cur.pn * tstep;
    S.a_ready(cur);
    if constexpr (SP2) {
        PG8_STAGE(PG8_SB(0, 0), cB, voffB); PG8_STAGE(PG8_SB(0, 1), cB + hstep, voffB); PG8_STAGE(PG8_SA(0, 0), cA, voffA); PG8_STAGE(PG8_SA(0, 1), cA + hstep, voffA);
        if (wr == 1) PG8_BAR;
        PG8_WAIT_V(2); PG8_BAR;
        PG8_STAGE(PG8_SB(1, 0), cB + kstep, voffB); PG8_STAGE(PG8_SA(1, 0), cA + kstep, voffA); PG8_STAGE(PG8_SB(1, 1), cB + hstep + kstep, voffB);
        PG8_WAIT_V(6); PG8_BAR;
    } else {
        PG8_STAGE(PG8_SB(0, 0), cB, voffB); PG8_STAGE(PG8_SA(0, 0), cA, voffA); PG8_STAGE(PG8_SB(0, 1), cB + hstep, voffB); PG8_STAGE(PG8_SA(0, 1), cA + hstep, voffA);
        if (wr == 1) PG8_BAR;
        PG8_WAIT_V(4); PG8_BAR;
        PG8_STAGE(PG8_SB(1, 0), cB + kstep, voffB); PG8_STAGE(PG8_SA(1, 0), cA + kstep, voffA); PG8_STAGE(PG8_SB(1, 1), cB + hstep + kstep, voffB);
        PG8_WAIT_V(6); PG8_BAR;
    }
    for (;;) {
        const bool has_next = S.next(ui + 1, nxt);
        const char* nA = has_next ? (const char*)g.A + (size_t)nxt.pm * tstep : cA; const char* nB = has_next ? (const char*)g.Bt + (size_t)nxt.pn * tstep : cB;
        for (int t = 0; t < nt; t += 2) {
            const bool last = (t == nt - 2);
            const char* a1 = cA + (size_t)(t + 1) * kstep;
            const char* a2 = last ? nA : cA + (size_t)(t + 2) * kstep; const char* b2 = last ? nB : cB + (size_t)(t + 2) * kstep;
            const char* a3 = a2 + kstep; const char* b3 = b2 + kstep;
            if (last && has_next) S.a_ready(nxt);
            if constexpr (SP2) {
            PG8_LDB(B0, 0, 0); PG8_LDB(B1, 0, 1); PG8_SCHED; PG8_LDA(At, 0, 0); PG8_STAGE(PG8_SA(1, 1), a1 + hstep, voffA);
            PG8_WAIT_V(8); PG8_WAIT_L(0); PG8_BAR; PG8_MMA(0, 0, At, B0); PG8_MMA(0, 1, At, B1); PG8_BAR; PG8_SCHED;
            PG8_LDA(At, 0, 1); PG8_STAGE(PG8_SB(0, 0), b2, voffB); PG8_STAGE(PG8_SB(0, 1), b2 + hstep, voffB); PG8_STAGE(PG8_SA(0, 0), a2, voffA);
            PG8_WAIT_V(8); PG8_WAIT_L(0); PG8_BAR; PG8_MMA(1, 0, At, B0); PG8_MMA(1, 1, At, B1); PG8_BAR; PG8_SCHED;
            PG8_LDB(B0, 1, 0); PG8_LDB(B1, 1, 1); PG8_SCHED; PG8_LDA(At, 1, 0); PG8_STAGE(PG8_SA(0, 1), a2 + hstep, voffA);
            PG8_WAIT_V(8); PG8_WAIT_L(0); PG8_BAR; PG8_MMA(0, 0, At, B0); PG8_MMA(0, 1, At, B1); PG8_BAR; PG8_SCHED;
            PG8_LDA(At, 1, 1); PG8_STAGE(PG8_SB(1, 0), b3, voffB); PG8_STAGE(PG8_SB(1, 1), b3 + hstep, voffB); PG8_STAGE(PG8_SA(1, 0), a3, voffA);
            PG8_WAIT_V(8); PG8_WAIT_L(0); PG8_BAR; PG8_MMA(1, 0, At, B0); PG8_MMA(1, 1, At, B1); PG8_BAR; PG8_SCHED;
            } else {
            PG8_LDB(B0, 0, 0); PG8_SCHED; PG8_LDA(At, 0, 0); PG8_STAGE(PG8_SA(1, 1), a1 + hstep, voffA);
            PG8_WAIT_L(8); PG8_BAR; PG8_WAIT_L(0); PG8_MMA(0, 0, At, B0); PG8_BAR; PG8_SCHED;
            PG8_LDB(B1, 0, 1); PG8_STAGE(PG8_SB(0, 0), b2, voffB);
            PG8_BAR; PG8_WAIT_L(0); PG8_MMA(0, 1, At, B1); PG8_BAR;
            PG8_LDA(At, 0, 1); PG8_STAGE(PG8_SA(0, 0), a2, voffA);
            PG8_BAR; PG8_WAIT_L(0); PG8_MMA(1, 0, At, B0); PG8_BAR; PG8_SCHED;
            PG8_STAGE(PG8_SB(0, 1), b2 + hstep, voffB);
            PG8_WAIT_V(6); PG8_BAR; PG8_MMA(1, 1, At, B1); PG8_BAR;
            PG8_LDB(B0, 1, 0); PG8_SCHED; PG8_LDA(At, 1, 0); PG8_STAGE(PG8_SA(0, 1), a2 + hstep, voffA);
            PG8_WAIT_L(8); PG8_BAR; PG8_WAIT_L(0); PG8_MMA(0, 0, At, B0); PG8_BAR; PG8_SCHED;
            PG8_LDB(B1, 1, 1); PG8_STAGE(PG8_SB(1, 0), b3, voffB);
            PG8_BAR; PG8_WAIT_L(0); PG8_MMA(0, 1, At, B1); PG8_BAR;
            PG8_LDA(At, 1, 1); PG8_STAGE(PG8_SA(1, 0), a3, voffA);
            PG8_BAR; PG8_WAIT_L(0); PG8_MMA(1, 0, At, B0); PG8_BAR; PG8_SCHED;
            PG8_STAGE(PG8_SB(1, 1), b3 + hstep, voffB);
            PG8_WAIT_V(6); PG8_BAR; PG8_MMA(1, 1, At, B1); PG8_BAR;
            }
        }
        if constexpr (ALIGN_EPI) { if (wr == 0) PG8_BAR; }
        if constexpr (!Epi::AFTER_DRAIN) { E(acc, cur, wr, wc, fr, fq); S.done(cur); }
        if (!has_next) break;
#pragma unroll
        for (int a = 0; a < 2; ++a)
#pragma unroll
            for (int b = 0; b < 2; ++b)
#pragma unroll
                for (int m = 0; m < 4; ++m)
#pragma unroll
                    for (int n = 0; n < 2; ++n) acc[a][b][m][n] = (f32x4){0.f, 0.f, 0.f, 0.f};
        cur = nxt; cA = nA; cB = nB; ++ui;
        if constexpr (ALIGN_EPI) { if (wr == 1) PG8_BAR; }
    }
    PG8_WAIT_V(0);
    if constexpr (!ALIGN_EPI) { if (wr == 0) PG8_BAR; }
    PG8_BAR;
#undef PG8_SA
#undef PG8_SB
#undef PG8_STAGE
#undef PG8_LDA
#undef PG8_LDB
#undef PG8_MMA
#undef PG8_WAIT_V
#undef PG8_WAIT_L
#undef PG8_BAR
#undef PG8_SCHED
}
}

#ifndef PG8_SP2
#define PG8_SP2 true
#endif
#ifndef PG8_ALIGN
#define PG8_ALIGN true
#endif

constexpr int NWAVES = 8;
constexpr int BATCH = 4, SEQ = 4096, D = 4096, M = BATCH * SEQ, DEPTH = 2;
constexpr int CW = 2048, RW = 2048, RH = 8, HD = 256, CHUNK = 128, NCH = SEQ / CHUNK;
constexpr int IN_COLS = 14336, N1 = 12288  , FF = 11008, NGU = 2 * FF;
constexpr int COL_AB = 0, COL_AC = 2048, COL_AX = 4096, COL_Q = 6144, COL_G = 8192, COL_K = 10240;
constexpr float EPS = 1e-6f;

constexpr size_t MiB = 1u << 20;
constexpr size_t WS_CTL = 0, CTL_ZERO_BYTES = 1 * MiB;
constexpr size_t WS_RSTD1 = 1 * MiB;
constexpr size_t WS_RSTD2 = WS_RSTD1 + 256 * 1024;
constexpr size_t WS_LGAM = WS_RSTD2 + 256 * 1024;
constexpr size_t WS_PART = 2 * MiB;
constexpr size_t WS_COS = 6 * MiB, WS_SIN = 14 * MiB, WS_COST = 22 * MiB, WS_SINT = 30 * MiB;
constexpr size_t WS_WIN = 38 * MiB;
constexpr size_t WS_WOUT = WS_WIN + 112 * MiB;
constexpr size_t WS_WGU = WS_WOUT + 32 * MiB;
constexpr size_t WS_WDN = WS_WGU + 172 * MiB;
constexpr size_t WS_XB = WS_WDN + 86 * MiB;
constexpr size_t WS_R = WS_XB + 128 * MiB;
constexpr size_t WS_PROJ = WS_R;
constexpr size_t WS_KFT = WS_PROJ + 384 * MiB, WS_KBT = WS_KFT + 64 * MiB, WS_VT = WS_KBT + 64 * MiB;
constexpr size_t WS_SFT = WS_VT + 64 * MiB, WS_SBT = WS_SFT + 128 * MiB;
constexpr size_t WS_YCAT = WS_SBT + 128 * MiB;
constexpr size_t WS_MIX_END = WS_YCAT + 128 * MiB;
constexpr size_t WS_GU = WS_R;
constexpr size_t WS_ACT = WS_GU + 688 * MiB;
constexpr size_t WS_END = WS_ACT + 344 * MiB;
static_assert(WS_MIX_END <= WS_END, "overlay");
static_assert((size_t)M * N1 * 2 == 384 * MiB && (size_t)M * NGU * 2 == 688 * MiB && (size_t)M * FF * 2 == 344 * MiB && (size_t)IN_COLS * D * 2 == 112 * MiB && (size_t)NGU * D * 2 == 172 * MiB && (size_t)D * FF * 2 == 86 * MiB, "sizes");
constexpr int CW_BAR = 4096;

constexpr int RING_OFF = 0, RING_BYTES = 136 * 1024;
constexpr int LDSCTL_OFF = RING_BYTES, MISC_OFF = LDSCTL_OFF + 320;
constexpr int LDS_BYTES = 147456;
static_assert(MISC_OFF + 128 <= LDS_BYTES && 8 * 16640 <= RING_BYTES, "LDS map");

#define GAS __attribute__((address_space(1)))
#define LAS __attribute__((address_space(3)))
typedef unsigned short bf16;
typedef unsigned v4u __attribute__((ext_vector_type(4)));
typedef unsigned v2u __attribute__((ext_vector_type(2)));
typedef float f32x4 __attribute__((ext_vector_type(4)));
typedef float f32x16 __attribute__((ext_vector_type(16)));
typedef short bf16x8 __attribute__((ext_vector_type(8)));
typedef GAS unsigned gu32;
#define RLX_AGENT __ATOMIC_RELAXED, __HIP_MEMORY_SCOPE_AGENT
#define LDS_WAIT() asm volatile("s_waitcnt lgkmcnt(0)" ::: "memory")
#define VM_WAIT() asm volatile("s_waitcnt vmcnt(0)" ::: "memory")
__device__ __forceinline__ unsigned pk2(float lo, float hi) { return pg8::cvt_pk_bf16(lo, hi); }
__device__ __forceinline__ float bflo(unsigned w) { return __uint_as_float(w << 16); }
__device__ __forceinline__ float bfhi(unsigned w) { return __uint_as_float(w & 0xffff0000u); }
__device__ __forceinline__ void unpack8(const v4u w, float (&f)[8]) { f[0] = bflo(w.x); f[1] = bfhi(w.x); f[2] = bflo(w.y); f[3] = bfhi(w.y); f[4] = bflo(w.z); f[5] = bfhi(w.z); f[6] = bflo(w.w); f[7] = bfhi(w.w); }

#define XB_TMO      128
#define XB_XCNT(j)  (256  + 64 * (j))
#define XB_XSUB(j)  (1280 + 64 * (j))
#define XB_XGEN(j)  (2304 + 64 * (j))
#define XB_TOP      3328
#define XB_TOPGEN   3392
#define XCD_BAR_WORDS 3456
#define XB_SPIN_CAP (1u << 18)

__device__ __forceinline__ unsigned xb_ld(unsigned* p)              { return __hip_atomic_load(p, __ATOMIC_RELAXED, __HIP_MEMORY_SCOPE_AGENT); }
__device__ __forceinline__ unsigned xb_add(unsigned* p, unsigned v) { return __hip_atomic_fetch_add(p, v, __ATOMIC_RELAXED, __HIP_MEMORY_SCOPE_AGENT); }
__device__ __forceinline__ unsigned xb_xcc_id() { return (unsigned)__builtin_amdgcn_s_getreg((3 << 11) | 20) & 0xFu; }
#define XB_SPIN(cond, bar) do { unsigned _sp = 0; while (cond) { __builtin_amdgcn_s_sleep(1); \
    if ((++_sp & 255u) == 0u) { if (xb_ld(&(bar)[XB_TMO])) break; if (_sp > XB_SPIN_CAP) { atomicAdd(&(bar)[XB_TMO], 1u); break; } } } } while (0)

struct XcdBarrier {
    unsigned* bar; unsigned x;
    volatile LAS unsigned* st;
};
__device__ __forceinline__ XcdBarrier xcd_barrier_post(unsigned* bar, volatile LAS unsigned* st) {
    XcdBarrier b; b.bar = bar; b.x = xb_xcc_id(); b.st = st;
    if (threadIdx.x == 0) (void)xb_add(&bar[XB_XCNT(b.x)], 1u);
    return b;
}
__device__ __forceinline__ void xcd_barrier_complete(unsigned* bar, unsigned x, unsigned& nloc, unsigned& nx) {
    const unsigned G = gridDim.x * gridDim.y * gridDim.z;
    unsigned sum, cnt, mine, sp = 0u;
    for (;;) {
        sum = 0u; cnt = 0u; mine = 0u;
#pragma unroll
        for (unsigned j = 0; j < 16; ++j) { const unsigned c = xb_ld(&bar[XB_XCNT(j)]); sum += c; cnt += (c > 0u) ? 1u : 0u; mine = (j == x) ? c : mine; }
        if (sum == G) break;
        __builtin_amdgcn_s_sleep(1);
        if ((++sp & 255u) == 0u) { if (xb_ld(&bar[XB_TMO])) break; if (sp > XB_SPIN_CAP) { atomicAdd(&bar[XB_TMO], 1u); break; } }
    }
    nloc = mine > 0u ? mine : 1u; nx = cnt > 0u ? cnt : 1u;
}
__device__ __forceinline__ void xcd_barrier(const XcdBarrier& b) {
    asm volatile("s_waitcnt vmcnt(0)" ::: "memory");
    __syncthreads();
    if (threadIdx.x == 0) {
        unsigned* bar = b.bar;
        __builtin_amdgcn_s_waitcnt(0);
        unsigned nloc = b.st[0], nx = b.st[1];
        if (nloc == 0u) { xcd_barrier_complete(bar, b.x, nloc, nx); b.st[0] = nloc; b.st[1] = nx; }
        const unsigned old = xb_add(&bar[XB_XSUB(b.x)], 1u);
        const unsigned gen = old / nloc;
        if (old + 1u == (gen + 1u) * nloc) {
            __builtin_amdgcn_fence(__ATOMIC_RELEASE, "agent");
            asm volatile("s_waitcnt vmcnt(0)" ::: "memory");
            const unsigned og = xb_add(&bar[XB_TOP], 1u);
            const unsigned tg = og / nx;
            if (og + 1u == (tg + 1u) * nx) xb_add(&bar[XB_TOPGEN], 1u);
            else XB_SPIN(xb_ld(&bar[XB_TOPGEN]) == tg, bar);
            __builtin_amdgcn_fence(__ATOMIC_ACQUIRE, "agent");
            xb_add(&bar[XB_XGEN(b.x)], 1u);
            asm volatile("s_waitcnt vmcnt(0)" ::: "memory");
        } else {
            XB_SPIN(xb_ld(&bar[XB_XGEN(b.x)]) == gen, bar);
            __builtin_amdgcn_fence(__ATOMIC_ACQUIRE, "agent");
            asm volatile("s_waitcnt vmcnt(0)" ::: "memory");
        }
    }
    __syncthreads();
}

struct Args { const void* in[17]; float* out; unsigned char* ws; int ph_lo, ph_hi; };
static_assert(sizeof(Args) == 17 * 8 + 8 + 8 + 8, "Args has no padding");
struct Frame {
    LAS unsigned char* lds;
    int tid, lane, wave;
    int vcu, G;
    const __attribute__((address_space(4))) Args* ap;
};
#define F_x ((const float*)(const GAS float*)F.ap->in[0])
#define F_pos ((const int*)(const GAS int*)F.ap->in[1])
#define F_norm1_g ((const float*)(const GAS float*)F.ap->in[2])
#define F_w_in ((const float*)(const GAS float*)F.ap->in[3])
#define F_conv_a_w ((const float*)(const GAS float*)F.ap->in[4])
#define F_conv_a_b ((const float*)(const GAS float*)F.ap->in[5])
#define F_beta_a ((const float*)(const GAS float*)F.ap->in[6])
#define F_dlogit ((const float*)(const GAS float*)F.ap->in[7])
#define F_gn_g ((const float*)(const GAS float*)F.ap->in[8])
#define F_w_out ((const float*)(const GAS float*)F.ap->in[9])
#define F_norm2_g ((const float*)(const GAS float*)F.ap->in[10])
#define F_w_gate ((const float*)(const GAS float*)F.ap->in[11])
#define F_w_up ((const float*)(const GAS float*)F.ap->in[12])
#define F_ffn_w ((const float*)(const GAS float*)F.ap->in[13])
#define F_ffn_b ((const float*)(const GAS float*)F.ap->in[14])
#define F_w_down ((const float*)(const GAS float*)F.ap->in[15])
#define F_norm_f ((const float*)(const GAS float*)F.ap->in[16])
#define F_out ((float*)(GAS float*)F.ap->out)
#define F_rstd1 ((float*)(GAS float*)(F.ap->ws + WS_RSTD1))
#define F_rstd2 ((float*)(GAS float*)(F.ap->ws + WS_RSTD2))
#define F_lgam ((float*)(GAS float*)(F.ap->ws + WS_LGAM))
#define F_part ((float*)(GAS float*)(F.ap->ws + WS_PART))
#define F_cosb ((float*)(GAS float*)(F.ap->ws + WS_COS))
#define F_sinb ((float*)(GAS float*)(F.ap->ws + WS_SIN))
#define F_cosT ((float*)(GAS float*)(F.ap->ws + WS_COST))
#define F_sinT ((float*)(GAS float*)(F.ap->ws + WS_SINT))
#define F_WIN ((bf16*)(GAS bf16*)(F.ap->ws + WS_WIN))
#define F_WOUT ((bf16*)(GAS bf16*)(F.ap->ws + WS_WOUT))
#define F_WGU ((bf16*)(GAS bf16*)(F.ap->ws + WS_WGU))
#define F_WDN ((bf16*)(GAS bf16*)(F.ap->ws + WS_WDN))
#define F_XB ((bf16*)(GAS bf16*)(F.ap->ws + WS_XB))
#define F_PROJ ((bf16*)(GAS bf16*)(F.ap->ws + WS_PROJ))
#define F_KFT ((bf16*)(GAS bf16*)(F.ap->ws + WS_KFT))
#define F_KBT ((bf16*)(GAS bf16*)(F.ap->ws + WS_KBT))
#define F_VT ((bf16*)(GAS bf16*)(F.ap->ws + WS_VT))
#define F_SFT ((bf16*)(GAS bf16*)(F.ap->ws + WS_SFT))
#define F_SBT ((bf16*)(GAS bf16*)(F.ap->ws + WS_SBT))
#define F_YCAT ((bf16*)(GAS bf16*)(F.ap->ws + WS_YCAT))
#define F_GU ((bf16*)(GAS bf16*)(F.ap->ws + WS_GU))
#define F_ACT ((bf16*)(GAS bf16*)(F.ap->ws + WS_ACT))
__device__ __forceinline__ float wave_sum(float v) {
#pragma unroll
    for (int o = 1; o < 64; o <<= 1) v += __shfl_xor(v, o);
    return v;
}

__device__ __forceinline__ void cvt_item(const float* __restrict__ W, int N, const float* __restrict__ gain, bf16* WT, int K, int k0, int n0s, int n0d, LAS float* scr, int lane) {
    const int r4 = lane >> 4, c4 = (lane & 15) * 4;
    f32x4 v[16];
#pragma unroll
    for (int i = 0; i < 16; ++i) v[i] = *(const f32x4*)(W + (size_t)(k0 + 4 * i + r4) * N + n0s + c4);
#pragma unroll
    for (int i = 0; i < 16; ++i) { const int kk = 4 * i + r4; const float g = gain ? gain[k0 + kk] : 1.0f; LAS float* s = scr + kk * 65 + c4;
        s[0] = v[i].x * g; s[1] = v[i].y * g; s[2] = v[i].z * g; s[3] = v[i].w * g; }
    LDS_WAIT(); asm volatile("" ::: "memory");
    const int c = lane & 7;
#pragma unroll
    for (int it = 0; it < 8; ++it) { const int n = (lane >> 3) + 8 * it; const LAS float* s = scr + (8 * c) * 65 + n;
        v4u o; o.x = pk2(s[0 * 65], s[1 * 65]); o.y = pk2(s[2 * 65], s[3 * 65]); o.z = pk2(s[4 * 65], s[5 * 65]); o.w = pk2(s[6 * 65], s[7 * 65]);
        *(v4u*)(WT + (size_t)(n0d + n) * K + k0 + 8 * c) = o; }
    LDS_WAIT(); asm volatile("" ::: "memory");
}
__device__ __forceinline__ void cvt_matrix(Frame& F, const float* W, int K, int N, const float* gain, bf16* WT, int dst_row0, bool in_perm, int& it, int it_end_prev, LAS float* scr) {
    const int nnb = N / 64, nitems = (K / 64) * nnb, NGW = F.G * NWAVES;
    for (; it < it_end_prev + nitems; it += NGW) {
        const int r = it - it_end_prev, kb = r / nnb, nb = r % nnb; const int n0s = nb * 64; int n0d = dst_row0 + n0s;
        if (in_perm) { const int blk = n0s >> 11, dblk = (blk < 4) ? blk : (blk == 4 ? 5 : (blk == 5 ? 6 : 4)); n0d = dblk * 2048 + (n0s & 2047); }
        cvt_item(W, N, gain, WT, K, kb * 64, n0s, n0d, scr, F.lane);
    }
}

__device__ __forceinline__ void rstd_from_part(Frame& F, float* rstd) {
    const int gw = F.vcu * NWAVES + F.wave, NGW = F.G * NWAVES;
    for (int row = gw; row < M; row += NGW) { const float s = wave_sum(F_part[(size_t)row * 64 + F.lane]); if (F.lane == 0) rstd[row] = 1.0f / sqrtf(s * (1.0f / D) + EPS); }
}
__device__ __forceinline__ void p0_phase(Frame& F, int l) {
    LAS float* scr = (LAS float*)(F.lds + RING_OFF + F.wave * 16640);
    const int gw = F.vcu * NWAVES + F.wave, NGW = F.G * NWAVES;
    int it = gw, base = 0;
    cvt_matrix(F, F_w_in + (size_t)l * D * IN_COLS, D, IN_COLS, F_norm1_g + l * D, F_WIN, 0, true, it, base, scr); base += (D / 64) * (IN_COLS / 64);
    cvt_matrix(F, F_w_out + (size_t)l * D * D, D, D, nullptr, F_WOUT, 0, false, it, base, scr); base += (D / 64) * (D / 64);
    cvt_matrix(F, F_w_gate + (size_t)l * D * FF, D, FF, F_norm2_g + l * D, F_WGU, 0, false, it, base, scr); base += (D / 64) * (FF / 64);
    cvt_matrix(F, F_w_up + (size_t)l * D * FF, D, FF, F_norm2_g + l * D, F_WGU, FF, false, it, base, scr); base += (D / 64) * (FF / 64);
    cvt_matrix(F, F_w_down + (size_t)l * FF * D, FF, D, nullptr, F_WDN, 0, false, it, base, scr);
    if (l == 0) {
        for (int m = gw; m < M; m += NGW) { const float* xr = F_x + (size_t)m * D + 8 * F.lane; f32x4 v[16]; float ss = 0.f;
#pragma unroll
            for (int j = 0; j < 8; ++j) { v[2 * j] = *(const f32x4*)(xr + 512 * j); v[2 * j + 1] = *(const f32x4*)(xr + 512 * j + 4); }
#pragma unroll
            for (int j = 0; j < 16; ++j) ss += (v[j].x * v[j].x + v[j].y * v[j].y) + (v[j].z * v[j].z + v[j].w * v[j].w);
            ss = wave_sum(ss); if (F.lane == 0) F_rstd1[m] = 1.0f / sqrtf(ss * (1.0f / D) + EPS);
            bf16* o = F_XB + (size_t)m * D + 8 * F.lane;
#pragma unroll
            for (int j = 0; j < 8; ++j) *(v4u*)(o + 512 * j) = pg8::pack8(v[2 * j], v[2 * j + 1]); }
        { const int gt = gw * 64 + F.lane, NT = NGW * 64; const int j = gt & 127;
          const float inv = exp2f(-(float)j * (13.287712379549449f / 128.0f));
          for (int idx = gt; idx < M * 128; idx += NT) { const int m = idx >> 7; const float ang = (float)F_pos[m] * inv;
              const double a = (double)ang, k = rint(a * 0.15915494309189535), r = a - k * 6.283185307179586; const float rf = (float)r;
              const float c = cosf(rf), s = sinf(rf);
              F_cosb[idx] = c; F_sinb[idx] = s; F_cosT[(size_t)j * M + m] = c; F_sinT[(size_t)j * M + m] = s; } }
        if (blockIdx.x == 0 && F.tid < DEPTH * 2 * RH) { const float xl = F_dlogit[F.tid]; const float t = __expf(-xl);
            const float ser = t * (1.0f - t * (0.5f - t * (0.33333334f - t * (0.25f - t * 0.2f)))); F_lgam[F.tid] = -((t < 0.04f) ? ser : __logf(1.0f + t)); }
    } else rstd_from_part(F, F_rstd1);
}

__device__ __forceinline__ void mixer_a(Frame& F, int l) {
    const int gw = F.vcu * NWAVES + F.wave, NGW = F.G * NWAVES;
    for (int item = gw; item < (M / 32) * 4; item += NGW) {
        const int t0 = (item >> 2) * 32, c0 = (item & 3) * 512 + F.lane * 8;
        float w0[8], w1[8], w2[8], bb[8], be[8];
        { const float* cw = F_conv_a_w + (size_t)l * 3 * CW + c0; const float* cb = F_conv_a_b + (size_t)l * CW + c0; const float* bt = F_beta_a + (size_t)l * CW + c0;
#pragma unroll
          for (int j = 0; j < 8; ++j) { w0[j] = cw[j]; w1[j] = cw[CW + j]; w2[j] = cw[2 * CW + j]; bb[j] = cb[j]; be[j] = bt[j]; } }
        float pp[8], pc[8], pn[8];
        auto prod = [&](int t, float (&p)[8]) { const bf16* r = F_PROJ + (size_t)t * N1 + c0; float a[8], b[8]; unpack8(*(const v4u*)(r + COL_AC), a); unpack8(*(const v4u*)(r + COL_AX), b);
#pragma unroll
            for (int j = 0; j < 8; ++j) p[j] = a[j] * b[j]; };
        if ((t0 & (SEQ - 1)) == 0) {
#pragma unroll
            for (int j = 0; j < 8; ++j) pp[j] = 0.f;
        } else prod(t0 - 1, pp);
        prod(t0, pc);
        for (int t = t0; t < t0 + 32; ++t) {
            if ((t & (SEQ - 1)) == SEQ - 1) {
#pragma unroll
                for (int j = 0; j < 8; ++j) pn[j] = 0.f;
            } else prod(t + 1, pn);
            float ab[8], y[8]; unpack8(*(const v4u*)(F_PROJ + (size_t)t * N1 + COL_AB + c0), ab); float ss = 0.f;
#pragma unroll
            for (int j = 0; j < 8; ++j) { y[j] = ab[j] * (w0[j] * pp[j] + w1[j] * pc[j] + w2[j] * pn[j] + bb[j]); ss += y[j] * y[j]; }
            ss += __shfl_xor(ss, 1); ss += __shfl_xor(ss, 2); ss += __shfl_xor(ss, 4); ss += __shfl_xor(ss, 8);
            const float r = 1.0f / sqrtf(ss * (1.0f / 128.0f) + EPS);
            v4u o; o.x = pk2(y[0] * r * be[0], y[1] * r * be[1]); o.y = pk2(y[2] * r * be[2], y[3] * r * be[3]); o.z = pk2(y[4] * r * be[4], y[5] * r * be[5]); o.w = pk2(y[6] * r * be[6], y[7] * r * be[7]);
            *(v4u*)(F_YCAT + (size_t)t * D + c0) = o;
#pragma unroll
            for (int j = 0; j < 8; ++j) { pp[j] = pc[j]; pc[j] = pn[j]; }
        }
    }
}

#define MFMA32(a, b, c) __builtin_amdgcn_mfma_f32_32x32x16_bf16((a), (b), (c), 0, 0, 0)
__device__ __forceinline__ void scan_phase(Frame& F, int l) {
    const int gw = F.vcu * NWAVES + F.wave, NGW = F.G * NWAVES, li = F.lane & 31, hh = F.lane >> 5;
    for (int unit = gw; unit < BATCH * RH * 2 * 8 * 4; unit += NGW) {
        const int eq = unit & 3, dblk = (unit >> 2) & 7, dir = (unit >> 5) & 1, h = (unit >> 6) & 7, b = unit >> 9;
        const bf16* KT = (dir ? F_KBT : F_KFT) + (size_t)(h * HD + dblk * 32 + li) * M + (size_t)b * SEQ + 8 * hh;
        const bf16* VT = F_VT + (size_t)(h * HD + eq * 64 + li) * M + (size_t)b * SEQ + 8 * hh;
        bf16* ST = (dir ? F_SBT : F_SFT) + ((size_t)(b * RH + h) * NCH * HD + eq * 64 + li) * HD + dblk * 32 + 4 * hh;
        const float g128 = __expf(128.0f * F_lgam[l * 16 + dir * 8 + h]);
        f32x16 s0, s1;
#pragma unroll
        for (int r = 0; r < 16; ++r) { s0[r] = 0.f; s1[r] = 0.f; }
        for (int step = 0; step < NCH; ++step) {
            const int n = dir ? (NCH - 1 - step) : step;
            bf16* st = ST + (size_t)n * HD * HD;
#pragma unroll
            for (int g = 0; g < 4; ++g) { v2u a; a.x = pk2(s0[4 * g], s0[4 * g + 1]); a.y = pk2(s0[4 * g + 2], s0[4 * g + 3]); *(v2u*)(st + 8 * g) = a;
                v2u c; c.x = pk2(s1[4 * g], s1[4 * g + 1]); c.y = pk2(s1[4 * g + 2], s1[4 * g + 3]); *(v2u*)(st + 32 * HD + 8 * g) = c; }
#pragma unroll
            for (int r = 0; r < 16; ++r) { s0[r] *= g128; s1[r] *= g128; }
            const bf16* kt = KT + n * CHUNK; const bf16* vt = VT + n * CHUNK;
#pragma unroll
            for (int ks = 0; ks < 8; ++ks) { const bf16x8 a = *(const bf16x8*)(kt + 16 * ks), b0 = *(const bf16x8*)(vt + 16 * ks), b1 = *(const bf16x8*)(vt + (size_t)32 * M + 16 * ks);
                s0 = MFMA32(a, b0, s0); s1 = MFMA32(a, b1, s1); }
        }
    }
}

__device__ __forceinline__ void dma16(const char* g, LAS unsigned char* l) { __builtin_amdgcn_global_load_lds((const unsigned*)g, (LAS unsigned*)l, 16, 0, 0); }
__device__ __forceinline__ void intra_dma(Frame& F, const int kind, const int p, LAS unsigned char* dst, int b, int h, int n, int w, int lane) {
    const int tok0 = b * SEQ + n * CHUNK;
    if (kind == 4) {
        const int r0 = w * 4 + (lane >> 4), c = (lane & 15) ^ (r0 & 15);
        const char* g0 = (const char*)F_VT + ((size_t)(h * HD) * M + tok0) * 2 + c * 16;
#pragma unroll
        for (int q = 0; q < 4; ++q) { const int row = q * 32 + r0, e = 128 * (row >> 6) + 64 * p + (row & 63); dma16(g0 + (size_t)e * M * 2, dst + q * 8192 + w * 1024); }
    } else {
        const int r0 = w * 2 + (lane >> 5), c = (lane & 31) ^ (r0 & 15);
        if (kind == 0 || kind == 1) {
            const char* g0 = (const char*)F_PROJ + ((size_t)(tok0 + (kind == 1 ? 64 * p : 0) + r0) * N1 + (kind == 0 ? COL_Q : COL_K) + h * HD) * 2 + c * 16;
#pragma unroll
            for (int q = 0; q < (kind == 0 ? 8 : 4); ++q) dma16(g0 + (size_t)q * 16 * N1 * 2, dst + q * 8192 + w * 1024);
        } else {
            const char* g0 = (const char*)(kind == 2 ? F_SFT : F_SBT) + ((size_t)(b * RH + h) * NCH + n) * HD * HD * 2 + c * 16;
#pragma unroll
            for (int q = 0; q < 4; ++q) { const int row = q * 16 + r0, e = 128 * (row >> 5) + 32 * p + (row & 31); dma16(g0 + (size_t)e * HD * 2, dst + q * 8192 + w * 1024); }
        }
    }
}
__device__ __forceinline__ void intra_phase(Frame& F, int l) {
    LAS unsigned char* QS = F.lds + RING_OFF; LAS unsigned char* BUF = QS + 65536; LAS float* red1 = (LAS float*)(QS + 131072); LAS float* red2 = red1 + 256;
    const int w = F.wave, ib = w & 3, eh = w >> 2, li = F.lane & 31, hh = F.lane >> 5, sw = li & 15, yx = hh ^ sw;
    const float L2E = 1.4426950408889634f;
    const int nun = BATCH * RH * NCH;
    if (F.vcu < nun) { const int u0 = F.vcu; intra_dma(F, 0, 0, QS, u0 >> 8, (u0 >> 5) & 7, u0 & 31, w, F.lane); intra_dma(F, 1, 0, BUF, u0 >> 8, (u0 >> 5) & 7, u0 & 31, w, F.lane); }
    for (int unit = F.vcu; unit < nun; unit += F.G) {
        const int n = unit & 31, h = (unit >> 5) & 7, b = unit >> 8;
        const int nxt = unit + F.G; const bool has_next = nxt < nun; const int n2 = nxt & 31, h2 = (nxt >> 5) & 7, b2 = nxt >> 8;
        int i = 32 * ib + li; asm volatile("" : "+v"(i));
        const int tok0 = b * SEQ + n * CHUNK, tok = tok0 + i;
        const float lf = F_lgam[l * 16 + h], lb = F_lgam[l * 16 + 8 + h];
        const float lf2 = lf * L2E, lb2 = lb * L2E;
        const LAS unsigned char* qrow = QS + (32 * ib + li) * 512;
#define QF(s) (*(const LAS bf16x8*)(qrow + (((2 * (s)) ^ yx) << 4)))
        bf16x8 pf[4][2];
        f32x16 acc[4];
#pragma unroll
        for (int et = 0; et < 4; ++et)
#pragma unroll
            for (int r = 0; r < 16; ++r) acc[et][r] = 0.f;
#pragma unroll
        for (int t = 0; t < 12; ++t) {
            VM_WAIT(); __syncthreads();
            LAS unsigned char* nb = BUF + ((t + 1) & 1) * 32768; const LAS unsigned char* cb = BUF + (t & 1) * 32768;
            int ln = F.lane; asm volatile("" : "+v"(ln));
            if (t < 11) { const int t1 = t + 1; intra_dma(F, t1 < 2 ? 1 : (t1 < 6 ? 2 : (t1 < 10 ? 3 : 4)), t1 < 2 ? t1 : (t1 < 6 ? t1 - 2 : (t1 < 10 ? t1 - 6 : t1 - 10)), nb, b, h, n, w, ln); }
            else if (has_next) intra_dma(F, 1, 0, nb, b2, h2, n2, w, ln);
            if (t == 10 && has_next) intra_dma(F, 0, 0, QS, b2, h2, n2, w, ln);
            if (t < 2) {
#pragma unroll
                for (int jtl = 0; jtl < 2; ++jtl) { const int jt = 2 * t + jtl; const LAS unsigned char* krow = cb + (32 * jtl + li) * 512;
                    f32x16 sc;
#pragma unroll
                    for (int r = 0; r < 16; ++r) sc[r] = 0.f;
#pragma unroll
                    for (int s = 0; s < 16; ++s) { const bf16x8 a = *(const LAS bf16x8*)(krow + (((2 * s) ^ yx) << 4)); sc = MFMA32(a, QF(s), sc); }
#pragma unroll
                    for (int s2 = 0; s2 < 2; ++s2) {
                        float pv[8];
#pragma unroll
                        for (int jj = 0; jj < 8; ++jj) { const int r = 8 * s2 + jj; const int j = 32 * jt + (r & 3) + 8 * (r >> 2) + 4 * hh; const int dd = i - j;
                            const float e = (dd >= 0) ? lf2 * (float)dd : lb2 * (float)(-dd); pv[jj] = sc[r] * exp2f(e); }
                        v4u pw; pw.x = pk2(pv[0], pv[1]); pw.y = pk2(pv[2], pv[3]); pw.z = pk2(pv[4], pv[5]); pw.w = pk2(pv[6], pv[7]);
                        pf[jt][s2] = __builtin_bit_cast(bf16x8, pw); } }
            } else if (t < 10) {
                const int et = (t - 2) & 3; const LAS unsigned char* srow = cb + (32 * eh + li) * 512;
#pragma unroll
                for (int s = 0; s < 16; ++s) { const bf16x8 a = *(const LAS bf16x8*)(srow + (((2 * s) ^ yx) << 4)); acc[et] = MFMA32(a, QF(s), acc[et]); }
                if (t == 5) { const float ratio = __expf(lf * (float)(i + 1) - lb * (float)(CHUNK - i));
#pragma unroll
                    for (int e2 = 0; e2 < 4; ++e2)
#pragma unroll
                        for (int r = 0; r < 16; ++r) acc[e2][r] *= ratio; }
                if (t == 9) { const float wb = __expf(lb * (float)(CHUNK - i));
#pragma unroll
                    for (int e2 = 0; e2 < 4; ++e2)
#pragma unroll
                        for (int r = 0; r < 16; ++r) acc[e2][r] *= wb; }
            } else {
                const int p = t - 10;
#pragma unroll
                for (int etl = 0; etl < 2; ++etl) { const int et = 2 * p + etl; const LAS unsigned char* vrow = cb + (64 * eh + 32 * etl + li) * 256 + 8 * hh;
#pragma unroll
                    for (int jt = 0; jt < 4; ++jt)
#pragma unroll
                        for (int s2 = 0; s2 < 2; ++s2) { const v2u lo = *(const LAS v2u*)(vrow + (((4 * jt + 2 * s2) ^ sw) << 4)), hi = *(const LAS v2u*)(vrow + (((4 * jt + 2 * s2 + 1) ^ sw) << 4));
                            v4u aw; aw.x = lo.x; aw.y = lo.y; aw.z = hi.x; aw.w = hi.y;
                            acc[et] = MFMA32(__builtin_bit_cast(bf16x8, aw), pf[jt][s2], acc[et]); } }
            }
        }
#undef QF
        float s = 0.f;
#pragma unroll
        for (int et = 0; et < 4; ++et)
#pragma unroll
            for (int r = 0; r < 16; ++r) s += acc[et][r];
        s += __shfl_xor(s, 32);
        if (hh == 0) red1[w * 32 + li] = s;
        LDS_WAIT(); __syncthreads();
        const float mean = (red1[ib * 32 + li] + red1[(ib + 4) * 32 + li]) * (1.0f / HD);
        float q = 0.f;
#pragma unroll
        for (int et = 0; et < 4; ++et)
#pragma unroll
            for (int r = 0; r < 16; ++r) { const float dlt = acc[et][r] - mean; q += dlt * dlt; }
        q += __shfl_xor(q, 32);
        if (hh == 0) red2[w * 32 + li] = q;
        LDS_WAIT(); __syncthreads();
        const float rstd = 1.0f / sqrtf((red2[ib * 32 + li] + red2[(ib + 4) * 32 + li]) * (1.0f / HD) + EPS);
        { const float* gn = F_gn_g + (size_t)l * RW + h * HD; const bf16* gp = F_PROJ + (size_t)tok * N1 + COL_G + h * HD; bf16* yp = F_YCAT + (size_t)tok * D + CW + h * HD;
#pragma unroll
          for (int et = 0; et < 4; ++et)
#pragma unroll
              for (int g = 0; g < 4; ++g) { const int e4 = 128 * eh + 32 * et + 8 * g + 4 * hh; const f32x4 gv = *(const f32x4*)(gn + e4); const v2u gw2 = *(const v2u*)(gp + e4);
                  const float gt[4] = {bflo(gw2.x), bfhi(gw2.x), bflo(gw2.y), bfhi(gw2.y)}; float y[4];
#pragma unroll
                  for (int j = 0; j < 4; ++j) { const float sg = gt[j] / (1.0f + __expf(-gt[j])); y[j] = (acc[et][4 * g + j] - mean) * rstd * gv[j] * sg; }
                  v2u o; o.x = pk2(y[0], y[1]); o.y = pk2(y[2], y[3]); *(v2u*)(yp + e4) = o; } }
    }
    VM_WAIT(); __syncthreads();
}

__device__ __forceinline__ void act_phase(Frame& F, int l) {
    const int gw = F.vcu * NWAVES + F.wave, NGW = F.G * NWAVES;
    for (int item = gw; item < (M / 32) * 22; item += NGW) {
        const int tb = item / 22, cg = item - tb * 22; const int t0 = tb * 32, c0 = cg * 512 + F.lane * 8;
        if (c0 >= FF) continue;
        float w0[8], w1[8], w2[8], bb[8];
        { const float* cw = F_ffn_w + (size_t)l * 3 * FF + c0; const float* cb = F_ffn_b + (size_t)l * FF + c0;
#pragma unroll
          for (int j = 0; j < 8; ++j) { w0[j] = cw[j]; w1[j] = cw[FF + j]; w2[j] = cw[2 * FF + j]; bb[j] = cb[j]; } }
        float gp[8], gc[8], gn[8];
        if ((t0 & (SEQ - 1)) == 0) {
#pragma unroll
            for (int j = 0; j < 8; ++j) gp[j] = 0.f;
        } else unpack8(*(const v4u*)(F_GU + (size_t)(t0 - 1) * NGU + c0), gp);
        unpack8(*(const v4u*)(F_GU + (size_t)t0 * NGU + c0), gc);
        for (int t = t0; t < t0 + 32; ++t) {
            if ((t & (SEQ - 1)) == SEQ - 1) {
#pragma unroll
                for (int j = 0; j < 8; ++j) gn[j] = 0.f;
            } else unpack8(*(const v4u*)(F_GU + (size_t)(t + 1) * NGU + c0), gn);
            float u[8], y[8]; unpack8(*(const v4u*)(F_GU + (size_t)t * NGU + FF + c0), u);
#pragma unroll
            for (int j = 0; j < 8; ++j) { const float z = w0[j] * gp[j] + w1[j] * gc[j] + w2[j] * gn[j] + bb[j]; y[j] = z / (1.0f + __expf(-z)) * u[j]; }
            v4u o; o.x = pk2(y[0], y[1]); o.y = pk2(y[2], y[3]); o.z = pk2(y[4], y[5]); o.w = pk2(y[6], y[7]);
            *(v4u*)(F_ACT + (size_t)t * FF + c0) = o;
#pragma unroll
            for (int j = 0; j < 8; ++j) { gp[j] = gc[j]; gc[j] = gn[j]; }
        }
    }
}

__device__ __forceinline__ void final_phase(Frame& F) {
    const int gw = F.vcu * NWAVES + F.wave, NGW = F.G * NWAVES;
    for (int m = gw; m < M; m += NGW) {
        const float s = wave_sum(F_part[(size_t)m * 64 + F.lane]); const float rs = 1.0f / sqrtf(s * (1.0f / D) + EPS);
        float* xr = F_out + (size_t)m * D + 4 * F.lane; const float* gr = F_norm_f + 4 * F.lane;
#pragma unroll
        for (int j = 0; j < 16; ++j) { const f32x4 v = *(const f32x4*)(xr + 256 * j), g = *(const f32x4*)(gr + 256 * j); *(f32x4*)(xr + 256 * j) = v * rs * g; }
    }
}

constexpr int PH_PER_LAYER = 9, N_PHASES = DEPTH * PH_PER_LAYER + 1;

__global__ void __launch_bounds__(NWAVES * 64, 2) enc_fwd(Args args) {
    extern __shared__ __attribute__((aligned(16))) unsigned char lds[];
    Frame F;
    F.lds = (LAS unsigned char*)lds;
    volatile LAS unsigned* MISC = (volatile LAS unsigned*)(F.lds + MISC_OFF);
    F.tid = threadIdx.x; F.lane = F.tid & 63; F.wave = __builtin_amdgcn_readfirstlane(F.tid >> 6);
    F.G = gridDim.x; { const int bx = blockIdx.x; F.vcu = (F.G % 8 == 0) ? (bx % 8) * (F.G / 8) + bx / 8 : bx; }
    F.ap = (const __attribute__((address_space(4))) Args*)__builtin_amdgcn_kernarg_segment_ptr();
    unsigned char* ws = args.ws;
    for (int u = F.tid; u < (LDS_BYTES - LDSCTL_OFF) / 4; u += NWAVES * 64) ((LAS unsigned*)(F.lds + LDSCTL_OFF))[u] = 0u;
    __syncthreads();
    XcdBarrier bar; bar.bar = (unsigned*)(ws + WS_CTL) + CW_BAR; bar.x = 0; bar.st = nullptr;
#if !MK_SPLIT
    bar = xcd_barrier_post((unsigned*)(ws + WS_CTL) + CW_BAR, MISC + 8);
#define GRID_BAR() xcd_barrier(bar)
#else
#define GRID_BAR() do {} while (0)
#endif
    const int lo = args.ph_lo, hi = args.ph_hi;
#define IN(k) (lo <= (k) && (k) < hi)
#define SEAM(k) do { if (IN(k) && IN((k) + 1)) GRID_BAR(); } while (0)
    using namespace pg8;
    for (int l = 0; l < DEPTH; ++l) {
        const int pb = l * PH_PER_LAYER;
#define LAUNDER() do { F.tid = threadIdx.x; asm volatile("" : "+v"(F.tid), "+s"(F.ap)); F.lane = F.tid & 63; } while (0)
        if (PHON(0) && IN(pb + 0)) { for (int rp = 0; rp < PHREP(0); ++rp) { LAUNDER(); p0_phase(F, l); } } SEAM(pb + 0);
        if (PHON(1) && IN(pb + 1)) { LAUNDER();
            { Gemm g{F_XB, F_WIN, M, N1, D}; StaticOrder S; S.init(M, N1, F.G, (int)blockIdx.x); EpiIn E{F_PROJ, N1, F_rstd1, F_cosb, F_sinb};
              gemm_phase<EpiIn, StaticOrder, PG8_ALIGN, PG8_SP2>(F.lds + RING_OFF, g, S, E); }
            { Gemm g{F_WIN + (size_t)COL_K * D, F_XB, 2 * RW, M, D}; StaticOrder S; S.init(2 * RW, M, F.G, (int)blockIdx.x); EpiKV E{F_KFT, F_KBT, F_VT, M, F_rstd1, F_cosT, F_sinT, F_lgam + l * 16};
              gemm_phase<EpiKV, StaticOrder, PG8_ALIGN, PG8_SP2>(F.lds + RING_OFF, g, S, E); }
        } SEAM(pb + 1);
        if (PHON(2) && IN(pb + 2)) { for (int rp = 0; rp < PHREP(2); ++rp) { LAUNDER(); mixer_a(F, l); scan_phase(F, l); } } SEAM(pb + 2);
        if (PHON(3) && IN(pb + 3)) { for (int rp = 0; rp < PHREP(3); ++rp) { LAUNDER(); intra_phase(F, l); } } SEAM(pb + 3);
        if (PHON(4) && IN(pb + 4)) { LAUNDER(); Gemm g{F_YCAT, F_WOUT, M, D, D}; StaticOrder S; S.init(M, D, F.G, (int)blockIdx.x); EpiRes E{l == 0 ? F_x : F_out, F_out, F_XB, F_part, D};
            gemm_phase<EpiRes, StaticOrder, PG8_ALIGN, PG8_SP2>(F.lds + RING_OFF, g, S, E); } SEAM(pb + 4);
        if (PHON(5) && IN(pb + 5)) { for (int rp = 0; rp < PHREP(5); ++rp) { LAUNDER(); rstd_from_part(F, F_rstd2); } } SEAM(pb + 5);
        if (PHON(6) && IN(pb + 6)) { LAUNDER(); Gemm g{F_XB, F_WGU, M, NGU, D}; StaticOrder S; S.init(M, NGU, F.G, (int)blockIdx.x); EpiScale E{F_GU, NGU, F_rstd2};
            gemm_phase<EpiScale, StaticOrder, PG8_ALIGN, PG8_SP2>(F.lds + RING_OFF, g, S, E); } SEAM(pb + 6);
#if PROBE_GEMM
        if (IN(pb + 6)) { GRID_BAR(); LAUNDER(); Gemm g{F_XB, F_WGU, M, FF, D}; ProbeOrder S; S.init(M, FF, F.G, (int)blockIdx.x); EpiScale E{F_ACT, FF, F_rstd2};
            gemm_phase<EpiScale, ProbeOrder, PG8_ALIGN, PG8_SP2>(F.lds + RING_OFF, g, S, E); GRID_BAR(); }
#endif
        if (PHON(7) && IN(pb + 7)) { for (int rp = 0; rp < PHREP(7); ++rp) { LAUNDER(); act_phase(F, l); } } SEAM(pb + 7);
        if (PHON(8) && IN(pb + 8)) { LAUNDER(); Gemm g{F_ACT, F_WDN, M, D, FF}; StaticOrder S; S.init(M, D, F.G, (int)blockIdx.x); EpiRes E{F_out, F_out, F_XB, F_part, D};
            gemm_phase<EpiRes, StaticOrder, PG8_ALIGN, PG8_SP2>(F.lds + RING_OFF, g, S, E); } SEAM(pb + 8);
    }
    if (PHON(9) && IN(N_PHASES - 1)) { LAUNDER(); final_phase(F); }
#undef IN
#undef SEAM
}

extern "C" void kernel_launch(void* const* d_in, const int* in_sizes, int n_in, void* d_out, int out_size, void* d_ws, size_t ws_size, hipStream_t stream) {
    static int grid = 0;
    if (grid == 0) {
        if (n_in != 17 || in_sizes[0] != M * D || out_size != M * D || ws_size < WS_END) { fprintf(stderr, "kernel_launch: unexpected shapes (n_in %d, in0 %d, out %d, ws %zu < %zu?)\n", n_in, n_in > 0 ? in_sizes[0] : -1, out_size, ws_size, (size_t)WS_END); grid = -1; return; }
        int dev = 0, cus = 0, per_cu = 0;
        if (hipGetDevice(&dev) != hipSuccess || hipDeviceGetAttribute(&cus, hipDeviceAttributeMultiprocessorCount, dev) != hipSuccess) { grid = -1; return; }
        if (hipFuncSetAttribute((const void*)enc_fwd, hipFuncAttributeMaxDynamicSharedMemorySize, LDS_BYTES) != hipSuccess) { fprintf(stderr, "kernel_launch: hipFuncSetAttribute failed\n"); grid = -1; return; }
        if (hipOccupancyMaxActiveBlocksPerMultiprocessor(&per_cu, (const void*)enc_fwd, NWAVES * 64, LDS_BYTES) != hipSuccess || per_cu < 1) fprintf(stderr, "kernel_launch: occupancy query reports %d\n", per_cu);
        (void)hipGetLastError();
        grid = cus;
    }
    if (grid < 0) return;
    if (hipMemsetAsync((char*)d_ws + WS_CTL, 0, CTL_ZERO_BYTES, stream) != hipSuccess) { fprintf(stderr, "kernel_launch: memset failed\n"); return; }
    Args a{};
    for (int i = 0; i < 17; ++i) a.in[i] = d_in[i];
    a.out = (float*)d_out; a.ws = (unsigned char*)d_ws;
#if MK_SPLIT
    for (int p = 0; p < N_PHASES; ++p) { a.ph_lo = p; a.ph_hi = p + 1; hipLaunchKernelGGL(enc_fwd, dim3(grid), dim3(NWAVES * 64), LDS_BYTES, stream, a); }
#else
    a.ph_lo = 0; a.ph_hi = N_PHASES;
    hipLaunchKernelGGL(enc_fwd, dim3(grid), dim3(NWAVES * 64), LDS_BYTES, stream, a);
#endif
    const hipError_t le = hipPeekAtLastError();
    if (le != hipSuccess) fprintf(stderr, "kernel_launch: launch failed: %s\n", hipGetErrorName(le));
}
```

```cpp
#include <hip/hip_runtime.h>
#include <cstdio>
#include <cstdint>

#ifndef PH_MASK
#define PH_MASK 0x3ff
#endif
#define PHON(k) ((PH_MASK >> (k)) & 1)
#ifndef PH_REPEAT
#define PH_REPEAT 0
#endif
#define PHREP(k) (((PH_REPEAT >> (k)) & 1) ? 2 : 1)
#ifndef MK_SPLIT
#define MK_SPLIT 0
#endif

namespace pg8 {
#define PG8_LAS __attribute__((address_space(3)))
typedef unsigned short bf16_t;
typedef short bf16x8 __attribute__((ext_vector_type(8)));
typedef float f32x4 __attribute__((ext_vector_type(4)));
typedef unsigned u32x4 __attribute__((ext_vector_type(4)));
constexpr int BM = 256, BK = 64, HALF = 128, HTB = HALF * BK * 2  , STAGE_BYTES = 8 * HTB, NXCD = 8, WGM = 8;

__host__ __device__ __forceinline__ int lds_byte(int r, int c) { const int st = (r >> 4) * 2 + (c >> 5), rr = r & 15, cc = c & 31, ob = rr * 64 + cc * 2; return st * 1024 + (ob ^ (((ob >> 9) & 1) << 5)); }
__host__ __device__ __forceinline__ void stage_rc(int b, int& R, int& C) { const int st = b / 1024, sb = b % 1024, swz = sb ^ (((sb >> 9) & 1) << 5); R = (st >> 1) * 16 + swz / 64; C = (st & 1) * 32 + (swz % 64) / 2; }
__host__ __device__ __forceinline__ int perm32(int rho) { const int n = rho >> 4, i = rho & 15; return 8 * (i >> 2) + 4 * n + (i & 3); }

struct Unit { int pm, pn; };
struct Gemm { const bf16_t* A; const bf16_t* Bt; int M, N, K; };

struct StaticOrder {
    int nM, nN, nwg, G, c;
    __host__ __device__ void init(int M, int N, int G_, int c_) { nM = M / BM; nN = N / BM; nwg = nM * nN; G = G_; c = c_; }
    __host__ __device__ bool next(int i, Unit& u) const {
        const long L = (long)i * G + c; if (L >= nwg) return false;
        int wgid = (int)L; { const int q = nwg / NXCD, r = nwg % NXCD, xcd = wgid % NXCD, off = wgid / NXCD; wgid = (xcd < r ? xcd * (q + 1) : r * (q + 1) + (xcd - r) * q) + off; }
        const int nig = WGM * nN, gid = wgid / nig, fm = gid * WGM, gsz = (nM - fm) < WGM ? (nM - fm) : WGM;
        u.pm = fm + ((wgid % nig) % gsz); u.pn = (wgid % nig) / gsz; return true;
    }
    __device__ __forceinline__ void a_ready(const Unit&) const {}
    __device__ __forceinline__ void done(const Unit&) const {}
};

#ifndef PROBE_GEMM
#define PROBE_GEMM 0
#endif
struct ProbeOrder : StaticOrder {
    __host__ __device__ bool next(int i, Unit& u) const { const bool ok = StaticOrder::next(i, u); if (PROBE_GEMM == 2) { u.pm = 0; u.pn = 0; } return ok; }
};
__device__ __forceinline__ unsigned cvt_pk_bf16(float lo, float hi) { unsigned r; asm volatile("v_cvt_pk_bf16_f32 %0, %1, %2" : "=v"(r) : "v"(lo), "v"(hi)); return r; }
__device__ __forceinline__ u32x4 pack8(const f32x4 a, const f32x4 b) { u32x4 w; w.x = cvt_pk_bf16(a[0], a[1]); w.y = cvt_pk_bf16(a[2], a[3]); w.z = cvt_pk_bf16(b[0], b[1]); w.w = cvt_pk_bf16(b[2], b[3]); return w; }

struct EpiIn {
    static constexpr bool PERM = true, AFTER_DRAIN = false;
    bf16_t* O; int ldc; const float* rstd; const float* cosb; const float* sinb;
    __device__ __forceinline__ void operator()(const f32x4 (&acc)[2][2][4][2], const Unit& u, int wr, int wc, int fr, int fq) const {
        asm volatile("" : "+v"(fr), "+v"(fq));
        const int row0 = u.pm * BM + wr * 64 + fr, col0 = u.pn * BM + wc * 32 + 8 * fq, typ = u.pn >> 3;
        const bool rot = (typ == 3) || (typ == 5); const float osc = (typ == 3) ? 0.0625f : 1.0f;
#pragma unroll
        for (int ai = 0; ai < 2; ++ai)
#pragma unroll
            for (int m = 0; m < 4; ++m) { const int row = row0 + ai * HALF + m * 16; const float rs = rstd[row]; bf16_t* rowp = O + (size_t)row * ldc + col0;
                if (rot) { const float sc = rs * osc; const float* cp = cosb + (size_t)row * 128 + wc * 32 + 8 * fq; const float* sp = sinb + (size_t)row * 128 + wc * 32 + 8 * fq;
                    const f32x4 c0 = *(const f32x4*)cp, c1 = *(const f32x4*)(cp + 4), s0 = *(const f32x4*)sp, s1 = *(const f32x4*)(sp + 4);
                    const f32x4 a0 = acc[ai][0][m][0] * sc, a1 = acc[ai][0][m][1] * sc, b0 = acc[ai][1][m][0] * sc, b1 = acc[ai][1][m][1] * sc;
                    *(u32x4*)(rowp) = pack8(a0 * c0 - b0 * s0, a1 * c1 - b1 * s1);
                    *(u32x4*)(rowp + HALF) = pack8(b0 * c0 + a0 * s0, b1 * c1 + a1 * s1);
                } else {
#pragma unroll
                    for (int bj = 0; bj < 2; ++bj) *(u32x4*)(rowp + bj * HALF) = pack8(acc[ai][bj][m][0] * rs, acc[ai][bj][m][1] * rs);
                } }
    }
};
struct EpiKV {
    static constexpr bool PERM = true, AFTER_DRAIN = false;
    bf16_t* KFT; bf16_t* KBT; bf16_t* VT; int ldc; const float* rstd; const float* cosT; const float* sinT; const float* lgam;
    __device__ __forceinline__ void operator()(const f32x4 (&acc)[2][2][4][2], const Unit& u, int wr, int wc, int fr, int fq) const {
        asm volatile("" : "+v"(fr), "+v"(fq));
        const int tok0 = u.pn * BM + wc * 32 + 8 * fq;
        if (u.pm < 8) {
            const int h = u.pm; const float lf = lgam[h], lb = lgam[8 + h];
#pragma unroll
            for (int bj = 0; bj < 2; ++bj) { const int tok = tok0 + bj * HALF; const f32x4 r0 = *(const f32x4*)(rstd + tok), r1 = *(const f32x4*)(rstd + tok + 4);
                f32x4 wf0, wf1, wb0, wb1; const int cpos = wc * 32 + 8 * fq;
#pragma unroll
                for (int j = 0; j < 4; ++j) { wf0[j] = __expf(lf * (float)(127 - (cpos + j))); wf1[j] = __expf(lf * (float)(127 - (cpos + 4 + j))); wb0[j] = __expf(lb * (float)(cpos + j)); wb1[j] = __expf(lb * (float)(cpos + 4 + j)); }
#pragma unroll
                for (int m = 0; m < 4; ++m) { const int d = wr * 64 + m * 16 + fr;
                    const float* cp = cosT + (size_t)d * ldc + tok; const float* sp = sinT + (size_t)d * ldc + tok;
                    const f32x4 c0 = *(const f32x4*)cp, c1 = *(const f32x4*)(cp + 4), s0 = *(const f32x4*)sp, s1 = *(const f32x4*)(sp + 4);
                    const f32x4 a0 = acc[0][bj][m][0] * r0, a1 = acc[0][bj][m][1] * r1, b0 = acc[1][bj][m][0] * r0, b1 = acc[1][bj][m][1] * r1;
                    const f32x4 o10 = a0 * c0 - b0 * s0, o11 = a1 * c1 - b1 * s1, o20 = b0 * c0 + a0 * s0, o21 = b1 * c1 + a1 * s1;
                    const size_t off1 = ((size_t)((tok >> 12) * 8 + h) * 32 + ((tok >> 7) & 31)) * 32768 + (size_t)d * 128 + (tok & 127), off2 = off1 + (size_t)128 * 128;
                    *(u32x4*)(KFT + off1) = pack8(o10 * wf0, o11 * wf1); *(u32x4*)(KFT + off2) = pack8(o20 * wf0, o21 * wf1);
                    *(u32x4*)(KBT + off1) = pack8(o10 * wb0, o11 * wb1); *(u32x4*)(KBT + off2) = pack8(o20 * wb0, o21 * wb1); } }
        } else {
#pragma unroll
            for (int bj = 0; bj < 2; ++bj) { const int tok = tok0 + bj * HALF; const f32x4 r0 = *(const f32x4*)(rstd + tok), r1 = *(const f32x4*)(rstd + tok + 4);
#pragma unroll
                for (int ai = 0; ai < 2; ++ai)
#pragma unroll
                    for (int m = 0; m < 4; ++m) *(u32x4*)(VT + ((size_t)((tok >> 12) * 8 + (u.pm - 8)) * 32 + ((tok >> 7) & 31)) * 32768 + (size_t)(wr * 64 + fr + ai * HALF + m * 16) * 128 + (tok & 127)) = pack8(acc[ai][bj][m][0] * r0, acc[ai][bj][m][1] * r1); }
        }
    }
};
struct EpiScale {
    static constexpr bool PERM = true, AFTER_DRAIN = false;
    bf16_t* O; int ldc; const float* rstd;
    __device__ __forceinline__ void operator()(const f32x4 (&acc)[2][2][4][2], const Unit& u, int wr, int wc, int fr, int fq) const {
        asm volatile("" : "+v"(fr), "+v"(fq));
        const int row0 = u.pm * BM + wr * 64 + fr, col0 = u.pn * BM + wc * 32 + 8 * fq;
#pragma unroll
        for (int ai = 0; ai < 2; ++ai)
#pragma unroll
            for (int m = 0; m < 4; ++m) { const int row = row0 + ai * HALF + m * 16; const float rs = rstd[row]; bf16_t* rowp = O + (size_t)row * ldc + col0;
#pragma unroll
                for (int bj = 0; bj < 2; ++bj) *(u32x4*)(rowp + bj * HALF) = pack8(acc[ai][bj][m][0] * rs, acc[ai][bj][m][1] * rs); }
    }
};
struct EpiRes {
    static constexpr bool PERM = true, AFTER_DRAIN = false;
    const float* xin32; bf16_t* xb; float* part; int ldc;
    __device__ __forceinline__ void operator()(const f32x4 (&acc)[2][2][4][2], const Unit& u, int wr, int wc, int fr, int fq) const {
        asm volatile("" : "+v"(fr), "+v"(fq));
        const int row0 = u.pm * BM + wr * 64 + fr, col0 = u.pn * BM + wc * 32 + 8 * fq;
#pragma unroll
        for (int ai = 0; ai < 2; ++ai)
#pragma unroll
            for (int m = 0; m < 4; ++m) { const int row = row0 + ai * HALF + m * 16; const size_t off = (size_t)row * ldc + col0; float ss = 0.f;
#pragma unroll
                for (int bj = 0; bj < 2; ++bj) { f32x4 x0, x1;
                    if (xin32) { x0 = *(const f32x4*)(xin32 + off + bj * HALF); x1 = *(const f32x4*)(xin32 + off + bj * HALF + 4); }
                    else { const u32x4 w = *(const u32x4*)(xb + off + bj * HALF);
                        x0 = (f32x4){__uint_as_float(w.x << 16), __uint_as_float(w.x & 0xffff0000u), __uint_as_float(w.y << 16), __uint_as_float(w.y & 0xffff0000u)};
                        x1 = (f32x4){__uint_as_float(w.z << 16), __uint_as_float(w.z & 0xffff0000u), __uint_as_float(w.w << 16), __uint_as_float(w.w & 0xffff0000u)}; }
                    const f32x4 v0 = x0 + acc[ai][bj][m][0], v1 = x1 + acc[ai][bj][m][1];
                    *(u32x4*)(xb + off + bj * HALF) = pack8(v0, v1);
                    ss += (v0[0] * v0[0] + v0[1] * v0[1]) + (v0[2] * v0[2] + v0[3] * v0[3]) + (v1[0] * v1[0] + v1[1] * v1[1]) + (v1[2] * v1[2] + v1[3] * v1[3]); }
                ss += __shfl_xor(ss, 16); ss += __shfl_xor(ss, 32);
                if (fq == 0) part[(size_t)row * 64 + u.pn * 4 + wc] = ss; }
    }
};

template <class Epi, class Sched, bool ALIGN_EPI = false, bool SP2 = false>
__device__ __forceinline__ void gemm_phase(PG8_LAS unsigned char* lds, const Gemm g, const Sched& S, const Epi& E) {
    int tid_ = threadIdx.x; asm volatile("" : "+v"(tid_));
    const int tid = tid_, wid = __builtin_amdgcn_readfirstlane(tid >> 6), lane = tid & 63, wr = wid >> 2, wc = wid & 3, fr = lane & 15, fq = lane >> 4;
    const int K = g.K, nt = K / BK;
    unsigned voffA[2], voffB[2];
#pragma unroll
    for (int i = 0; i < 2; ++i) { int R, C; stage_rc(tid * 16 + i * 8192, R, C); const int Rb = Epi::PERM ? ((R & ~31) + perm32(R & 31)) : R;
        voffA[i] = (unsigned)(R * K + C) * 2u; voffB[i] = (unsigned)(Rb * K + C) * 2u; }
    const size_t kstep = (size_t)(BK * 2);
    const size_t hstep = (size_t)HALF * K * 2;
    const size_t tstep = 2 * hstep;
    const unsigned ldsw = (unsigned)wid * 1024u;
    const int aoff = lds_byte(wr * 64 + fr, fq * 8), boff = lds_byte(wc * 32 + fr, fq * 8);
#define PG8_SA(b, h) (((b) * 2 + (h)) * HTB)
#define PG8_SB(b, h) ((4 + (b) * 2 + (h)) * HTB)
#define PG8_STAGE(bufoff, gbase, voff) do { _Pragma("unroll") for (int _i = 0; _i < 2; ++_i) \
        __builtin_amdgcn_global_load_lds((const unsigned*)((const char*)(gbase) + (voff)[_i]), (PG8_LAS unsigned*)(lds + (bufoff) + ldsw + _i * 8192), 16, 0, 0); } while (0)
#define PG8_LDA(dst, b, h) do { _Pragma("unroll") for (int m = 0; m < 4; ++m) _Pragma("unroll") for (int k = 0; k < 2; ++k) dst[m][k] = *(const PG8_LAS bf16x8*)(lds + PG8_SA(b, h) + aoff + m * 2048 + k * 1024); } while (0)
#define PG8_LDB(dst, b, h) do { _Pragma("unroll") for (int n = 0; n < 2; ++n) _Pragma("unroll") for (int k = 0; k < 2; ++k) dst[n][k] = *(const PG8_LAS bf16x8*)(lds + PG8_SB(b, h) + boff + n * 2048 + k * 1024); } while (0)
#define PG8_MMA(ai, bj, At, Bt) do { __builtin_amdgcn_s_setprio(1); _Pragma("unroll") for (int m = 0; m < 4; ++m) _Pragma("unroll") for (int n = 0; n < 2; ++n) _Pragma("unroll") for (int k = 0; k < 2; ++k) \
        acc[ai][bj][m][n] = __builtin_amdgcn_mfma_f32_16x16x32_bf16(Bt[n][k], At[m][k], acc[ai][bj][m][n], 0, 0, 0); __builtin_amdgcn_s_setprio(0); } while (0)
#define PG8_WAIT_V(n) asm volatile("s_waitcnt vmcnt(" #n ")" ::: "memory")
#define PG8_WAIT_L(n) asm volatile("s_waitcnt lgkmcnt(" #n ")" ::: "memory")
#define PG8_BAR __builtin_amdgcn_s_barrier()
#define PG8_SCHED __builtin_amdgcn_sched_barrier(0)
    Unit cur, nxt; int ui = 0;
    if (!S.next(0, cur)) return;
    f32x4 acc[2][2][4][2];
#pragma unroll
    for (int a = 0; a < 2; ++a)
#pragma unroll
        for (int b = 0; b < 2; ++b)
#pragma unroll
            for (int m = 0; m < 4; ++m)
#pragma unroll
                for (int n = 0; n < 2; ++n) acc[a][b][m][n] = (f32x4){0.f, 0.f, 0.f, 0.f};
    bf16x8 At[4][2], B0[2][2], B1[2][2];
    const char* cA = (const char*)g.A + (size_t)cur.pm * tstep; const char* cB = (const char*)g.Bt + (size_t)cur.pn * tstep;
    S.a_ready(cur);
    if constexpr (SP2) {
        PG8_STAGE(PG8_SB(0, 0), cB, voffB); PG8_STAGE(PG8_SB(0, 1), cB + hstep, voffB); PG8_STAGE(PG8_SA(0, 0), cA, voffA); PG8_STAGE(PG8_SA(0, 1), cA + hstep, voffA);
        if (wr == 1) PG8_BAR;
        PG8_WAIT_V(2); PG8_BAR;
        PG8_STAGE(PG8_SB(1, 0), cB + kstep, voffB); PG8_STAGE(PG8_SA(1, 0), cA + kstep, voffA); PG8_STAGE(PG8_SB(1, 1), cB + hstep + kstep, voffB);
        PG8_WAIT_V(6); PG8_BAR;
    } else {
        PG8_STAGE(PG8_SB(0, 0), cB, voffB); PG8_STAGE(PG8_SA(0, 0), cA, voffA); PG8_STAGE(PG8_SB(0, 1), cB + hstep, voffB); PG8_STAGE(PG8_SA(0, 1), cA + hstep, voffA);
        if (wr == 1) PG8_BAR;
        PG8_WAIT_V(4); PG8_BAR;
        PG8_STAGE(PG8_SB(1, 0), cB + kstep, voffB); PG8_STAGE(PG8_SA(1, 0), cA + kstep, voffA); PG8_STAGE(PG8_SB(1, 1), cB + hstep + kstep, voffB);
        PG8_WAIT_V(6); PG8_BAR;
    }
    for (;;) {
        const bool has_next = S.next(ui + 1, nxt);
        const char* nA = has_next ? (const char*)g.A + (size_t)nxt.pm * tstep : cA; const char* nB = has_next ? (const char*)g.Bt + (size_t)nxt.pn * tstep : cB;
        for (int t = 0; t < nt; t += 2) {
            const bool last = (t == nt - 2);
            const char* a1 = cA + (size_t)(t + 1) * kstep;
            const char* a2 = last ? nA : cA + (size_t)(t + 2) * kstep; const char* b2 = last ? nB : cB + (size_t)(t + 2) * kstep;
            const char* a3 = a2 + kstep; const char* b3 = b2 + kstep;
            if (last && has_next) S.a_ready(nxt);
            if constexpr (SP2) {
            PG8_LDB(B0, 0, 0); PG8_LDB(B1, 0, 1); PG8_SCHED; PG8_LDA(At, 0, 0); PG8_STAGE(PG8_SA(1, 1), a1 + hstep, voffA);
            PG8_WAIT_V(8); PG8_WAIT_L(0); PG8_BAR; PG8_MMA(0, 0, At, B0); PG8_MMA(0, 1, At, B1); PG8_BAR; PG8_SCHED;
            PG8_LDA(At, 0, 1); PG8_STAGE(PG8_SB(0, 0), b2, voffB); PG8_STAGE(PG8_SB(0, 1), b2 + hstep, voffB); PG8_STAGE(PG8_SA(0, 0), a2, voffA);
            PG8_WAIT_V(8); PG8_WAIT_L(0); PG8_BAR; PG8_MMA(1, 0, At, B0); PG8_MMA(1, 1, At, B1); PG8_BAR; PG8_SCHED;
            PG8_LDB(B0, 1, 0); PG8_LDB(B1, 1, 1); PG8_SCHED; PG8_LDA(At, 1, 0); PG8_STAGE(PG8_SA(0, 1), a2 + hstep, voffA);
            PG8_WAIT_V(8); PG8_WAIT_L(0); PG8_BAR; PG8_MMA(0, 0, At, B0); PG8_MMA(0, 1, At, B1); PG8_BAR; PG8_SCHED;
            PG8_LDA(At, 1, 1); PG8_STAGE(PG8_SB(1, 0), b3, voffB); PG8_STAGE(PG8_SB(1, 1), b3 + hstep, voffB); PG8_STAGE(PG8_SA(1, 0), a3, voffA);
            PG8_WAIT_V(8); PG8_WAIT_L(0); PG8_BAR; PG8_MMA(1, 0, At, B0); PG8_MMA(1, 1, At, B1); PG8_BAR; PG8_SCHED;
            } else {
            PG8_LDB(B0, 0, 0); PG8_SCHED; PG8_LDA(At, 0, 0); PG8_STAGE(PG8_SA(1, 1), a1 + hstep, voffA);
            PG8_WAIT_L(8); PG8_BAR; PG8_WAIT_L(0); PG8_MMA(0, 0, At, B0); PG8_BAR; PG8_SCHED;
            PG8_LDB(B1, 0, 1); PG8_STAGE(PG8_SB(0, 0), b2, voffB);
            PG8_BAR; PG8_WAIT_L(0); PG8_MMA(0, 1, At, B1); PG8_BAR;
            PG8_LDA(At, 0, 1); PG8_STAGE(PG8_SA(0, 0), a2, voffA);
            PG8_BAR; PG8_WAIT_L(0); PG8_MMA(1, 0, At, B0); PG8_BAR; PG8_SCHED;
            PG8_STAGE(PG8_SB(0, 1), b2 + hstep, voffB);
            PG8_WAIT_V(6); PG8_BAR; PG8_MMA(1, 1, At, B1); PG8_BAR;
            PG8_LDB(B0, 1, 0); PG8_SCHED; PG8_LDA(At, 1, 0); PG8_STAGE(PG8_SA(0, 1), a2 + hstep, voffA);
            PG8_WAIT_L(8); PG8_BAR; PG8_WAIT_L(0); PG8_MMA(0, 0, At, B0); PG8_BAR; PG8_SCHED;
            PG8_LDB(B1, 1, 1); PG8_STAGE(PG8_SB(1, 0), b3, voffB);
            PG8_BAR; PG8_WAIT_L(0); PG8_MMA(0, 1, At, B1); PG8_BAR;
            PG8_LDA(At, 1, 1); PG8_STAGE(PG8_SA(1, 0), a3, voffA);
            PG8_BAR; PG8_WAIT_L(0); PG8_MMA(1, 0, At, B0); PG8_BAR; PG8_SCHED;
            PG8_STAGE(PG8_SB(1, 1), b3 + hstep, voffB);
            PG8_WAIT_V(6); PG8_BAR; PG8_MMA(1, 1, At, B1); PG8_BAR;
            }
        }
        if constexpr (ALIGN_EPI) { if (wr == 0) PG8_BAR; }
        if constexpr (!Epi::AFTER_DRAIN) { E(acc, cur, wr, wc, fr, fq); S.done(cur); }
        if (!has_next) break;
#pragma unroll
        for (int a = 0; a < 2; ++a)
#pragma unroll
            for (int b = 0; b < 2; ++b)
#pragma unroll
                for (int m = 0; m < 4; ++m)
#pragma unroll
                    for (int n = 0; n < 2; ++n) acc[a][b][m][n] = (f32x4){0.f, 0.f, 0.f, 0.f};
        cur = nxt; cA = nA; cB = nB; ++ui;
        if constexpr (ALIGN_EPI) { if (wr == 1) PG8_BAR; }
    }
    PG8_WAIT_V(0);
    if constexpr (!ALIGN_EPI) { if (wr == 0) PG8_BAR; }
    PG8_BAR;
#undef PG8_SA
#undef PG8_SB
#undef PG8_STAGE
#undef PG8_LDA
#undef PG8_LDB
#undef PG8_MMA
#undef PG8_WAIT_V
#undef PG8_WAIT_L
#undef PG8_BAR
#undef PG8_SCHED
}
}

#ifndef PG8_SP2
#define PG8_SP2 true
#endif
#ifndef PG8_ALIGN
#define PG8_ALIGN true
#endif

constexpr int NWAVES = 8;
constexpr int BATCH = 4, SEQ = 4096, D = 4096, M = BATCH * SEQ, DEPTH = 2;
constexpr int CW = 2048, RW = 2048, RH = 8, HD = 256, CHUNK = 128, NCH = SEQ / CHUNK;
constexpr int IN_COLS = 14336, N1 = 12288  , FF = 11008, NGU = 2 * FF;
constexpr int COL_AB = 0, COL_AC = 2048, COL_AX = 4096, COL_Q = 6144, COL_G = 8192, COL_K = 10240;
constexpr float EPS = 1e-6f;

constexpr size_t MiB = 1u << 20;
constexpr size_t WS_CTL = 0, CTL_ZERO_BYTES = 1 * MiB;
constexpr size_t WS_RSTD1 = 1 * MiB;
constexpr size_t WS_RSTD2 = WS_RSTD1 + 256 * 1024;
constexpr size_t WS_LGAM = WS_RSTD2 + 256 * 1024;
constexpr size_t WS_PART = 2 * MiB;
constexpr size_t WS_COS = 6 * MiB, WS_SIN = 14 * MiB, WS_COST = 22 * MiB, WS_SINT = 30 * MiB;
constexpr size_t WS_WIN = 38 * MiB;
constexpr size_t WS_WOUT = WS_WIN + 112 * MiB;
constexpr size_t WS_WGU = WS_WOUT + 32 * MiB;
constexpr size_t WS_WDN = WS_WGU + 172 * MiB;
constexpr size_t WS_XB = WS_WDN + 86 * MiB;
constexpr size_t WS_R = WS_XB + 128 * MiB;
constexpr size_t WS_PROJ = WS_R;
constexpr size_t WS_KFT = WS_PROJ + 384 * MiB, WS_KBT = WS_KFT + 64 * MiB, WS_VT = WS_KBT + 64 * MiB;
constexpr size_t WS_SFT = WS_VT + 64 * MiB, WS_SBT = WS_SFT + 128 * MiB;
constexpr size_t WS_YCAT = WS_SBT + 128 * MiB;
constexpr size_t WS_MIX_END = WS_YCAT + 128 * MiB;
constexpr size_t WS_GU = WS_R;
constexpr size_t WS_ACT = WS_GU + 688 * MiB;
constexpr size_t WS_END = WS_ACT + 344 * MiB;
static_assert(WS_MIX_END <= WS_END, "overlay");
static_assert((size_t)M * N1 * 2 == 384 * MiB && (size_t)M * NGU * 2 == 688 * MiB && (size_t)M * FF * 2 == 344 * MiB && (size_t)IN_COLS * D * 2 == 112 * MiB && (size_t)NGU * D * 2 == 172 * MiB && (size_t)D * FF * 2 == 86 * MiB, "sizes");
constexpr int CW_BAR = 4096;

constexpr int RING_OFF = 0, RING_BYTES = 136 * 1024;
constexpr int LDSCTL_OFF = RING_BYTES, MISC_OFF = LDSCTL_OFF + 320;
constexpr int LDS_BYTES = 147456;
static_assert(MISC_OFF + 128 <= LDS_BYTES && 8 * 16640 <= RING_BYTES, "LDS map");

#define GAS __attribute__((address_space(1)))
#define LAS __attribute__((address_space(3)))
typedef unsigned short bf16;
typedef unsigned v4u __attribute__((ext_vector_type(4)));
typedef unsigned v2u __attribute__((ext_vector_type(2)));
typedef float f32x4 __attribute__((ext_vector_type(4)));
typedef float f32x16 __attribute__((ext_vector_type(16)));
typedef short bf16x8 __attribute__((ext_vector_type(8)));
typedef GAS unsigned gu32;
#define RLX_AGENT __ATOMIC_RELAXED, __HIP_MEMORY_SCOPE_AGENT
#define LDS_WAIT() asm volatile("s_waitcnt lgkmcnt(0)" ::: "memory")
#define VM_WAIT() asm volatile("s_waitcnt vmcnt(0)" ::: "memory")
__device__ __forceinline__ unsigned pk2(float lo, float hi) { return pg8::cvt_pk_bf16(lo, hi); }
__device__ __forceinline__ float bflo(unsigned w) { return __uint_as_float(w << 16); }
__device__ __forceinline__ float bfhi(unsigned w) { return __uint_as_float(w & 0xffff0000u); }
__device__ __forceinline__ void unpack8(const v4u w, float (&f)[8]) { f[0] = bflo(w.x); f[1] = bfhi(w.x); f[2] = bflo(w.y); f[3] = bfhi(w.y); f[4] = bflo(w.z); f[5] = bfhi(w.z); f[6] = bflo(w.w); f[7] = bfhi(w.w); }

#define XB_TMO      128
#define XB_XCNT(j)  (256  + 64 * (j))
#define XB_XSUB(j)  (1280 + 64 * (j))
#define XB_XGEN(j)  (2304 + 64 * (j))
#define XB_TOP      3328
#define XB_TOPGEN   3392
#define XCD_BAR_WORDS 3456
#define XB_SPIN_CAP (1u << 18)

__device__ __forceinline__ unsigned xb_ld(unsigned* p)              { return __hip_atomic_load(p, __ATOMIC_RELAXED, __HIP_MEMORY_SCOPE_AGENT); }
__device__ __forceinline__ unsigned xb_add(unsigned* p, unsigned v) { return __hip_atomic_fetch_add(p, v, __ATOMIC_RELAXED, __HIP_MEMORY_SCOPE_AGENT); }
__device__ __forceinline__ unsigned xb_xcc_id() { return (unsigned)__builtin_amdgcn_s_getreg((3 << 11) | 20) & 0xFu; }
#define XB_SPIN(cond, bar) do { unsigned _sp = 0; while (cond) { __builtin_amdgcn_s_sleep(1); \
    if ((++_sp & 255u) == 0u) { if (xb_ld(&(bar)[XB_TMO])) break; if (_sp > XB_SPIN_CAP) { atomicAdd(&(bar)[XB_TMO], 1u); break; } } } } while (0)

struct XcdBarrier {
    unsigned* bar; unsigned x;
    volatile LAS unsigned* st;
};
__device__ __forceinline__ XcdBarrier xcd_barrier_post(unsigned* bar, volatile LAS unsigned* st) {
    XcdBarrier b; b.bar = bar; b.x = xb_xcc_id(); b.st = st;
    if (threadIdx.x == 0) (void)xb_add(&bar[XB_XCNT(b.x)], 1u);
    return b;
}
__device__ __forceinline__ void xcd_barrier_complete(unsigned* bar, unsigned x, unsigned& nloc, unsigned& nx) {
    const unsigned G = gridDim.x * gridDim.y * gridDim.z;
    unsigned sum, cnt, mine, sp = 0u;
    for (;;) {
        sum = 0u; cnt = 0u; mine = 0u;
#pragma unroll
        for (unsigned j = 0; j < 16; ++j) { const unsigned c = xb_ld(&bar[XB_XCNT(j)]); sum += c; cnt += (c > 0u) ? 1u : 0u; mine = (j == x) ? c : mine; }
        if (sum == G) break;
        __builtin_amdgcn_s_sleep(1);
        if ((++sp & 255u) == 0u) { if (xb_ld(&bar[XB_TMO])) break; if (sp > XB_SPIN_CAP) { atomicAdd(&bar[XB_TMO], 1u); break; } }
    }
    nloc = mine > 0u ? mine : 1u; nx = cnt > 0u ? cnt : 1u;
}
__device__ __forceinline__ void xcd_barrier(const XcdBarrier& b) {
    asm volatile("s_waitcnt vmcnt(0)" ::: "memory");
    __syncthreads();
    if (threadIdx.x == 0) {
        unsigned* bar = b.bar;
        __builtin_amdgcn_s_waitcnt(0);
        unsigned nloc = b.st[0], nx = b.st[1];
        if (nloc == 0u) { xcd_barrier_complete(bar, b.x, nloc, nx); b.st[0] = nloc; b.st[1] = nx; }
        const unsigned old = xb_add(&bar[XB_XSUB(b.x)], 1u);
        const unsigned gen = old / nloc;
        if (old + 1u == (gen + 1u) * nloc) {
            __builtin_amdgcn_fence(__ATOMIC_RELEASE, "agent");
            asm volatile("s_waitcnt vmcnt(0)" ::: "memory");
            const unsigned og = xb_add(&bar[XB_TOP], 1u);
            const unsigned tg = og / nx;
            if (og + 1u == (tg + 1u) * nx) xb_add(&bar[XB_TOPGEN], 1u);
            else XB_SPIN(xb_ld(&bar[XB_TOPGEN]) == tg, bar);
            __builtin_amdgcn_fence(__ATOMIC_ACQUIRE, "agent");
            xb_add(&bar[XB_XGEN(b.x)], 1u);
            asm volatile("s_waitcnt vmcnt(0)" ::: "memory");
        } else {
            XB_SPIN(xb_ld(&bar[XB_XGEN(b.x)]) == gen, bar);
            __builtin_amdgcn_fence(__ATOMIC_ACQUIRE, "agent");
            asm volatile("s_waitcnt vmcnt(0)" ::: "memory");
        }
    }
    __syncthreads();
}

struct Args { const void* in[17]; float* out; unsigned char* ws; int ph_lo, ph_hi; };
static_assert(sizeof(Args) == 17 * 8 + 8 + 8 + 8, "Args has no padding");
struct Frame {
    LAS unsigned char* lds;
    int tid, lane, wave;
    int vcu, G;
    const __attribute__((address_space(4))) Args* ap;
};
#define F_x ((const float*)(const GAS float*)F.ap->in[0])
#define F_pos ((const int*)(const GAS int*)F.ap->in[1])
#define F_norm1_g ((const float*)(const GAS float*)F.ap->in[2])
#define F_w_in ((const float*)(const GAS float*)F.ap->in[3])
#define F_conv_a_w ((const float*)(const GAS float*)F.ap->in[4])
#define F_conv_a_b ((const float*)(const GAS float*)F.ap->in[5])
#define F_beta_a ((const float*)(const GAS float*)F.ap->in[6])
#define F_dlogit ((const float*)(const GAS float*)F.ap->in[7])
#define F_gn_g ((const float*)(const GAS float*)F.ap->in[8])
#define F_w_out ((const float*)(const GAS float*)F.ap->in[9])
#define F_norm2_g ((const float*)(const GAS float*)F.ap->in[10])
#define F_w_gate ((const float*)(const GAS float*)F.ap->in[11])
#define F_w_up ((const float*)(const GAS float*)F.ap->in[12])
#define F_ffn_w ((const float*)(const GAS float*)F.ap->in[13])
#define F_ffn_b ((const float*)(const GAS float*)F.ap->in[14])
#define F_w_down ((const float*)(const GAS float*)F.ap->in[15])
#define F_norm_f ((const float*)(const GAS float*)F.ap->in[16])
#define F_out ((float*)(GAS float*)F.ap->out)
#define F_rstd1 ((float*)(GAS float*)(F.ap->ws + WS_RSTD1))
#define F_rstd2 ((float*)(GAS float*)(F.ap->ws + WS_RSTD2))
#define F_lgam ((float*)(GAS float*)(F.ap->ws + WS_LGAM))
#define F_part ((float*)(GAS float*)(F.ap->ws + WS_PART))
#define F_cosb ((float*)(GAS float*)(F.ap->ws + WS_COS))
#define F_sinb ((float*)(GAS float*)(F.ap->ws + WS_SIN))
#define F_cosT ((float*)(GAS float*)(F.ap->ws + WS_COST))
#define F_sinT ((float*)(GAS float*)(F.ap->ws + WS_SINT))
#define F_WIN ((bf16*)(GAS bf16*)(F.ap->ws + WS_WIN))
#define F_WOUT ((bf16*)(GAS bf16*)(F.ap->ws + WS_WOUT))
#define F_WGU ((bf16*)(GAS bf16*)(F.ap->ws + WS_WGU))
#define F_WDN ((bf16*)(GAS bf16*)(F.ap->ws + WS_WDN))
#define F_XB ((bf16*)(GAS bf16*)(F.ap->ws + WS_XB))
#define F_PROJ ((bf16*)(GAS bf16*)(F.ap->ws + WS_PROJ))
#define F_KFT ((bf16*)(GAS bf16*)(F.ap->ws + WS_KFT))
#define F_KBT ((bf16*)(GAS bf16*)(F.ap->ws + WS_KBT))
#define F_VT ((bf16*)(GAS bf16*)(F.ap->ws + WS_VT))
#define F_SFT ((bf16*)(GAS bf16*)(F.ap->ws + WS_SFT))
#define F_SBT ((bf16*)(GAS bf16*)(F.ap->ws + WS_SBT))
#define F_YCAT ((bf16*)(GAS bf16*)(F.ap->ws + WS_YCAT))
#define F_GU ((bf16*)(GAS bf16*)(F.ap->ws + WS_GU))
#define F_ACT ((bf16*)(GAS bf16*)(F.ap->ws + WS_ACT))
__device__ __forceinline__ float wave_sum(float v) {
#pragma unroll
    for (int o = 1; o < 64; o <<= 1) v += __shfl_xor(v, o);
    return v;
}

__device__ __forceinline__ void cvt_item(const float* __restrict__ W, int N, const float* __restrict__ gain, bf16* WT, int K, int k0, int n0s, int n0d, LAS float* scr, int lane) {
    const int r4 = lane >> 4, c4 = (lane & 15) * 4;
    f32x4 v[16];
#pragma unroll
    for (int i = 0; i < 16; ++i) v[i] = *(const f32x4*)(W + (size_t)(k0 + 4 * i + r4) * N + n0s + c4);
#pragma unroll
    for (int i = 0; i < 16; ++i) { const int kk = 4 * i + r4; const float g = gain ? gain[k0 + kk] : 1.0f; LAS float* s = scr + kk * 65 + c4;
        s[0] = v[i].x * g; s[1] = v[i].y * g; s[2] = v[i].z * g; s[3] = v[i].w * g; }
    LDS_WAIT(); asm volatile("" ::: "memory");
    const int c = lane & 7;
#pragma unroll
    for (int it = 0; it < 8; ++it) { const int n = (lane >> 3) + 8 * it; const LAS float* s = scr + (8 * c) * 65 + n;
        v4u o; o.x = pk2(s[0 * 65], s[1 * 65]); o.y = pk2(s[2 * 65], s[3 * 65]); o.z = pk2(s[4 * 65], s[5 * 65]); o.w = pk2(s[6 * 65], s[7 * 65]);
        *(v4u*)(WT + (size_t)(n0d + n) * K + k0 + 8 * c) = o; }
    LDS_WAIT(); asm volatile("" ::: "memory");
}
__device__ __forceinline__ void cvt_matrix(Frame& F, const float* W, int K, int N, const float* gain, bf16* WT, int dst_row0, bool in_perm, int& it, int it_end_prev, LAS float* scr) {
    const int nnb = N / 64, nitems = (K / 64) * nnb, NGW = F.G * NWAVES;
    for (; it < it_end_prev + nitems; it += NGW) {
        const int r = it - it_end_prev, kb = r / nnb, nb = r % nnb; const int n0s = nb * 64; int n0d = dst_row0 + n0s;
        if (in_perm) { const int blk = n0s >> 11, dblk = (blk < 4) ? blk : (blk == 4 ? 5 : (blk == 5 ? 6 : 4)); n0d = dblk * 2048 + (n0s & 2047); }
        cvt_item(W, N, gain, WT, K, kb * 64, n0s, n0d, scr, F.lane);
    }
}

__device__ __forceinline__ void rstd_from_part(Frame& F, float* rstd) {
    const int gw = F.vcu * NWAVES + F.wave, NGW = F.G * NWAVES;
    for (int row = gw; row < M; row += NGW) { const float s = wave_sum(F_part[(size_t)row * 64 + F.lane]); if (F.lane == 0) rstd[row] = 1.0f / sqrtf(s * (1.0f / D) + EPS); }
}
__device__ __forceinline__ void p0_phase(Frame& F, int l) {
    LAS float* scr = (LAS float*)(F.lds + RING_OFF + F.wave * 16640);
    const int gw = F.vcu * NWAVES + F.wave, NGW = F.G * NWAVES;
    int it = gw, base = 0;
    cvt_matrix(F, F_w_in + (size_t)l * D * IN_COLS, D, IN_COLS, F_norm1_g + l * D, F_WIN, 0, true, it, base, scr); base += (D / 64) * (IN_COLS / 64);
    cvt_matrix(F, F_w_out + (size_t)l * D * D, D, D, nullptr, F_WOUT, 0, false, it, base, scr); base += (D / 64) * (D / 64);
    cvt_matrix(F, F_w_gate + (size_t)l * D * FF, D, FF, F_norm2_g + l * D, F_WGU, 0, false, it, base, scr); base += (D / 64) * (FF / 64);
    cvt_matrix(F, F_w_up + (size_t)l * D * FF, D, FF, F_norm2_g + l * D, F_WGU, FF, false, it, base, scr); base += (D / 64) * (FF / 64);
    cvt_matrix(F, F_w_down + (size_t)l * FF * D, FF, D, nullptr, F_WDN, 0, false, it, base, scr);
    if (l == 0) {
        for (int m = gw; m < M; m += NGW) { const float* xr = F_x + (size_t)m * D + 8 * F.lane; f32x4 v[16]; float ss = 0.f;
#pragma unroll
            for (int j = 0; j < 8; ++j) { v[2 * j] = *(const f32x4*)(xr + 512 * j); v[2 * j + 1] = *(const f32x4*)(xr + 512 * j + 4); }
#pragma unroll
            for (int j = 0; j < 16; ++j) ss += (v[j].x * v[j].x + v[j].y * v[j].y) + (v[j].z * v[j].z + v[j].w * v[j].w);
            ss = wave_sum(ss); if (F.lane == 0) F_rstd1[m] = 1.0f / sqrtf(ss * (1.0f / D) + EPS);
            bf16* o = F_XB + (size_t)m * D + 8 * F.lane;
#pragma unroll
            for (int j = 0; j < 8; ++j) *(v4u*)(o + 512 * j) = pg8::pack8(v[2 * j], v[2 * j + 1]); }
        { const int gt = gw * 64 + F.lane, NT = NGW * 64; const int j = gt & 127;
          const float inv = exp2f(-(float)j * (13.287712379549449f / 128.0f));
          for (int idx = gt; idx < M * 128; idx += NT) { const int m = idx >> 7; const float ang = (float)F_pos[m] * inv;
              const double a = (double)ang, k = rint(a * 0.15915494309189535), r = a - k * 6.283185307179586; const float rf = (float)r;
              const float c = cosf(rf), s = sinf(rf);
              F_cosb[idx] = c; F_sinb[idx] = s; F_cosT[(size_t)j * M + m] = c; F_sinT[(size_t)j * M + m] = s; } }
        if (blockIdx.x == 0 && F.tid < DEPTH * 2 * RH) { const float xl = F_dlogit[F.tid]; const float t = __expf(-xl);
            const float ser = t * (1.0f - t * (0.5f - t * (0.33333334f - t * (0.25f - t * 0.2f)))); F_lgam[F.tid] = -((t < 0.04f) ? ser : __logf(1.0f + t)); }
    } else rstd_from_part(F, F_rstd1);
}

__device__ __forceinline__ void mixer_a(Frame& F, int l) {
    const int gw = F.vcu * NWAVES + F.wave, NGW = F.G * NWAVES;
    for (int item = gw; item < (M / 32) * 4; item += NGW) {
        const int t0 = (item >> 2) * 32, c0 = (item & 3) * 512 + F.lane * 8;
        float w0[8], w1[8], w2[8], bb[8], be[8];
        { const float* cw = F_conv_a_w + (size_t)l * 3 * CW + c0; const float* cb = F_conv_a_b + (size_t)l * CW + c0; const float* bt = F_beta_a + (size_t)l * CW + c0;
#pragma unroll
          for (int j = 0; j < 8; ++j) { w0[j] = cw[j]; w1[j] = cw[CW + j]; w2[j] = cw[2 * CW + j]; bb[j] = cb[j]; be[j] = bt[j]; } }
        float pp[8], pc[8], pn[8];
        auto prod = [&](int t, float (&p)[8]) { const bf16* r = F_PROJ + (size_t)t * N1 + c0; float a[8], b[8]; unpack8(*(const v4u*)(r + COL_AC), a); unpack8(*(const v4u*)(r + COL_AX), b);
#pragma unroll
            for (int j = 0; j < 8; ++j) p[j] = a[j] * b[j]; };
        if ((t0 & (SEQ - 1)) == 0) {
#pragma unroll
            for (int j = 0; j < 8; ++j) pp[j] = 0.f;
        } else prod(t0 - 1, pp);
        prod(t0, pc);
        for (int t = t0; t < t0 + 32; ++t) {
            if ((t & (SEQ - 1)) == SEQ - 1) {
#pragma unroll
                for (int j = 0; j < 8; ++j) pn[j] = 0.f;
            } else prod(t + 1, pn);
            float ab[8], y[8]; unpack8(*(const v4u*)(F_PROJ + (size_t)t * N1 + COL_AB + c0), ab); float ss = 0.f;
#pragma unroll
            for (int j = 0; j < 8; ++j) { y[j] = ab[j] * (w0[j] * pp[j] + w1[j] * pc[j] + w2[j] * pn[j] + bb[j]); ss += y[j] * y[j]; }
            ss += __shfl_xor(ss, 1); ss += __shfl_xor(ss, 2); ss += __shfl_xor(ss, 4); ss += __shfl_xor(ss, 8);
            const float r = 1.0f / sqrtf(ss * (1.0f / 128.0f) + EPS);
            v4u o; o.x = pk2(y[0] * r * be[0], y[1] * r * be[1]); o.y = pk2(y[2] * r * be[2], y[3] * r * be[3]); o.z = pk2(y[4] * r * be[4], y[5] * r * be[5]); o.w = pk2(y[6] * r * be[6], y[7] * r * be[7]);
            *(v4u*)(F_YCAT + (size_t)t * D + c0) = o;
#pragma unroll
            for (int j = 0; j < 8; ++j) { pp[j] = pc[j]; pc[j] = pn[j]; }
        }
    }
}

#define MFMA32(a, b, c) __builtin_amdgcn_mfma_f32_32x32x16_bf16((a), (b), (c), 0, 0, 0)
struct ScanFrags { bf16x8 a[4], b0[4], b1[4]; };
__device__ __forceinline__ void scan_load(ScanFrags& f, const bf16* kt, const bf16* vt, const int half) {
#pragma unroll
    for (int k = 0; k < 4; ++k) { const int ks = 4 * half + k; f.a[k] = *(const bf16x8*)(kt + 16 * ks); f.b0[k] = *(const bf16x8*)(vt + 16 * ks); f.b1[k] = *(const bf16x8*)(vt + 32 * CHUNK + 16 * ks); }
}
__device__ __forceinline__ void scan_phase(Frame& F, int l) {
    const int gw = F.vcu * NWAVES + F.wave, NGW = F.G * NWAVES, li = F.lane & 31, hh = F.lane >> 5;
    for (int unit = gw; unit < BATCH * RH * 2 * 8 * 4; unit += NGW) {
        const int eq = unit & 3, dblk = (unit >> 2) & 7, dir = (unit >> 5) & 1, h = (unit >> 6) & 7, b = unit >> 9;
        const size_t blk0 = (size_t)(b * RH + h) * NCH * (HD * CHUNK);
        const bf16* KT = (dir ? F_KBT : F_KFT) + blk0 + (size_t)(dblk * 32 + li) * CHUNK + 8 * hh;
        const bf16* VT = F_VT + blk0 + (size_t)(eq * 64 + li) * CHUNK + 8 * hh;
        bf16* ST = (dir ? F_SBT : F_SFT) + ((size_t)(b * RH + h) * NCH * HD + eq * 64 + li) * HD + dblk * 32 + 4 * hh;
        const float g128 = __expf(128.0f * F_lgam[l * 16 + dir * 8 + h]);
        f32x16 s0, s1;
#pragma unroll
        for (int r = 0; r < 16; ++r) { s0[r] = 0.f; s1[r] = 0.f; }
        ScanFrags fa, fb;
        { const int n0 = dir ? (NCH - 1) : 0; scan_load(fa, KT + (size_t)n0 * HD * CHUNK, VT + (size_t)n0 * HD * CHUNK, 0); }
        for (int step = 0; step < NCH; ++step) {
            const int n = dir ? (NCH - 1 - step) : step, nn = dir ? (n - 1) : (n + 1);
            const bf16* kt = KT + (size_t)n * HD * CHUNK; const bf16* vt = VT + (size_t)n * HD * CHUNK;
            scan_load(fb, kt, vt, 1);
            bf16* st = ST + (size_t)n * HD * HD;
#pragma unroll
            for (int g = 0; g < 4; ++g) { v2u a; a.x = pk2(s0[4 * g], s0[4 * g + 1]); a.y = pk2(s0[4 * g + 2], s0[4 * g + 3]); *(v2u*)(st + 8 * g) = a;
                v2u c; c.x = pk2(s1[4 * g], s1[4 * g + 1]); c.y = pk2(s1[4 * g + 2], s1[4 * g + 3]); *(v2u*)(st + 32 * HD + 8 * g) = c; }
#pragma unroll
            for (int r = 0; r < 16; ++r) { s0[r] *= g128; s1[r] *= g128; }
#pragma unroll
            for (int k = 0; k < 4; ++k) { s0 = MFMA32(fa.a[k], fa.b0[k], s0); s1 = MFMA32(fa.a[k], fa.b1[k], s1); }
            if (step + 1 < NCH) scan_load(fa, KT + (size_t)nn * HD * CHUNK, VT + (size_t)nn * HD * CHUNK, 0);
#pragma unroll
            for (int k = 0; k < 4; ++k) { s0 = MFMA32(fb.a[k], fb.b0[k], s0); s1 = MFMA32(fb.a[k], fb.b1[k], s1); }
        }
    }
}

__device__ __forceinline__ void dma16(const char* g, LAS unsigned char* l) { __builtin_amdgcn_global_load_lds((const unsigned*)g, (LAS unsigned*)l, 16, 0, 0); }
__device__ __forceinline__ void intra_dma(Frame& F, const int kind, const int p, LAS unsigned char* dst, int b, int h, int n, int w, int lane) {
    const int tok0 = b * SEQ + n * CHUNK;
    if (kind == 4) {
        const int r0 = w * 4 + (lane >> 4), c = (lane & 15) ^ (r0 & 15);
        const char* g0 = (const char*)F_VT + (((size_t)(b * RH + h) * NCH + n) * (HD * CHUNK)) * 2 + c * 16;
#pragma unroll
        for (int q = 0; q < 4; ++q) { const int row = q * 32 + r0, e = 128 * (row >> 6) + 64 * p + (row & 63); dma16(g0 + (size_t)e * CHUNK * 2, dst + q * 8192 + w * 1024); }
    } else {
        const int r0 = w * 2 + (lane >> 5), c = (lane & 31) ^ (r0 & 15);
        if (kind == 0 || kind == 1) {
            const char* g0 = (const char*)F_PROJ + ((size_t)(tok0 + (kind == 1 ? 64 * p : 0) + r0) * N1 + (kind == 0 ? COL_Q : COL_K) + h * HD) * 2 + c * 16;
#pragma unroll
            for (int q = 0; q < (kind == 0 ? 8 : 4); ++q) dma16(g0 + (size_t)q * 16 * N1 * 2, dst + q * 8192 + w * 1024);
        } else {
            const char* g0 = (const char*)(kind == 2 ? F_SFT : F_SBT) + ((size_t)(b * RH + h) * NCH + n) * HD * HD * 2 + c * 16;
#pragma unroll
            for (int q = 0; q < 4; ++q) { const int row = q * 16 + r0, e = 128 * (row >> 5) + 32 * p + (row & 31); dma16(g0 + (size_t)e * HD * 2, dst + q * 8192 + w * 1024); }
        }
    }
}
__device__ __forceinline__ void intra_phase(Frame& F, int l) {
    LAS unsigned char* QS = F.lds + RING_OFF; LAS unsigned char* BUF = QS + 65536; LAS float* red1 = (LAS float*)(QS + 131072); LAS float* red2 = red1 + 256;
    const int w = F.wave, ib = w & 3, eh = w >> 2, li = F.lane & 31, hh = F.lane >> 5, sw = li & 15, yx = hh ^ sw;
    const float L2E = 1.4426950408889634f;
    const int nun = BATCH * RH * NCH;
    if (F.vcu < nun) { const int u0 = F.vcu; intra_dma(F, 0, 0, QS, u0 >> 8, (u0 >> 5) & 7, u0 & 31, w, F.lane); intra_dma(F, 1, 0, BUF, u0 >> 8, (u0 >> 5) & 7, u0 & 31, w, F.lane); }
    for (int unit = F.vcu; unit < nun; unit += F.G) {
        const int n = unit & 31, h = (unit >> 5) & 7, b = unit >> 8;
        const int nxt = unit + F.G; const bool has_next = nxt < nun; const int n2 = nxt & 31, h2 = (nxt >> 5) & 7, b2 = nxt >> 8;
        int i = 32 * ib + li; asm volatile("" : "+v"(i));
        const int tok0 = b * SEQ + n * CHUNK, tok = tok0 + i;
        const float lf = F_lgam[l * 16 + h], lb = F_lgam[l * 16 + 8 + h];
        const float lf2 = lf * L2E, lb2 = lb * L2E;
        const LAS unsigned char* qrow = QS + (32 * ib + li) * 512;
#define QF(s) (*(const LAS bf16x8*)(qrow + (((2 * (s)) ^ yx) << 4)))
        bf16x8 pf[4][2];
        f32x16 acc[4];
#pragma unroll
        for (int et = 0; et < 4; ++et)
#pragma unroll
            for (int r = 0; r < 16; ++r) acc[et][r] = 0.f;
#pragma unroll
        for (int t = 0; t < 12; ++t) {
            VM_WAIT(); __syncthreads();
            LAS unsigned char* nb = BUF + ((t + 1) & 1) * 32768; const LAS unsigned char* cb = BUF + (t & 1) * 32768;
            int ln = F.lane; asm volatile("" : "+v"(ln));
            if (t < 11) { const int t1 = t + 1; intra_dma(F, t1 < 2 ? 1 : (t1 < 6 ? 2 : (t1 < 10 ? 3 : 4)), t1 < 2 ? t1 : (t1 < 6 ? t1 - 2 : (t1 < 10 ? t1 - 6 : t1 - 10)), nb, b, h, n, w, ln); }
            else if (has_next) intra_dma(F, 1, 0, nb, b2, h2, n2, w, ln);
            if (t == 10 && has_next) intra_dma(F, 0, 0, QS, b2, h2, n2, w, ln);
            if (t < 2) {
#pragma unroll
                for (int jtl = 0; jtl < 2; ++jtl) { const int jt = 2 * t + jtl; const LAS unsigned char* krow = cb + (32 * jtl + li) * 512;
                    f32x16 sc;
#pragma unroll
                    for (int r = 0; r < 16; ++r) sc[r] = 0.f;
#pragma unroll
                    for (int s = 0; s < 16; ++s) { const bf16x8 a = *(const LAS bf16x8*)(krow + (((2 * s) ^ yx) << 4)); sc = MFMA32(a, QF(s), sc); }
#pragma unroll
                    for (int s2 = 0; s2 < 2; ++s2) {
                        float pv[8];
#pragma unroll
                        for (int jj = 0; jj < 8; ++jj) { const int r = 8 * s2 + jj; const int j = 32 * jt + (r & 3) + 8 * (r >> 2) + 4 * hh; const int dd = i - j;
                            const float e = (dd >= 0) ? lf2 * (float)dd : lb2 * (float)(-dd); pv[jj] = sc[r] * exp2f(e); }
                        v4u pw; pw.x = pk2(pv[0], pv[1]); pw.y = pk2(pv[2], pv[3]); pw.z = pk2(pv[4], pv[5]); pw.w = pk2(pv[6], pv[7]);
                        pf[jt][s2] = __builtin_bit_cast(bf16x8, pw); } }
            } else if (t < 10) {
                const int et = (t - 2) & 3; const LAS unsigned char* srow = cb + (32 * eh + li) * 512;
#pragma unroll
                for (int s = 0; s < 16; ++s) { const bf16x8 a = *(const LAS bf16x8*)(srow + (((2 * s) ^ yx) << 4)); acc[et] = MFMA32(a, QF(s), acc[et]); }
                if (t == 5) { const float ratio = __expf(lf * (float)(i + 1) - lb * (float)(CHUNK - i));
#pragma unroll
                    for (int e2 = 0; e2 < 4; ++e2)
#pragma unroll
                        for (int r = 0; r < 16; ++r) acc[e2][r] *= ratio; }
                if (t == 9) { const float wb = __expf(lb * (float)(CHUNK - i));
#pragma unroll
                    for (int e2 = 0; e2 < 4; ++e2)
#pragma unroll
                        for (int r = 0; r < 16; ++r) acc[e2][r] *= wb; }
            } else {
                const int p = t - 10;
#pragma unroll
                for (int etl = 0; etl < 2; ++etl) { const int et = 2 * p + etl; const LAS unsigned char* vrow = cb + (64 * eh + 32 * etl + li) * 256 + 8 * hh;
#pragma unroll
                    for (int jt = 0; jt < 4; ++jt)
#pragma unroll
                        for (int s2 = 0; s2 < 2; ++s2) { const v2u lo = *(const LAS v2u*)(vrow + (((4 * jt + 2 * s2) ^ sw) << 4)), hi = *(const LAS v2u*)(vrow + (((4 * jt + 2 * s2 + 1) ^ sw) << 4));
                            v4u aw; aw.x = lo.x; aw.y = lo.y; aw.z = hi.x; aw.w = hi.y;
                            acc[et] = MFMA32(__builtin_bit_cast(bf16x8, aw), pf[jt][s2], acc[et]); } }
            }
        }
#undef QF
        float s = 0.f;
#pragma unroll
        for (int et = 0; et < 4; ++et)
#pragma unroll
            for (int r = 0; r < 16; ++r) s += acc[et][r];
        s += __shfl_xor(s, 32);
        if (hh == 0) red1[w * 32 + li] = s;
        LDS_WAIT(); __syncthreads();
        const float mean = (red1[ib * 32 + li] + red1[(ib + 4) * 32 + li]) * (1.0f / HD);
        float q = 0.f;
#pragma unroll
        for (int et = 0; et < 4; ++et)
#pragma unroll
            for (int r = 0; r < 16; ++r) { const float dlt = acc[et][r] - mean; q += dlt * dlt; }
        q += __shfl_xor(q, 32);
        if (hh == 0) red2[w * 32 + li] = q;
        LDS_WAIT(); __syncthreads();
        const float rstd = 1.0f / sqrtf((red2[ib * 32 + li] + red2[(ib + 4) * 32 + li]) * (1.0f / HD) + EPS);
        { const float* gn = F_gn_g + (size_t)l * RW + h * HD; const bf16* gp = F_PROJ + (size_t)tok * N1 + COL_G + h * HD; bf16* yp = F_YCAT + (size_t)tok * D + CW + h * HD;
#pragma unroll
          for (int et = 0; et < 4; ++et)
#pragma unroll
              for (int g = 0; g < 4; ++g) { const int e4 = 128 * eh + 32 * et + 8 * g + 4 * hh; const f32x4 gv = *(const f32x4*)(gn + e4); const v2u gw2 = *(const v2u*)(gp + e4);
                  const float gt[4] = {bflo(gw2.x), bfhi(gw2.x), bflo(gw2.y), bfhi(gw2.y)}; float y[4];
#pragma unroll
                  for (int j = 0; j < 4; ++j) { const float sg = gt[j] / (1.0f + __expf(-gt[j])); y[j] = (acc[et][4 * g + j] - mean) * rstd * gv[j] * sg; }
                  v2u o; o.x = pk2(y[0], y[1]); o.y = pk2(y[2], y[3]); *(v2u*)(yp + e4) = o; } }
    }
    VM_WAIT(); __syncthreads();
}

__device__ __forceinline__ void act_phase(Frame& F, int l) {
    const int gw = F.vcu * NWAVES + F.wave, NGW = F.G * NWAVES;
    for (int item = gw; item < (M / 32) * 22; item += NGW) {
        const int tb = item / 22, cg = item - tb * 22; const int t0 = tb * 32, c0 = cg * 512 + F.lane * 8;
        if (c0 >= FF) continue;
        float w0[8], w1[8], w2[8], bb[8];
        { const float* cw = F_ffn_w + (size_t)l * 3 * FF + c0; const float* cb = F_ffn_b + (size_t)l * FF + c0;
#pragma unroll
          for (int j = 0; j < 8; ++j) { w0[j] = cw[j]; w1[j] = cw[FF + j]; w2[j] = cw[2 * FF + j]; bb[j] = cb[j]; } }
        float gp[8], gc[8], gn[8];
        if ((t0 & (SEQ - 1)) == 0) {
#pragma unroll
            for (int j = 0; j < 8; ++j) gp[j] = 0.f;
        } else unpack8(*(const v4u*)(F_GU + (size_t)(t0 - 1) * NGU + c0), gp);
        unpack8(*(const v4u*)(F_GU + (size_t)t0 * NGU + c0), gc);
        for (int t = t0; t < t0 + 32; ++t) {
            if ((t & (SEQ - 1)) == SEQ - 1) {
#pragma unroll
                for (int j = 0; j < 8; ++j) gn[j] = 0.f;
            } else unpack8(*(const v4u*)(F_GU + (size_t)(t + 1) * NGU + c0), gn);
            float u[8], y[8]; unpack8(*(const v4u*)(F_GU + (size_t)t * NGU + FF + c0), u);
#pragma unroll
            for (int j = 0; j < 8; ++j) { const float z = w0[j] * gp[j] + w1[j] * gc[j] + w2[j] * gn[j] + bb[j]; y[j] = z / (1.0f + __expf(-z)) * u[j]; }
            v4u o; o.x = pk2(y[0], y[1]); o.y = pk2(y[2], y[3]); o.z = pk2(y[4], y[5]); o.w = pk2(y[6], y[7]);
            *(v4u*)(F_ACT + (size_t)t * FF + c0) = o;
#pragma unroll
            for (int j = 0; j < 8; ++j) { gp[j] = gc[j]; gc[j] = gn[j]; }
        }
    }
}

__device__ __forceinline__ void final_phase(Frame& F) {
    const int gw = F.vcu * NWAVES + F.wave, NGW = F.G * NWAVES;
    for (int m = gw; m < M; m += NGW) {
        const float s = wave_sum(F_part[(size_t)m * 64 + F.lane]); const float rs = 1.0f / sqrtf(s * (1.0f / D) + EPS);
        const bf16* xr = F_XB + (size_t)m * D + 8 * F.lane; float* orow = F_out + (size_t)m * D + 8 * F.lane; const float* gr = F_norm_f + 8 * F.lane;
#pragma unroll
        for (int j = 0; j < 8; ++j) { float v[8]; unpack8(*(const v4u*)(xr + 512 * j), v); const f32x4 g0 = *(const f32x4*)(gr + 512 * j), g1 = *(const f32x4*)(gr + 512 * j + 4);
            *(f32x4*)(orow + 512 * j) = (f32x4){v[0] * rs * g0[0], v[1] * rs * g0[1], v[2] * rs * g0[2], v[3] * rs * g0[3]};
            *(f32x4*)(orow + 512 * j + 4) = (f32x4){v[4] * rs * g1[0], v[5] * rs * g1[1], v[6] * rs * g1[2], v[7] * rs * g1[3]}; }
    }
}

constexpr int PH_PER_LAYER = 9, N_PHASES = DEPTH * PH_PER_LAYER + 1;

__global__ void __launch_bounds__(NWAVES * 64, 2) enc_fwd(Args args) {
    extern __shared__ __attribute__((aligned(16))) unsigned char lds[];
    Frame F;
    F.lds = (LAS unsigned char*)lds;
    volatile LAS unsigned* MISC = (volatile LAS unsigned*)(F.lds + MISC_OFF);
    F.tid = threadIdx.x; F.lane = F.tid & 63; F.wave = __builtin_amdgcn_readfirstlane(F.tid >> 6);
    F.G = gridDim.x; { const int bx = blockIdx.x; F.vcu = (F.G % 8 == 0) ? (bx % 8) * (F.G / 8) + bx / 8 : bx; }
    F.ap = (const __attribute__((address_space(4))) Args*)__builtin_amdgcn_kernarg_segment_ptr();
    unsigned char* ws = args.ws;
    for (int u = F.tid; u < (LDS_BYTES - LDSCTL_OFF) / 4; u += NWAVES * 64) ((LAS unsigned*)(F.lds + LDSCTL_OFF))[u] = 0u;
    __syncthreads();
    XcdBarrier bar; bar.bar = (unsigned*)(ws + WS_CTL) + CW_BAR; bar.x = 0; bar.st = nullptr;
#if !MK_SPLIT
    bar = xcd_barrier_post((unsigned*)(ws + WS_CTL) + CW_BAR, MISC + 8);
#define GRID_BAR() xcd_barrier(bar)
#else
#define GRID_BAR() do {} while (0)
#endif
    const int lo = args.ph_lo, hi = args.ph_hi;
#define IN(k) (lo <= (k) && (k) < hi)
#define SEAM(k) do { if (IN(k) && IN((k) + 1)) GRID_BAR(); } while (0)
    using namespace pg8;
    for (int l = 0; l < DEPTH; ++l) {
        const int pb = l * PH_PER_LAYER;
#define LAUNDER() do { F.tid = threadIdx.x; asm volatile("" : "+v"(F.tid), "+s"(F.ap)); F.lane = F.tid & 63; } while (0)
        if (PHON(0) && IN(pb + 0)) { for (int rp = 0; rp < PHREP(0); ++rp) { LAUNDER(); p0_phase(F, l); } } SEAM(pb + 0);
        if (PHON(1) && IN(pb + 1)) for (int rp = 0; rp < PHREP(1); ++rp) { LAUNDER();
            { Gemm g{F_XB, F_WIN, M, N1, D}; StaticOrder S; S.init(M, N1, F.G, (int)blockIdx.x); EpiIn E{F_PROJ, N1, F_rstd1, F_cosb, F_sinb};
              gemm_phase<EpiIn, StaticOrder, PG8_ALIGN, PG8_SP2>(F.lds + RING_OFF, g, S, E); }
            { Gemm g{F_WIN + (size_t)COL_K * D, F_XB, 2 * RW, M, D}; StaticOrder S; S.init(2 * RW, M, F.G, (int)blockIdx.x); EpiKV E{F_KFT, F_KBT, F_VT, M, F_rstd1, F_cosT, F_sinT, F_lgam + l * 16};
              gemm_phase<EpiKV, StaticOrder, PG8_ALIGN, PG8_SP2>(F.lds + RING_OFF, g, S, E); }
        } SEAM(pb + 1);
        if (PHON(2) && IN(pb + 2)) { for (int rp = 0; rp < PHREP(2); ++rp) { LAUNDER(); for (int r2 = 0; r2 < PHREP(10); ++r2) mixer_a(F, l); for (int r2 = 0; r2 < PHREP(11); ++r2) scan_phase(F, l); } } SEAM(pb + 2);
        if (PHON(3) && IN(pb + 3)) { for (int rp = 0; rp < PHREP(3); ++rp) { LAUNDER(); intra_phase(F, l); } } SEAM(pb + 3);
        if (PHON(4) && IN(pb + 4)) for (int rp = 0; rp < PHREP(4); ++rp) { LAUNDER(); Gemm g{F_YCAT, F_WOUT, M, D, D}; StaticOrder S; S.init(M, D, F.G, (int)blockIdx.x); EpiRes E{l == 0 ? F_x : nullptr, F_XB, F_part, D};
            gemm_phase<EpiRes, StaticOrder, PG8_ALIGN, PG8_SP2>(F.lds + RING_OFF, g, S, E); } SEAM(pb + 4);
        if (PHON(5) && IN(pb + 5)) { for (int rp = 0; rp < PHREP(5); ++rp) { LAUNDER(); rstd_from_part(F, F_rstd2); } } SEAM(pb + 5);
        if (PHON(6) && IN(pb + 6)) for (int rp = 0; rp < PHREP(6); ++rp) { LAUNDER(); Gemm g{F_XB, F_WGU, M, NGU, D}; StaticOrder S; S.init(M, NGU, F.G, (int)blockIdx.x); EpiScale E{F_GU, NGU, F_rstd2};
            gemm_phase<EpiScale, StaticOrder, PG8_ALIGN, PG8_SP2>(F.lds + RING_OFF, g, S, E); } SEAM(pb + 6);
#if PROBE_GEMM
        if (IN(pb + 6)) { GRID_BAR(); LAUNDER(); Gemm g{F_XB, F_WGU, M, FF, D}; ProbeOrder S; S.init(M, FF, F.G, (int)blockIdx.x); EpiScale E{F_ACT, FF, F_rstd2};
            gemm_phase<EpiScale, ProbeOrder, PG8_ALIGN, PG8_SP2>(F.lds + RING_OFF, g, S, E); GRID_BAR(); }
#endif
        if (PHON(7) && IN(pb + 7)) { for (int rp = 0; rp < PHREP(7); ++rp) { LAUNDER(); act_phase(F, l); } } SEAM(pb + 7);
        if (PHON(8) && IN(pb + 8)) for (int rp = 0; rp < PHREP(8); ++rp) { LAUNDER(); Gemm g{F_ACT, F_WDN, M, D, FF}; StaticOrder S; S.init(M, D, F.G, (int)blockIdx.x); EpiRes E{nullptr, F_XB, F_part, D};
            gemm_phase<EpiRes, StaticOrder, PG8_ALIGN, PG8_SP2>(F.lds + RING_OFF, g, S, E); } SEAM(pb + 8);
    }
    if (PHON(9) && IN(N_PHASES - 1)) { LAUNDER(); final_phase(F); }
#undef IN
#undef SEAM
}

extern "C" void kernel_launch(void* const* d_in, const int* in_sizes, int n_in, void* d_out, int out_size, void* d_ws, size_t ws_size, hipStream_t stream) {
    static int grid = 0;
    if (grid == 0) {
        if (n_in != 17 || in_sizes[0] != M * D || out_size != M * D || ws_size < WS_END) { fprintf(stderr, "kernel_launch: unexpected shapes (n_in %d, in0 %d, out %d, ws %zu < %zu?)\n", n_in, n_in > 0 ? in_sizes[0] : -1, out_size, ws_size, (size_t)WS_END); grid = -1; return; }
        int dev = 0, cus = 0, per_cu = 0;
        if (hipGetDevice(&dev) != hipSuccess || hipDeviceGetAttribute(&cus, hipDeviceAttributeMultiprocessorCount, dev) != hipSuccess) { grid = -1; return; }
        if (hipFuncSetAttribute((const void*)enc_fwd, hipFuncAttributeMaxDynamicSharedMemorySize, LDS_BYTES) != hipSuccess) { fprintf(stderr, "kernel_launch: hipFuncSetAttribute failed\n"); grid = -1; return; }
        if (hipOccupancyMaxActiveBlocksPerMultiprocessor(&per_cu, (const void*)enc_fwd, NWAVES * 64, LDS_BYTES) != hipSuccess || per_cu < 1) fprintf(stderr, "kernel_launch: occupancy query reports %d\n", per_cu);
        (void)hipGetLastError();
        grid = cus;
    }
    if (grid < 0) return;
    if (hipMemsetAsync((char*)d_ws + WS_CTL, 0, CTL_ZERO_BYTES, stream) != hipSuccess) { fprintf(stderr, "kernel_launch: memset failed\n"); return; }
    Args a{};
    for (int i = 0; i < 17; ++i) a.in[i] = d_in[i];
    a.out = (float*)d_out; a.ws = (unsigned char*)d_ws;
#if MK_SPLIT
    for (int p = 0; p < N_PHASES; ++p) { a.ph_lo = p; a.ph_hi = p + 1; hipLaunchKernelGGL(enc_fwd, dim3(grid), dim3(NWAVES * 64), LDS_BYTES, stream, a); }
#else
    a.ph_lo = 0; a.ph_hi = N_PHASES;
    hipLaunchKernelGGL(enc_fwd, dim3(grid), dim3(NWAVES * 64), LDS_BYTES, stream, a);
#endif
    const hipError_t le = hipPeekAtLastError();
    if (le != hipSuccess) fprintf(stderr, "kernel_launch: launch failed: %s\n", hipGetErrorName(le));
}
```

```cpp
#include <hip/hip_runtime.h>
#include <cstdio>
#include <cstdint>

#ifndef PH_MASK
#define PH_MASK 0x3ff
#endif
#define PHON(k) ((PH_MASK >> (k)) & 1)
#ifndef PH_REPEAT
#define PH_REPEAT 0
#endif
#define PHREP(k) (((PH_REPEAT >> (k)) & 1) ? 2 : 1)
#ifndef MK_SPLIT
#define MK_SPLIT 0
#endif

namespace pg8 {
#define PG8_LAS __attribute__((address_space(3)))
typedef unsigned short bf16_t;
typedef short bf16x8 __attribute__((ext_vector_type(8)));
typedef float f32x4 __attribute__((ext_vector_type(4)));
typedef unsigned u32x4 __attribute__((ext_vector_type(4)));
constexpr int BM = 256, BK = 64, HALF = 128, HTB = HALF * BK * 2  , STAGE_BYTES = 8 * HTB, NXCD = 8, WGM = 8;

__host__ __device__ __forceinline__ int lds_byte(int r, int c) { const int st = (r >> 4) * 2 + (c >> 5), rr = r & 15, cc = c & 31, ob = rr * 64 + cc * 2; return st * 1024 + (ob ^ (((ob >> 9) & 1) << 5)); }
__host__ __device__ __forceinline__ void stage_rc(int b, int& R, int& C) { const int st = b / 1024, sb = b % 1024, swz = sb ^ (((sb >> 9) & 1) << 5); R = (st >> 1) * 16 + swz / 64; C = (st & 1) * 32 + (swz % 64) / 2; }
__host__ __device__ __forceinline__ int perm32(int rho) { const int n = rho >> 4, i = rho & 15; return 8 * (i >> 2) + 4 * n + (i & 3); }

struct Unit { int pm, pn; };
struct Gemm { const bf16_t* A; const bf16_t* Bt; int M, N, K; };

struct StaticOrder {
    int nM, nN, nwg, G, c;
    __host__ __device__ void init(int M, int N, int G_, int c_) { nM = M / BM; nN = N / BM; nwg = nM * nN; G = G_; c = c_; }
    __host__ __device__ bool next(int i, Unit& u) const {
        const long L = (long)i * G + c; if (L >= nwg) return false;
        int wgid = (int)L; { const int q = nwg / NXCD, r = nwg % NXCD, xcd = wgid % NXCD, off = wgid / NXCD; wgid = (xcd < r ? xcd * (q + 1) : r * (q + 1) + (xcd - r) * q) + off; }
        const int nig = WGM * nN, gid = wgid / nig, fm = gid * WGM, gsz = (nM - fm) < WGM ? (nM - fm) : WGM;
        u.pm = fm + ((wgid % nig) % gsz); u.pn = (wgid % nig) / gsz; return true;
    }
    __device__ __forceinline__ void a_ready(const Unit&) const {}
    __device__ __forceinline__ void done(const Unit&) const {}
};

#ifndef PROBE_GEMM
#define PROBE_GEMM 0
#endif
struct ProbeOrder : StaticOrder {
    __host__ __device__ bool next(int i, Unit& u) const { const bool ok = StaticOrder::next(i, u); if (PROBE_GEMM == 2) { u.pm = 0; u.pn = 0; } return ok; }
};
__device__ __forceinline__ unsigned cvt_pk_bf16(float lo, float hi) { unsigned r; asm volatile("v_cvt_pk_bf16_f32 %0, %1, %2" : "=v"(r) : "v"(lo), "v"(hi)); return r; }
typedef unsigned u32x2 __attribute__((ext_vector_type(2)));
__device__ __forceinline__ u32x2 pack4(const f32x4 a) { u32x2 w; w.x = cvt_pk_bf16(a[0], a[1]); w.y = cvt_pk_bf16(a[2], a[3]); return w; }
__device__ __forceinline__ u32x4 pack8(const f32x4 a, const f32x4 b) { u32x4 w; w.x = cvt_pk_bf16(a[0], a[1]); w.y = cvt_pk_bf16(a[2], a[3]); w.z = cvt_pk_bf16(b[0], b[1]); w.w = cvt_pk_bf16(b[2], b[3]); return w; }

struct EpiIn {
    static constexpr bool PERM = true, AFTER_DRAIN = false;
    bf16_t* O; int ldc; const float* rstd; const float* cosb; const float* sinb;
    __device__ __forceinline__ void operator()(const f32x4 (&acc)[2][2][4][2], const Unit& u, int wr, int wc, int fr, int fq) const {
        asm volatile("" : "+v"(fr), "+v"(fq));
        const int row0 = u.pm * BM + wr * 64 + fr, col0 = u.pn * BM + wc * 32 + 8 * fq, typ = u.pn >> 3;
        const bool rot = (typ == 3) || (typ == 5); const float osc = (typ == 3) ? 0.0625f : 1.0f;
#pragma unroll
        for (int ai = 0; ai < 2; ++ai)
#pragma unroll
            for (int m = 0; m < 4; ++m) { const int row = row0 + ai * HALF + m * 16; const float rs = rstd[row]; bf16_t* rowp = O + (size_t)row * ldc + col0;
                if (rot) { const float sc = rs * osc; const float* cp = cosb + (size_t)row * 128 + wc * 32 + 8 * fq; const float* sp = sinb + (size_t)row * 128 + wc * 32 + 8 * fq;
                    const f32x4 c0 = *(const f32x4*)cp, c1 = *(const f32x4*)(cp + 4), s0 = *(const f32x4*)sp, s1 = *(const f32x4*)(sp + 4);
                    const f32x4 a0 = acc[ai][0][m][0] * sc, a1 = acc[ai][0][m][1] * sc, b0 = acc[ai][1][m][0] * sc, b1 = acc[ai][1][m][1] * sc;
                    bf16_t* rp2 = O + (size_t)row * ldc + u.pn * BM + 16 * (2 * wc + (fq >> 1)) + 4 * (fq & 1);
                    const f32x4 o10 = a0 * c0 - b0 * s0, o11 = a1 * c1 - b1 * s1, o20 = b0 * c0 + a0 * s0, o21 = b1 * c1 + a1 * s1;
                    *(u32x2*)(rp2) = pack4(o10); *(u32x2*)(rp2 + 8) = pack4(o11);
                    *(u32x2*)(rp2 + HALF) = pack4(o20); *(u32x2*)(rp2 + HALF + 8) = pack4(o21);
                } else {
#pragma unroll
                    for (int bj = 0; bj < 2; ++bj) *(u32x4*)(rowp + bj * HALF) = pack8(acc[ai][bj][m][0] * rs, acc[ai][bj][m][1] * rs);
                } }
    }
};
struct EpiKV {
    static constexpr bool PERM = true, AFTER_DRAIN = false;
    bf16_t* KFT; bf16_t* KBT; bf16_t* VT; int ldc; const float* rstd; const float* cosT; const float* sinT; const float* lgam;
    __device__ __forceinline__ void operator()(const f32x4 (&acc)[2][2][4][2], const Unit& u, int wr, int wc, int fr, int fq) const {
        asm volatile("" : "+v"(fr), "+v"(fq));
        const int tok0 = u.pn * BM + wc * 32 + 8 * fq, ks = 2 * wc + (fq >> 1), jh = fq & 1;
        if (u.pm < 8) {
            const int h = u.pm; const float lf = lgam[h], lb = lgam[8 + h];
#pragma unroll
            for (int bj = 0; bj < 2; ++bj) { const int tok = tok0 + bj * HALF; const f32x4 r0 = *(const f32x4*)(rstd + tok), r1 = *(const f32x4*)(rstd + tok + 4);
                f32x4 wf0, wf1, wb0, wb1; const int cpos = wc * 32 + 8 * fq;
#pragma unroll
                for (int j = 0; j < 4; ++j) { wf0[j] = __expf(lf * (float)(127 - (cpos + j))); wf1[j] = __expf(lf * (float)(127 - (cpos + 4 + j))); wb0[j] = __expf(lb * (float)(cpos + j)); wb1[j] = __expf(lb * (float)(cpos + 4 + j)); }
                const size_t blk = ((size_t)((tok >> 12) * 8 + h) * 32 + ((tok >> 7) & 31)) * 32768;
#pragma unroll
                for (int m = 0; m < 4; ++m) { const int d = wr * 64 + m * 16 + fr;
                    const float* cp = cosT + (size_t)d * ldc + tok; const float* sp = sinT + (size_t)d * ldc + tok;
                    const f32x4 c0 = *(const f32x4*)cp, c1 = *(const f32x4*)(cp + 4), s0 = *(const f32x4*)sp, s1 = *(const f32x4*)(sp + 4);
                    const f32x4 a0 = acc[0][bj][m][0] * r0, a1 = acc[0][bj][m][1] * r1, b0 = acc[1][bj][m][0] * r0, b1 = acc[1][bj][m][1] * r1;
                    const f32x4 o10 = a0 * c0 - b0 * s0, o11 = a1 * c1 - b1 * s1, o20 = b0 * c0 + a0 * s0, o21 = b1 * c1 + a1 * s1;
                    const size_t e0 = blk + (size_t)((((d >> 5) * 8 + ks) * 64 + (d & 31)) * 8 + 4 * jh), e1 = e0 + 32 * 8;
                    *(u32x2*)(KFT + e0) = pack4(o10 * wf0); *(u32x2*)(KFT + e1) = pack4(o11 * wf1); *(u32x2*)(KFT + e0 + 4 * 4096) = pack4(o20 * wf0); *(u32x2*)(KFT + e1 + 4 * 4096) = pack4(o21 * wf1);
                    *(u32x2*)(KBT + e0) = pack4(o10 * wb0); *(u32x2*)(KBT + e1) = pack4(o11 * wb1); *(u32x2*)(KBT + e0 + 4 * 4096) = pack4(o20 * wb0); *(u32x2*)(KBT + e1 + 4 * 4096) = pack4(o21 * wb1); } }
        } else {
#pragma unroll
            for (int bj = 0; bj < 2; ++bj) { const int tok = tok0 + bj * HALF; const f32x4 r0 = *(const f32x4*)(rstd + tok), r1 = *(const f32x4*)(rstd + tok + 4);
                const size_t blk = ((size_t)((tok >> 12) * 8 + (u.pm - 8)) * 32 + ((tok >> 7) & 31)) * 32768;
#pragma unroll
                for (int ai = 0; ai < 2; ++ai)
#pragma unroll
                    for (int m = 0; m < 4; ++m) { const int f = wr * 64 + fr + ai * HALF + m * 16; const size_t e0 = blk + (size_t)((((f >> 5) * 8 + ks) * 64 + (f & 31)) * 8 + 4 * jh);
                        *(u32x2*)(VT + e0) = pack4(acc[ai][bj][m][0] * r0); *(u32x2*)(VT + e0 + 32 * 8) = pack4(acc[ai][bj][m][1] * r1); } }
        }
    }
};
struct EpiScale {
    static constexpr bool PERM = true, AFTER_DRAIN = false;
    bf16_t* O; int ldc; const float* rstd;
    __device__ __forceinline__ void operator()(const f32x4 (&acc)[2][2][4][2], const Unit& u, int wr, int wc, int fr, int fq) const {
        asm volatile("" : "+v"(fr), "+v"(fq));
        const int row0 = u.pm * BM + wr * 64 + fr, col0 = u.pn * BM + wc * 32 + 8 * fq;
#pragma unroll
        for (int ai = 0; ai < 2; ++ai)
#pragma unroll
            for (int m = 0; m < 4; ++m) { const int row = row0 + ai * HALF + m * 16; const float rs = rstd[row]; bf16_t* rowp = O + (size_t)row * ldc + col0;
#pragma unroll
                for (int bj = 0; bj < 2; ++bj) *(u32x4*)(rowp + bj * HALF) = pack8(acc[ai][bj][m][0] * rs, acc[ai][bj][m][1] * rs); }
    }
};
struct EpiRes {
    static constexpr bool PERM = true, AFTER_DRAIN = false;
    const float* xin32; bf16_t* xb; float* part; int ldc;
    __device__ __forceinline__ void operator()(const f32x4 (&acc)[2][2][4][2], const Unit& u, int wr, int wc, int fr, int fq) const {
        asm volatile("" : "+v"(fr), "+v"(fq));
        const int row0 = u.pm * BM + wr * 64 + fr, col0 = u.pn * BM + wc * 32 + 8 * fq;
#pragma unroll
        for (int ai = 0; ai < 2; ++ai)
#pragma unroll
            for (int m = 0; m < 4; ++m) { const int row = row0 + ai * HALF + m * 16; const size_t off = (size_t)row * ldc + col0; float ss = 0.f;
#pragma unroll
                for (int bj = 0; bj < 2; ++bj) { f32x4 x0, x1;
                    if (xin32) { x0 = *(const f32x4*)(xin32 + off + bj * HALF); x1 = *(const f32x4*)(xin32 + off + bj * HALF + 4); }
                    else { const u32x4 w = *(const u32x4*)(xb + off + bj * HALF);
                        x0 = (f32x4){__uint_as_float(w.x << 16), __uint_as_float(w.x & 0xffff0000u), __uint_as_float(w.y << 16), __uint_as_float(w.y & 0xffff0000u)};
                        x1 = (f32x4){__uint_as_float(w.z << 16), __uint_as_float(w.z & 0xffff0000u), __uint_as_float(w.w << 16), __uint_as_float(w.w & 0xffff0000u)}; }
                    const f32x4 v0 = x0 + acc[ai][bj][m][0], v1 = x1 + acc[ai][bj][m][1];
                    *(u32x4*)(xb + off + bj * HALF) = pack8(v0, v1);
                    ss += (v0[0] * v0[0] + v0[1] * v0[1]) + (v0[2] * v0[2] + v0[3] * v0[3]) + (v1[0] * v1[0] + v1[1] * v1[1]) + (v1[2] * v1[2] + v1[3] * v1[3]); }
                ss += __shfl_xor(ss, 16); ss += __shfl_xor(ss, 32);
                if (fq == 0) part[(size_t)row * 64 + u.pn * 4 + wc] = ss; }
    }
};

template <class Epi, class Sched, bool ALIGN_EPI = false, bool SP2 = false>
__device__ __forceinline__ void gemm_phase(PG8_LAS unsigned char* lds, const Gemm g, const Sched& S, const Epi& E) {
    int tid_ = threadIdx.x; asm volatile("" : "+v"(tid_));
    const int tid = tid_, wid = __builtin_amdgcn_readfirstlane(tid >> 6), lane = tid & 63, wr = wid >> 2, wc = wid & 3, fr = lane & 15, fq = lane >> 4;
    const int K = g.K, nt = K / BK;
    unsigned voffA[2], voffB[2];
#pragma unroll
    for (int i = 0; i < 2; ++i) { int R, C; stage_rc(tid * 16 + i * 8192, R, C); const int Rb = Epi::PERM ? ((R & ~31) + perm32(R & 31)) : R;
        voffA[i] = (unsigned)(R * K + C) * 2u; voffB[i] = (unsigned)(Rb * K + C) * 2u; }
    const size_t kstep = (size_t)(BK * 2);
    const size_t hstep = (size_t)HALF * K * 2;
    const size_t tstep = 2 * hstep;
    const unsigned ldsw = (unsigned)wid * 1024u;
    const int aoff = lds_byte(wr * 64 + fr, fq * 8), boff = lds_byte(wc * 32 + fr, fq * 8);
#define PG8_SA(b, h) (((b) * 2 + (h)) * HTB)
#define PG8_SB(b, h) ((4 + (b) * 2 + (h)) * HTB)
#define PG8_STAGE(bufoff, gbase, voff) do { _Pragma("unroll") for (int _i = 0; _i < 2; ++_i) \
        __builtin_amdgcn_global_load_lds((const unsigned*)((const char*)(gbase) + (voff)[_i]), (PG8_LAS unsigned*)(lds + (bufoff) + ldsw + _i * 8192), 16, 0, 0); } while (0)
#define PG8_LDA(dst, b, h) do { _Pragma("unroll") for (int m = 0; m < 4; ++m) _Pragma("unroll") for (int k = 0; k < 2; ++k) dst[m][k] = *(const PG8_LAS bf16x8*)(lds + PG8_SA(b, h) + aoff + m * 2048 + k * 1024); } while (0)
#define PG8_LDB(dst, b, h) do { _Pragma("unroll") for (int n = 0; n < 2; ++n) _Pragma("unroll") for (int k = 0; k < 2; ++k) dst[n][k] = *(const PG8_LAS bf16x8*)(lds + PG8_SB(b, h) + boff + n * 2048 + k * 1024); } while (0)
#define PG8_MMA(ai, bj, At, Bt) do { __builtin_amdgcn_s_setprio(1); _Pragma("unroll") for (int m = 0; m < 4; ++m) _Pragma("unroll") for (int n = 0; n < 2; ++n) _Pragma("unroll") for (int k = 0; k < 2; ++k) \
        acc[ai][bj][m][n] = __builtin_amdgcn_mfma_f32_16x16x32_bf16(Bt[n][k], At[m][k], acc[ai][bj][m][n], 0, 0, 0); __builtin_amdgcn_s_setprio(0); } while (0)
#define PG8_WAIT_V(n) asm volatile("s_waitcnt vmcnt(" #n ")" ::: "memory")
#define PG8_WAIT_L(n) asm volatile("s_waitcnt lgkmcnt(" #n ")" ::: "memory")
#define PG8_BAR __builtin_amdgcn_s_barrier()
#define PG8_SCHED __builtin_amdgcn_sched_barrier(0)
    Unit cur, nxt; int ui = 0;
    if (!S.next(0, cur)) return;
    f32x4 acc[2][2][4][2];
#pragma unroll
    for (int a = 0; a < 2; ++a)
#pragma unroll
        for (int b = 0; b < 2; ++b)
#pragma unroll
            for (int m = 0; m < 4; ++m)
#pragma unroll
                for (int n = 0; n < 2; ++n) acc[a][b][m][n] = (f32x4){0.f, 0.f, 0.f, 0.f};
    bf16x8 At[4][2], B0[2][2], B1[2][2];
    const char* cA = (const char*)g.A + (size_t)cur.pm * tstep; const char* cB = (const char*)g.Bt + (size_t)cur.pn * tstep;
    S.a_ready(cur);
    if constexpr (SP2) {
        PG8_STAGE(PG8_SB(0, 0), cB, voffB); PG8_STAGE(PG8_SB(0, 1), cB + hstep, voffB); PG8_STAGE(PG8_SA(0, 0), cA, voffA); PG8_STAGE(PG8_SA(0, 1), cA + hstep, voffA);
        if (wr == 1) PG8_BAR;
        PG8_WAIT_V(2); PG8_BAR;
        PG8_STAGE(PG8_SB(1, 0), cB + kstep, voffB); PG8_STAGE(PG8_SA(1, 0), cA + kstep, voffA); PG8_STAGE(PG8_SB(1, 1), cB + hstep + kstep, voffB);
        PG8_WAIT_V(6); PG8_BAR;
    } else {
        PG8_STAGE(PG8_SB(0, 0), cB, voffB); PG8_STAGE(PG8_SA(0, 0), cA, voffA); PG8_STAGE(PG8_SB(0, 1), cB + hstep, voffB); PG8_STAGE(PG8_SA(0, 1), cA + hstep, voffA);
        if (wr == 1) PG8_BAR;
        PG8_WAIT_V(4); PG8_BAR;
        PG8_STAGE(PG8_SB(1, 0), cB + kstep, voffB); PG8_STAGE(PG8_SA(1, 0), cA + kstep, voffA); PG8_STAGE(PG8_SB(1, 1), cB + hstep + kstep, voffB);
        PG8_WAIT_V(6); PG8_BAR;
    }
    for (;;) {
        const bool has_next = S.next(ui + 1, nxt);
        const char* nA = has_next ? (const char*)g.A + (size_t)nxt.pm * tstep : cA; const char* nB = has_next ? (const char*)g.Bt + (size_t)nxt.pn * tstep : cB;
        for (int t = 0; t < nt; t += 2) {
            const bool last = (t == nt - 2);
            const char* a1 = cA + (size_t)(t + 1) * kstep;
            const char* a2 = last ? nA : cA + (size_t)(t + 2) * kstep; const char* b2 = last ? nB : cB + (size_t)(t + 2) * kstep;
            const char* a3 = a2 + kstep; const char* b3 = b2 + kstep;
            if (last && has_next) S.a_ready(nxt);
            if constexpr (SP2) {
            PG8_LDB(B0, 0, 0); PG8_LDB(B1, 0, 1); PG8_SCHED; PG8_LDA(At, 0, 0); PG8_STAGE(PG8_SA(1, 1), a1 + hstep, voffA);
            PG8_WAIT_V(8); PG8_WAIT_L(0); PG8_BAR; PG8_MMA(0, 0, At, B0); PG8_MMA(0, 1, At, B1); PG8_BAR; PG8_SCHED;
            PG8_LDA(At, 0, 1); PG8_STAGE(PG8_SB(0, 0), b2, voffB); PG8_STAGE(PG8_SB(0, 1), b2 + hstep, voffB); PG8_STAGE(PG8_SA(0, 0), a2, voffA);
            PG8_WAIT_V(8); PG8_WAIT_L(0); PG8_BAR; PG8_MMA(1, 0, At, B0); PG8_MMA(1, 1, At, B1); PG8_BAR; PG8_SCHED;
            PG8_LDB(B0, 1, 0); PG8_LDB(B1, 1, 1); PG8_SCHED; PG8_LDA(At, 1, 0); PG8_STAGE(PG8_SA(0, 1), a2 + hstep, voffA);
            PG8_WAIT_V(8); PG8_WAIT_L(0); PG8_BAR; PG8_MMA(0, 0, At, B0); PG8_MMA(0, 1, At, B1); PG8_BAR; PG8_SCHED;
            PG8_LDA(At, 1, 1); PG8_STAGE(PG8_SB(1, 0), b3, voffB); PG8_STAGE(PG8_SB(1, 1), b3 + hstep, voffB); PG8_STAGE(PG8_SA(1, 0), a3, voffA);
            PG8_WAIT_V(8); PG8_WAIT_L(0); PG8_BAR; PG8_MMA(1, 0, At, B0); PG8_MMA(1, 1, At, B1); PG8_BAR; PG8_SCHED;
            } else {
            PG8_LDB(B0, 0, 0); PG8_SCHED; PG8_LDA(At, 0, 0); PG8_STAGE(PG8_SA(1, 1), a1 + hstep, voffA);
            PG8_WAIT_L(8); PG8_BAR; PG8_WAIT_L(0); PG8_MMA(0, 0, At, B0); PG8_BAR; PG8_SCHED;
            PG8_LDB(B1, 0, 1); PG8_STAGE(PG8_SB(0, 0), b2, voffB);
            PG8_BAR; PG8_WAIT_L(0); PG8_MMA(0, 1, At, B1); PG8_BAR;
            PG8_LDA(At, 0, 1); PG8_STAGE(PG8_SA(0, 0), a2, voffA);
            PG8_BAR; PG8_WAIT_L(0); PG8_MMA(1, 0, At, B0); PG8_BAR; PG8_SCHED;
            PG8_STAGE(PG8_SB(0, 1), b2 + hstep, voffB);
            PG8_WAIT_V(6); PG8_BAR; PG8_MMA(1, 1, At, B1); PG8_BAR;
            PG8_LDB(B0, 1, 0); PG8_SCHED; PG8_LDA(At, 1, 0); PG8_STAGE(PG8_SA(0, 1), a2 + hstep, voffA);
            PG8_WAIT_L(8); PG8_BAR; PG8_WAIT_L(0); PG8_MMA(0, 0, At, B0); PG8_BAR; PG8_SCHED;
            PG8_LDB(B1, 1, 1); PG8_STAGE(PG8_SB(1, 0), b3, voffB);
            PG8_BAR; PG8_WAIT_L(0); PG8_MMA(0, 1, At, B1); PG8_BAR;
            PG8_LDA(At, 1, 1); PG8_STAGE(PG8_SA(1, 0), a3, voffA);
            PG8_BAR; PG8_WAIT_L(0); PG8_MMA(1, 0, At, B0); PG8_BAR; PG8_SCHED;
            PG8_STAGE(PG8_SB(1, 1), b3 + hstep, voffB);
            PG8_WAIT_V(6); PG8_BAR; PG8_MMA(1, 1, At, B1); PG8_BAR;
            }
        }
        if constexpr (ALIGN_EPI) { if (wr == 0) PG8_BAR; }
        if constexpr (!Epi::AFTER_DRAIN) { E(acc, cur, wr, wc, fr, fq); S.done(cur); }
        if (!has_next) break;
#pragma unroll
        for (int a = 0; a < 2; ++a)
#pragma unroll
            for (int b = 0; b < 2; ++b)
#pragma unroll
                for (int m = 0; m < 4; ++m)
#pragma unroll
                    for (int n = 0; n < 2; ++n) acc[a][b][m][n] = (f32x4){0.f, 0.f, 0.f, 0.f};
        cur = nxt; cA = nA; cB = nB; ++ui;
        if constexpr (ALIGN_EPI) { if (wr == 1) PG8_BAR; }
    }
    PG8_WAIT_V(0);
    if constexpr (!ALIGN_EPI) { if (wr == 0) PG8_BAR; }
    PG8_BAR;
#undef PG8_SA
#undef PG8_SB
#undef PG8_STAGE
#undef PG8_LDA
#undef PG8_LDB
#undef PG8_MMA
#undef PG8_WAIT_V
#undef PG8_WAIT_L
#undef PG8_BAR
#undef PG8_SCHED
}
}

#ifndef PG8_SP2
#define PG8_SP2 true
#endif
#ifndef PG8_ALIGN
#define PG8_ALIGN true
#endif

constexpr int NWAVES = 8;
constexpr int BATCH = 4, SEQ = 4096, D = 4096, M = BATCH * SEQ, DEPTH = 2;
constexpr int CW = 2048, RW = 2048, RH = 8, HD = 256, CHUNK = 128, NCH = SEQ / CHUNK;
constexpr int IN_COLS = 14336, N1 = 12288  , FF = 11008, NGU = 2 * FF;
constexpr int COL_AB = 0, COL_AC = 2048, COL_AX = 4096, COL_Q = 6144, COL_G = 8192, COL_K = 10240;
constexpr float EPS = 1e-6f;

constexpr size_t MiB = 1u << 20;
constexpr size_t WS_CTL = 0, CTL_ZERO_BYTES = 1 * MiB;
constexpr size_t WS_RSTD1 = 1 * MiB;
constexpr size_t WS_RSTD2 = WS_RSTD1 + 256 * 1024;
constexpr size_t WS_LGAM = WS_RSTD2 + 256 * 1024;
constexpr size_t WS_PART = 2 * MiB;
constexpr size_t WS_COS = 6 * MiB, WS_SIN = 14 * MiB, WS_COST = 22 * MiB, WS_SINT = 30 * MiB;
constexpr size_t WS_WIN = 38 * MiB;
constexpr size_t WS_WOUT = WS_WIN + 112 * MiB;
constexpr size_t WS_WGU = WS_WOUT + 32 * MiB;
constexpr size_t WS_WDN = WS_WGU + 172 * MiB;
constexpr size_t WS_XB = WS_WDN + 86 * MiB;
constexpr size_t WS_R = WS_XB + 128 * MiB;
constexpr size_t WS_PROJ = WS_R;
constexpr size_t WS_KFT = WS_PROJ + 384 * MiB, WS_KBT = WS_KFT + 64 * MiB, WS_VT = WS_KBT + 64 * MiB;
constexpr size_t WS_SFT = WS_VT + 64 * MiB, WS_SBT = WS_SFT + 128 * MiB;
constexpr size_t WS_YCAT = WS_SBT + 128 * MiB;
constexpr size_t WS_MIX_END = WS_YCAT + 128 * MiB;
constexpr size_t WS_GU = WS_R;
constexpr size_t WS_ACT = WS_GU + 688 * MiB;
constexpr size_t WS_END = WS_ACT + 344 * MiB;
static_assert(WS_MIX_END <= WS_END, "overlay");
static_assert((size_t)M * N1 * 2 == 384 * MiB && (size_t)M * NGU * 2 == 688 * MiB && (size_t)M * FF * 2 == 344 * MiB && (size_t)IN_COLS * D * 2 == 112 * MiB && (size_t)NGU * D * 2 == 172 * MiB && (size_t)D * FF * 2 == 86 * MiB, "sizes");
constexpr int CW_BAR = 4096;

constexpr int RING_OFF = 0, RING_BYTES = 136 * 1024;
constexpr int LDSCTL_OFF = RING_BYTES, MISC_OFF = LDSCTL_OFF + 320;
constexpr int LDS_BYTES = 147456;
static_assert(MISC_OFF + 128 <= LDS_BYTES && 8 * 16640 <= RING_BYTES, "LDS map");

#define GAS __attribute__((address_space(1)))
#define LAS __attribute__((address_space(3)))
typedef unsigned short bf16;
typedef unsigned v4u __attribute__((ext_vector_type(4)));
typedef unsigned v2u __attribute__((ext_vector_type(2)));
typedef float f32x4 __attribute__((ext_vector_type(4)));
typedef float f32x16 __attribute__((ext_vector_type(16)));
typedef short bf16x8 __attribute__((ext_vector_type(8)));
typedef GAS unsigned gu32;
#define RLX_AGENT __ATOMIC_RELAXED, __HIP_MEMORY_SCOPE_AGENT
#define LDS_WAIT() asm volatile("s_waitcnt lgkmcnt(0)" ::: "memory")
#define VM_WAIT() asm volatile("s_waitcnt vmcnt(0)" ::: "memory")
__device__ __forceinline__ unsigned pk2(float lo, float hi) { return pg8::cvt_pk_bf16(lo, hi); }
__device__ __forceinline__ float bflo(unsigned w) { return __uint_as_float(w << 16); }
__device__ __forceinline__ float bfhi(unsigned w) { return __uint_as_float(w & 0xffff0000u); }
__device__ __forceinline__ void unpack8(const v4u w, float (&f)[8]) { f[0] = bflo(w.x); f[1] = bfhi(w.x); f[2] = bflo(w.y); f[3] = bfhi(w.y); f[4] = bflo(w.z); f[5] = bfhi(w.z); f[6] = bflo(w.w); f[7] = bfhi(w.w); }

#define XB_TMO      128
#define XB_XCNT(j)  (256  + 64 * (j))
#define XB_XSUB(j)  (1280 + 64 * (j))
#define XB_XGEN(j)  (2304 + 64 * (j))
#define XB_TOP      3328
#define XB_TOPGEN   3392
#define XCD_BAR_WORDS 3456
#define XB_SPIN_CAP (1u << 18)

__device__ __forceinline__ unsigned xb_ld(unsigned* p)              { return __hip_atomic_load(p, __ATOMIC_RELAXED, __HIP_MEMORY_SCOPE_AGENT); }
__device__ __forceinline__ unsigned xb_add(unsigned* p, unsigned v) { return __hip_atomic_fetch_add(p, v, __ATOMIC_RELAXED, __HIP_MEMORY_SCOPE_AGENT); }
__device__ __forceinline__ unsigned xb_xcc_id() { return (unsigned)__builtin_amdgcn_s_getreg((3 << 11) | 20) & 0xFu; }
#define XB_SPIN(cond, bar) do { unsigned _sp = 0; while (cond) { __builtin_amdgcn_s_sleep(1); \
    if ((++_sp & 255u) == 0u) { if (xb_ld(&(bar)[XB_TMO])) break; if (_sp > XB_SPIN_CAP) { atomicAdd(&(bar)[XB_TMO], 1u); break; } } } } while (0)

struct XcdBarrier {
    unsigned* bar; unsigned x;
    volatile LAS unsigned* st;
};
__device__ __forceinline__ XcdBarrier xcd_barrier_post(unsigned* bar, volatile LAS unsigned* st) {
    XcdBarrier b; b.bar = bar; b.x = xb_xcc_id(); b.st = st;
    if (threadIdx.x == 0) (void)xb_add(&bar[XB_XCNT(b.x)], 1u);
    return b;
}
__device__ __forceinline__ void xcd_barrier_complete(unsigned* bar, unsigned x, unsigned& nloc, unsigned& nx) {
    const unsigned G = gridDim.x * gridDim.y * gridDim.z;
    unsigned sum, cnt, mine, sp = 0u;
    for (;;) {
        sum = 0u; cnt = 0u; mine = 0u;
#pragma unroll
        for (unsigned j = 0; j < 16; ++j) { const unsigned c = xb_ld(&bar[XB_XCNT(j)]); sum += c; cnt += (c > 0u) ? 1u : 0u; mine = (j == x) ? c : mine; }
        if (sum == G) break;
        __builtin_amdgcn_s_sleep(1);
        if ((++sp & 255u) == 0u) { if (xb_ld(&bar[XB_TMO])) break; if (sp > XB_SPIN_CAP) { atomicAdd(&bar[XB_TMO], 1u); break; } }
    }
    nloc = mine > 0u ? mine : 1u; nx = cnt > 0u ? cnt : 1u;
}
__device__ __forceinline__ void xcd_barrier(const XcdBarrier& b) {
    asm volatile("s_waitcnt vmcnt(0)" ::: "memory");
    __syncthreads();
    if (threadIdx.x == 0) {
        unsigned* bar = b.bar;
        __builtin_amdgcn_s_waitcnt(0);
        unsigned nloc = b.st[0], nx = b.st[1];
        if (nloc == 0u) { xcd_barrier_complete(bar, b.x, nloc, nx); b.st[0] = nloc; b.st[1] = nx; }
        const unsigned old = xb_add(&bar[XB_XSUB(b.x)], 1u);
        const unsigned gen = old / nloc;
        if (old + 1u == (gen + 1u) * nloc) {
            __builtin_amdgcn_fence(__ATOMIC_RELEASE, "agent");
            asm volatile("s_waitcnt vmcnt(0)" ::: "memory");
            const unsigned og = xb_add(&bar[XB_TOP], 1u);
            const unsigned tg = og / nx;
            if (og + 1u == (tg + 1u) * nx) xb_add(&bar[XB_TOPGEN], 1u);
            else XB_SPIN(xb_ld(&bar[XB_TOPGEN]) == tg, bar);
            __builtin_amdgcn_fence(__ATOMIC_ACQUIRE, "agent");
            xb_add(&bar[XB_XGEN(b.x)], 1u);
            asm volatile("s_waitcnt vmcnt(0)" ::: "memory");
        } else {
            XB_SPIN(xb_ld(&bar[XB_XGEN(b.x)]) == gen, bar);
            __builtin_amdgcn_fence(__ATOMIC_ACQUIRE, "agent");
            asm volatile("s_waitcnt vmcnt(0)" ::: "memory");
        }
    }
    __syncthreads();
}

struct Args { const void* in[17]; float* out; unsigned char* ws; int ph_lo, ph_hi; };
static_assert(sizeof(Args) == 17 * 8 + 8 + 8 + 8, "Args has no padding");
struct Frame {
    LAS unsigned char* lds;
    int tid, lane, wave;
    int vcu, G;
    const __attribute__((address_space(4))) Args* ap;
};
#define F_x ((const float*)(const GAS float*)F.ap->in[0])
#define F_pos ((const int*)(const GAS int*)F.ap->in[1])
#define F_norm1_g ((const float*)(const GAS float*)F.ap->in[2])
#define F_w_in ((const float*)(const GAS float*)F.ap->in[3])
#define F_conv_a_w ((const float*)(const GAS float*)F.ap->in[4])
#define F_conv_a_b ((const float*)(const GAS float*)F.ap->in[5])
#define F_beta_a ((const float*)(const GAS float*)F.ap->in[6])
#define F_dlogit ((const float*)(const GAS float*)F.ap->in[7])
#define F_gn_g ((const float*)(const GAS float*)F.ap->in[8])
#define F_w_out ((const float*)(const GAS float*)F.ap->in[9])
#define F_norm2_g ((const float*)(const GAS float*)F.ap->in[10])
#define F_w_gate ((const float*)(const GAS float*)F.ap->in[11])
#define F_w_up ((const float*)(const GAS float*)F.ap->in[12])
#define F_ffn_w ((const float*)(const GAS float*)F.ap->in[13])
#define F_ffn_b ((const float*)(const GAS float*)F.ap->in[14])
#define F_w_down ((const float*)(const GAS float*)F.ap->in[15])
#define F_norm_f ((const float*)(const GAS float*)F.ap->in[16])
#define F_out ((float*)(GAS float*)F.ap->out)
#define F_rstd1 ((float*)(GAS float*)(F.ap->ws + WS_RSTD1))
#define F_rstd2 ((float*)(GAS float*)(F.ap->ws + WS_RSTD2))
#define F_lgam ((float*)(GAS float*)(F.ap->ws + WS_LGAM))
#define F_part ((float*)(GAS float*)(F.ap->ws + WS_PART))
#define F_cosb ((float*)(GAS float*)(F.ap->ws + WS_COS))
#define F_sinb ((float*)(GAS float*)(F.ap->ws + WS_SIN))
#define F_cosT ((float*)(GAS float*)(F.ap->ws + WS_COST))
#define F_sinT ((float*)(GAS float*)(F.ap->ws + WS_SINT))
#define F_WIN ((bf16*)(GAS bf16*)(F.ap->ws + WS_WIN))
#define F_WOUT ((bf16*)(GAS bf16*)(F.ap->ws + WS_WOUT))
#define F_WGU ((bf16*)(GAS bf16*)(F.ap->ws + WS_WGU))
#define F_WDN ((bf16*)(GAS bf16*)(F.ap->ws + WS_WDN))
#define F_XB ((bf16*)(GAS bf16*)(F.ap->ws + WS_XB))
#define F_PROJ ((bf16*)(GAS bf16*)(F.ap->ws + WS_PROJ))
#define F_KFT ((bf16*)(GAS bf16*)(F.ap->ws + WS_KFT))
#define F_KBT ((bf16*)(GAS bf16*)(F.ap->ws + WS_KBT))
#define F_VT ((bf16*)(GAS bf16*)(F.ap->ws + WS_VT))
#define F_SFT ((bf16*)(GAS bf16*)(F.ap->ws + WS_SFT))
#define F_SBT ((bf16*)(GAS bf16*)(F.ap->ws + WS_SBT))
#define F_YCAT ((bf16*)(GAS bf16*)(F.ap->ws + WS_YCAT))
#define F_GU ((bf16*)(GAS bf16*)(F.ap->ws + WS_GU))
#define F_ACT ((bf16*)(GAS bf16*)(F.ap->ws + WS_ACT))
__device__ __forceinline__ float wave_sum(float v) {
#pragma unroll
    for (int o = 1; o < 64; o <<= 1) v += __shfl_xor(v, o);
    return v;
}

__device__ __forceinline__ void cvt_item(const float* __restrict__ W, int N, const float* __restrict__ gain, bf16* WT, int K, int k0, int n0s, int n0d, LAS float* scr, int lane) {
    const int r4 = lane >> 4, c4 = (lane & 15) * 4;
    f32x4 v[16];
#pragma unroll
    for (int i = 0; i < 16; ++i) v[i] = *(const f32x4*)(W + (size_t)(k0 + 4 * i + r4) * N + n0s + c4);
#pragma unroll
    for (int i = 0; i < 16; ++i) { const int kk = 4 * i + r4; const float g = gain ? gain[k0 + kk] : 1.0f; LAS float* s = scr + kk * 65 + c4;
        s[0] = v[i].x * g; s[1] = v[i].y * g; s[2] = v[i].z * g; s[3] = v[i].w * g; }
    LDS_WAIT(); asm volatile("" ::: "memory");
    const int c = lane & 7;
#pragma unroll
    for (int it = 0; it < 8; ++it) { const int n = (lane >> 3) + 8 * it; const LAS float* s = scr + (8 * c) * 65 + n;
        v4u o; o.x = pk2(s[0 * 65], s[1 * 65]); o.y = pk2(s[2 * 65], s[3 * 65]); o.z = pk2(s[4 * 65], s[5 * 65]); o.w = pk2(s[6 * 65], s[7 * 65]);
        *(v4u*)(WT + (size_t)(n0d + n) * K + k0 + 8 * c) = o; }
    LDS_WAIT(); asm volatile("" ::: "memory");
}
__device__ __forceinline__ void cvt_matrix(Frame& F, const float* W, int K, int N, const float* gain, bf16* WT, int dst_row0, bool in_perm, int& it, int it_end_prev, LAS float* scr) {
    const int nnb = N / 64, nitems = (K / 64) * nnb, NGW = F.G * NWAVES;
    for (; it < it_end_prev + nitems; it += NGW) {
        const int r = it - it_end_prev, kb = r / nnb, nb = r % nnb; const int n0s = nb * 64; int n0d = dst_row0 + n0s;
        if (in_perm) { const int blk = n0s >> 11, dblk = (blk < 4) ? blk : (blk == 4 ? 5 : (blk == 5 ? 6 : 4)); n0d = dblk * 2048 + (n0s & 2047); }
        cvt_item(W, N, gain, WT, K, kb * 64, n0s, n0d, scr, F.lane);
    }
}

__device__ __forceinline__ void rstd_from_part(Frame& F, float* rstd) {
    const int gw = F.vcu * NWAVES + F.wave, NGW = F.G * NWAVES;
    for (int row = gw; row < M; row += NGW) { const float s = wave_sum(F_part[(size_t)row * 64 + F.lane]); if (F.lane == 0) rstd[row] = 1.0f / sqrtf(s * (1.0f / D) + EPS); }
}
__device__ __forceinline__ void p0_phase(Frame& F, int l) {
    LAS float* scr = (LAS float*)(F.lds + RING_OFF + F.wave * 16640);
    const int gw = F.vcu * NWAVES + F.wave, NGW = F.G * NWAVES;
    int it = gw, base = 0;
    cvt_matrix(F, F_w_in + (size_t)l * D * IN_COLS, D, IN_COLS, F_norm1_g + l * D, F_WIN, 0, true, it, base, scr); base += (D / 64) * (IN_COLS / 64);
    cvt_matrix(F, F_w_out + (size_t)l * D * D, D, D, nullptr, F_WOUT, 0, false, it, base, scr); base += (D / 64) * (D / 64);
    cvt_matrix(F, F_w_gate + (size_t)l * D * FF, D, FF, F_norm2_g + l * D, F_WGU, 0, false, it, base, scr); base += (D / 64) * (FF / 64);
    cvt_matrix(F, F_w_up + (size_t)l * D * FF, D, FF, F_norm2_g + l * D, F_WGU, FF, false, it, base, scr); base += (D / 64) * (FF / 64);
    cvt_matrix(F, F_w_down + (size_t)l * FF * D, FF, D, nullptr, F_WDN, 0, false, it, base, scr);
    if (l == 0) {
        for (int m = gw; m < M; m += NGW) { const float* xr = F_x + (size_t)m * D + 8 * F.lane; f32x4 v[16]; float ss = 0.f;
#pragma unroll
            for (int j = 0; j < 8; ++j) { v[2 * j] = *(const f32x4*)(xr + 512 * j); v[2 * j + 1] = *(const f32x4*)(xr + 512 * j + 4); }
#pragma unroll
            for (int j = 0; j < 16; ++j) ss += (v[j].x * v[j].x + v[j].y * v[j].y) + (v[j].z * v[j].z + v[j].w * v[j].w);
            ss = wave_sum(ss); if (F.lane == 0) F_rstd1[m] = 1.0f / sqrtf(ss * (1.0f / D) + EPS);
            bf16* o = F_XB + (size_t)m * D + 8 * F.lane;
#pragma unroll
            for (int j = 0; j < 8; ++j) *(v4u*)(o + 512 * j) = pg8::pack8(v[2 * j], v[2 * j + 1]); }
        { const int gt = gw * 64 + F.lane, NT = NGW * 64; const int j = gt & 127;
          const float inv = exp2f(-(float)j * (13.287712379549449f / 128.0f));
          for (int idx = gt; idx < M * 128; idx += NT) { const int m = idx >> 7; const float ang = (float)F_pos[m] * inv;
              const double a = (double)ang, k = rint(a * 0.15915494309189535), r = a - k * 6.283185307179586; const float rf = (float)r;
              const float c = cosf(rf), s = sinf(rf);
              F_cosb[idx] = c; F_sinb[idx] = s; F_cosT[(size_t)j * M + m] = c; F_sinT[(size_t)j * M + m] = s; } }
        if (blockIdx.x == 0 && F.tid < DEPTH * 2 * RH) { const float xl = F_dlogit[F.tid]; const float t = __expf(-xl);
            const float ser = t * (1.0f - t * (0.5f - t * (0.33333334f - t * (0.25f - t * 0.2f)))); F_lgam[F.tid] = -((t < 0.04f) ? ser : __logf(1.0f + t)); }
    } else rstd_from_part(F, F_rstd1);
}

__device__ __forceinline__ void mixer_a(Frame& F, int l) {
    const int gw = F.vcu * NWAVES + F.wave, NGW = F.G * NWAVES;
    for (int item = gw; item < (M / 32) * 4; item += NGW) {
        const int t0 = (item >> 2) * 32, c0 = (item & 3) * 512 + F.lane * 8;
        float w0[8], w1[8], w2[8], bb[8], be[8];
        { const float* cw = F_conv_a_w + (size_t)l * 3 * CW + c0; const float* cb = F_conv_a_b + (size_t)l * CW + c0; const float* bt = F_beta_a + (size_t)l * CW + c0;
#pragma unroll
          for (int j = 0; j < 8; ++j) { w0[j] = cw[j]; w1[j] = cw[CW + j]; w2[j] = cw[2 * CW + j]; bb[j] = cb[j]; be[j] = bt[j]; } }
        float pp[8], pc[8], pn[8];
        auto prod = [&](int t, float (&p)[8]) { const bf16* r = F_PROJ + (size_t)t * N1 + c0; float a[8], b[8]; unpack8(*(const v4u*)(r + COL_AC), a); unpack8(*(const v4u*)(r + COL_AX), b);
#pragma unroll
            for (int j = 0; j < 8; ++j) p[j] = a[j] * b[j]; };
        if ((t0 & (SEQ - 1)) == 0) {
#pragma unroll
            for (int j = 0; j < 8; ++j) pp[j] = 0.f;
        } else prod(t0 - 1, pp);
        prod(t0, pc);
        for (int t = t0; t < t0 + 32; ++t) {
            if ((t & (SEQ - 1)) == SEQ - 1) {
#pragma unroll
                for (int j = 0; j < 8; ++j) pn[j] = 0.f;
            } else prod(t + 1, pn);
            float ab[8], y[8]; unpack8(*(const v4u*)(F_PROJ + (size_t)t * N1 + COL_AB + c0), ab); float ss = 0.f;
#pragma unroll
            for (int j = 0; j < 8; ++j) { y[j] = ab[j] * (w0[j] * pp[j] + w1[j] * pc[j] + w2[j] * pn[j] + bb[j]); ss += y[j] * y[j]; }
            ss += __shfl_xor(ss, 1); ss += __shfl_xor(ss, 2); ss += __shfl_xor(ss, 4); ss += __shfl_xor(ss, 8);
            const float r = 1.0f / sqrtf(ss * (1.0f / 128.0f) + EPS);
            v4u o; o.x = pk2(y[0] * r * be[0], y[1] * r * be[1]); o.y = pk2(y[2] * r * be[2], y[3] * r * be[3]); o.z = pk2(y[4] * r * be[4], y[5] * r * be[5]); o.w = pk2(y[6] * r * be[6], y[7] * r * be[7]);
            *(v4u*)(F_YCAT + (size_t)t * D + c0) = o;
#pragma unroll
            for (int j = 0; j < 8; ++j) { pp[j] = pc[j]; pc[j] = pn[j]; }
        }
    }
}

#define MFMA32(a, b, c) __builtin_amdgcn_mfma_f32_32x32x16_bf16((a), (b), (c), 0, 0, 0)
struct ScanFrags { bf16x8 a[4], b0[4], b1[4]; };
__device__ __forceinline__ void scan_load(ScanFrags& f, const bf16* kt, const bf16* vt, const int half) {
#pragma unroll
    for (int k = 0; k < 4; ++k) { const int ks = 4 * half + k; f.a[k] = *(const bf16x8*)(kt + 512 * ks); f.b0[k] = *(const bf16x8*)(vt + 512 * ks); f.b1[k] = *(const bf16x8*)(vt + 8 * 512 + 512 * ks); }
}
__device__ __forceinline__ void scan_phase(Frame& F, int l) {
    const int gw = F.vcu * NWAVES + F.wave, NGW = F.G * NWAVES;
    for (int unit = gw; unit < BATCH * RH * 2 * 8 * 4; unit += NGW) {
        const int eq = unit & 3, dblk = (unit >> 2) & 7, dir = (unit >> 5) & 1, h = (unit >> 6) & 7, b = unit >> 9;
        const size_t blk0 = (size_t)(b * RH + h) * NCH * (HD * CHUNK);
        const bf16* KT = (dir ? F_KBT : F_KFT) + blk0 + (size_t)(dblk * 8 * 64 + F.lane) * 8;
        const bf16* VT = F_VT + blk0 + (size_t)(2 * eq * 8 * 64 + F.lane) * 8;
        bf16* ST = (dir ? F_SBT : F_SFT) + (size_t)(b * RH + h) * NCH * (HD * HD) + (size_t)(((2 * eq) * 16 + 2 * dblk) * 64 + F.lane) * 8;
        const float g128 = __expf(128.0f * F_lgam[l * 16 + dir * 8 + h]);
        f32x16 s0, s1;
#pragma unroll
        for (int r = 0; r < 16; ++r) { s0[r] = 0.f; s1[r] = 0.f; }
        ScanFrags fa, fb;
        { const int n0 = dir ? (NCH - 1) : 0; scan_load(fa, KT + (size_t)n0 * HD * CHUNK, VT + (size_t)n0 * HD * CHUNK, 0); }
        for (int step = 0; step < NCH; ++step) {
            const int n = dir ? (NCH - 1 - step) : step, nn = dir ? (n - 1) : (n + 1);
            const bf16* kt = KT + (size_t)n * HD * CHUNK; const bf16* vt = VT + (size_t)n * HD * CHUNK;
            scan_load(fb, kt, vt, 1);
            bf16* st = ST + (size_t)n * HD * HD;
#pragma unroll
            for (int sp = 0; sp < 2; ++sp) {
                v4u a; a.x = pk2(s0[8 * sp], s0[8 * sp + 1]); a.y = pk2(s0[8 * sp + 2], s0[8 * sp + 3]); a.z = pk2(s0[8 * sp + 4], s0[8 * sp + 5]); a.w = pk2(s0[8 * sp + 6], s0[8 * sp + 7]);
                *(v4u*)(st + sp * 512) = a;
                v4u c; c.x = pk2(s1[8 * sp], s1[8 * sp + 1]); c.y = pk2(s1[8 * sp + 2], s1[8 * sp + 3]); c.z = pk2(s1[8 * sp + 4], s1[8 * sp + 5]); c.w = pk2(s1[8 * sp + 6], s1[8 * sp + 7]);
                *(v4u*)(st + 16 * 512 + sp * 512) = c; }
#pragma unroll
            for (int r = 0; r < 16; ++r) { s0[r] *= g128; s1[r] *= g128; }
#pragma unroll
            for (int k = 0; k < 4; ++k) { s0 = MFMA32(fa.a[k], fa.b0[k], s0); s1 = MFMA32(fa.a[k], fa.b1[k], s1); }
            if (step + 1 < NCH) scan_load(fa, KT + (size_t)nn * HD * CHUNK, VT + (size_t)nn * HD * CHUNK, 0);
#pragma unroll
            for (int k = 0; k < 4; ++k) { s0 = MFMA32(fb.a[k], fb.b0[k], s0); s1 = MFMA32(fb.a[k], fb.b1[k], s1); }
        }
    }
}

__device__ __forceinline__ void dma16(const char* g, LAS unsigned char* l) { __builtin_amdgcn_global_load_lds((const unsigned*)g, (LAS unsigned*)l, 16, 0, 0); }
__device__ __forceinline__ void intra_dma(Frame& F, const int kind, const int p, LAS unsigned char* dst, int b, int h, int n, int w, int lane) {
    const int tok0 = b * SEQ + n * CHUNK;
    if (kind == 4) {
        const char* g0 = (const char*)F_VT + (((size_t)(b * RH + h) * NCH + n) * (HD * CHUNK)) * 2 + (size_t)(w * 64 + lane) * 16;
#pragma unroll
        for (int q = 0; q < 4; ++q) dma16(g0 + (size_t)(4 * (q >> 1) + 2 * p + (q & 1)) * 8192, dst + q * 8192 + w * 1024);
    } else if (kind == 2 || kind == 3) {
        const char* g0 = (const char*)(kind == 2 ? F_SFT : F_SBT) + ((size_t)(b * RH + h) * NCH + n) * HD * HD * 2 + (size_t)lane * 16;
#pragma unroll
        for (int q = 0; q < 4; ++q) { const int idx = q * 8 + w, ehl = idx >> 4, sx = idx & 15; dma16(g0 + (size_t)(((4 * ehl + p) * 16 + sx) * 1024), dst + q * 8192 + w * 1024); }
    } else {
        const int r0 = w * 2 + (lane >> 5), c = (lane & 31) ^ (r0 & 15);
        const char* g0 = (const char*)F_PROJ + ((size_t)(tok0 + (kind == 1 ? 64 * p : 0) + r0) * N1 + (kind == 0 ? COL_Q : COL_K) + h * HD) * 2 + c * 16;
#pragma unroll
        for (int q = 0; q < (kind == 0 ? 8 : 4); ++q) dma16(g0 + (size_t)q * 16 * N1 * 2, dst + q * 8192 + w * 1024);
    }
}
__device__ __forceinline__ void intra_phase(Frame& F, int l) {
    LAS unsigned char* QS = F.lds + RING_OFF; LAS unsigned char* BUF = QS + 65536; LAS float* red1 = (LAS float*)(QS + 131072); LAS float* red2 = red1 + 256;
    const int w = F.wave, ib = w & 3, eh = w >> 2, li = F.lane & 31, hh = F.lane >> 5, sw = li & 15, yx = hh ^ sw;
    const float L2E = 1.4426950408889634f;
    const int nun = BATCH * RH * NCH;
    if (F.vcu < nun) { const int u0 = F.vcu; intra_dma(F, 0, 0, QS, u0 >> 8, (u0 >> 5) & 7, u0 & 31, w, F.lane); intra_dma(F, 1, 0, BUF, u0 >> 8, (u0 >> 5) & 7, u0 & 31, w, F.lane); }
    for (int unit = F.vcu; unit < nun; unit += F.G) {
        const int n = unit & 31, h = (unit >> 5) & 7, b = unit >> 8;
        const int nxt = unit + F.G; const bool has_next = nxt < nun; const int n2 = nxt & 31, h2 = (nxt >> 5) & 7, b2 = nxt >> 8;
        int i = 32 * ib + li; asm volatile("" : "+v"(i));
        const int tok0 = b * SEQ + n * CHUNK, tok = tok0 + i;
        const float lf = F_lgam[l * 16 + h], lb = F_lgam[l * 16 + 8 + h];
        const float lf2 = lf * L2E, lb2 = lb * L2E;
        const LAS unsigned char* qrow = QS + (32 * ib + li) * 512;
#define QF(s) (*(const LAS bf16x8*)(qrow + (((2 * (s)) ^ yx) << 4)))
        bf16x8 pf[4][2];
        f32x16 acc[4];
#pragma unroll
        for (int et = 0; et < 4; ++et)
#pragma unroll
            for (int r = 0; r < 16; ++r) acc[et][r] = 0.f;
#pragma unroll
        for (int t = 0; t < 12; ++t) {
            VM_WAIT(); __syncthreads();
            LAS unsigned char* nb = BUF + ((t + 1) & 1) * 32768; const LAS unsigned char* cb = BUF + (t & 1) * 32768;
            int ln = F.lane; asm volatile("" : "+v"(ln));
            if (t < 11) { const int t1 = t + 1; intra_dma(F, t1 < 2 ? 1 : (t1 < 6 ? 2 : (t1 < 10 ? 3 : 4)), t1 < 2 ? t1 : (t1 < 6 ? t1 - 2 : (t1 < 10 ? t1 - 6 : t1 - 10)), nb, b, h, n, w, ln); }
            else if (has_next) intra_dma(F, 1, 0, nb, b2, h2, n2, w, ln);
            if (t == 10 && has_next) intra_dma(F, 0, 0, QS, b2, h2, n2, w, ln);
            if (t < 2) {
#pragma unroll
                for (int jtl = 0; jtl < 2; ++jtl) { const int jt = 2 * t + jtl; const LAS unsigned char* krow = cb + (32 * jtl + li) * 512;
                    f32x16 sc;
#pragma unroll
                    for (int r = 0; r < 16; ++r) sc[r] = 0.f;
#pragma unroll
                    for (int s = 0; s < 16; ++s) { const bf16x8 a = *(const LAS bf16x8*)(krow + (((2 * s) ^ yx) << 4)); sc = MFMA32(a, QF(s), sc); }
#pragma unroll
                    for (int s2 = 0; s2 < 2; ++s2) {
                        float pv[8];
#pragma unroll
                        for (int jj = 0; jj < 8; ++jj) { const int r = 8 * s2 + jj; const int j = 32 * jt + (r & 3) + 8 * (r >> 2) + 4 * hh; const int dd = i - j;
                            const float e = (dd >= 0) ? lf2 * (float)dd : lb2 * (float)(-dd); pv[jj] = sc[r] * exp2f(e); }
                        v4u pw; pw.x = pk2(pv[0], pv[1]); pw.y = pk2(pv[2], pv[3]); pw.z = pk2(pv[4], pv[5]); pw.w = pk2(pv[6], pv[7]);
                        pf[jt][s2] = __builtin_bit_cast(bf16x8, pw); } }
            } else if (t < 10) {
                const int et = (t - 2) & 3; const LAS unsigned char* srow = cb + (eh * 16 * 64 + F.lane) * 16;
#pragma unroll
                for (int s = 0; s < 16; ++s) { const bf16x8 a = *(const LAS bf16x8*)(srow + s * 1024); acc[et] = MFMA32(a, QF(s), acc[et]); }
                if (t == 5) { const float ratio = __expf(lf * (float)(i + 1) - lb * (float)(CHUNK - i));
#pragma unroll
                    for (int e2 = 0; e2 < 4; ++e2)
#pragma unroll
                        for (int r = 0; r < 16; ++r) acc[e2][r] *= ratio; }
                if (t == 9) { const float wb = __expf(lb * (float)(CHUNK - i));
#pragma unroll
                    for (int e2 = 0; e2 < 4; ++e2)
#pragma unroll
                        for (int r = 0; r < 16; ++r) acc[e2][r] *= wb; }
            } else {
                const int p = t - 10;
#pragma unroll
                for (int etl = 0; etl < 2; ++etl) { const int et = 2 * p + etl; const LAS unsigned char* vrow = cb + ((2 * eh + etl) * 8 * 64 + F.lane) * 16;
#pragma unroll
                    for (int jt = 0; jt < 4; ++jt)
#pragma unroll
                        for (int s2 = 0; s2 < 2; ++s2) { const bf16x8 a = *(const LAS bf16x8*)(vrow + (2 * jt + s2) * 1024); acc[et] = MFMA32(a, pf[jt][s2], acc[et]); } }
            }
        }
#undef QF
        float s = 0.f;
#pragma unroll
        for (int et = 0; et < 4; ++et)
#pragma unroll
            for (int r = 0; r < 16; ++r) s += acc[et][r];
        s += __shfl_xor(s, 32);
        if (hh == 0) red1[w * 32 + li] = s;
        LDS_WAIT(); __syncthreads();
        const float mean = (red1[ib * 32 + li] + red1[(ib + 4) * 32 + li]) * (1.0f / HD);
        float q = 0.f;
#pragma unroll
        for (int et = 0; et < 4; ++et)
#pragma unroll
            for (int r = 0; r < 16; ++r) { const float dlt = acc[et][r] - mean; q += dlt * dlt; }
        q += __shfl_xor(q, 32);
        if (hh == 0) red2[w * 32 + li] = q;
        LDS_WAIT(); __syncthreads();
        const float rstd = 1.0f / sqrtf((red2[ib * 32 + li] + red2[(ib + 4) * 32 + li]) * (1.0f / HD) + EPS);
        { const float* gn = F_gn_g + (size_t)l * RW + h * HD; const bf16* gp = F_PROJ + (size_t)tok * N1 + COL_G + h * HD; bf16* yp = F_YCAT + (size_t)tok * D + CW + h * HD;
#pragma unroll
          for (int et = 0; et < 4; ++et)
#pragma unroll
              for (int g = 0; g < 4; ++g) { const int e4 = 128 * eh + 32 * et + 8 * g + 4 * hh; const f32x4 gv = *(const f32x4*)(gn + e4); const v2u gw2 = *(const v2u*)(gp + e4);
                  const float gt[4] = {bflo(gw2.x), bfhi(gw2.x), bflo(gw2.y), bfhi(gw2.y)}; float y[4];
#pragma unroll
                  for (int j = 0; j < 4; ++j) { const float sg = gt[j] / (1.0f + __expf(-gt[j])); y[j] = (acc[et][4 * g + j] - mean) * rstd * gv[j] * sg; }
                  v2u o; o.x = pk2(y[0], y[1]); o.y = pk2(y[2], y[3]); *(v2u*)(yp + e4) = o; } }
    }
    VM_WAIT(); __syncthreads();
}

__device__ __forceinline__ void act_phase(Frame& F, int l) {
    const int gw = F.vcu * NWAVES + F.wave, NGW = F.G * NWAVES;
    for (int item = gw; item < (M / 32) * 22; item += NGW) {
        const int tb = item / 22, cg = item - tb * 22; const int t0 = tb * 32, c0 = cg * 512 + F.lane * 8;
        if (c0 >= FF) continue;
        float w0[8], w1[8], w2[8], bb[8];
        { const float* cw = F_ffn_w + (size_t)l * 3 * FF + c0; const float* cb = F_ffn_b + (size_t)l * FF + c0;
#pragma unroll
          for (int j = 0; j < 8; ++j) { w0[j] = cw[j]; w1[j] = cw[FF + j]; w2[j] = cw[2 * FF + j]; bb[j] = cb[j]; } }
        float gp[8], gc[8], gn[8];
        if ((t0 & (SEQ - 1)) == 0) {
#pragma unroll
            for (int j = 0; j < 8; ++j) gp[j] = 0.f;
        } else unpack8(*(const v4u*)(F_GU + (size_t)(t0 - 1) * NGU + c0), gp);
        unpack8(*(const v4u*)(F_GU + (size_t)t0 * NGU + c0), gc);
        for (int t = t0; t < t0 + 32; ++t) {
            if ((t & (SEQ - 1)) == SEQ - 1) {
#pragma unroll
                for (int j = 0; j < 8; ++j) gn[j] = 0.f;
            } else unpack8(*(const v4u*)(F_GU + (size_t)(t + 1) * NGU + c0), gn);
            float u[8], y[8]; unpack8(*(const v4u*)(F_GU + (size_t)t * NGU + FF + c0), u);
#pragma unroll
            for (int j = 0; j < 8; ++j) { const float z = w0[j] * gp[j] + w1[j] * gc[j] + w2[j] * gn[j] + bb[j]; y[j] = z / (1.0f + __expf(-z)) * u[j]; }
            v4u o; o.x = pk2(y[0], y[1]); o.y = pk2(y[2], y[3]); o.z = pk2(y[4], y[5]); o.w = pk2(y[6], y[7]);
            *(v4u*)(F_ACT + (size_t)t * FF + c0) = o;
#pragma unroll
            for (int j = 0; j < 8; ++j) { gp[j] = gc[j]; gc[j] = gn[j]; }
        }
    }
}

__device__ __forceinline__ void final_phase(Frame& F) {
    const int gw = F.vcu * NWAVES + F.wave, NGW = F.G * NWAVES;
    for (int m = gw; m < M; m += NGW) {
        const float s = wave_sum(F_part[(size_t)m * 64 + F.lane]); const float rs = 1.0f / sqrtf(s * (1.0f / D) + EPS);
        const bf16* xr = F_XB + (size_t)m * D + 8 * F.lane; float* orow = F_out + (size_t)m * D + 8 * F.lane; const float* gr = F_norm_f + 8 * F.lane;
#pragma unroll
        for (int j = 0; j < 8; ++j) { float v[8]; unpack8(*(const v4u*)(xr + 512 * j), v); const f32x4 g0 = *(const f32x4*)(gr + 512 * j), g1 = *(const f32x4*)(gr + 512 * j + 4);
            *(f32x4*)(orow + 512 * j) = (f32x4){v[0] * rs * g0[0], v[1] * rs * g0[1], v[2] * rs * g0[2], v[3] * rs * g0[3]};
            *(f32x4*)(orow + 512 * j + 4) = (f32x4){v[4] * rs * g1[0], v[5] * rs * g1[1], v[6] * rs * g1[2], v[7] * rs * g1[3]}; }
    }
}

constexpr int PH_PER_LAYER = 9, N_PHASES = DEPTH * PH_PER_LAYER + 1;

__global__ void __launch_bounds__(NWAVES * 64, 2) enc_fwd(Args args) {
    extern __shared__ __attribute__((aligned(16))) unsigned char lds[];
    Frame F;
    F.lds = (LAS unsigned char*)lds;
    volatile LAS unsigned* MISC = (volatile LAS unsigned*)(F.lds + MISC_OFF);
    F.tid = threadIdx.x; F.lane = F.tid & 63; F.wave = __builtin_amdgcn_readfirstlane(F.tid >> 6);
    F.G = gridDim.x; { const int bx = blockIdx.x; F.vcu = (F.G % 8 == 0) ? (bx % 8) * (F.G / 8) + bx / 8 : bx; }
    F.ap = (const __attribute__((address_space(4))) Args*)__builtin_amdgcn_kernarg_segment_ptr();
    unsigned char* ws = args.ws;
    for (int u = F.tid; u < (LDS_BYTES - LDSCTL_OFF) / 4; u += NWAVES * 64) ((LAS unsigned*)(F.lds + LDSCTL_OFF))[u] = 0u;
    __syncthreads();
    XcdBarrier bar; bar.bar = (unsigned*)(ws + WS_CTL) + CW_BAR; bar.x = 0; bar.st = nullptr;
#if !MK_SPLIT
    bar = xcd_barrier_post((unsigned*)(ws + WS_CTL) + CW_BAR, MISC + 8);
#define GRID_BAR() xcd_barrier(bar)
#else
#define GRID_BAR() do {} while (0)
#endif
    const int lo = args.ph_lo, hi = args.ph_hi;
#define IN(k) (lo <= (k) && (k) < hi)
#define SEAM(k) do { if (IN(k) && IN((k) + 1)) GRID_BAR(); } while (0)
    using namespace pg8;
    for (int l = 0; l < DEPTH; ++l) {
        const int pb = l * PH_PER_LAYER;
#define LAUNDER() do { F.tid = threadIdx.x; asm volatile("" : "+v"(F.tid), "+s"(F.ap)); F.lane = F.tid & 63; } while (0)
        if (PHON(0) && IN(pb + 0)) { for (int rp = 0; rp < PHREP(0); ++rp) { LAUNDER(); p0_phase(F, l); } } SEAM(pb + 0);
        if (PHON(1) && IN(pb + 1)) for (int rp = 0; rp < PHREP(1); ++rp) { LAUNDER();
            { Gemm g{F_XB, F_WIN, M, N1, D}; StaticOrder S; S.init(M, N1, F.G, (int)blockIdx.x); EpiIn E{F_PROJ, N1, F_rstd1, F_cosb, F_sinb};
              gemm_phase<EpiIn, StaticOrder, PG8_ALIGN, PG8_SP2>(F.lds + RING_OFF, g, S, E); }
            { Gemm g{F_WIN + (size_t)COL_K * D, F_XB, 2 * RW, M, D}; StaticOrder S; S.init(2 * RW, M, F.G, (int)blockIdx.x); EpiKV E{F_KFT, F_KBT, F_VT, M, F_rstd1, F_cosT, F_sinT, F_lgam + l * 16};
              gemm_phase<EpiKV, StaticOrder, PG8_ALIGN, PG8_SP2>(F.lds + RING_OFF, g, S, E); }
        } SEAM(pb + 1);
        if (PHON(2) && IN(pb + 2)) { for (int rp = 0; rp < PHREP(2); ++rp) { LAUNDER(); for (int r2 = 0; r2 < PHREP(10); ++r2) mixer_a(F, l); for (int r2 = 0; r2 < PHREP(11); ++r2) scan_phase(F, l); } } SEAM(pb + 2);
        if (PHON(3) && IN(pb + 3)) { for (int rp = 0; rp < PHREP(3); ++rp) { LAUNDER(); intra_phase(F, l); } } SEAM(pb + 3);
        if (PHON(4) && IN(pb + 4)) for (int rp = 0; rp < PHREP(4); ++rp) { LAUNDER(); Gemm g{F_YCAT, F_WOUT, M, D, D}; StaticOrder S; S.init(M, D, F.G, (int)blockIdx.x); EpiRes E{l == 0 ? F_x : nullptr, F_XB, F_part, D};
            gemm_phase<EpiRes, StaticOrder, PG8_ALIGN, PG8_SP2>(F.lds + RING_OFF, g, S, E); } SEAM(pb + 4);
        if (PHON(5) && IN(pb + 5)) { for (int rp = 0; rp < PHREP(5); ++rp) { LAUNDER(); rstd_from_part(F, F_rstd2); } } SEAM(pb + 5);
        if (PHON(6) && IN(pb + 6)) for (int rp = 0; rp < PHREP(6); ++rp) { LAUNDER(); Gemm g{F_XB, F_WGU, M, NGU, D}; StaticOrder S; S.init(M, NGU, F.G, (int)blockIdx.x); EpiScale E{F_GU, NGU, F_rstd2};
            gemm_phase<EpiScale, StaticOrder, PG8_ALIGN, PG8_SP2>(F.lds + RING_OFF, g, S, E); } SEAM(pb + 6);
#if PROBE_GEMM
        if (IN(pb + 6)) { GRID_BAR(); LAUNDER(); Gemm g{F_XB, F_WGU, M, FF, D}; ProbeOrder S; S.init(M, FF, F.G, (int)blockIdx.x); EpiScale E{F_ACT, FF, F_rstd2};
            gemm_phase<EpiScale, ProbeOrder, PG8_ALIGN, PG8_SP2>(F.lds + RING_OFF, g, S, E); GRID_BAR(); }
#endif
        if (PHON(7) && IN(pb + 7)) { for (int rp = 0; rp < PHREP(7); ++rp) { LAUNDER(); act_phase(F, l); } } SEAM(pb + 7);
        if (PHON(8) && IN(pb + 8)) for (int rp = 0; rp < PHREP(8); ++rp) { LAUNDER(); Gemm g{F_ACT, F_WDN, M, D, FF}; StaticOrder S; S.init(M, D, F.G, (int)blockIdx.x); EpiRes E{nullptr, F_XB, F_part, D};
            gemm_phase<EpiRes, StaticOrder, PG8_ALIGN, PG8_SP2>(F.lds + RING_OFF, g, S, E); } SEAM(pb + 8);
    }
    if (PHON(9) && IN(N_PHASES - 1)) { LAUNDER(); final_phase(F); }
#undef IN
#undef SEAM
}

extern "C" void kernel_launch(void* const* d_in, const int* in_sizes, int n_in, void* d_out, int out_size, void* d_ws, size_t ws_size, hipStream_t stream) {
    static int grid = 0;
    if (grid == 0) {
        if (n_in != 17 || in_sizes[0] != M * D || out_size != M * D || ws_size < WS_END) { fprintf(stderr, "kernel_launch: unexpected shapes (n_in %d, in0 %d, out %d, ws %zu < %zu?)\n", n_in, n_in > 0 ? in_sizes[0] : -1, out_size, ws_size, (size_t)WS_END); grid = -1; return; }
        int dev = 0, cus = 0, per_cu = 0;
        if (hipGetDevice(&dev) != hipSuccess || hipDeviceGetAttribute(&cus, hipDeviceAttributeMultiprocessorCount, dev) != hipSuccess) { grid = -1; return; }
        if (hipFuncSetAttribute((const void*)enc_fwd, hipFuncAttributeMaxDynamicSharedMemorySize, LDS_BYTES) != hipSuccess) { fprintf(stderr, "kernel_launch: hipFuncSetAttribute failed\n"); grid = -1; return; }
        if (hipOccupancyMaxActiveBlocksPerMultiprocessor(&per_cu, (const void*)enc_fwd, NWAVES * 64, LDS_BYTES) != hipSuccess || per_cu < 1) fprintf(stderr, "kernel_launch: occupancy query reports %d\n", per_cu);
        (void)hipGetLastError();
        grid = cus;
    }
    if (grid < 0) return;
    if (hipMemsetAsync((char*)d_ws + WS_CTL, 0, CTL_ZERO_BYTES, stream) != hipSuccess) { fprintf(stderr, "kernel_launch: memset failed\n"); return; }
    Args a{};
    for (int i = 0; i < 17; ++i) a.in[i] = d_in[i];
    a.out = (float*)d_out; a.ws = (unsigned char*)d_ws;
#if MK_SPLIT
    for (int p = 0; p < N_PHASES; ++p) { a.ph_lo = p; a.ph_hi = p + 1; hipLaunchKernelGGL(enc_fwd, dim3(grid), dim3(NWAVES * 64), LDS_BYTES, stream, a); }
#else
    a.ph_lo = 0; a.ph_hi = N_PHASES;
    hipLaunchKernelGGL(enc_fwd, dim3(grid), dim3(NWAVES * 64), LDS_BYTES, stream, a);
#endif
    const hipError_t le = hipPeekAtLastError();
    if (le != hipSuccess) fprintf(stderr, "kernel_launch: launch failed: %s\n", hipGetErrorName(le));
}
```

```cpp
#include <hip/hip_runtime.h>
#include <cstdio>
#include <cstdint>

#ifndef PH_MASK
#define PH_MASK 0x3ff
#endif
#define PHON(k) ((PH_MASK >> (k)) & 1)
#ifndef PH_REPEAT
#define PH_REPEAT 0
#endif
#define PHREP(k) (((PH_REPEAT >> (k)) & 1) ? 2 : 1)
#ifndef MK_SPLIT
#define MK_SPLIT 0
#endif

namespace pg8 {
#define PG8_LAS __attribute__((address_space(3)))
typedef unsigned short bf16_t;
typedef short bf16x8 __attribute__((ext_vector_type(8)));
typedef float f32x4 __attribute__((ext_vector_type(4)));
typedef unsigned u32x4 __attribute__((ext_vector_type(4)));
constexpr int ROWTAB_OFF = 131072;
constexpr int BM = 256, BK = 64, HALF = 128, HTB = HALF * BK * 2  , STAGE_BYTES = 8 * HTB, NXCD = 8, WGM = 8;

__host__ __device__ __forceinline__ int lds_byte(int r, int c) { const int st = (r >> 4) * 2 + (c >> 5), rr = r & 15, cc = c & 31, ob = rr * 64 + cc * 2; return st * 1024 + (ob ^ (((ob >> 9) & 1) << 5)); }
__host__ __device__ __forceinline__ void stage_rc(int b, int& R, int& C) { const int st = b / 1024, sb = b % 1024, swz = sb ^ (((sb >> 9) & 1) << 5); R = (st >> 1) * 16 + swz / 64; C = (st & 1) * 32 + (swz % 64) / 2; }
__host__ __device__ __forceinline__ int perm32(int rho) { const int n = rho >> 4, i = rho & 15; return 8 * (i >> 2) + 4 * n + (i & 3); }

struct Unit { int pm, pn; };
struct Gemm { const bf16_t* A; const bf16_t* Bt; int M, N, K; };

struct StaticOrder {
    int nM, nN, nwg, G, c;
    __host__ __device__ void init(int M, int N, int G_, int c_) { nM = M / BM; nN = N / BM; nwg = nM * nN; G = G_; c = c_; }
    __host__ __device__ bool next(int i, Unit& u) const {
        const long L = (long)i * G + c; if (L >= nwg) return false;
        int wgid = (int)L; { const int q = nwg / NXCD, r = nwg % NXCD, xcd = wgid % NXCD, off = wgid / NXCD; wgid = (xcd < r ? xcd * (q + 1) : r * (q + 1) + (xcd - r) * q) + off; }
        const int nig = WGM * nN, gid = wgid / nig, fm = gid * WGM, gsz = (nM - fm) < WGM ? (nM - fm) : WGM;
        u.pm = fm + ((wgid % nig) % gsz); u.pn = (wgid % nig) / gsz; return true;
    }
    __device__ __forceinline__ void a_ready(const Unit&) const {}
    __device__ __forceinline__ void done(const Unit&) const {}
    __device__ __forceinline__ void tick(int, bool) const {}
};

struct TailOrder : StaticOrder {
    unsigned* ctr; volatile PG8_LAS int* slot; int full, rem;
    __device__ __forceinline__ void init2(unsigned* c_, volatile PG8_LAS int* s_) { ctr = c_; slot = s_; full = nwg / G; rem = nwg - full * G; }
    __device__ __forceinline__ bool next(int i, Unit& u) const {
        if (i < full || full < 2) return StaticOrder::next(i, u);
        if (i > full || rem == 0) return false;
        const int t = *slot; if (t < 0 || t >= rem) return false;
        TailOrder tmp = *this; tmp.c = t; return tmp.StaticOrder::next(full, u);
    }
    __device__ __forceinline__ void tick(int ui, bool t0) const {
        if (rem != 0 && ui == full - 2 && t0) { const int t = (int)__hip_atomic_fetch_add(ctr, 1u, __ATOMIC_RELAXED, __HIP_MEMORY_SCOPE_AGENT); *slot = t; }
    }
};
#ifndef PROBE_GEMM
#define PROBE_GEMM 0
#endif
struct ProbeOrder : StaticOrder {
    __host__ __device__ bool next(int i, Unit& u) const { const bool ok = StaticOrder::next(i, u); if (PROBE_GEMM == 2) { u.pm = 0; u.pn = 0; } return ok; }
};
__device__ __forceinline__ unsigned cvt_pk_bf16(float lo, float hi) { unsigned r; asm volatile("v_cvt_pk_bf16_f32 %0, %1, %2" : "=v"(r) : "v"(lo), "v"(hi)); return r; }
typedef unsigned u32x2 __attribute__((ext_vector_type(2)));
constexpr float F8_ASCALE = 4.0f, F8_WSCALE = 64.0f;
__device__ __forceinline__ float f8clamp(float v) { return __builtin_fminf(__builtin_fmaxf(v * F8_ASCALE, -440.0f), 440.0f); }
__device__ __forceinline__ u32x2 pack8_fp8(const f32x4 a, const f32x4 b) { u32x2 w; int t = __builtin_amdgcn_cvt_pk_fp8_f32(f8clamp(a[0]), f8clamp(a[1]), 0, false); t = __builtin_amdgcn_cvt_pk_fp8_f32(f8clamp(a[2]), f8clamp(a[3]), t, true); w.x = (unsigned)t;
    int q = __builtin_amdgcn_cvt_pk_fp8_f32(f8clamp(b[0]), f8clamp(b[1]), 0, false); q = __builtin_amdgcn_cvt_pk_fp8_f32(f8clamp(b[2]), f8clamp(b[3]), q, true); w.y = (unsigned)q; return w; }
__device__ __forceinline__ float dpp_qp(float v, const int ctrl) { const int x = __builtin_bit_cast(int, v); return __builtin_bit_cast(float, ctrl == 0xB1 ? __builtin_amdgcn_update_dpp(x, x, 0xB1, 0xF, 0xF, false) : __builtin_amdgcn_update_dpp(x, x, 0x4E, 0xF, 0xF, false)); }
__device__ __forceinline__ f32x4 quad_transpose(f32x4 a, int q) {
    { const bool odd = (q & 1) != 0; const float s0 = odd ? a[0] : a[1], s1 = odd ? a[2] : a[3]; const float r0 = dpp_qp(s0, 0xB1), r1 = dpp_qp(s1, 0xB1);
      if (odd) { a[0] = r0; a[2] = r1; } else { a[1] = r0; a[3] = r1; } }
    { const bool hi = (q & 2) != 0; const float s0 = hi ? a[0] : a[2], s1 = hi ? a[1] : a[3]; const float r0 = dpp_qp(s0, 0x4E), r1 = dpp_qp(s1, 0x4E);
      if (hi) { a[0] = r0; a[1] = r1; } else { a[2] = r0; a[3] = r1; } }
    return a;
}
__device__ __forceinline__ u32x2 pack4(const f32x4 a) { u32x2 w; w.x = cvt_pk_bf16(a[0], a[1]); w.y = cvt_pk_bf16(a[2], a[3]); return w; }
__device__ __forceinline__ u32x4 pack8(const f32x4 a, const f32x4 b) { u32x4 w; w.x = cvt_pk_bf16(a[0], a[1]); w.y = cvt_pk_bf16(a[2], a[3]); w.z = cvt_pk_bf16(b[0], b[1]); w.w = cvt_pk_bf16(b[2], b[3]); return w; }

struct EpiIn {
    static constexpr bool PERM = true, AFTER_DRAIN = false, ROWTAB = true, CONVTAB = false;
    bf16_t* O; int ldc; const float* rstd; PG8_LAS const float* tab; const float* cosb; const float* sinb;
    bf16_t* KFT; bf16_t* KBT; bf16_t* VT; const float* lgam;
    __device__ __forceinline__ void operator()(const f32x4 (&acc)[2][2][4][2], const Unit& u, int wr, int wc, int fr, int fq) const {
        asm volatile("" : "+v"(fr), "+v"(fq));
        const int row0 = u.pm * BM + wr * 64 + fr, col0 = u.pn * BM + wc * 32 + 8 * fq, typ = u.pn >> 3;
        if (typ == 3 || typ == 5) {
            const float osc = (typ == 3) ? 0.0625f : 1.0f; const int h = u.pn & 7;
            float lf = 0.f, lb = 0.f; if (typ == 5) { lf = lgam[h]; lb = lgam[8 + h]; }
            const int tlane = ((((fr >> 2) & 1) * 32 + 8 * fq + (fr & 3)) * 8) + 4 * (fr >> 3);
#pragma unroll
            for (int ai = 0; ai < 2; ++ai) {
                const int tokb = u.pm * BM + ai * HALF; const size_t blk = ((size_t)((tokb >> 12) * 8 + h) * 32 + ((tokb >> 7) & 31)) * 32768 + (size_t)((wc * 8 + 4 * wr) * 512 + tlane);
#pragma unroll
              for (int mh = 0; mh < 2; ++mh) {
                float rsv[2]; f32x4 cv[2][2], sv[2][2];
#pragma unroll
                for (int m2 = 0; m2 < 2; ++m2) { const int row = row0 + ai * HALF + (2 * mh + m2) * 16; rsv[m2] = tab[row - u.pm * BM]; const float* cp = cosb + (size_t)row * 128 + wc * 32 + 8 * fq; const float* sp = sinb + (size_t)row * 128 + wc * 32 + 8 * fq;
                    cv[m2][0] = *(const f32x4*)cp; cv[m2][1] = *(const f32x4*)(cp + 4); sv[m2][0] = *(const f32x4*)sp; sv[m2][1] = *(const f32x4*)(sp + 4); }
                asm volatile("" : "+v"(rsv[0]), "+v"(rsv[1]), "+v"(cv[0][0]), "+v"(cv[0][1]), "+v"(cv[1][0]), "+v"(cv[1][1]), "+v"(sv[0][0]), "+v"(sv[0][1]), "+v"(sv[1][0]), "+v"(sv[1][1]));
#pragma unroll
                for (int m2 = 0; m2 < 2; ++m2) { const int m = 2 * mh + m2; const int row = row0 + ai * HALF + m * 16; const float rs = rsv[m2];
                    const float sc = rs * osc;
                    const f32x4 c0 = cv[m2][0], c1 = cv[m2][1], s0 = sv[m2][0], s1 = sv[m2][1];
                    const f32x4 a0 = acc[ai][0][m][0] * sc, a1 = acc[ai][0][m][1] * sc, b0 = acc[ai][1][m][0] * sc, b1 = acc[ai][1][m][1] * sc;
                    bf16_t* rp2 = O + (size_t)row * ldc + u.pn * BM + 16 * (2 * wc + (fq >> 1)) + 4 * (fq & 1);
                    const f32x4 o10 = a0 * c0 - b0 * s0, o11 = a1 * c1 - b1 * s1, o20 = b0 * c0 + a0 * s0, o21 = b1 * c1 + a1 * s1;
                    *(u32x2*)(rp2) = pack4(o10); *(u32x2*)(rp2 + 8) = pack4(o11);
                    *(u32x2*)(rp2 + HALF) = pack4(o20); *(u32x2*)(rp2 + HALF + 8) = pack4(o21);
                    if (typ == 5) {
                        const int c = wr * 64 + m * 16 + fr; const float wf = __expf(lf * (float)(127 - c)), wb = __expf(lb * (float)c); const int q = fr & 3;
                        bf16_t* pf = KFT + blk + m * 512; bf16_t* pb = KBT + blk + m * 512;
                        *(u32x2*)(pf) = pack4(quad_transpose(o10 * wf, q)); *(u32x2*)(pf + 32) = pack4(quad_transpose(o11 * wf, q)); *(u32x2*)(pf + 16384) = pack4(quad_transpose(o20 * wf, q)); *(u32x2*)(pf + 16384 + 32) = pack4(quad_transpose(o21 * wf, q));
                        *(u32x2*)(pb) = pack4(quad_transpose(o10 * wb, q)); *(u32x2*)(pb + 32) = pack4(quad_transpose(o11 * wb, q)); *(u32x2*)(pb + 16384) = pack4(quad_transpose(o20 * wb, q)); *(u32x2*)(pb + 16384 + 32) = pack4(quad_transpose(o21 * wb, q));
                    } } } }
        } else if (typ == 6) {
            const int h = u.pn & 7; const int tlane = ((((fr >> 2) & 1) * 32 + 8 * fq + (fr & 3)) * 8) + 4 * (fr >> 3), q = fr & 3;
            float rs8[8];
#pragma unroll
            for (int i = 0; i < 8; ++i) rs8[i] = tab[row0 - u.pm * BM + (i >> 2) * HALF + (i & 3) * 16];
            asm volatile("" : "+v"(rs8[0]), "+v"(rs8[1]), "+v"(rs8[2]), "+v"(rs8[3]), "+v"(rs8[4]), "+v"(rs8[5]), "+v"(rs8[6]), "+v"(rs8[7]));
#pragma unroll
            for (int ai = 0; ai < 2; ++ai) {
                const int tokb = u.pm * BM + ai * HALF; const size_t blk = ((size_t)((tokb >> 12) * 8 + h) * 32 + ((tokb >> 7) & 31)) * 32768 + (size_t)((wc * 8 + 4 * wr) * 512 + tlane);
#pragma unroll
                for (int m = 0; m < 4; ++m) { const float rs = rs8[ai * 4 + m]; bf16_t* pv = VT + blk + m * 512;
#pragma unroll
                    for (int bj = 0; bj < 2; ++bj)
#pragma unroll
                        for (int n = 0; n < 2; ++n) *(u32x2*)(pv + bj * 16384 + n * 32) = pack4(quad_transpose(acc[ai][bj][m][n] * rs, q)); } }
        } else {
            float rs8[8];
#pragma unroll
            for (int i = 0; i < 8; ++i) rs8[i] = tab[row0 - u.pm * BM + (i >> 2) * HALF + (i & 3) * 16];
            asm volatile("" : "+v"(rs8[0]), "+v"(rs8[1]), "+v"(rs8[2]), "+v"(rs8[3]), "+v"(rs8[4]), "+v"(rs8[5]), "+v"(rs8[6]), "+v"(rs8[7]));
#pragma unroll
            for (int ai = 0; ai < 2; ++ai)
#pragma unroll
                for (int m = 0; m < 4; ++m) { const int row = row0 + ai * HALF + m * 16; const float rs = rs8[ai * 4 + m]; bf16_t* rowp = O + (size_t)row * ldc + col0;
#pragma unroll
                    for (int bj = 0; bj < 2; ++bj) *(u32x4*)(rowp + bj * HALF) = pack8(acc[ai][bj][m][0] * rs, acc[ai][bj][m][1] * rs); }
        }
    }
};
struct EpiScale {
    static constexpr bool PERM = true, AFTER_DRAIN = false, ROWTAB = true, CONVTAB = false;
    bf16_t* O; int ldc; const float* rstd; PG8_LAS const float* tab;
    __device__ __forceinline__ void operator()(const f32x4 (&acc)[2][2][4][2], const Unit& u, int wr, int wc, int fr, int fq) const {
        asm volatile("" : "+v"(fr), "+v"(fq));
        const int rl0 = wr * 64 + fr, row0 = u.pm * BM + rl0, col0 = u.pn * BM + wc * 32 + 8 * fq;
#pragma unroll
        for (int ai = 0; ai < 2; ++ai)
#pragma unroll
            for (int m = 0; m < 4; ++m) { const int row = row0 + ai * HALF + m * 16; const float r = tab[rl0 + ai * HALF + m * 16]; bf16_t* rowp = O + (size_t)row * ldc + col0;
#pragma unroll
                for (int bj = 0; bj < 2; ++bj) *(u32x4*)(rowp + bj * HALF) = pack8(acc[ai][bj][m][0] * r, acc[ai][bj][m][1] * r); }
    }
};
__device__ __forceinline__ float dpp_row(float oldv, float v, const int ctrl) { const int o = __builtin_bit_cast(int, oldv), x = __builtin_bit_cast(int, v);
    return __builtin_bit_cast(float, ctrl == 0x111 ? __builtin_amdgcn_update_dpp(o, x, 0x111, 0xF, 0xF, false) : ctrl == 0x101 ? __builtin_amdgcn_update_dpp(o, x, 0x101, 0xF, 0xF, false)
                                   : ctrl == 0x10F ? __builtin_amdgcn_update_dpp(o, x, 0x10F, 0xF, 0xF, false) : __builtin_amdgcn_update_dpp(o, x, 0x11F, 0xF, 0xF, false)); }
__device__ __forceinline__ float dpp_in(float v, const int ctrl) { const int x = __builtin_bit_cast(int, v);
    return __builtin_bit_cast(float, ctrl == 0x10F ? __builtin_amdgcn_mov_dpp(x, 0x10F, 0xF, 0xF, true) : __builtin_amdgcn_mov_dpp(x, 0x11F, 0xF, 0xF, true)); }
struct EpiAct {
    static constexpr bool PERM = true, AFTER_DRAIN = false, ROWTAB = true, CONVTAB = true;
    bf16_t* ACT; int ldc; const float* rstd; PG8_LAS float* tab;
    float scg, scu; int pn0;
    int k8; size_t a16off;
    const float* cw; const float* cb; float* HG; float* HU;
    __device__ __forceinline__ void operator()(const f32x4 (&acc)[2][2][4][2], const Unit& u, int wr, int wc, int fr, int fq) const {
        asm volatile("" : "+v"(fr), "+v"(fq));
        const int rl0 = wr * 64 + fr, ch0 = wc * 32 + 8 * fq;
        f32x4 G[2][4][2], U[2][4][2];
#pragma unroll
        for (int ai = 0; ai < 2; ++ai)
#pragma unroll
            for (int m = 0; m < 4; ++m) { const float r = tab[rl0 + ai * HALF + m * 16]; const float rg = r * scg, ru = r * scu;
#pragma unroll
                for (int n = 0; n < 2; ++n) { G[ai][m][n] = acc[ai][0][m][n] * rg; U[ai][m][n] = acc[ai][1][m][n] * ru; } }
        PG8_LAS float* hb = tab + 768;
#define EPA_H(wr_, ai_, fl_) (((((wr_) * 4 + wc) * 2 + (ai_)) * 2 + (fl_)) * 32 + 8 * fq)
        if (fr == 0) {
#pragma unroll
            for (int ai = 0; ai < 2; ++ai) { *(PG8_LAS f32x4*)(hb + EPA_H(wr, ai, 0)) = G[ai][0][0]; *(PG8_LAS f32x4*)(hb + EPA_H(wr, ai, 0) + 4) = G[ai][0][1]; } }
        if (fr == 15) {
#pragma unroll
            for (int ai = 0; ai < 2; ++ai) { *(PG8_LAS f32x4*)(hb + EPA_H(wr, ai, 1)) = G[ai][3][0]; *(PG8_LAS f32x4*)(hb + EPA_H(wr, ai, 1) + 4) = G[ai][3][1]; } }
        asm volatile("s_waitcnt lgkmcnt(0)" ::: "memory"); __builtin_amdgcn_s_barrier(); asm volatile("" ::: "memory");
        f32x4 top[2][2], bot[2][2];
#pragma unroll
        for (int ai = 0; ai < 2; ++ai) {
            const int to = (wr == 1) ? EPA_H(0, ai, 1) : EPA_H(1, 0, 1);
            const int bo = (wr == 0) ? EPA_H(1, ai, 0) : EPA_H(0, 1, 0);
            top[ai][0] = *(PG8_LAS const f32x4*)(hb + to); top[ai][1] = *(PG8_LAS const f32x4*)(hb + to + 4); bot[ai][0] = *(PG8_LAS const f32x4*)(hb + bo); bot[ai][1] = *(PG8_LAS const f32x4*)(hb + bo + 4); }
#undef EPA_H
        f32x4 w0[2], w1[2], w2[2], bb[2];
#pragma unroll
        for (int n = 0; n < 2; ++n) { w0[n] = *(PG8_LAS const f32x4*)(tab + 256 + ch0 + 4 * n); w1[n] = *(PG8_LAS const f32x4*)(tab + 384 + ch0 + 4 * n); w2[n] = *(PG8_LAS const f32x4*)(tab + 512 + ch0 + 4 * n); bb[n] = *(PG8_LAS const f32x4*)(tab + 640 + ch0 + 4 * n); }
        const int chg = (u.pn + pn0) * HALF + ch0;
        const bool f8 = (u.pn + pn0) * HALF < k8;
        unsigned char* const ab = f8 ? (unsigned char*)ACT + chg : (unsigned char*)ACT + a16off + (size_t)(chg - k8) * 2; const size_t ap = f8 ? (size_t)k8 : (size_t)(ldc - k8) * 2;
#pragma unroll
        for (int ai = 0; ai < 2; ++ai)
#pragma unroll
            for (int m = 0; m < 4; ++m) {
                f32x4 o[2];
#pragma unroll
                for (int n = 0; n < 2; ++n)
#pragma unroll
                    for (int j = 0; j < 4; ++j) {
                        const float g = G[ai][m][n][j];
                        const float xo = (m > 0) ? dpp_in(G[ai][m > 0 ? m - 1 : 0][n][j], 0x10F) : top[ai][n][j];
                        const float gp = dpp_row(xo, g, 0x111);
                        const float yo = (m < 3) ? dpp_in(G[ai][m < 3 ? m + 1 : 3][n][j], 0x11F) : bot[ai][n][j];
                        const float gn = dpp_row(yo, g, 0x101);
                        const float z = __builtin_fmaf(w0[n][j], gp, __builtin_fmaf(w1[n][j], g, __builtin_fmaf(w2[n][j], gn, bb[n][j])));
                        o[n][j] = z * __builtin_amdgcn_rcpf(1.0f + __builtin_amdgcn_exp2f(z * -1.4426950408889634f)) * U[ai][m][n][j]; }
                const int tr = ai * HALF + wr * 64 + m * 16 + fr;
                const bool first = (ai == 0 && m == 0 && wr == 0 && fr == 0), lastr = (ai == 1 && m == 3 && wr == 1 && fr == 15);
                if (!first && !lastr) { if (f8) *(u32x2*)(ab + (size_t)(u.pm * BM + tr) * ap) = pack8_fp8(o[0], o[1]); else *(u32x4*)(ab + (size_t)(u.pm * BM + tr) * ap) = pack8(o[0], o[1]); }
                if (ai == 0 && m == 0 && wr == 0 && fr <= 1) { float* hg = HG + (size_t)(u.pm * 4 + fr) * ldc + chg; *(f32x4*)hg = G[0][0][0]; *(f32x4*)(hg + 4) = G[0][0][1];
                    if (fr == 0) { float* hu = HU + (size_t)(u.pm * 2) * ldc + chg; *(f32x4*)hu = U[0][0][0]; *(f32x4*)(hu + 4) = U[0][0][1]; } }
                if (ai == 1 && m == 3 && wr == 1 && fr >= 14) { float* hg = HG + (size_t)(u.pm * 4 + 2 + (fr - 14)) * ldc + chg; *(f32x4*)hg = G[1][3][0]; *(f32x4*)(hg + 4) = G[1][3][1];
                    if (fr == 15) { float* hu = HU + (size_t)(u.pm * 2 + 1) * ldc + chg; *(f32x4*)hu = U[1][3][0]; *(f32x4*)(hu + 4) = U[1][3][1]; } }
            }
    }
};
struct EpiRes {
    static constexpr bool PERM = true, AFTER_DRAIN = false, ROWTAB = false, CONVTAB = false;
    const float* xin32; bf16_t* xb; float* part; int ldc; float sc;
    __device__ __forceinline__ void operator()(const f32x4 (&acc)[2][2][4][2], const Unit& u, int wr, int wc, int fr, int fq) const {
        asm volatile("" : "+v"(fr), "+v"(fq));
        const int row0 = u.pm * BM + wr * 64 + fr, col0 = u.pn * BM + wc * 32 + 8 * fq;
        float ssv[8];
        if (xin32) {
#pragma unroll
            for (int q = 0; q < 4; ++q) {
                const int ai = q >> 1, mh = q & 1;
                f32x4 xv[2][2][2];
#pragma unroll
                for (int m2 = 0; m2 < 2; ++m2)
#pragma unroll
                    for (int bj = 0; bj < 2; ++bj) { const float* p = xin32 + (size_t)(row0 + ai * HALF + (2 * mh + m2) * 16) * ldc + col0 + bj * HALF; xv[m2][bj][0] = *(const f32x4*)p; xv[m2][bj][1] = *(const f32x4*)(p + 4); }
                asm volatile("" : "+v"(xv[0][0][0]), "+v"(xv[0][0][1]), "+v"(xv[0][1][0]), "+v"(xv[0][1][1]), "+v"(xv[1][0][0]), "+v"(xv[1][0][1]), "+v"(xv[1][1][0]), "+v"(xv[1][1][1]));
#pragma unroll
                for (int m2 = 0; m2 < 2; ++m2) { const int m = 2 * mh + m2; const size_t off = (size_t)(row0 + ai * HALF + m * 16) * ldc + col0; float ss = 0.f;
#pragma unroll
                    for (int bj = 0; bj < 2; ++bj) { const f32x4 v0 = xv[m2][bj][0] + acc[ai][bj][m][0] * sc, v1 = xv[m2][bj][1] + acc[ai][bj][m][1] * sc;
                        *(u32x4*)(xb + off + bj * HALF) = pack8(v0, v1);
                        ss += (v0[0] * v0[0] + v0[1] * v0[1]) + (v0[2] * v0[2] + v0[3] * v0[3]) + (v1[0] * v1[0] + v1[1] * v1[1]) + (v1[2] * v1[2] + v1[3] * v1[3]); }
                    ss += __shfl_xor(ss, 16); ss += __shfl_xor(ss, 32); ssv[ai * 4 + m] = ss; } }
        } else {
#pragma unroll
            for (int q = 0; q < 4; ++q) {
                const int ai = q >> 1, mh = q & 1;
                u32x4 xo[2][2];
#pragma unroll
                for (int m2 = 0; m2 < 2; ++m2)
#pragma unroll
                    for (int bj = 0; bj < 2; ++bj) xo[m2][bj] = *(const u32x4*)(xb + (size_t)(row0 + ai * HALF + (2 * mh + m2) * 16) * ldc + col0 + bj * HALF);
                asm volatile("" : "+v"(xo[0][0]), "+v"(xo[0][1]), "+v"(xo[1][0]), "+v"(xo[1][1]));
#pragma unroll
                for (int m2 = 0; m2 < 2; ++m2) { const int m = 2 * mh + m2; const size_t off = (size_t)(row0 + ai * HALF + m * 16) * ldc + col0; float ss = 0.f;
#pragma unroll
                    for (int bj = 0; bj < 2; ++bj) { const u32x4 w = xo[m2][bj];
                        const f32x4 x0 = (f32x4){__uint_as_float(w.x << 16), __uint_as_float(w.x & 0xffff0000u), __uint_as_float(w.y << 16), __uint_as_float(w.y & 0xffff0000u)};
                        const f32x4 x1 = (f32x4){__uint_as_float(w.z << 16), __uint_as_float(w.z & 0xffff0000u), __uint_as_float(w.w << 16), __uint_as_float(w.w & 0xffff0000u)};
                        const f32x4 v0 = x0 + acc[ai][bj][m][0] * sc, v1 = x1 + acc[ai][bj][m][1] * sc;
                        *(u32x4*)(xb + off + bj * HALF) = pack8(v0, v1);
                        ss += (v0[0] * v0[0] + v0[1] * v0[1]) + (v0[2] * v0[2] + v0[3] * v0[3]) + (v1[0] * v1[0] + v1[1] * v1[1]) + (v1[2] * v1[2] + v1[3] * v1[3]); }
                    ss += __shfl_xor(ss, 16); ss += __shfl_xor(ss, 32); ssv[ai * 4 + m] = ss; } }
        }
        if (fq == 0) {
#pragma unroll
            for (int i = 0; i < 8; ++i) part[(size_t)(row0 + (i >> 2) * HALF + (i & 3) * 16) * 64 + u.pn * 4 + wc] = ssv[i]; }
    }
};

#ifndef PROBE_PHTIME
#define PROBE_PHTIME (-1)
#endif
#ifndef PROBE_SPREAD
#define PROBE_SPREAD (-1)
#endif
#ifndef PROBE_BWAIT
#define PROBE_BWAIT (-1)
#endif
#ifndef PROBE_BARS
#define PROBE_BARS 0
#endif
#ifndef PROBE_TIMER
#define PROBE_TIMER 0
#endif
#ifndef PROBE_PHASE
#define PROBE_PHASE 6
#endif
#define PROBE_NOW() ((PROBE_TIMER & 1) ? __builtin_amdgcn_s_memtime() : __builtin_amdgcn_s_memrealtime())
typedef int v8i_t __attribute__((ext_vector_type(8)));
typedef int v4i_t __attribute__((ext_vector_type(4)));
__device__ __forceinline__ v8i_t cat8(const bf16x8 lo, const bf16x8 hi) { const u32x4 a = __builtin_bit_cast(u32x4, lo), b = __builtin_bit_cast(u32x4, hi); return (v8i_t){(int)a.x, (int)a.y, (int)a.z, (int)a.w, (int)b.x, (int)b.y, (int)b.z, (int)b.w}; }
template <class Epi, class Sched, bool ALIGN_EPI = false, bool SP2 = false, int PROBE = 0, bool F8 = false, bool I8 = false>
__device__ __forceinline__ void gemm_phase(PG8_LAS unsigned char* lds, const Gemm g, const Sched& S, const Epi& E, int tid_) {
    asm volatile("" : "+v"(tid_));
    const int tid = tid_, wid = __builtin_amdgcn_readfirstlane(tid >> 6), lane = tid & 63, wr = wid >> 2, wc = wid & 3, fr = lane & 15, fq = lane >> 4;
    const int K = g.K, nt = K / BK;
    unsigned voffA[2], voffB[2];
#pragma unroll
    for (int i = 0; i < 2; ++i) { int R, C; stage_rc(tid * 16 + i * 8192, R, C); const int Rb = Epi::PERM ? ((R & ~31) + perm32(R & 31)) : R;
        voffA[i] = (unsigned)(R * K + C) * 2u; voffB[i] = (unsigned)(Rb * K + C) * 2u; }
    const size_t kstep = (size_t)(BK * 2);
    const size_t hstep = (size_t)HALF * K * 2;
    const size_t tstep = 2 * hstep;
    const unsigned ldsw = (unsigned)wid * 1024u;
    const int aoff = lds_byte(wr * 64 + fr, fq * 8), boff = lds_byte(wc * 32 + fr, fq * 8);
#define PG8_SA(b, h) (((b) * 2 + (h)) * HTB)
#define PG8_SB(b, h) ((4 + (b) * 2 + (h)) * HTB)
#define PG8_STAGE(bufoff, gbase, voff) do { _Pragma("unroll") for (int _i = 0; _i < 2; ++_i) { unsigned _v = (voff)[_i]; if constexpr (F8) asm volatile("" : "+v"(_v));     \
        __builtin_amdgcn_global_load_lds((const unsigned*)((const char*)(gbase) + _v), (PG8_LAS unsigned*)(lds + (bufoff) + ldsw + _i * 8192), 16, 0, 0); } } while (0)
#define PG8_LDA8(dst, b, h) do { _Pragma("unroll") for (int m = 0; m < 4; ++m) dst[m] = cat8(*(const PG8_LAS bf16x8*)(lds + PG8_SA(b, h) + aoff + m * 2048), *(const PG8_LAS bf16x8*)(lds + PG8_SA(b, h) + aoff + m * 2048 + 1024)); } while (0)
#define PG8_LDB8(dst, b, h) do { _Pragma("unroll") for (int n = 0; n < 2; ++n) dst[n] = cat8(*(const PG8_LAS bf16x8*)(lds + PG8_SB(b, h) + boff + n * 2048), *(const PG8_LAS bf16x8*)(lds + PG8_SB(b, h) + boff + n * 2048 + 1024)); } while (0)
#define PG8_LDA(dst, b, h) do { _Pragma("unroll") for (int m = 0; m < 4; ++m) _Pragma("unroll") for (int k = 0; k < 2; ++k) dst[m][k] = *(const PG8_LAS bf16x8*)(lds + PG8_SA(b, h) + aoff + m * 2048 + k * 1024); } while (0)
#define PG8_LDB(dst, b, h) do { _Pragma("unroll") for (int n = 0; n < 2; ++n) _Pragma("unroll") for (int k = 0; k < 2; ++k) dst[n][k] = *(const PG8_LAS bf16x8*)(lds + PG8_SB(b, h) + boff + n * 2048 + k * 1024); } while (0)
#define PG8_MMA(ai, bj, At, Bt) do { __builtin_amdgcn_s_setprio(1); if constexpr (F8) { _Pragma("unroll") for (int m = 0; m < 4; ++m) _Pragma("unroll") for (int n = 0; n < 2; ++n) \
        acc[ai][bj][m][n] = __builtin_amdgcn_mfma_scale_f32_16x16x128_f8f6f4(Bt##8[n], At##8[m], acc[ai][bj][m][n], 0, 0, 0, 0, 0, 0); } \
        else { _Pragma("unroll") for (int m = 0; m < 4; ++m) _Pragma("unroll") for (int n = 0; n < 2; ++n) _Pragma("unroll") for (int k = 0; k < 2; ++k) \
        { if constexpr (I8) acc[ai][bj][m][n] = __builtin_bit_cast(f32x4, __builtin_amdgcn_mfma_i32_16x16x64_i8(__builtin_bit_cast(v4i_t, Bt[n][k]), __builtin_bit_cast(v4i_t, At[m][k]), __builtin_bit_cast(v4i_t, acc[ai][bj][m][n]), 0, 0, 0)); \
          else acc[ai][bj][m][n] = __builtin_amdgcn_mfma_f32_16x16x32_bf16(Bt[n][k], At[m][k], acc[ai][bj][m][n], 0, 0, 0); } } __builtin_amdgcn_s_setprio(0); } while (0)
#define PG8_WAIT_V(n) asm volatile("s_waitcnt vmcnt(" #n ")" ::: "memory")
#define PG8_WAIT_L(n) asm volatile("s_waitcnt lgkmcnt(" #n ")" ::: "memory")
#define PG8_BAR __builtin_amdgcn_s_barrier()
#define PG8_SCHED __builtin_amdgcn_sched_barrier(0)
    if (PROBE && PROBE_TIMER == 6 && tid == 0 && blockIdx.x == 0) { volatile PG8_LAS unsigned* pm = (volatile PG8_LAS unsigned*)(lds + 139264 + 320 + 64); pm[2] = (unsigned)__builtin_amdgcn_s_memrealtime(); }
    Unit cur, nxt; int ui = 0;
    if (!S.next(0, cur)) return;
    f32x4 acc[2][2][4][2];
#pragma unroll
    for (int a = 0; a < 2; ++a)
#pragma unroll
        for (int b = 0; b < 2; ++b)
#pragma unroll
            for (int m = 0; m < 4; ++m)
#pragma unroll
                for (int n = 0; n < 2; ++n) acc[a][b][m][n] = (f32x4){0.f, 0.f, 0.f, 0.f};
    bf16x8 At[4][2], B0[2][2], B1[2][2];
    v8i_t At8[4], B08[2], B18[2];
    const char* cA = (const char*)g.A + (size_t)cur.pm * tstep; const char* cB = (const char*)g.Bt + (size_t)cur.pn * tstep;
    S.a_ready(cur);
    if constexpr (SP2) {
        PG8_STAGE(PG8_SB(0, 0), cB, voffB); PG8_STAGE(PG8_SB(0, 1), cB + hstep, voffB); PG8_STAGE(PG8_SA(0, 0), cA, voffA); PG8_STAGE(PG8_SA(0, 1), cA + hstep, voffA);
        if (wr == 1) PG8_BAR;
        PG8_WAIT_V(2); PG8_BAR;
        PG8_STAGE(PG8_SB(1, 0), cB + kstep, voffB); PG8_STAGE(PG8_SA(1, 0), cA + kstep, voffA); PG8_STAGE(PG8_SB(1, 1), cB + hstep + kstep, voffB);
        PG8_WAIT_V(6); PG8_BAR;
    } else {
        PG8_STAGE(PG8_SB(0, 0), cB, voffB); PG8_STAGE(PG8_SA(0, 0), cA, voffA); PG8_STAGE(PG8_SB(0, 1), cB + hstep, voffB); PG8_STAGE(PG8_SA(0, 1), cA + hstep, voffA);
        if (wr == 1) PG8_BAR;
        PG8_WAIT_V(4); PG8_BAR;
        PG8_STAGE(PG8_SB(1, 0), cB + kstep, voffB); PG8_STAGE(PG8_SA(1, 0), cA + kstep, voffA); PG8_STAGE(PG8_SB(1, 1), cB + hstep + kstep, voffB);
        PG8_WAIT_V(6); PG8_BAR;
    }
    for (;;) {
        S.tick(ui, tid == 0);
        const bool has_next = S.next(ui + 1, nxt);
        const char* nA = has_next ? (const char*)g.A + (size_t)nxt.pm * tstep : cA; const char* nB = has_next ? (const char*)g.Bt + (size_t)nxt.pn * tstep : cB;
        unsigned long long pk0 = 0, pk1 = 0; if (PROBE && PROBE_TIMER) pk0 = PROBE_NOW();
        for (int t = 0; t < nt; t += 2) {
            const bool last = (t == nt - 2);
            const char* a1 = cA + (size_t)(t + 1) * kstep;
            const char* a2 = last ? nA : cA + (size_t)(t + 2) * kstep; const char* b2 = last ? nB : cB + (size_t)(t + 2) * kstep;
            const char* a3 = a2 + kstep; const char* b3 = b2 + kstep;
            if (last && has_next) S.a_ready(nxt);
            if constexpr (Epi::CONVTAB) { if (last && wid == 1) { int lane; asm volatile("v_mbcnt_lo_u32_b32 %0, -1, 0\n\tv_mbcnt_hi_u32_b32 %0, -1, %0" : "=v"(lane));
                const int cho = (cur.pn + E.pn0) * HALF + (lane & 31) * 4;
                __builtin_amdgcn_global_load_lds((const unsigned*)(E.cw + (lane >> 5) * 11008 + cho), (PG8_LAS unsigned*)(lds + ROWTAB_OFF + 1024), 16, 0, 0);
                __builtin_amdgcn_global_load_lds((const unsigned*)((lane >> 5) ? E.cb + cho : E.cw + 2 * 11008 + cho), (PG8_LAS unsigned*)(lds + ROWTAB_OFF + 2048), 16, 0, 0); } }
            if constexpr (Epi::ROWTAB) { if (last && wid == 0) { int lane; asm volatile("v_mbcnt_lo_u32_b32 %0, -1, 0\n\tv_mbcnt_hi_u32_b32 %0, -1, %0" : "=v"(lane)); __builtin_amdgcn_global_load_lds((const unsigned*)(E.rstd + cur.pm * BM + lane * 4), (PG8_LAS unsigned*)(lds + ROWTAB_OFF), 16, 0, 0); } }
            if constexpr (SP2 && F8) {
            PG8_LDB8(B08, 0, 0); PG8_LDB8(B18, 0, 1); PG8_SCHED; PG8_LDA8(At8, 0, 0); PG8_STAGE(PG8_SA(1, 1), a1 + hstep, voffA);
            PG8_WAIT_V(8); PG8_WAIT_L(0); PG8_BAR; PG8_MMA(0, 0, At, B0); PG8_MMA(0, 1, At, B1); PG8_BAR; PG8_SCHED;
            PG8_LDA8(At8, 0, 1); PG8_STAGE(PG8_SB(0, 0), b2, voffB); PG8_STAGE(PG8_SB(0, 1), b2 + hstep, voffB); PG8_STAGE(PG8_SA(0, 0), a2, voffA);
            PG8_WAIT_V(8); PG8_WAIT_L(0); PG8_BAR; PG8_MMA(1, 0, At, B0); PG8_MMA(1, 1, At, B1); PG8_BAR; PG8_SCHED;
            PG8_LDB8(B08, 1, 0); PG8_LDB8(B18, 1, 1); PG8_SCHED; PG8_LDA8(At8, 1, 0); PG8_STAGE(PG8_SA(0, 1), a2 + hstep, voffA);
            PG8_WAIT_V(8); PG8_WAIT_L(0); PG8_BAR; PG8_MMA(0, 0, At, B0); PG8_MMA(0, 1, At, B1); PG8_BAR; PG8_SCHED;
            PG8_LDA8(At8, 1, 1); PG8_STAGE(PG8_SB(1, 0), b3, voffB); PG8_STAGE(PG8_SB(1, 1), b3 + hstep, voffB); PG8_STAGE(PG8_SA(1, 0), a3, voffA);
            PG8_WAIT_V(8); PG8_WAIT_L(0); PG8_BAR; PG8_MMA(1, 0, At, B0); PG8_MMA(1, 1, At, B1); PG8_BAR; PG8_SCHED;
            } else if constexpr (SP2) {
            PG8_LDB(B0, 0, 0); PG8_LDB(B1, 0, 1); PG8_SCHED; PG8_LDA(At, 0, 0); PG8_STAGE(PG8_SA(1, 1), a1 + hstep, voffA);
            PG8_WAIT_V(8); PG8_WAIT_L(0); PG8_BAR; PG8_MMA(0, 0, At, B0); PG8_MMA(0, 1, At, B1); PG8_BAR; PG8_SCHED;
            PG8_LDA(At, 0, 1); PG8_STAGE(PG8_SB(0, 0), b2, voffB); PG8_STAGE(PG8_SB(0, 1), b2 + hstep, voffB); PG8_STAGE(PG8_SA(0, 0), a2, voffA);
            PG8_WAIT_V(8); PG8_WAIT_L(0); PG8_BAR; PG8_MMA(1, 0, At, B0); PG8_MMA(1, 1, At, B1); PG8_BAR; PG8_SCHED;
            PG8_LDB(B0, 1, 0); PG8_LDB(B1, 1, 1); PG8_SCHED; PG8_LDA(At, 1, 0); PG8_STAGE(PG8_SA(0, 1), a2 + hstep, voffA);
            PG8_WAIT_V(8); PG8_WAIT_L(0); PG8_BAR; PG8_MMA(0, 0, At, B0); PG8_MMA(0, 1, At, B1); PG8_BAR; PG8_SCHED;
            PG8_LDA(At, 1, 1); PG8_STAGE(PG8_SB(1, 0), b3, voffB); PG8_STAGE(PG8_SB(1, 1), b3 + hstep, voffB); PG8_STAGE(PG8_SA(1, 0), a3, voffA);
            PG8_WAIT_V(8); PG8_WAIT_L(0); PG8_BAR; PG8_MMA(1, 0, At, B0); PG8_MMA(1, 1, At, B1); PG8_BAR; PG8_SCHED;
            } else {
            PG8_LDB(B0, 0, 0); PG8_SCHED; PG8_LDA(At, 0, 0); PG8_STAGE(PG8_SA(1, 1), a1 + hstep, voffA);
            PG8_WAIT_L(8); PG8_BAR; PG8_WAIT_L(0); PG8_MMA(0, 0, At, B0); PG8_BAR; PG8_SCHED;
            PG8_LDB(B1, 0, 1); PG8_STAGE(PG8_SB(0, 0), b2, voffB);
            PG8_BAR; PG8_WAIT_L(0); PG8_MMA(0, 1, At, B1); PG8_BAR;
            PG8_LDA(At, 0, 1); PG8_STAGE(PG8_SA(0, 0), a2, voffA);
            PG8_BAR; PG8_WAIT_L(0); PG8_MMA(1, 0, At, B0); PG8_BAR; PG8_SCHED;
            PG8_STAGE(PG8_SB(0, 1), b2 + hstep, voffB);
            PG8_WAIT_V(6); PG8_BAR; PG8_MMA(1, 1, At, B1); PG8_BAR;
            PG8_LDB(B0, 1, 0); PG8_SCHED; PG8_LDA(At, 1, 0); PG8_STAGE(PG8_SA(0, 1), a2 + hstep, voffA);
            PG8_WAIT_L(8); PG8_BAR; PG8_WAIT_L(0); PG8_MMA(0, 0, At, B0); PG8_BAR; PG8_SCHED;
            PG8_LDB(B1, 1, 1); PG8_STAGE(PG8_SB(1, 0), b3, voffB);
            PG8_BAR; PG8_WAIT_L(0); PG8_MMA(0, 1, At, B1); PG8_BAR;
            PG8_LDA(At, 1, 1); PG8_STAGE(PG8_SA(1, 0), a3, voffA);
            PG8_BAR; PG8_WAIT_L(0); PG8_MMA(1, 0, At, B0); PG8_BAR; PG8_SCHED;
            PG8_STAGE(PG8_SB(1, 1), b3 + hstep, voffB);
            PG8_WAIT_V(6); PG8_BAR; PG8_MMA(1, 1, At, B1); PG8_BAR;
            }
        }
        if (PROBE && PROBE_TIMER) pk1 = PROBE_NOW();
        if constexpr (ALIGN_EPI) { if (wr == 0) PG8_BAR; }
        if constexpr (I8) {
#pragma unroll
            for (int a = 0; a < 2; ++a)
#pragma unroll
                for (int b = 0; b < 2; ++b)
#pragma unroll
                    for (int m = 0; m < 4; ++m)
#pragma unroll
                        for (int n = 0; n < 2; ++n) acc[a][b][m][n] = __builtin_convertvector(__builtin_bit_cast(v4i_t, acc[a][b][m][n]), f32x4); }
        if constexpr (!Epi::AFTER_DRAIN) { int l2_; asm volatile("v_mbcnt_lo_u32_b32 %0, -1, 0\n\tv_mbcnt_hi_u32_b32 %0, -1, %0" : "=v"(l2_)); E(acc, cur, wr, wc, l2_ & 15, l2_ >> 4); S.done(cur); }
        if (PROBE && PROBE_TIMER && PROBE_TIMER != 6) { const unsigned long long pk2 = PROBE_NOW(); if (tid == 0 && blockIdx.x == 0) { volatile PG8_LAS unsigned* pm = (volatile PG8_LAS unsigned*)(lds + 139264 + 320 + 64);
            pm[0] += (unsigned)((PROBE_TIMER <= 2) ? (pk1 - pk0) : (pk2 - pk1)); pm[1] += 1u; } }
        if (!has_next) break;
#pragma unroll
        for (int a = 0; a < 2; ++a)
#pragma unroll
            for (int b = 0; b < 2; ++b)
#pragma unroll
                for (int m = 0; m < 4; ++m)
#pragma unroll
                    for (int n = 0; n < 2; ++n) acc[a][b][m][n] = (f32x4){0.f, 0.f, 0.f, 0.f};
        cur = nxt; cA = nA; cB = nB; ++ui;
        if constexpr (ALIGN_EPI) { if (wr == 1) PG8_BAR; }
    }
    if (PROBE && PROBE_TIMER == 6 && wid == 0 && blockIdx.x == 0) { int l0; asm volatile("v_mbcnt_lo_u32_b32 %0, -1, 0\n\tv_mbcnt_hi_u32_b32 %0, -1, %0" : "=v"(l0)); if (l0 == 0) { volatile PG8_LAS unsigned* pm = (volatile PG8_LAS unsigned*)(lds + 139264 + 320 + 64); pm[0] += (unsigned)__builtin_amdgcn_s_memrealtime() - pm[2]; pm[1] += (unsigned)(ui + 1); } }
    PG8_WAIT_V(0);
    if constexpr (!ALIGN_EPI) { if (wr == 0) PG8_BAR; }
    PG8_BAR;
#undef PG8_SA
#undef PG8_SB
#undef PG8_STAGE
#undef PG8_LDA
#undef PG8_LDB
#undef PG8_MMA
#undef PG8_WAIT_V
#undef PG8_WAIT_L
#undef PG8_BAR
#undef PG8_SCHED
}
}

#ifndef PG8_SP2
#define PG8_SP2 true
#endif
#ifndef PG8_ALIGN
#define PG8_ALIGN true
#endif

constexpr int NWAVES = 8;
constexpr int BATCH = 4, SEQ = 4096, D = 4096, M = BATCH * SEQ, DEPTH = 2;
constexpr int CW = 2048, RW = 2048, RH = 8, HD = 256, CHUNK = 128, NCH = SEQ / CHUNK;
constexpr int IN_COLS = 14336, N1 = 12288  , FF = 11008, NGU = 2 * FF;
constexpr int COL_AB = 0, COL_AC = 2048, COL_AX = 4096, COL_Q = 6144, COL_G = 8192, COL_K = 10240;
constexpr float EPS = 1e-6f;
#ifndef F8_K0
#define F8_K0 0
#endif
static_assert(F8_K0 % 256 == 0 && F8_K0 <= FF && (FF - F8_K0) % 128 == 0 && FF % 256 == 0, "fp8 / bf16 K split: whole pairs of K-tiles on both sides");
__device__ __forceinline__ int k8_of(int l) { return (l == DEPTH - 1) ? FF : F8_K0; }
#ifndef GU8_TILES_L0
#define GU8_TILES_L0 86
#endif
#ifndef GU8_TILES_L1
#define GU8_TILES_L1 86
#endif
static_assert(GU8_TILES_L0 >= 0 && GU8_TILES_L0 <= NGU / 256 && GU8_TILES_L1 >= 0 && GU8_TILES_L1 <= NGU / 256, "int8 column tiles");
__device__ __forceinline__ int gu8_of(int l) { return (l == DEPTH - 1) ? GU8_TILES_L1 : GU8_TILES_L0; }
constexpr int WABS_WORD = 3000;

constexpr size_t MiB = 1u << 20;
constexpr size_t WS_CTL = 0, CTL_ZERO_BYTES = 1 * MiB;
constexpr size_t WS_RSTD1 = 1 * MiB;
constexpr size_t WS_RSTD2 = WS_RSTD1 + 256 * 1024;
constexpr size_t WS_LGAM = WS_RSTD2 + 256 * 1024;
constexpr size_t WS_WSQ = WS_LGAM + 64 * 1024;
constexpr size_t WS_RS8 = WS_LGAM + 128 * 1024;
constexpr size_t WS_PART = 2 * MiB;
constexpr size_t WS_COS = 6 * MiB, WS_SIN = 14 * MiB;
constexpr size_t WS_WIN = 38 * MiB;
constexpr size_t WS_WOUT = WS_WIN + 112 * MiB;
constexpr size_t WS_WGU = WS_WOUT + 32 * MiB;
constexpr size_t WS_WDN = WS_WGU + 172 * MiB;
constexpr size_t WS_XB = WS_WDN + 86 * MiB;
constexpr size_t WS_R = WS_XB + 128 * MiB;
constexpr size_t WS_PROJ = WS_R;
constexpr size_t WS_KFT = WS_PROJ + 384 * MiB, WS_KBT = WS_KFT + 64 * MiB, WS_VT = WS_KBT + 64 * MiB;
constexpr size_t WS_SFT = WS_VT + 64 * MiB, WS_SBT = WS_SFT + 128 * MiB;
constexpr size_t WS_YCAT = WS_SBT + 128 * MiB;
constexpr size_t WS_MIX_END = WS_YCAT + 128 * MiB;
constexpr size_t WS_GU = WS_R;
constexpr size_t WS_ACT = WS_GU + 688 * MiB;
constexpr size_t WS_HG = 22 * MiB;
constexpr size_t WS_HU = WS_ACT + 344 * MiB;
constexpr size_t WS_END = WS_HU + 6 * MiB;
static_assert(WS_MIX_END <= WS_END, "overlay");
static_assert((size_t)M * N1 * 2 == 384 * MiB && (size_t)M * NGU * 2 == 688 * MiB && (size_t)M * FF * 2 == 344 * MiB && (size_t)IN_COLS * D * 2 == 112 * MiB && (size_t)NGU * D * 2 == 172 * MiB && (size_t)D * FF * 2 == 86 * MiB, "sizes");
constexpr int CW_BAR = 4096;

constexpr int RING_OFF = 0, RING_BYTES = 136 * 1024;
constexpr int LDSCTL_OFF = RING_BYTES, MISC_OFF = LDSCTL_OFF + 320;
constexpr int LDS_BYTES = 147456;
static_assert(MISC_OFF + 128 <= LDS_BYTES && 8 * 16640 <= RING_BYTES, "LDS map");

#define GAS __attribute__((address_space(1)))
#define LAS __attribute__((address_space(3)))
typedef unsigned short bf16;
typedef unsigned v4u __attribute__((ext_vector_type(4)));
typedef unsigned v2u __attribute__((ext_vector_type(2)));
typedef float f32x4 __attribute__((ext_vector_type(4)));
typedef float f32x16 __attribute__((ext_vector_type(16)));
typedef short bf16x8 __attribute__((ext_vector_type(8)));
typedef GAS unsigned gu32;
#define RLX_AGENT __ATOMIC_RELAXED, __HIP_MEMORY_SCOPE_AGENT
#define LDS_WAIT() asm volatile("s_waitcnt lgkmcnt(0)" ::: "memory")
#define VM_WAIT() asm volatile("s_waitcnt vmcnt(0)" ::: "memory")
__device__ __forceinline__ unsigned pk2(float lo, float hi) { return pg8::cvt_pk_bf16(lo, hi); }
__device__ __forceinline__ float bflo(unsigned w) { return __uint_as_float(w << 16); }
__device__ __forceinline__ float bfhi(unsigned w) { return __uint_as_float(w & 0xffff0000u); }
__device__ __forceinline__ void unpack8(const v4u w, float (&f)[8]) { f[0] = bflo(w.x); f[1] = bfhi(w.x); f[2] = bflo(w.y); f[3] = bfhi(w.y); f[4] = bflo(w.z); f[5] = bfhi(w.z); f[6] = bflo(w.w); f[7] = bfhi(w.w); }

#define XB_TMO      128
#define XB_XCNT(j)  (256  + 64 * (j))
#define XB_XSUB(j)  (1280 + 64 * (j))
#define XB_XGEN(j)  (2304 + 64 * (j))
#define XB_TOP      3328
#define XB_TOPGEN   3392
#define XCD_BAR_WORDS 3456
#define XB_SPIN_CAP (1u << 18)

__device__ __forceinline__ unsigned xb_ld(unsigned* p)              { return __hip_atomic_load(p, __ATOMIC_RELAXED, __HIP_MEMORY_SCOPE_AGENT); }
__device__ __forceinline__ unsigned xb_add(unsigned* p, unsigned v) { return __hip_atomic_fetch_add(p, v, __ATOMIC_RELAXED, __HIP_MEMORY_SCOPE_AGENT); }
__device__ __forceinline__ unsigned xb_xcc_id() { return (unsigned)__builtin_amdgcn_s_getreg((3 << 11) | 20) & 0xFu; }
#define XB_SPIN(cond, bar) do { unsigned _sp = 0; while (cond) { __builtin_amdgcn_s_sleep(1); \
    if ((++_sp & 255u) == 0u) { if (xb_ld(&(bar)[XB_TMO])) break; if (_sp > XB_SPIN_CAP) { atomicAdd(&(bar)[XB_TMO], 1u); break; } } } } while (0)

struct XcdBarrier {
    unsigned* bar; unsigned x;
    volatile LAS unsigned* st;
};
__device__ __forceinline__ XcdBarrier xcd_barrier_post(unsigned* bar, volatile LAS unsigned* st, bool is_t0) {
    XcdBarrier b; b.bar = bar; b.x = xb_xcc_id(); b.st = st;
    if (is_t0) (void)xb_add(&bar[XB_XCNT(b.x)], 1u);
    return b;
}
__device__ __forceinline__ void xcd_barrier_complete(unsigned* bar, unsigned x, unsigned& nloc, unsigned& nx) {
    const unsigned G = gridDim.x * gridDim.y * gridDim.z;
    unsigned sum, cnt, mine, sp = 0u;
    for (;;) {
        sum = 0u; cnt = 0u; mine = 0u;
#pragma unroll
        for (unsigned j = 0; j < 16; ++j) { const unsigned c = xb_ld(&bar[XB_XCNT(j)]); sum += c; cnt += (c > 0u) ? 1u : 0u; mine = (j == x) ? c : mine; }
        if (sum == G) break;
        __builtin_amdgcn_s_sleep(1);
        if ((++sp & 255u) == 0u) { if (xb_ld(&bar[XB_TMO])) break; if (sp > XB_SPIN_CAP) { atomicAdd(&bar[XB_TMO], 1u); break; } }
    }
    nloc = mine > 0u ? mine : 1u; nx = cnt > 0u ? cnt : 1u;
}
__device__ __forceinline__ void xcd_barrier(const XcdBarrier& b, bool is_t0) {
    asm volatile("s_waitcnt vmcnt(0)" ::: "memory");
    __syncthreads();
    if (is_t0) {
        unsigned* bar = b.bar;
        __builtin_amdgcn_s_waitcnt(0);
        unsigned nloc = b.st[0], nx = b.st[1];
        if (nloc == 0u) { xcd_barrier_complete(bar, b.x, nloc, nx); b.st[0] = nloc; b.st[1] = nx; }
        const unsigned old = xb_add(&bar[XB_XSUB(b.x)], 1u);
        const unsigned gen = old / nloc;
        if (old + 1u == (gen + 1u) * nloc) {
            __builtin_amdgcn_fence(__ATOMIC_RELEASE, "agent");
            asm volatile("s_waitcnt vmcnt(0)" ::: "memory");
            const unsigned og = xb_add(&bar[XB_TOP], 1u);
            const unsigned tg = og / nx;
            if (og + 1u == (tg + 1u) * nx) xb_add(&bar[XB_TOPGEN], 1u);
            else XB_SPIN(xb_ld(&bar[XB_TOPGEN]) == tg, bar);
            __builtin_amdgcn_fence(__ATOMIC_ACQUIRE, "agent");
            xb_add(&bar[XB_XGEN(b.x)], 1u);
            asm volatile("s_waitcnt vmcnt(0)" ::: "memory");
        } else {
            XB_SPIN(xb_ld(&bar[XB_XGEN(b.x)]) == gen, bar);
            __builtin_amdgcn_fence(__ATOMIC_ACQUIRE, "agent");
            asm volatile("s_waitcnt vmcnt(0)" ::: "memory");
        }
    }
    __syncthreads();
}

struct Args { const void* in[17]; float* out; unsigned char* ws; int ph_lo, ph_hi; };
static_assert(sizeof(Args) == 17 * 8 + 8 + 8 + 8, "Args has no padding");
struct Frame {
    LAS unsigned char* lds;
    int tid, lane, wave;
    int vcu, G;
    const __attribute__((address_space(4))) Args* ap;
};
#define F_x ((const float*)(const GAS float*)F.ap->in[0])
#define F_pos ((const int*)(const GAS int*)F.ap->in[1])
#define F_norm1_g ((const float*)(const GAS float*)F.ap->in[2])
#define F_w_in ((const float*)(const GAS float*)F.ap->in[3])
#define F_conv_a_w ((const float*)(const GAS float*)F.ap->in[4])
#define F_conv_a_b ((const float*)(const GAS float*)F.ap->in[5])
#define F_beta_a ((const float*)(const GAS float*)F.ap->in[6])
#define F_dlogit ((const float*)(const GAS float*)F.ap->in[7])
#define F_gn_g ((const float*)(const GAS float*)F.ap->in[8])
#define F_w_out ((const float*)(const GAS float*)F.ap->in[9])
#define F_norm2_g ((const float*)(const GAS float*)F.ap->in[10])
#define F_w_gate ((const float*)(const GAS float*)F.ap->in[11])
#define F_w_up ((const float*)(const GAS float*)F.ap->in[12])
#define F_ffn_w ((const float*)(const GAS float*)F.ap->in[13])
#define F_ffn_b ((const float*)(const GAS float*)F.ap->in[14])
#define F_w_down ((const float*)(const GAS float*)F.ap->in[15])
#define F_norm_f ((const float*)(const GAS float*)F.ap->in[16])
#define F_out ((float*)(GAS float*)F.ap->out)
#define F_rstd1 ((float*)(GAS float*)(F.ap->ws + WS_RSTD1))
#define F_rstd2 ((float*)(GAS float*)(F.ap->ws + WS_RSTD2))
#define F_lgam ((float*)(GAS float*)(F.ap->ws + WS_LGAM))
#define F_part ((float*)(GAS float*)(F.ap->ws + WS_PART))
#define F_rs8 ((float*)(GAS float*)(F.ap->ws + WS_RS8))
#define F_wsq ((float*)(GAS float*)(F.ap->ws + WS_WSQ))
#define F_xq8 ((unsigned char*)(GAS unsigned char*)(F.ap->ws + WS_GU))
#define F_wabs ((unsigned*)(GAS unsigned*)(F.ap->ws) + WABS_WORD)
#define F_cosb ((float*)(GAS float*)(F.ap->ws + WS_COS))
#define F_sinb ((float*)(GAS float*)(F.ap->ws + WS_SIN))
#define F_WIN ((bf16*)(GAS bf16*)(F.ap->ws + WS_WIN))
#define F_WOUT ((bf16*)(GAS bf16*)(F.ap->ws + WS_WOUT))
#define F_WGU ((bf16*)(GAS bf16*)(F.ap->ws + WS_WGU))
#define F_WDN ((bf16*)(GAS bf16*)(F.ap->ws + WS_WDN))
#define F_XB ((bf16*)(GAS bf16*)(F.ap->ws + WS_XB))
#define F_PROJ ((bf16*)(GAS bf16*)(F.ap->ws + WS_PROJ))
#define F_KFT ((bf16*)(GAS bf16*)(F.ap->ws + WS_KFT))
#define F_KBT ((bf16*)(GAS bf16*)(F.ap->ws + WS_KBT))
#define F_VT ((bf16*)(GAS bf16*)(F.ap->ws + WS_VT))
#define F_SFT ((bf16*)(GAS bf16*)(F.ap->ws + WS_SFT))
#define F_SBT ((bf16*)(GAS bf16*)(F.ap->ws + WS_SBT))
#define F_YCAT ((bf16*)(GAS bf16*)(F.ap->ws + WS_YCAT))
#define F_GU ((bf16*)(GAS bf16*)(F.ap->ws + WS_GU))
#define F_HG ((float*)(GAS float*)(F.ap->ws + WS_HG))
#define F_HU ((float*)(GAS float*)(F.ap->ws + WS_HU))
#define F_ACT ((bf16*)(GAS bf16*)(F.ap->ws + WS_ACT))
__device__ __forceinline__ float wave_sum(float v) {
#pragma unroll
    for (int o = 1; o < 64; o <<= 1) v += __shfl_xor(v, o);
    return v;
}

__device__ __forceinline__ void cvt_item(const float* __restrict__ W, int N, const float* __restrict__ gain, bf16* WT, int K, int k0, int n0s, int n0d, LAS float* scr, int lane, bool f8 = false, int kd = -1, float qs = 0.f) {
    if (kd < 0) kd = k0;
    const int r4 = lane >> 4, c4 = (lane & 15) * 4;
    f32x4 v[16];
#pragma unroll
    for (int i = 0; i < 16; ++i) v[i] = *(const f32x4*)(W + (size_t)(k0 + 4 * i + r4) * N + n0s + c4);
#pragma unroll
    for (int i = 0; i < 16; ++i) { const int kk = 4 * i + r4; const float g = gain ? gain[k0 + kk] : 1.0f; LAS float* s = scr + kk * 65 + c4;
        s[0] = v[i].x * g; s[1] = v[i].y * g; s[2] = v[i].z * g; s[3] = v[i].w * g;
        }
    LDS_WAIT(); asm volatile("" ::: "memory");
    const int c = lane & 7;
#pragma unroll
    for (int it = 0; it < 8; ++it) { const int n = (lane >> 3) + 8 * it; const LAS float* s = scr + (8 * c) * 65 + n;
        if (qs > 0.f) {
#define Q8(i) ((int)__builtin_rintf(__builtin_fminf(__builtin_fmaxf(s[(i) * 65] * qs, -127.0f), 127.0f)) & 255)
            v2u o8; o8.x = (unsigned)(Q8(0) | (Q8(1) << 8) | (Q8(2) << 16) | (Q8(3) << 24)); o8.y = (unsigned)(Q8(4) | (Q8(5) << 8) | (Q8(6) << 16) | (Q8(7) << 24));
#undef Q8
            *(v2u*)((unsigned char*)WT + (size_t)(n0d + n) * K + kd + 8 * c) = o8;
        } else if (f8) {
#define W8(i) __builtin_fminf(__builtin_fmaxf(s[(i) * 65] * pg8::F8_WSCALE, -440.0f), 440.0f)
            int t = __builtin_amdgcn_cvt_pk_fp8_f32(W8(0), W8(1), 0, false); t = __builtin_amdgcn_cvt_pk_fp8_f32(W8(2), W8(3), t, true);
            int q = __builtin_amdgcn_cvt_pk_fp8_f32(W8(4), W8(5), 0, false); q = __builtin_amdgcn_cvt_pk_fp8_f32(W8(6), W8(7), q, true);
#undef W8
            v2u o8; o8.x = (unsigned)t; o8.y = (unsigned)q; *(v2u*)((unsigned char*)WT + (size_t)(n0d + n) * K + kd + 8 * c) = o8;
        } else {
        v4u o; o.x = pk2(s[0 * 65], s[1 * 65]); o.y = pk2(s[2 * 65], s[3 * 65]); o.z = pk2(s[4 * 65], s[5 * 65]); o.w = pk2(s[6 * 65], s[7 * 65]);
        *(v4u*)(WT + (size_t)(n0d + n) * K + kd + 8 * c) = o; } }
    LDS_WAIT(); asm volatile("" ::: "memory");
}
__device__ __forceinline__ void cvt_matrix(Frame& F, const float* W, int K, int N, const float* gain, bf16* WT, int dst_row0, bool in_perm, int& it, int it_end_prev, LAS float* scr, int k8 = 0, int n8rows = 0, float qs = 0.f, bool pairk = false) {
    const int nnb = N / 64, nitems = (K / 64) * nnb, NGW = F.G * NWAVES;
    for (; it < it_end_prev + nitems; it += NGW) {
        const int r = it - it_end_prev, r2 = r >> 1, kb = pairk ? 2 * (r2 / nnb) + (r & 1) : r / nnb, nb = pairk ? r2 % nnb : r % nnb; const int n0s = nb * 64; int n0d = dst_row0 + n0s;
        if (dst_row0 < 0) { n0d = (n0s >> 7) * 256 + (dst_row0 == -2 ? 128 : 0) + (n0s & 127); }
        if (in_perm) { const int blk = n0s >> 11, dblk = (blk < 4) ? blk : (blk == 4 ? 5 : (blk == 5 ? 6 : 4)); n0d = dblk * 2048 + (n0s & 2047); }
        const bool f8 = kb * 64 < k8;
        if (n0d < n8rows) cvt_item(W, N, gain, WT, K, kb * 64, n0s, n0d, scr, F.lane, false, -1, qs);
        else if (f8) cvt_item(W, N, gain, WT, k8, kb * 64, n0s, n0d, scr, F.lane, true);
        else cvt_item(W, N, gain, (bf16*)((unsigned char*)WT + (size_t)N * k8), K - k8, kb * 64, n0s, n0d, scr, F.lane, false, kb * 64 - k8);
    }
}

constexpr int WQ_KBLOCKS = 4;
__device__ __forceinline__ float wave_max(float v) {
#pragma unroll
    for (int o = 1; o < 64; o <<= 1) v = __builtin_fmaxf(v, __shfl_xor(v, o));
    return v;
}
__device__ __forceinline__ void wabs_phase(Frame& F) {
    const int gw = F.vcu * NWAVES + F.wave, NGW = F.G * NWAVES, r4 = F.lane >> 4, c4 = (F.lane & 15) * 4;
    for (int l = 0; l < DEPTH; ++l) { const int nnb = gu8_of(l) * 2; if (nnb == 0) continue;
        for (int mat = 0; mat < 2; ++mat) { const float* W = (mat ? F_w_up : F_w_gate) + (size_t)l * D * FF; const float* gain = F_norm2_g + l * D; float mx = 0.f, sq = 0.f;
            for (int it = gw; it < WQ_KBLOCKS * nnb; it += NGW) { const int kbi = it / nnb, nb = it - kbi * nnb, kb = kbi * ((D / 64) / WQ_KBLOCKS); f32x4 v[16];
#pragma unroll
                for (int i = 0; i < 16; ++i) v[i] = *(const f32x4*)(W + (size_t)(kb * 64 + 4 * i + r4) * FF + nb * 64 + c4);
#pragma unroll
                for (int i = 0; i < 16; ++i) { const float g = gain[kb * 64 + 4 * i + r4]; const f32x4 p = v[i] * g; mx = __builtin_fmaxf(mx, __builtin_fmaxf(__builtin_fmaxf(__builtin_fabsf(p.x), __builtin_fabsf(p.y)), __builtin_fmaxf(__builtin_fabsf(p.z), __builtin_fabsf(p.w)))); sq += (p.x * p.x + p.y * p.y) + (p.z * p.z + p.w * p.w); } }
            mx = wave_max(mx); sq = wave_sum(sq); if (F.lane == 0) { __hip_atomic_fetch_max(F_wabs + 2 * l + mat, __float_as_uint(mx), RLX_AGENT); if (gw < 4096) F_wsq[(2 * l + mat) * 4096 + gw] = sq; } } }
}
__device__ __forceinline__ float wq_range(Frame& F, int l, int mat) {
    const int NGW = F.G * NWAVES; float s = 0.f;
    for (int i = F.lane; i < NGW && i < 4096; i += 64) s += F_wsq[(2 * l + mat) * 4096 + i];
    s = wave_sum(s); const float cnt = (float)(WQ_KBLOCKS * 64) * (float)(gu8_of(l) * 128);
    return __builtin_fminf(__uint_as_float(__hip_atomic_load(F_wabs + 2 * l + mat, RLX_AGENT)), 4.25f * sqrtf(s / cnt));
}
__device__ __forceinline__ void p5_i8_phase(Frame& F) {
    const int gw = F.vcu * NWAVES + F.wave, NGW = F.G * NWAVES;
    for (int row = gw; row < M; row += NGW) {
        const float s = wave_sum(F_part[(size_t)row * 64 + F.lane]); const float rstd = 1.0f / sqrtf(s * (1.0f / D) + EPS);
        const bf16* xr = F_XB + (size_t)row * D + 8 * F.lane; v4u w[8]; float mx = 0.f;
#pragma unroll
        for (int j = 0; j < 8; ++j) w[j] = *(const v4u*)(xr + 512 * j);
#pragma unroll
        for (int j = 0; j < 8; ++j) { float v[8]; unpack8(w[j], v);
#pragma unroll
            for (int e = 0; e < 8; ++e) mx = __builtin_fmaxf(mx, __builtin_fabsf(v[e])); }
        mx = wave_max(mx); const float qs = mx > 0.f ? 127.0f / mx : 0.f;
        unsigned char* qr = F_xq8 + (size_t)row * D + 8 * F.lane;
#pragma unroll
        for (int j = 0; j < 8; ++j) { float v[8]; unpack8(w[j], v);
#define Q8(i) ((int)__builtin_rintf(v[i] * qs) & 255)
            v2u o; o.x = (unsigned)(Q8(0) | (Q8(1) << 8) | (Q8(2) << 16) | (Q8(3) << 24)); o.y = (unsigned)(Q8(4) | (Q8(5) << 8) | (Q8(6) << 16) | (Q8(7) << 24));
#undef Q8
            *(v2u*)(qr + 512 * j) = o; }
        if (F.lane == 0) { F_rstd2[row] = rstd; F_rs8[row] = rstd * mx * (1.0f / 127.0f); } }
}
__device__ __forceinline__ void rstd_from_part(Frame& F, float* rstd) {
    const int gw = F.vcu * NWAVES + F.wave, NGW = F.G * NWAVES;
    for (int row = gw; row < M; row += NGW) { const float s = wave_sum(F_part[(size_t)row * 64 + F.lane]); if (F.lane == 0) rstd[row] = 1.0f / sqrtf(s * (1.0f / D) + EPS); }
}
__device__ __forceinline__ void p0_phase(Frame& F, int l) {
    LAS float* scr = (LAS float*)(F.lds + RING_OFF + F.wave * 16640);
    const int gw = F.vcu * NWAVES + F.wave, NGW = F.G * NWAVES;
    int it = gw, base = 0;
    cvt_matrix(F, F_w_in + (size_t)l * D * IN_COLS, D, IN_COLS, F_norm1_g + l * D, F_WIN, 0, true, it, base, scr); base += (D / 64) * (IN_COLS / 64);
    cvt_matrix(F, F_w_out + (size_t)l * D * D, D, D, nullptr, F_WOUT, 0, false, it, base, scr); base += (D / 64) * (D / 64);
    cvt_matrix(F, F_w_gate + (size_t)l * D * FF, D, FF, F_norm2_g + l * D, F_WGU, -1, false, it, base, scr, 0, gu8_of(l) * 256, gu8_of(l) > 0 ? 127.0f / __builtin_fmaxf(wq_range(F, l, 0), 1e-30f) : 0.f, gu8_of(l) == NGU / 256); base += (D / 64) * (FF / 64);
    cvt_matrix(F, F_w_up + (size_t)l * D * FF, D, FF, F_norm2_g + l * D, F_WGU, -2, false, it, base, scr, 0, gu8_of(l) * 256, gu8_of(l) > 0 ? 127.0f / __builtin_fmaxf(wq_range(F, l, 1), 1e-30f) : 0.f, gu8_of(l) == NGU / 256); base += (D / 64) * (FF / 64);
    cvt_matrix(F, F_w_down + (size_t)l * FF * D, FF, D, nullptr, F_WDN, 0, false, it, base, scr, k8_of(l), 0, 0.f, k8_of(l) == FF);
    if (l == 0) {
        for (int m = gw; m < M; m += NGW) { const float* xr = F_x + (size_t)m * D + 8 * F.lane; f32x4 v[16]; float ss = 0.f;
#pragma unroll
            for (int j = 0; j < 8; ++j) { v[2 * j] = *(const f32x4*)(xr + 512 * j); v[2 * j + 1] = *(const f32x4*)(xr + 512 * j + 4); }
#pragma unroll
            for (int j = 0; j < 16; ++j) ss += (v[j].x * v[j].x + v[j].y * v[j].y) + (v[j].z * v[j].z + v[j].w * v[j].w);
            ss = wave_sum(ss); if (F.lane == 0) F_rstd1[m] = 1.0f / sqrtf(ss * (1.0f / D) + EPS);
            bf16* o = F_XB + (size_t)m * D + 8 * F.lane;
#pragma unroll
            for (int j = 0; j < 8; ++j) *(v4u*)(o + 512 * j) = pg8::pack8(v[2 * j], v[2 * j + 1]); }
        { const int gt = gw * 64 + F.lane, NT = NGW * 64; const int j = gt & 127;
          const float inv = exp2f(-(float)j * (13.287712379549449f / 128.0f));
          for (int idx = gt; idx < M * 128; idx += NT) { const int m = idx >> 7; const float ang = (float)F_pos[m] * inv;
              const double a = (double)ang, k = rint(a * 0.15915494309189535), r = a - k * 6.283185307179586; const float rf = (float)r;
              const float c = cosf(rf), s = sinf(rf);
              F_cosb[idx] = c; F_sinb[idx] = s; } }
        if (blockIdx.x == 0 && F.tid < DEPTH * 2 * RH) { const float xl = F_dlogit[F.tid]; const float t = __expf(-xl);
            const float ser = t * (1.0f - t * (0.5f - t * (0.33333334f - t * (0.25f - t * 0.2f)))); F_lgam[F.tid] = -((t < 0.04f) ? ser : __logf(1.0f + t)); }
    } else rstd_from_part(F, F_rstd1);
}

__device__ __forceinline__ void mixer_a(Frame& F, int l) {
    const int gw = F.vcu * NWAVES + F.wave, NGW = F.G * NWAVES;
    for (int item = gw; item < (M / 32) * 4; item += NGW) {
        const int t0 = (item >> 2) * 32, c0 = (item & 3) * 512 + F.lane * 8;
        float w0[8], w1[8], w2[8], bb[8], be[8];
        { const float* cw = F_conv_a_w + (size_t)l * 3 * CW + c0; const float* cb = F_conv_a_b + (size_t)l * CW + c0; const float* bt = F_beta_a + (size_t)l * CW + c0;
#pragma unroll
          for (int j = 0; j < 8; ++j) { w0[j] = cw[j]; w1[j] = cw[CW + j]; w2[j] = cw[2 * CW + j]; bb[j] = cb[j]; be[j] = bt[j]; } }
        const bf16* pbase = F_PROJ + c0;
        float pp[8], pc[8];
        if ((t0 & (SEQ - 1)) == 0) {
#pragma unroll
            for (int j = 0; j < 8; ++j) pp[j] = 0.f;
        } else { float a[8], b[8]; unpack8(*(const v4u*)(pbase + (size_t)(t0 - 1) * N1 + COL_AC), a); unpack8(*(const v4u*)(pbase + (size_t)(t0 - 1) * N1 + COL_AX), b);
#pragma unroll
            for (int j = 0; j < 8; ++j) pp[j] = a[j] * b[j]; }
        { float a[8], b[8]; unpack8(*(const v4u*)(pbase + (size_t)t0 * N1 + COL_AC), a); unpack8(*(const v4u*)(pbase + (size_t)t0 * N1 + COL_AX), b);
#pragma unroll
          for (int j = 0; j < 8; ++j) pc[j] = a[j] * b[j]; }
        for (int t = t0; t < t0 + 32; t += 4) {
            v4u ac[4], ax[4], ab[4];
#pragma unroll
            for (int k = 0; k < 4; ++k) { const int tn = t + k + 1; const bool z = (tn & (SEQ - 1)) == 0;
                ac[k] = z ? (v4u){0u, 0u, 0u, 0u} : *(const v4u*)(pbase + (size_t)tn * N1 + COL_AC); ax[k] = z ? (v4u){0u, 0u, 0u, 0u} : *(const v4u*)(pbase + (size_t)tn * N1 + COL_AX);
                ab[k] = *(const v4u*)(pbase + (size_t)(t + k) * N1 + COL_AB); }
#pragma unroll
            for (int k = 0; k < 4; ++k) {
                float pn[8], fa[8], fx[8], fb[8], y[8]; unpack8(ac[k], fa); unpack8(ax[k], fx); unpack8(ab[k], fb); float ss = 0.f;
#pragma unroll
                for (int j = 0; j < 8; ++j) { pn[j] = fa[j] * fx[j]; y[j] = fb[j] * (w0[j] * pp[j] + w1[j] * pc[j] + w2[j] * pn[j] + bb[j]); ss += y[j] * y[j]; }
                ss += __shfl_xor(ss, 1); ss += __shfl_xor(ss, 2); ss += __shfl_xor(ss, 4); ss += __shfl_xor(ss, 8);
                const float r = 1.0f / sqrtf(ss * (1.0f / 128.0f) + EPS);
                v4u o; o.x = pk2(y[0] * r * be[0], y[1] * r * be[1]); o.y = pk2(y[2] * r * be[2], y[3] * r * be[3]); o.z = pk2(y[4] * r * be[4], y[5] * r * be[5]); o.w = pk2(y[6] * r * be[6], y[7] * r * be[7]);
                *(v4u*)(F_YCAT + (size_t)(t + k) * D + c0) = o;
#pragma unroll
                for (int j = 0; j < 8; ++j) { pp[j] = pc[j]; pc[j] = pn[j]; } }
        }
    }
}

#define MFMA32(a, b, c) __builtin_amdgcn_mfma_f32_32x32x16_bf16((a), (b), (c), 0, 0, 0)
__device__ __forceinline__ void scan_dma(const char* kt, const char* vt, LAS unsigned char* dst, int w, int lane) {
#pragma unroll
    for (int q = 0; q < 4; ++q) { __builtin_amdgcn_global_load_lds((const unsigned*)(kt + q * 8192), (LAS unsigned*)(dst + q * 8192 + w * 1024), 16, 0, 0);
        __builtin_amdgcn_global_load_lds((const unsigned*)(vt + q * 8192), (LAS unsigned*)(dst + 32768 + q * 8192 + w * 1024), 16, 0, 0); }
}
__device__ __forceinline__ void scan_phase(Frame& F, int l) {
    LAS unsigned char* BUF = F.lds + RING_OFF;
    const int w = F.wave, dbl = w & 3, eql = w >> 2;
    for (int unit = F.vcu; unit < BATCH * RH * 2 * 2 * 2; unit += F.G) {
        const int eh2 = unit & 1, dq = (unit >> 1) & 1, dir = (unit >> 2) & 1, h = (unit >> 3) & 7, b = unit >> 6;
        const size_t blk0 = (size_t)(b * RH + h) * NCH * (HD * CHUNK);
        const char* KT = (const char*)((dir ? F_KBT : F_KFT) + blk0) + (size_t)((4 * dq * 8 + w) * 64 + F.lane) * 16;
        const char* VT = (const char*)(F_VT + blk0) + (size_t)((4 * eh2 * 8 + w) * 64 + F.lane) * 16;
        const int eq = 2 * eh2 + eql, dblk = 4 * dq + dbl;
        bf16* ST = (dir ? F_SBT : F_SFT) + (size_t)(b * RH + h) * NCH * (HD * HD) + (size_t)(((2 * eq) * 16 + 2 * dblk) * 64 + F.lane) * 8;
        const float g128 = __expf(128.0f * F_lgam[l * 16 + dir * 8 + h]);
        f32x16 s0, s1;
#pragma unroll
        for (int r = 0; r < 16; ++r) { s0[r] = 0.f; s1[r] = 0.f; }
        __syncthreads();
        { const int n0 = dir ? (NCH - 1) : 0; scan_dma(KT + (size_t)n0 * HD * CHUNK * 2, VT + (size_t)n0 * HD * CHUNK * 2, BUF, w, F.lane); }
        for (int step = 0; step < NCH; ++step) {
            const int n = dir ? (NCH - 1 - step) : step, nn = dir ? (n - 1) : (n + 1);
            VM_WAIT(); __syncthreads();
            if (step + 1 < NCH) scan_dma(KT + (size_t)nn * HD * CHUNK * 2, VT + (size_t)nn * HD * CHUNK * 2, BUF + ((step + 1) & 1) * 65536, w, F.lane);
            bf16* st = ST + (size_t)n * HD * HD;
#pragma unroll
            for (int sp = 0; sp < 2; ++sp) {
                v4u a; a.x = pk2(s0[8 * sp], s0[8 * sp + 1]); a.y = pk2(s0[8 * sp + 2], s0[8 * sp + 3]); a.z = pk2(s0[8 * sp + 4], s0[8 * sp + 5]); a.w = pk2(s0[8 * sp + 6], s0[8 * sp + 7]);
                *(v4u*)(st + sp * 512) = a;
                v4u c; c.x = pk2(s1[8 * sp], s1[8 * sp + 1]); c.y = pk2(s1[8 * sp + 2], s1[8 * sp + 3]); c.z = pk2(s1[8 * sp + 4], s1[8 * sp + 5]); c.w = pk2(s1[8 * sp + 6], s1[8 * sp + 7]);
                *(v4u*)(st + 16 * 512 + sp * 512) = c; }
#pragma unroll
            for (int r = 0; r < 16; ++r) { s0[r] *= g128; s1[r] *= g128; }
            const LAS unsigned char* kb = BUF + (step & 1) * 65536 + (dbl * 8 * 64 + F.lane) * 16; const LAS unsigned char* vb = BUF + (step & 1) * 65536 + 32768 + (2 * eql * 8 * 64 + F.lane) * 16;
#pragma unroll
            for (int ks = 0; ks < 8; ++ks) { const bf16x8 a = *(const LAS bf16x8*)(kb + ks * 1024), b0 = *(const LAS bf16x8*)(vb + ks * 1024), b1 = *(const LAS bf16x8*)(vb + 8192 + ks * 1024);
                s0 = MFMA32(a, b0, s0); s1 = MFMA32(a, b1, s1); }
        }
    }
    VM_WAIT(); __syncthreads();
}

__device__ __forceinline__ void dma16(const char* g, LAS unsigned char* l) { __builtin_amdgcn_global_load_lds((const unsigned*)g, (LAS unsigned*)l, 16, 0, 0); }
__device__ __forceinline__ void intra_dma(Frame& F, const int kind, const int p, LAS unsigned char* dst, int b, int h, int n, int w, int lane) {
    const int tok0 = b * SEQ + n * CHUNK;
    if (kind == 4) {
        const char* g0 = (const char*)F_VT + (((size_t)(b * RH + h) * NCH + n) * (HD * CHUNK)) * 2 + (size_t)(w * 64 + lane) * 16;
#pragma unroll
        for (int q = 0; q < 4; ++q) dma16(g0 + (size_t)(4 * (q >> 1) + 2 * p + (q & 1)) * 8192, dst + q * 8192 + w * 1024);
    } else if (kind == 2 || kind == 3) {
        const char* g0 = (const char*)(kind == 2 ? F_SFT : F_SBT) + ((size_t)(b * RH + h) * NCH + n) * HD * HD * 2 + (size_t)lane * 16;
#pragma unroll
        for (int q = 0; q < 4; ++q) { const int idx = q * 8 + w, ehl = idx >> 4, sx = idx & 15; dma16(g0 + (size_t)(((4 * ehl + p) * 16 + sx) * 1024), dst + q * 8192 + w * 1024); }
    } else {
        const int r0 = w * 2 + (lane >> 5), c = (lane & 31) ^ (r0 & 15);
        const char* g0 = (const char*)F_PROJ + ((size_t)(tok0 + (kind == 1 ? 64 * p : 0) + r0) * N1 + (kind == 0 ? COL_Q : COL_K) + h * HD) * 2 + c * 16;
#pragma unroll
        for (int q = 0; q < (kind == 0 ? 8 : 4); ++q) dma16(g0 + (size_t)q * 16 * N1 * 2, dst + q * 8192 + w * 1024);
    }
}
__device__ __forceinline__ void intra_phase(Frame& F, int l) {
    LAS unsigned char* QS = F.lds + RING_OFF; LAS unsigned char* BUF = QS + 65536; LAS float* red1 = (LAS float*)(QS + 131072); LAS float* red2 = red1 + 256;
    const int w = F.wave, ib = w & 3, eh = w >> 2, li = F.lane & 31, hh = F.lane >> 5, sw = li & 15, yx = hh ^ sw;
    const float L2E = 1.4426950408889634f;
    const int nun = BATCH * RH * NCH;
    if (F.vcu < nun) { const int u0 = F.vcu; intra_dma(F, 0, 0, QS, u0 >> 8, (u0 >> 5) & 7, u0 & 31, w, F.lane); intra_dma(F, 1, 0, BUF, u0 >> 8, (u0 >> 5) & 7, u0 & 31, w, F.lane); }
    for (int unit = F.vcu; unit < nun; unit += F.G) {
        const int n = unit & 31, h = (unit >> 5) & 7, b = unit >> 8;
        const int nxt = unit + F.G; const bool has_next = nxt < nun; const int n2 = nxt & 31, h2 = (nxt >> 5) & 7, b2 = nxt >> 8;
        int i = 32 * ib + li; asm volatile("" : "+v"(i));
        const int tok0 = b * SEQ + n * CHUNK, tok = tok0 + i;
        const float lf = F_lgam[l * 16 + h], lb = F_lgam[l * 16 + 8 + h];
        const float lf2 = lf * L2E, lb2 = lb * L2E;
        const LAS unsigned char* qrow = QS + (32 * ib + li) * 512;
#define QF(s) (*(const LAS bf16x8*)(qrow + (((2 * (s)) ^ yx) << 4)))
        bf16x8 pf[4][2];
        f32x16 acc[4];
#pragma unroll
        for (int et = 0; et < 4; ++et)
#pragma unroll
            for (int r = 0; r < 16; ++r) acc[et][r] = 0.f;
#pragma unroll
        for (int t = 0; t < 12; ++t) {
            VM_WAIT(); __syncthreads();
            LAS unsigned char* nb = BUF + ((t + 1) & 1) * 32768; const LAS unsigned char* cb = BUF + (t & 1) * 32768;
            int ln = F.lane; asm volatile("" : "+v"(ln));
            if (t < 11) { const int t1 = t + 1; intra_dma(F, t1 < 2 ? 1 : (t1 < 6 ? 2 : (t1 < 10 ? 3 : 4)), t1 < 2 ? t1 : (t1 < 6 ? t1 - 2 : (t1 < 10 ? t1 - 6 : t1 - 10)), nb, b, h, n, w, ln); }
            else if (has_next) intra_dma(F, 1, 0, nb, b2, h2, n2, w, ln);
            if (t == 10 && has_next) intra_dma(F, 0, 0, QS, b2, h2, n2, w, ln);
            if (t < 2) {
#pragma unroll
                for (int jtl = 0; jtl < 2; ++jtl) { const int jt = 2 * t + jtl; const LAS unsigned char* krow = cb + (32 * jtl + li) * 512;
                    f32x16 sc;
#pragma unroll
                    for (int r = 0; r < 16; ++r) sc[r] = 0.f;
#pragma unroll
                    for (int s = 0; s < 16; ++s) { const bf16x8 a = *(const LAS bf16x8*)(krow + (((2 * s) ^ yx) << 4)); sc = MFMA32(a, QF(s), sc); }
#pragma unroll
                    for (int s2 = 0; s2 < 2; ++s2) {
                        float pv[8];
#pragma unroll
                        for (int jj = 0; jj < 8; ++jj) { const int r = 8 * s2 + jj; const int j = 32 * jt + (r & 3) + 8 * (r >> 2) + 4 * hh; const int dd = i - j;
                            const float e = (dd >= 0) ? lf2 * (float)dd : lb2 * (float)(-dd); pv[jj] = sc[r] * exp2f(e); }
                        v4u pw; pw.x = pk2(pv[0], pv[1]); pw.y = pk2(pv[2], pv[3]); pw.z = pk2(pv[4], pv[5]); pw.w = pk2(pv[6], pv[7]);
                        pf[jt][s2] = __builtin_bit_cast(bf16x8, pw); } }
            } else if (t < 10) {
                const int et = (t - 2) & 3; const LAS unsigned char* srow = cb + (eh * 16 * 64 + F.lane) * 16;
#pragma unroll
                for (int s = 0; s < 16; ++s) { const bf16x8 a = *(const LAS bf16x8*)(srow + s * 1024); acc[et] = MFMA32(a, QF(s), acc[et]); }
                if (t == 5) { const float ratio = __expf(lf * (float)(i + 1) - lb * (float)(CHUNK - i));
#pragma unroll
                    for (int e2 = 0; e2 < 4; ++e2)
#pragma unroll
                        for (int r = 0; r < 16; ++r) acc[e2][r] *= ratio; }
                if (t == 9) { const float wb = __expf(lb * (float)(CHUNK - i));
#pragma unroll
                    for (int e2 = 0; e2 < 4; ++e2)
#pragma unroll
                        for (int r = 0; r < 16; ++r) acc[e2][r] *= wb; }
            } else {
                const int p = t - 10;
#pragma unroll
                for (int etl = 0; etl < 2; ++etl) { const int et = 2 * p + etl; const LAS unsigned char* vrow = cb + ((2 * eh + etl) * 8 * 64 + F.lane) * 16;
#pragma unroll
                    for (int jt = 0; jt < 4; ++jt)
#pragma unroll
                        for (int s2 = 0; s2 < 2; ++s2) { const bf16x8 a = *(const LAS bf16x8*)(vrow + (2 * jt + s2) * 1024); acc[et] = MFMA32(a, pf[jt][s2], acc[et]); } }
            }
        }
#undef QF
        float s = 0.f;
#pragma unroll
        for (int et = 0; et < 4; ++et)
#pragma unroll
            for (int r = 0; r < 16; ++r) s += acc[et][r];
        s += __shfl_xor(s, 32);
        if (hh == 0) red1[w * 32 + li] = s;
        LDS_WAIT(); __syncthreads();
        const float mean = (red1[ib * 32 + li] + red1[(ib + 4) * 32 + li]) * (1.0f / HD);
        float q = 0.f;
#pragma unroll
        for (int et = 0; et < 4; ++et)
#pragma unroll
            for (int r = 0; r < 16; ++r) { const float dlt = acc[et][r] - mean; q += dlt * dlt; }
        q += __shfl_xor(q, 32);
        if (hh == 0) red2[w * 32 + li] = q;
        LDS_WAIT(); __syncthreads();
        const float rstd = 1.0f / sqrtf((red2[ib * 32 + li] + red2[(ib + 4) * 32 + li]) * (1.0f / HD) + EPS);
        { const float* gn = F_gn_g + (size_t)l * RW + h * HD; const bf16* gp = F_PROJ + (size_t)tok * N1 + COL_G + h * HD; bf16* yp = F_YCAT + (size_t)tok * D + CW + h * HD;
          f32x4 gv[4][4]; v2u gw2[4][4];
#pragma unroll
          for (int et = 0; et < 4; ++et)
#pragma unroll
              for (int g = 0; g < 4; ++g) { const int e4 = 128 * eh + 32 * et + 8 * g + 4 * hh; gv[et][g] = *(const f32x4*)(gn + e4); gw2[et][g] = *(const v2u*)(gp + e4); }
          asm volatile("" : "+v"(gv[0][0]), "+v"(gv[0][1]), "+v"(gv[0][2]), "+v"(gv[0][3]), "+v"(gv[1][0]), "+v"(gv[1][1]), "+v"(gv[1][2]), "+v"(gv[1][3]),
                            "+v"(gv[2][0]), "+v"(gv[2][1]), "+v"(gv[2][2]), "+v"(gv[2][3]), "+v"(gv[3][0]), "+v"(gv[3][1]), "+v"(gv[3][2]), "+v"(gv[3][3]));
          asm volatile("" : "+v"(gw2[0][0]), "+v"(gw2[0][1]), "+v"(gw2[0][2]), "+v"(gw2[0][3]), "+v"(gw2[1][0]), "+v"(gw2[1][1]), "+v"(gw2[1][2]), "+v"(gw2[1][3]),
                            "+v"(gw2[2][0]), "+v"(gw2[2][1]), "+v"(gw2[2][2]), "+v"(gw2[2][3]), "+v"(gw2[3][0]), "+v"(gw2[3][1]), "+v"(gw2[3][2]), "+v"(gw2[3][3]));
#pragma unroll
          for (int et = 0; et < 4; ++et)
#pragma unroll
              for (int g = 0; g < 4; ++g) { const int e4 = 128 * eh + 32 * et + 8 * g + 4 * hh; const f32x4 gvv = gv[et][g]; const v2u gw = gw2[et][g];
                  const float gt[4] = {bflo(gw.x), bfhi(gw.x), bflo(gw.y), bfhi(gw.y)}; float y[4];
#pragma unroll
                  for (int j = 0; j < 4; ++j) { const float sg = gt[j] * __builtin_amdgcn_rcpf(1.0f + __expf(-gt[j])); y[j] = (acc[et][4 * g + j] - mean) * rstd * gvv[j] * sg; }
                  v2u o; o.x = pk2(y[0], y[1]); o.y = pk2(y[2], y[3]); *(v2u*)(yp + e4) = o; } }
    }
    VM_WAIT(); __syncthreads();
}

__device__ __forceinline__ void act_fix_phase(Frame& F, int l) {
    const int gt = (F.vcu * NWAVES + F.wave) * 64 + F.lane, NT = F.G * NWAVES * 64;
    for (int idx = gt; idx < (M / 256) * 2 * (FF / 8); idx += NT) {
        const int rs = idx / (FF / 8), c0 = (idx - rs * (FF / 8)) * 8, pm = rs >> 1, lastr = rs & 1, r = pm * 256 + (lastr ? 255 : 0);
        const float* hg = F_HG + (size_t)pm * 4 * FF + c0; const float* hu = F_HU + (size_t)(pm * 2 + lastr) * FF + c0;
        const bool zprev = !lastr && (r & (SEQ - 1)) == 0, znext = lastr && ((r + 1) & (SEQ - 1)) == 0;
        const float* gm = lastr ? hg + 2 * FF : hg - FF;
        const float* g0 = lastr ? hg + 3 * FF : hg;
        const float* gp = lastr ? hg + 4 * FF : hg + FF;
        const float* cw = F_ffn_w + (size_t)l * 3 * FF + c0; const float* cb = F_ffn_b + (size_t)l * FF + c0;
        float y[8];
#pragma unroll
        for (int j = 0; j < 8; ++j) { const float a = zprev ? 0.f : gm[j], c = znext ? 0.f : gp[j]; const float z = cw[j] * a + cw[FF + j] * g0[j] + cw[2 * FF + j] * c + cb[j]; y[j] = z / (1.0f + __expf(-z)) * hu[j]; }
        const int k8 = k8_of(l);
        if (c0 < k8) *(v2u*)((unsigned char*)F_ACT + (size_t)r * k8 + c0) = __builtin_bit_cast(v2u, pg8::pack8_fp8((f32x4){y[0], y[1], y[2], y[3]}, (f32x4){y[4], y[5], y[6], y[7]}));
        else { v4u o; o.x = pk2(y[0], y[1]); o.y = pk2(y[2], y[3]); o.z = pk2(y[4], y[5]); o.w = pk2(y[6], y[7]); *(v4u*)((unsigned char*)F_ACT + (size_t)M * k8 + ((size_t)r * (FF - k8) + (c0 - k8)) * 2) = o; }
    }
}

__device__ __forceinline__ void final_phase(Frame& F) {
    const int gw = F.vcu * NWAVES + F.wave, NGW = F.G * NWAVES;
    f32x4 gg[8][2];
    { const float* gr0 = F_norm_f + 8 * F.lane;
#pragma unroll
      for (int j = 0; j < 8; ++j) { gg[j][0] = *(const f32x4*)(gr0 + 512 * j); gg[j][1] = *(const f32x4*)(gr0 + 512 * j + 4); } }
    for (int m = gw; m < M; m += NGW) {
        const float s = wave_sum(F_part[(size_t)m * 64 + F.lane]); const float rs = 1.0f / sqrtf(s * (1.0f / D) + EPS);
        const bf16* xr = F_XB + (size_t)m * D + 8 * F.lane; float* orow = F_out + (size_t)m * D + 8 * F.lane;
        v4u xv[8];
#pragma unroll
        for (int j = 0; j < 8; ++j) xv[j] = *(const v4u*)(xr + 512 * j);
        asm volatile("" : "+v"(xv[0]), "+v"(xv[1]), "+v"(xv[2]), "+v"(xv[3]), "+v"(xv[4]), "+v"(xv[5]), "+v"(xv[6]), "+v"(xv[7]));
#pragma unroll
        for (int j = 0; j < 8; ++j) { float v[8]; unpack8(xv[j], v); const f32x4 g0 = gg[j][0], g1 = gg[j][1];
            *(f32x4*)(orow + 512 * j) = (f32x4){v[0] * rs * g0[0], v[1] * rs * g0[1], v[2] * rs * g0[2], v[3] * rs * g0[3]};
            *(f32x4*)(orow + 512 * j + 4) = (f32x4){v[4] * rs * g1[0], v[5] * rs * g1[1], v[6] * rs * g1[2], v[7] * rs * g1[3]}; }
    }
}

constexpr int PH_PER_LAYER = 9, N_PHASES = DEPTH * PH_PER_LAYER + 1;

__global__ void __launch_bounds__(NWAVES * 64, 2) enc_fwd(Args args) {
    extern __shared__ __attribute__((aligned(16))) unsigned char lds[];
    Frame F;
    F.lds = (LAS unsigned char*)lds;
    volatile LAS unsigned* MISC = (volatile LAS unsigned*)(F.lds + MISC_OFF);
    { int wv = __builtin_amdgcn_readfirstlane((int)threadIdx.x >> 6); asm volatile("" : "+s"(wv)); F.wave = wv; }
    { int ln_; asm volatile("v_mbcnt_lo_u32_b32 %0, -1, 0\n\tv_mbcnt_hi_u32_b32 %0, -1, %0" : "=v"(ln_)); F.lane = ln_; F.tid = F.wave * 64 + ln_; }
    F.G = gridDim.x; { const int bx = blockIdx.x; F.vcu = (F.G % 8 == 0) ? (bx % 8) * (F.G / 8) + bx / 8 : bx; }
    F.ap = (const __attribute__((address_space(4))) Args*)__builtin_amdgcn_kernarg_segment_ptr();
    unsigned char* ws = args.ws;
    for (int u = F.tid; u < (LDS_BYTES - LDSCTL_OFF) / 4; u += NWAVES * 64) ((LAS unsigned*)(F.lds + LDSCTL_OFF))[u] = 0u;
    __syncthreads();
    XcdBarrier bar; bar.bar = (unsigned*)(ws + WS_CTL) + CW_BAR; bar.x = 0; bar.st = nullptr;
#define LAUNDER() do { int ln_; asm volatile("v_mbcnt_lo_u32_b32 %0, -1, 0\n\tv_mbcnt_hi_u32_b32 %0, -1, %0" : "=v"(ln_)); asm volatile("" : "+s"(F.ap)); F.lane = ln_; F.tid = F.wave * 64 + ln_; } while (0)
#if !MK_SPLIT
    bar = xcd_barrier_post((unsigned*)(ws + WS_CTL) + CW_BAR, MISC + 8, F.tid == 0);
#define GRID_BAR() do { asm volatile("" : "+s"(bar.bar));     LAUNDER(); xcd_barrier(bar, F.tid == 0); } while (0)
#else
#define GRID_BAR() do {} while (0)
#endif
    const int lo = args.ph_lo, hi = args.ph_hi;
#define IN(k) (lo <= (k) && (k) < hi)
#define SEAM(k) do { if (IN(k) && IN((k) + 1)) GRID_BAR(); } while (0)
    using namespace pg8;
    if (IN(0) && (GU8_TILES_L0 > 0 || GU8_TILES_L1 > 0)) { LAUNDER(); wabs_phase(F); GRID_BAR(); }
    for (int l = 0; l < DEPTH; ++l) {
        const int pb = l * PH_PER_LAYER;
#define PT0(k) unsigned long long pt_##k = 0; if (PROBE_PHTIME == (k)) pt_##k = __builtin_amdgcn_s_memrealtime()
#define PT1(k) if (PROBE_PHTIME == (k) && blockIdx.x == 0 && F.tid == 0) MISC[18] += (unsigned)(__builtin_amdgcn_s_memrealtime() - pt_##k)
#define SP0(k) if (PROBE_SPREAD == (k) && F.tid == 0) { const unsigned t = (unsigned)__builtin_amdgcn_s_memrealtime(); gu32* cw = (gu32*)(F.ap->ws) + 2048 + l * 128; __hip_atomic_fetch_max(cw, t, RLX_AGENT); __hip_atomic_fetch_max(cw + 64, 0xFFFFFFFFu - t, RLX_AGENT); }
#define SP1(k) if (PROBE_SPREAD == (k) && blockIdx.x == 0 && F.tid == 0) { gu32* cw = (gu32*)(F.ap->ws) + 2048 + l * 128; const unsigned mx = __hip_atomic_load(cw, RLX_AGENT), mn = 0xFFFFFFFFu - __hip_atomic_load(cw + 64, RLX_AGENT); MISC[19] += mx - mn; }
#define BW0(k) unsigned long long bw_##k = 0; if (PROBE_BWAIT == (k)) bw_##k = __builtin_amdgcn_s_memrealtime()
#define BW1(k) if (PROBE_BWAIT == (k) && blockIdx.x == 0 && F.tid == 0) MISC[20] += (unsigned)(__builtin_amdgcn_s_memrealtime() - bw_##k)
        PT0(0); if (PHON(0) && IN(pb + 0)) { for (int rp = 0; rp < PHREP(0); ++rp) { LAUNDER(); p0_phase(F, l); } } SP0(0); BW0(0); SEAM(pb + 0); BW1(0); PT1(0); SP1(0);
        PT0(1); if (PHON(1) && IN(pb + 1)) for (int rp = 0; rp < PHREP(1); ++rp) { LAUNDER();
            { Gemm g{F_XB, F_WIN, M, IN_COLS, D}; StaticOrder S; S.init(M, IN_COLS, F.G, (int)blockIdx.x); EpiIn E{F_PROJ, N1, F_rstd1, (PG8_LAS const float*)(F.lds + RING_OFF + ROWTAB_OFF), F_cosb, F_sinb, F_KFT, F_KBT, F_VT, F_lgam + l * 16};
              gemm_phase<EpiIn, StaticOrder, PG8_ALIGN, PG8_SP2, PROBE_PHASE == 1>(F.lds + RING_OFF, g, S, E, F.tid); }
        } SP0(1); BW0(1); SEAM(pb + 1); BW1(1); PT1(1); SP1(1);
        PT0(2); if (PHON(2) && IN(pb + 2)) { for (int rp = 0; rp < PHREP(2); ++rp) { LAUNDER(); for (int r2 = 0; r2 < PHREP(10); ++r2) mixer_a(F, l); for (int r2 = 0; r2 < PHREP(11); ++r2) scan_phase(F, l); } } SP0(2); BW0(2); SEAM(pb + 2); BW1(2); PT1(2); SP1(2);
        PT0(3); if (PHON(3) && IN(pb + 3)) { for (int rp = 0; rp < PHREP(3); ++rp) { LAUNDER(); intra_phase(F, l); } } SP0(3); BW0(3); SEAM(pb + 3); BW1(3); PT1(3); SP1(3);
        PT0(4); if (PHON(4) && IN(pb + 4)) for (int rp = 0; rp < PHREP(4); ++rp) { LAUNDER(); Gemm g{F_YCAT, F_WOUT, M, D, D}; StaticOrder S; S.init(M, D, F.G, (int)blockIdx.x); EpiRes E{l == 0 ? F_x : nullptr, F_XB, F_part, D, 1.0f};
            gemm_phase<EpiRes, StaticOrder, PG8_ALIGN, PG8_SP2, PROBE_PHASE == 4>(F.lds + RING_OFF, g, S, E, F.tid); } SP0(4); BW0(4); SEAM(pb + 4); BW1(4); PT1(4); SP1(4);
        PT0(5); if (PHON(5) && IN(pb + 5)) { for (int rp = 0; rp < PHREP(5); ++rp) { LAUNDER(); if (gu8_of(l) > 0) p5_i8_phase(F); else rstd_from_part(F, F_rstd2); } } SP0(5); BW0(5); SEAM(pb + 5); BW1(5); PT1(5); SP1(5);
        PT0(6); if (PHON(6) && IN(pb + 6)) for (int rp = 0; rp < PHREP(6); ++rp) { const int n8 = gu8_of(l);
            if (n8 > 0) { LAUNDER(); Gemm g{(const bf16*)F_xq8, F_WGU, M, n8 * 256, D / 2}; TailOrder S; S.init(M, n8 * 256, F.G, (int)blockIdx.x); S.init2((unsigned*)(F.ap->ws) + 1024 + 64 * l + 32, (volatile PG8_LAS int*)(MISC + 24)); if (F.tid == 0) MISC[24] = 0xffffffffu;
                const float sg = __builtin_fmaxf(wq_range(F, l, 0), 1e-30f) * (1.0f / 127.0f), su = __builtin_fmaxf(wq_range(F, l, 1), 1e-30f) * (1.0f / 127.0f);
                EpiAct E{F_ACT, FF, F_rs8, (PG8_LAS float*)(F.lds + RING_OFF + ROWTAB_OFF), sg, su, 0, k8_of(l), (size_t)M * k8_of(l), F_ffn_w + (size_t)l * 3 * FF, F_ffn_b + (size_t)l * FF, F_HG, F_HU};
                gemm_phase<EpiAct, TailOrder, PG8_ALIGN, PG8_SP2, 0, false, true>(F.lds + RING_OFF, g, S, E, F.tid); }
            if (n8 < NGU / 256) { LAUNDER(); Gemm g{F_XB, F_WGU + (size_t)n8 * 256 * D, M, NGU - n8 * 256, D}; TailOrder S; S.init(M, NGU - n8 * 256, F.G, (int)blockIdx.x); S.init2((unsigned*)(F.ap->ws) + 1024 + 64 * l, (volatile PG8_LAS int*)(MISC + 24)); if (F.tid == 0) MISC[24] = 0xffffffffu;
              EpiAct E{F_ACT, FF, F_rstd2, (PG8_LAS float*)(F.lds + RING_OFF + ROWTAB_OFF), 1.0f, 1.0f, n8, k8_of(l), (size_t)M * k8_of(l), F_ffn_w + (size_t)l * 3 * FF, F_ffn_b + (size_t)l * FF, F_HG, F_HU};
              gemm_phase<EpiAct, TailOrder, PG8_ALIGN, PG8_SP2, PROBE_PHASE == 6>(F.lds + RING_OFF, g, S, E, F.tid); } } SP0(6); BW0(6); SEAM(pb + 6); BW1(6); PT1(6); SP1(6);
#if PROBE_GEMM
        if (IN(pb + 6)) { GRID_BAR(); LAUNDER(); Gemm g{F_XB, F_WGU, M, FF, D}; ProbeOrder S; S.init(M, FF, F.G, (int)blockIdx.x); EpiScale E{F_ACT, FF, F_rstd2, (PG8_LAS const float*)(F.lds + RING_OFF + ROWTAB_OFF)};
            gemm_phase<EpiScale, ProbeOrder, PG8_ALIGN, PG8_SP2>(F.lds + RING_OFF, g, S, E, F.tid); GRID_BAR(); }
#endif
        PT0(7); if (PHON(7) && IN(pb + 7)) { for (int rp = 0; rp < PHREP(7); ++rp) { LAUNDER(); act_fix_phase(F, l); } } SP0(7); BW0(7); SEAM(pb + 7); BW1(7); PT1(7); SP1(7);
        PT0(8); if (PHON(8) && IN(pb + 8)) { LAUNDER(); StaticOrder S; S.init(M, D, F.G, (int)blockIdx.x);
            const int k8 = k8_of(l);
            if (k8 > 0) { Gemm g{F_ACT, F_WDN, M, D, k8 / 2}; EpiRes E{nullptr, F_XB, F_part, D, 1.0f / (F8_ASCALE * F8_WSCALE)};
                gemm_phase<EpiRes, StaticOrder, PG8_ALIGN, PG8_SP2, 0, true>(F.lds + RING_OFF, g, S, E, F.tid); }
            if (k8 < FF) { LAUNDER(); Gemm g{(const bf16*)((const unsigned char*)F_ACT + (size_t)M * k8), (const bf16*)((const unsigned char*)F_WDN + (size_t)D * k8), M, D, FF - k8}; EpiRes E{nullptr, F_XB, F_part, D, 1.0f};
                gemm_phase<EpiRes, StaticOrder, PG8_ALIGN, PG8_SP2, PROBE_PHASE == 8>(F.lds + RING_OFF, g, S, E, F.tid); } } SP0(8); BW0(8); SEAM(pb + 8); BW1(8); PT1(8); SP1(8);
    }
    PT0(9); if (PHON(9) && IN(N_PHASES - 1)) { LAUNDER(); final_phase(F); }
#if PROBE_PHTIME == 9
    GRID_BAR(); PT1(9);
#endif
#if PROBE_BARS
    for (int i = 0; i < PROBE_BARS; ++i) GRID_BAR();
#endif
#if PROBE_SPREAD >= 0
    if (blockIdx.x == 0 && F.tid == 0) { const unsigned long long ticks = 4ull * MISC[19]; const unsigned long long t0 = __builtin_amdgcn_s_memrealtime(); while (__builtin_amdgcn_s_memrealtime() - t0 < ticks) __builtin_amdgcn_s_sleep(8); }
#endif
#if PROBE_BWAIT >= 0
    if (blockIdx.x == 0 && F.tid == 0) { const unsigned long long ticks = 2ull * MISC[20]; const unsigned long long t0 = __builtin_amdgcn_s_memrealtime(); while (__builtin_amdgcn_s_memrealtime() - t0 < ticks) __builtin_amdgcn_s_sleep(8); }
#endif
#if PROBE_PHTIME >= 0
    if (blockIdx.x == 0 && F.tid == 0) { const unsigned long long ticks = MISC[18]; const unsigned long long t0 = __builtin_amdgcn_s_memrealtime(); while (__builtin_amdgcn_s_memrealtime() - t0 < ticks) __builtin_amdgcn_s_sleep(8); }
#endif
#if PROBE_TIMER
    if (blockIdx.x == 0 && F.tid == 0) { const unsigned v = MISC[16] / (MISC[17] ? MISC[17] : 1u);
        const unsigned long long ticks = (PROBE_TIMER & 1) ? (unsigned long long)v / 2ull : (unsigned long long)v * 10ull;
        const unsigned long long t0 = __builtin_amdgcn_s_memrealtime(); while (__builtin_amdgcn_s_memrealtime() - t0 < ticks) __builtin_amdgcn_s_sleep(8); }
#endif
#undef IN
#undef SEAM
}

extern "C" void kernel_launch(void* const* d_in, const int* in_sizes, int n_in, void* d_out, int out_size, void* d_ws, size_t ws_size, hipStream_t stream) {
    static int grid = 0;
    if (grid == 0) {
        if (n_in != 17 || in_sizes[0] != M * D || out_size != M * D || ws_size < WS_END) { fprintf(stderr, "kernel_launch: unexpected shapes (n_in %d, in0 %d, out %d, ws %zu < %zu?)\n", n_in, n_in > 0 ? in_sizes[0] : -1, out_size, ws_size, (size_t)WS_END); grid = -1; return; }
        int dev = 0, cus = 0, per_cu = 0;
        if (hipGetDevice(&dev) != hipSuccess || hipDeviceGetAttribute(&cus, hipDeviceAttributeMultiprocessorCount, dev) != hipSuccess) { grid = -1; return; }
        if (hipFuncSetAttribute((const void*)enc_fwd, hipFuncAttributeMaxDynamicSharedMemorySize, LDS_BYTES) != hipSuccess) { fprintf(stderr, "kernel_launch: hipFuncSetAttribute failed\n"); grid = -1; return; }
        if (hipOccupancyMaxActiveBlocksPerMultiprocessor(&per_cu, (const void*)enc_fwd, NWAVES * 64, LDS_BYTES) != hipSuccess || per_cu < 1) fprintf(stderr, "kernel_launch: occupancy query reports %d\n", per_cu);
        (void)hipGetLastError();
        grid = cus;
    }
    if (grid < 0) return;
    if (hipMemsetAsync((char*)d_ws + WS_CTL, 0, CTL_ZERO_BYTES, stream) != hipSuccess) { fprintf(stderr, "kernel_launch: memset failed\n"); return; }
    Args a{};
    for (int i = 0; i < 17; ++i) a.in[i] = d_in[i];
    a.out = (float*)d_out; a.ws = (unsigned char*)d_ws;
#if MK_SPLIT
    for (int p = 0; p < N_PHASES; ++p) { a.ph_lo = p; a.ph_hi = p + 1; hipLaunchKernelGGL(enc_fwd, dim3(grid), dim3(NWAVES * 64), LDS_BYTES, stream, a); }
#else
    a.ph_lo = 0; a.ph_hi = N_PHASES;
    hipLaunchKernelGGL(enc_fwd, dim3(grid), dim3(NWAVES * 64), LDS_BYTES, stream, a);
#endif
    const hipError_t le = hipPeekAtLastError();
    if (le != hipSuccess) fprintf(stderr, "kernel_launch: launch failed: %s\n", hipGetErrorName(le));
}
```

```cpp
#include <hip/hip_runtime.h>
#include <cstdio>
#include <cstdint>

#ifndef PH_MASK
#define PH_MASK 0x3ff
#endif
#define PHON(k) ((PH_MASK >> (k)) & 1)
#ifndef PH_REPEAT
#define PH_REPEAT 0
#endif
#define PHREP(k) (((PH_REPEAT >> (k)) & 1) ? 2 : 1)
#ifndef MK_SPLIT
#define MK_SPLIT 0
#endif

namespace pg8 {
#define PG8_LAS __attribute__((address_space(3)))
typedef unsigned short bf16_t;
typedef short bf16x8 __attribute__((ext_vector_type(8)));
typedef float f32x4 __attribute__((ext_vector_type(4)));
typedef unsigned u32x4 __attribute__((ext_vector_type(4)));
constexpr int ROWTAB_OFF = 131072;
constexpr int BM = 256, BK = 64, HALF = 128, HTB = HALF * BK * 2  , STAGE_BYTES = 8 * HTB, NXCD = 8, WGM = 8;

__host__ __device__ __forceinline__ int lds_byte(int r, int c) { const int st = (r >> 4) * 2 + (c >> 5), rr = r & 15, cc = c & 31, ob = rr * 64 + cc * 2; return st * 1024 + (ob ^ (((ob >> 9) & 1) << 5)); }
__host__ __device__ __forceinline__ void stage_rc(int b, int& R, int& C) { const int st = b / 1024, sb = b % 1024, swz = sb ^ (((sb >> 9) & 1) << 5); R = (st >> 1) * 16 + swz / 64; C = (st & 1) * 32 + (swz % 64) / 2; }
__host__ __device__ __forceinline__ int perm32(int rho) { const int n = rho >> 4, i = rho & 15; return 8 * (i >> 2) + 4 * n + (i & 3); }

struct Unit { int pm, pn; };
struct Gemm { const bf16_t* A; const bf16_t* Bt; int M, N, K; };

struct StaticOrder {
    int nM, nN, nwg, G, c;
    __host__ __device__ void init(int M, int N, int G_, int c_) { nM = M / BM; nN = N / BM; nwg = nM * nN; G = G_; c = c_; }
    __host__ __device__ bool next(int i, Unit& u) const {
        const long L = (long)i * G + c; if (L >= nwg) return false;
        int wgid = (int)L; { const int q = nwg / NXCD, r = nwg % NXCD, xcd = wgid % NXCD, off = wgid / NXCD; wgid = (xcd < r ? xcd * (q + 1) : r * (q + 1) + (xcd - r) * q) + off; }
        const int nig = WGM * nN, gid = wgid / nig, fm = gid * WGM, gsz = (nM - fm) < WGM ? (nM - fm) : WGM;
        u.pm = fm + ((wgid % nig) % gsz); u.pn = (wgid % nig) / gsz; return true;
    }
    __device__ __forceinline__ void a_ready(const Unit&) const {}
    __device__ __forceinline__ void done(const Unit&) const {}
    __device__ __forceinline__ void tick(int, bool) const {}
};

struct TailOrder : StaticOrder {
    unsigned* ctr; volatile PG8_LAS int* slot; int full, rem;
    __device__ __forceinline__ void init2(unsigned* c_, volatile PG8_LAS int* s_) { ctr = c_; slot = s_; full = nwg / G; rem = nwg - full * G; }
    __device__ __forceinline__ bool next(int i, Unit& u) const {
        if (i < full || full < 2) return StaticOrder::next(i, u);
        if (i > full || rem == 0) return false;
        const int t = *slot; if (t < 0 || t >= rem) return false;
        TailOrder tmp = *this; tmp.c = t; return tmp.StaticOrder::next(full, u);
    }
    __device__ __forceinline__ void tick(int ui, bool t0) const {
        if (rem != 0 && ui == full - 2 && t0) { const int t = (int)__hip_atomic_fetch_add(ctr, 1u, __ATOMIC_RELAXED, __HIP_MEMORY_SCOPE_AGENT); *slot = t; }
    }
};
#ifndef PROBE_GEMM
#define PROBE_GEMM 0
#endif
struct ProbeOrder : StaticOrder {
    __host__ __device__ bool next(int i, Unit& u) const { const bool ok = StaticOrder::next(i, u); if (PROBE_GEMM == 2) { u.pm = 0; u.pn = 0; } return ok; }
};
__device__ __forceinline__ unsigned cvt_pk_bf16(float lo, float hi) { unsigned r; asm volatile("v_cvt_pk_bf16_f32 %0, %1, %2" : "=v"(r) : "v"(lo), "v"(hi)); return r; }
typedef unsigned u32x2 __attribute__((ext_vector_type(2)));
constexpr float F8_ASCALE = 4.0f, F8_WSCALE = 64.0f;
__device__ __forceinline__ float f8clamp(float v) { return __builtin_fminf(__builtin_fmaxf(v * F8_ASCALE, -440.0f), 440.0f); }
__device__ __forceinline__ u32x2 pack8_fp8(const f32x4 a, const f32x4 b) { u32x2 w; int t = __builtin_amdgcn_cvt_pk_fp8_f32(f8clamp(a[0]), f8clamp(a[1]), 0, false); t = __builtin_amdgcn_cvt_pk_fp8_f32(f8clamp(a[2]), f8clamp(a[3]), t, true); w.x = (unsigned)t;
    int q = __builtin_amdgcn_cvt_pk_fp8_f32(f8clamp(b[0]), f8clamp(b[1]), 0, false); q = __builtin_amdgcn_cvt_pk_fp8_f32(f8clamp(b[2]), f8clamp(b[3]), q, true); w.y = (unsigned)q; return w; }
__device__ __forceinline__ float dpp_qp(float v, const int ctrl) { const int x = __builtin_bit_cast(int, v); return __builtin_bit_cast(float, ctrl == 0xB1 ? __builtin_amdgcn_update_dpp(x, x, 0xB1, 0xF, 0xF, false) : __builtin_amdgcn_update_dpp(x, x, 0x4E, 0xF, 0xF, false)); }
__device__ __forceinline__ f32x4 quad_transpose(f32x4 a, int q) {
    { const bool odd = (q & 1) != 0; const float s0 = odd ? a[0] : a[1], s1 = odd ? a[2] : a[3]; const float r0 = dpp_qp(s0, 0xB1), r1 = dpp_qp(s1, 0xB1);
      if (odd) { a[0] = r0; a[2] = r1; } else { a[1] = r0; a[3] = r1; } }
    { const bool hi = (q & 2) != 0; const float s0 = hi ? a[0] : a[2], s1 = hi ? a[1] : a[3]; const float r0 = dpp_qp(s0, 0x4E), r1 = dpp_qp(s1, 0x4E);
      if (hi) { a[0] = r0; a[1] = r1; } else { a[2] = r0; a[3] = r1; } }
    return a;
}
__device__ __forceinline__ u32x2 pack4(const f32x4 a) { u32x2 w; w.x = cvt_pk_bf16(a[0], a[1]); w.y = cvt_pk_bf16(a[2], a[3]); return w; }
__device__ __forceinline__ u32x4 pack8(const f32x4 a, const f32x4 b) { u32x4 w; w.x = cvt_pk_bf16(a[0], a[1]); w.y = cvt_pk_bf16(a[2], a[3]); w.z = cvt_pk_bf16(b[0], b[1]); w.w = cvt_pk_bf16(b[2], b[3]); return w; }

struct EpiIn {
    static constexpr bool PERM = true, AFTER_DRAIN = false, ROWTAB = true, CONVTAB = false;
    bf16_t* O; int ldc; const float* rstd; PG8_LAS const float* tab; const float* cosb; const float* sinb;
    bf16_t* KFT; bf16_t* KBT; bf16_t* VT; const float* lgam;
    int pn0 = 0;
    __device__ __forceinline__ void operator()(const f32x4 (&acc)[2][2][4][2], const Unit& u, int wr, int wc, int fr, int fq) const {
        asm volatile("" : "+v"(fr), "+v"(fq));
        const int upn = u.pn + pn0; const int row0 = u.pm * BM + wr * 64 + fr, col0 = upn * BM + wc * 32 + 8 * fq, typ = upn >> 3;
        if (typ == 3 || typ == 5) {
            const float osc = (typ == 3) ? 0.0625f : 1.0f; const int h = upn & 7;
            float lf = 0.f, lb = 0.f; if (typ == 5) { lf = lgam[h]; lb = lgam[8 + h]; }
            const int tlane = ((((fr >> 2) & 1) * 32 + 8 * fq + (fr & 3)) * 8) + 4 * (fr >> 3);
#pragma unroll
            for (int ai = 0; ai < 2; ++ai) {
                const int tokb = u.pm * BM + ai * HALF; const size_t blk = ((size_t)((tokb >> 12) * 8 + h) * 32 + ((tokb >> 7) & 31)) * 32768 + (size_t)((wc * 8 + 4 * wr) * 512 + tlane);
#pragma unroll
              for (int mh = 0; mh < 2; ++mh) {
                float rsv[2]; f32x4 cv[2][2], sv[2][2];
#pragma unroll
                for (int m2 = 0; m2 < 2; ++m2) { const int row = row0 + ai * HALF + (2 * mh + m2) * 16; rsv[m2] = tab[row - u.pm * BM]; const float* cp = cosb + (size_t)row * 128 + wc * 32 + 8 * fq; const float* sp = sinb + (size_t)row * 128 + wc * 32 + 8 * fq;
                    cv[m2][0] = *(const f32x4*)cp; cv[m2][1] = *(const f32x4*)(cp + 4); sv[m2][0] = *(const f32x4*)sp; sv[m2][1] = *(const f32x4*)(sp + 4); }
                asm volatile("" : "+v"(rsv[0]), "+v"(rsv[1]), "+v"(cv[0][0]), "+v"(cv[0][1]), "+v"(cv[1][0]), "+v"(cv[1][1]), "+v"(sv[0][0]), "+v"(sv[0][1]), "+v"(sv[1][0]), "+v"(sv[1][1]));
#pragma unroll
                for (int m2 = 0; m2 < 2; ++m2) { const int m = 2 * mh + m2; const int row = row0 + ai * HALF + m * 16; const float rs = rsv[m2];
                    const float sc = rs * osc;
                    const f32x4 c0 = cv[m2][0], c1 = cv[m2][1], s0 = sv[m2][0], s1 = sv[m2][1];
                    const f32x4 a0 = acc[ai][0][m][0] * sc, a1 = acc[ai][0][m][1] * sc, b0 = acc[ai][1][m][0] * sc, b1 = acc[ai][1][m][1] * sc;
                    bf16_t* rp2 = O + (size_t)row * ldc + upn * BM + 16 * (2 * wc + (fq >> 1)) + 4 * (fq & 1);
                    const f32x4 o10 = a0 * c0 - b0 * s0, o11 = a1 * c1 - b1 * s1, o20 = b0 * c0 + a0 * s0, o21 = b1 * c1 + a1 * s1;
                    *(u32x2*)(rp2) = pack4(o10); *(u32x2*)(rp2 + 8) = pack4(o11);
                    *(u32x2*)(rp2 + HALF) = pack4(o20); *(u32x2*)(rp2 + HALF + 8) = pack4(o21);
                    if (typ == 5) {
                        const int c = wr * 64 + m * 16 + fr; const float wf = __expf(lf * (float)(127 - c)), wb = __expf(lb * (float)c); const int q = fr & 3;
                        bf16_t* pf = KFT + blk + m * 512; bf16_t* pb = KBT + blk + m * 512;
                        *(u32x2*)(pf) = pack4(quad_transpose(o10 * wf, q)); *(u32x2*)(pf + 32) = pack4(quad_transpose(o11 * wf, q)); *(u32x2*)(pf + 16384) = pack4(quad_transpose(o20 * wf, q)); *(u32x2*)(pf + 16384 + 32) = pack4(quad_transpose(o21 * wf, q));
                        *(u32x2*)(pb) = pack4(quad_transpose(o10 * wb, q)); *(u32x2*)(pb + 32) = pack4(quad_transpose(o11 * wb, q)); *(u32x2*)(pb + 16384) = pack4(quad_transpose(o20 * wb, q)); *(u32x2*)(pb + 16384 + 32) = pack4(quad_transpose(o21 * wb, q));
                    } } } }
        } else if (typ == 6) {
            const int h = upn & 7; const int tlane = ((((fr >> 2) & 1) * 32 + 8 * fq + (fr & 3)) * 8) + 4 * (fr >> 3), q = fr & 3;
            float rs8[8];
#pragma unroll
            for (int i = 0; i < 8; ++i) rs8[i] = tab[row0 - u.pm * BM + (i >> 2) * HALF + (i & 3) * 16];
            asm volatile("" : "+v"(rs8[0]), "+v"(rs8[1]), "+v"(rs8[2]), "+v"(rs8[3]), "+v"(rs8[4]), "+v"(rs8[5]), "+v"(rs8[6]), "+v"(rs8[7]));
#pragma unroll
            for (int ai = 0; ai < 2; ++ai) {
                const int tokb = u.pm * BM + ai * HALF; const size_t blk = ((size_t)((tokb >> 12) * 8 + h) * 32 + ((tokb >> 7) & 31)) * 32768 + (size_t)((wc * 8 + 4 * wr) * 512 + tlane);
#pragma unroll
                for (int m = 0; m < 4; ++m) { const float rs = rs8[ai * 4 + m]; bf16_t* pv = VT + blk + m * 512;
#pragma unroll
                    for (int bj = 0; bj < 2; ++bj)
#pragma unroll
                        for (int n = 0; n < 2; ++n) *(u32x2*)(pv + bj * 16384 + n * 32) = pack4(quad_transpose(acc[ai][bj][m][n] * rs, q)); } }
        } else {
            float rs8[8];
#pragma unroll
            for (int i = 0; i < 8; ++i) rs8[i] = tab[row0 - u.pm * BM + (i >> 2) * HALF + (i & 3) * 16];
            asm volatile("" : "+v"(rs8[0]), "+v"(rs8[1]), "+v"(rs8[2]), "+v"(rs8[3]), "+v"(rs8[4]), "+v"(rs8[5]), "+v"(rs8[6]), "+v"(rs8[7]));
#pragma unroll
            for (int ai = 0; ai < 2; ++ai)
#pragma unroll
                for (int m = 0; m < 4; ++m) { const int row = row0 + ai * HALF + m * 16; const float rs = rs8[ai * 4 + m]; bf16_t* rowp = O + (size_t)row * ldc + col0;
#pragma unroll
                    for (int bj = 0; bj < 2; ++bj) *(u32x4*)(rowp + bj * HALF) = pack8(acc[ai][bj][m][0] * rs, acc[ai][bj][m][1] * rs); }
        }
    }
};
struct EpiScale {
    static constexpr bool PERM = true, AFTER_DRAIN = false, ROWTAB = true, CONVTAB = false;
    bf16_t* O; int ldc; const float* rstd; PG8_LAS const float* tab;
    __device__ __forceinline__ void operator()(const f32x4 (&acc)[2][2][4][2], const Unit& u, int wr, int wc, int fr, int fq) const {
        asm volatile("" : "+v"(fr), "+v"(fq));
        const int rl0 = wr * 64 + fr, row0 = u.pm * BM + rl0, col0 = u.pn * BM + wc * 32 + 8 * fq;
#pragma unroll
        for (int ai = 0; ai < 2; ++ai)
#pragma unroll
            for (int m = 0; m < 4; ++m) { const int row = row0 + ai * HALF + m * 16; const float r = tab[rl0 + ai * HALF + m * 16]; bf16_t* rowp = O + (size_t)row * ldc + col0;
#pragma unroll
                for (int bj = 0; bj < 2; ++bj) *(u32x4*)(rowp + bj * HALF) = pack8(acc[ai][bj][m][0] * r, acc[ai][bj][m][1] * r); }
    }
};
__device__ __forceinline__ float dpp_row(float oldv, float v, const int ctrl) { const int o = __builtin_bit_cast(int, oldv), x = __builtin_bit_cast(int, v);
    return __builtin_bit_cast(float, ctrl == 0x111 ? __builtin_amdgcn_update_dpp(o, x, 0x111, 0xF, 0xF, false) : ctrl == 0x101 ? __builtin_amdgcn_update_dpp(o, x, 0x101, 0xF, 0xF, false)
                                   : ctrl == 0x10F ? __builtin_amdgcn_update_dpp(o, x, 0x10F, 0xF, 0xF, false) : __builtin_amdgcn_update_dpp(o, x, 0x11F, 0xF, 0xF, false)); }
__device__ __forceinline__ float dpp_in(float v, const int ctrl) { const int x = __builtin_bit_cast(int, v);
    return __builtin_bit_cast(float, ctrl == 0x10F ? __builtin_amdgcn_mov_dpp(x, 0x10F, 0xF, 0xF, true) : __builtin_amdgcn_mov_dpp(x, 0x11F, 0xF, 0xF, true)); }
struct EpiAct {
    static constexpr bool PERM = true, AFTER_DRAIN = false, ROWTAB = true, CONVTAB = true;
    bf16_t* ACT; int ldc; const float* rstd; PG8_LAS float* tab;
    float scg, scu; int pn0;
    int k8; size_t a16off;
    const float* cw; const float* cb; float* HG; float* HU;
    __device__ __forceinline__ void operator()(const f32x4 (&acc)[2][2][4][2], const Unit& u, int wr, int wc, int fr, int fq) const {
        asm volatile("" : "+v"(fr), "+v"(fq));
        const int rl0 = wr * 64 + fr, ch0 = wc * 32 + 8 * fq;
        f32x4 G[2][4][2], U[2][4][2];
#pragma unroll
        for (int ai = 0; ai < 2; ++ai)
#pragma unroll
            for (int m = 0; m < 4; ++m) { const float r = tab[rl0 + ai * HALF + m * 16]; const float rg = r * scg, ru = r * scu;
#pragma unroll
                for (int n = 0; n < 2; ++n) { G[ai][m][n] = acc[ai][0][m][n] * rg; U[ai][m][n] = acc[ai][1][m][n] * ru; } }
        PG8_LAS float* hb = tab + 768;
#define EPA_H(wr_, ai_, fl_) (((((wr_) * 4 + wc) * 2 + (ai_)) * 2 + (fl_)) * 32 + 8 * fq)
        if (fr == 0) {
#pragma unroll
            for (int ai = 0; ai < 2; ++ai) { *(PG8_LAS f32x4*)(hb + EPA_H(wr, ai, 0)) = G[ai][0][0]; *(PG8_LAS f32x4*)(hb + EPA_H(wr, ai, 0) + 4) = G[ai][0][1]; } }
        if (fr == 15) {
#pragma unroll
            for (int ai = 0; ai < 2; ++ai) { *(PG8_LAS f32x4*)(hb + EPA_H(wr, ai, 1)) = G[ai][3][0]; *(PG8_LAS f32x4*)(hb + EPA_H(wr, ai, 1) + 4) = G[ai][3][1]; } }
        asm volatile("s_waitcnt lgkmcnt(0)" ::: "memory"); __builtin_amdgcn_s_barrier(); asm volatile("" ::: "memory");
        f32x4 top[2][2], bot[2][2];
#pragma unroll
        for (int ai = 0; ai < 2; ++ai) {
            const int to = (wr == 1) ? EPA_H(0, ai, 1) : EPA_H(1, 0, 1);
            const int bo = (wr == 0) ? EPA_H(1, ai, 0) : EPA_H(0, 1, 0);
            top[ai][0] = *(PG8_LAS const f32x4*)(hb + to); top[ai][1] = *(PG8_LAS const f32x4*)(hb + to + 4); bot[ai][0] = *(PG8_LAS const f32x4*)(hb + bo); bot[ai][1] = *(PG8_LAS const f32x4*)(hb + bo + 4); }
#undef EPA_H
        f32x4 w0[2], w1[2], w2[2], bb[2];
#pragma unroll
        for (int n = 0; n < 2; ++n) { w0[n] = *(PG8_LAS const f32x4*)(tab + 256 + ch0 + 4 * n); w1[n] = *(PG8_LAS const f32x4*)(tab + 384 + ch0 + 4 * n); w2[n] = *(PG8_LAS const f32x4*)(tab + 512 + ch0 + 4 * n); bb[n] = *(PG8_LAS const f32x4*)(tab + 640 + ch0 + 4 * n); }
        const int chg = (u.pn + pn0) * HALF + ch0;
        const bool f8 = (u.pn + pn0) * HALF < k8;
        unsigned char* const ab = f8 ? (unsigned char*)ACT + chg : (unsigned char*)ACT + a16off + (size_t)(chg - k8) * 2; const size_t ap = f8 ? (size_t)k8 : (size_t)(ldc - k8) * 2;
#pragma unroll
        for (int ai = 0; ai < 2; ++ai)
#pragma unroll
            for (int m = 0; m < 4; ++m) {
                f32x4 o[2];
#pragma unroll
                for (int n = 0; n < 2; ++n)
#pragma unroll
                    for (int j = 0; j < 4; ++j) {
                        const float g = G[ai][m][n][j];
                        const float xo = (m > 0) ? dpp_in(G[ai][m > 0 ? m - 1 : 0][n][j], 0x10F) : top[ai][n][j];
                        const float gp = dpp_row(xo, g, 0x111);
                        const float yo = (m < 3) ? dpp_in(G[ai][m < 3 ? m + 1 : 3][n][j], 0x11F) : bot[ai][n][j];
                        const float gn = dpp_row(yo, g, 0x101);
                        const float z = __builtin_fmaf(w0[n][j], gp, __builtin_fmaf(w1[n][j], g, __builtin_fmaf(w2[n][j], gn, bb[n][j])));
                        o[n][j] = z * __builtin_amdgcn_rcpf(1.0f + __builtin_amdgcn_exp2f(z * -1.4426950408889634f)) * U[ai][m][n][j]; }
                const int tr = ai * HALF + wr * 64 + m * 16 + fr;
                const bool first = (ai == 0 && m == 0 && wr == 0 && fr == 0), lastr = (ai == 1 && m == 3 && wr == 1 && fr == 15);
                if (!first && !lastr) { if (f8) *(u32x2*)(ab + (size_t)(u.pm * BM + tr) * ap) = pack8_fp8(o[0], o[1]); else *(u32x4*)(ab + (size_t)(u.pm * BM + tr) * ap) = pack8(o[0], o[1]); }
                if (ai == 0 && m == 0 && wr == 0 && fr <= 1) { float* hg = HG + (size_t)(u.pm * 4 + fr) * ldc + chg; *(f32x4*)hg = G[0][0][0]; *(f32x4*)(hg + 4) = G[0][0][1];
                    if (fr == 0) { float* hu = HU + (size_t)(u.pm * 2) * ldc + chg; *(f32x4*)hu = U[0][0][0]; *(f32x4*)(hu + 4) = U[0][0][1]; } }
                if (ai == 1 && m == 3 && wr == 1 && fr >= 14) { float* hg = HG + (size_t)(u.pm * 4 + 2 + (fr - 14)) * ldc + chg; *(f32x4*)hg = G[1][3][0]; *(f32x4*)(hg + 4) = G[1][3][1];
                    if (fr == 15) { float* hu = HU + (size_t)(u.pm * 2 + 1) * ldc + chg; *(f32x4*)hu = U[1][3][0]; *(f32x4*)(hu + 4) = U[1][3][1]; } }
            }
    }
};
struct EpiRes {
    static constexpr bool PERM = true, AFTER_DRAIN = false, ROWTAB = false, CONVTAB = false;
    const float* xin32; bf16_t* xb; float* part; int ldc; float sc;
    __device__ __forceinline__ void operator()(const f32x4 (&acc)[2][2][4][2], const Unit& u, int wr, int wc, int fr, int fq) const {
        asm volatile("" : "+v"(fr), "+v"(fq));
        const int row0 = u.pm * BM + wr * 64 + fr, col0 = u.pn * BM + wc * 32 + 8 * fq;
        float ssv[8];
        if (xin32) {
#pragma unroll
            for (int q = 0; q < 4; ++q) {
                const int ai = q >> 1, mh = q & 1;
                f32x4 xv[2][2][2];
#pragma unroll
                for (int m2 = 0; m2 < 2; ++m2)
#pragma unroll
                    for (int bj = 0; bj < 2; ++bj) { const float* p = xin32 + (size_t)(row0 + ai * HALF + (2 * mh + m2) * 16) * ldc + col0 + bj * HALF; xv[m2][bj][0] = *(const f32x4*)p; xv[m2][bj][1] = *(const f32x4*)(p + 4); }
                asm volatile("" : "+v"(xv[0][0][0]), "+v"(xv[0][0][1]), "+v"(xv[0][1][0]), "+v"(xv[0][1][1]), "+v"(xv[1][0][0]), "+v"(xv[1][0][1]), "+v"(xv[1][1][0]), "+v"(xv[1][1][1]));
#pragma unroll
                for (int m2 = 0; m2 < 2; ++m2) { const int m = 2 * mh + m2; const size_t off = (size_t)(row0 + ai * HALF + m * 16) * ldc + col0; float ss = 0.f;
#pragma unroll
                    for (int bj = 0; bj < 2; ++bj) { const f32x4 v0 = xv[m2][bj][0] + acc[ai][bj][m][0] * sc, v1 = xv[m2][bj][1] + acc[ai][bj][m][1] * sc;
                        *(u32x4*)(xb + off + bj * HALF) = pack8(v0, v1);
                        ss += (v0[0] * v0[0] + v0[1] * v0[1]) + (v0[2] * v0[2] + v0[3] * v0[3]) + (v1[0] * v1[0] + v1[1] * v1[1]) + (v1[2] * v1[2] + v1[3] * v1[3]); }
                    ss += __shfl_xor(ss, 16); ss += __shfl_xor(ss, 32); ssv[ai * 4 + m] = ss; } }
        } else {
#pragma unroll
            for (int q = 0; q < 4; ++q) {
                const int ai = q >> 1, mh = q & 1;
                u32x4 xo[2][2];
#pragma unroll
                for (int m2 = 0; m2 < 2; ++m2)
#pragma unroll
                    for (int bj = 0; bj < 2; ++bj) xo[m2][bj] = *(const u32x4*)(xb + (size_t)(row0 + ai * HALF + (2 * mh + m2) * 16) * ldc + col0 + bj * HALF);
                asm volatile("" : "+v"(xo[0][0]), "+v"(xo[0][1]), "+v"(xo[1][0]), "+v"(xo[1][1]));
#pragma unroll
                for (int m2 = 0; m2 < 2; ++m2) { const int m = 2 * mh + m2; const size_t off = (size_t)(row0 + ai * HALF + m * 16) * ldc + col0; float ss = 0.f;
#pragma unroll
                    for (int bj = 0; bj < 2; ++bj) { const u32x4 w = xo[m2][bj];
                        const f32x4 x0 = (f32x4){__uint_as_float(w.x << 16), __uint_as_float(w.x & 0xffff0000u), __uint_as_float(w.y << 16), __uint_as_float(w.y & 0xffff0000u)};
                        const f32x4 x1 = (f32x4){__uint_as_float(w.z << 16), __uint_as_float(w.z & 0xffff0000u), __uint_as_float(w.w << 16), __uint_as_float(w.w & 0xffff0000u)};
                        const f32x4 v0 = x0 + acc[ai][bj][m][0] * sc, v1 = x1 + acc[ai][bj][m][1] * sc;
                        *(u32x4*)(xb + off + bj * HALF) = pack8(v0, v1);
                        ss += (v0[0] * v0[0] + v0[1] * v0[1]) + (v0[2] * v0[2] + v0[3] * v0[3]) + (v1[0] * v1[0] + v1[1] * v1[1]) + (v1[2] * v1[2] + v1[3] * v1[3]); }
                    ss += __shfl_xor(ss, 16); ss += __shfl_xor(ss, 32); ssv[ai * 4 + m] = ss; } }
        }
        if (fq == 0) {
#pragma unroll
            for (int i = 0; i < 8; ++i) part[(size_t)(row0 + (i >> 2) * HALF + (i & 3) * 16) * 64 + u.pn * 4 + wc] = ssv[i]; }
    }
};

#ifndef PROBE_PHTIME
#define PROBE_PHTIME (-1)
#endif
#ifndef PROBE_SPREAD
#define PROBE_SPREAD (-1)
#endif
#ifndef PROBE_BWAIT
#define PROBE_BWAIT (-1)
#endif
#ifndef PROBE_BARS
#define PROBE_BARS 0
#endif
#ifndef PROBE_TIMER
#define PROBE_TIMER 0
#endif
#ifndef PROBE_PHASE
#define PROBE_PHASE 6
#endif
#define PROBE_NOW() ((PROBE_TIMER & 1) ? __builtin_amdgcn_s_memtime() : __builtin_amdgcn_s_memrealtime())
typedef int v8i_t __attribute__((ext_vector_type(8)));
typedef int v4i_t __attribute__((ext_vector_type(4)));
__device__ __forceinline__ v8i_t cat8(const bf16x8 lo, const bf16x8 hi) { const u32x4 a = __builtin_bit_cast(u32x4, lo), b = __builtin_bit_cast(u32x4, hi); return (v8i_t){(int)a.x, (int)a.y, (int)a.z, (int)a.w, (int)b.x, (int)b.y, (int)b.z, (int)b.w}; }
template <class Epi, class Sched, bool ALIGN_EPI = false, bool SP2 = false, int PROBE = 0, bool F8 = false, bool I8 = false>
__device__ __forceinline__ void gemm_phase(PG8_LAS unsigned char* lds, const Gemm g, const Sched& S, const Epi& E, int tid_) {
    asm volatile("" : "+v"(tid_));
    const int tid = tid_, wid = __builtin_amdgcn_readfirstlane(tid >> 6), lane = tid & 63, wr = wid >> 2, wc = wid & 3, fr = lane & 15, fq = lane >> 4;
    const int K = g.K, nt = K / BK;
    unsigned voffA[2], voffB[2];
#pragma unroll
    for (int i = 0; i < 2; ++i) { int R, C; stage_rc(tid * 16 + i * 8192, R, C); const int Rb = Epi::PERM ? ((R & ~31) + perm32(R & 31)) : R;
        voffA[i] = (unsigned)(R * K + C) * 2u; voffB[i] = (unsigned)(Rb * K + C) * 2u; }
    const size_t kstep = (size_t)(BK * 2);
    const size_t hstep = (size_t)HALF * K * 2;
    const size_t tstep = 2 * hstep;
    const unsigned ldsw = (unsigned)wid * 1024u;
    const int aoff = lds_byte(wr * 64 + fr, fq * 8), boff = lds_byte(wc * 32 + fr, fq * 8);
#define PG8_SA(b, h) (((b) * 2 + (h)) * HTB)
#define PG8_SB(b, h) ((4 + (b) * 2 + (h)) * HTB)
#define PG8_STAGE(bufoff, gbase, voff) do { _Pragma("unroll") for (int _i = 0; _i < 2; ++_i) { unsigned _v = (voff)[_i]; if constexpr (F8) asm volatile("" : "+v"(_v));     \
        __builtin_amdgcn_global_load_lds((const unsigned*)((const char*)(gbase) + _v), (PG8_LAS unsigned*)(lds + (bufoff) + ldsw + _i * 8192), 16, 0, 0); } } while (0)
#define PG8_LDA8(dst, b, h) do { _Pragma("unroll") for (int m = 0; m < 4; ++m) dst[m] = cat8(*(const PG8_LAS bf16x8*)(lds + PG8_SA(b, h) + aoff + m * 2048), *(const PG8_LAS bf16x8*)(lds + PG8_SA(b, h) + aoff + m * 2048 + 1024)); } while (0)
#define PG8_LDB8(dst, b, h) do { _Pragma("unroll") for (int n = 0; n < 2; ++n) dst[n] = cat8(*(const PG8_LAS bf16x8*)(lds + PG8_SB(b, h) + boff + n * 2048), *(const PG8_LAS bf16x8*)(lds + PG8_SB(b, h) + boff + n * 2048 + 1024)); } while (0)
#define PG8_LDA(dst, b, h) do { _Pragma("unroll") for (int m = 0; m < 4; ++m) _Pragma("unroll") for (int k = 0; k < 2; ++k) dst[m][k] = *(const PG8_LAS bf16x8*)(lds + PG8_SA(b, h) + aoff + m * 2048 + k * 1024); } while (0)
#define PG8_LDB(dst, b, h) do { _Pragma("unroll") for (int n = 0; n < 2; ++n) _Pragma("unroll") for (int k = 0; k < 2; ++k) dst[n][k] = *(const PG8_LAS bf16x8*)(lds + PG8_SB(b, h) + boff + n * 2048 + k * 1024); } while (0)
#define PG8_MMA(ai, bj, At, Bt) do { __builtin_amdgcn_s_setprio(1); if constexpr (F8) { _Pragma("unroll") for (int m = 0; m < 4; ++m) _Pragma("unroll") for (int n = 0; n < 2; ++n) \
        acc[ai][bj][m][n] = __builtin_amdgcn_mfma_scale_f32_16x16x128_f8f6f4(Bt##8[n], At##8[m], acc[ai][bj][m][n], 0, 0, 0, 0, 0, 0); } \
        else { _Pragma("unroll") for (int m = 0; m < 4; ++m) _Pragma("unroll") for (int n = 0; n < 2; ++n) _Pragma("unroll") for (int k = 0; k < 2; ++k) \
        { if constexpr (I8) acc[ai][bj][m][n] = __builtin_bit_cast(f32x4, __builtin_amdgcn_mfma_i32_16x16x64_i8(__builtin_bit_cast(v4i_t, Bt[n][k]), __builtin_bit_cast(v4i_t, At[m][k]), __builtin_bit_cast(v4i_t, acc[ai][bj][m][n]), 0, 0, 0)); \
          else acc[ai][bj][m][n] = __builtin_amdgcn_mfma_f32_16x16x32_bf16(Bt[n][k], At[m][k], acc[ai][bj][m][n], 0, 0, 0); } } __builtin_amdgcn_s_setprio(0); } while (0)
#define PG8_WAIT_V(n) asm volatile("s_waitcnt vmcnt(" #n ")" ::: "memory")
#define PG8_WAIT_L(n) asm volatile("s_waitcnt lgkmcnt(" #n ")" ::: "memory")
#define PG8_BAR __builtin_amdgcn_s_barrier()
#define PG8_SCHED __builtin_amdgcn_sched_barrier(0)
    if (PROBE && PROBE_TIMER == 6 && tid == 0 && blockIdx.x == 0) { volatile PG8_LAS unsigned* pm = (volatile PG8_LAS unsigned*)(lds + 139264 + 320 + 64); pm[2] = (unsigned)__builtin_amdgcn_s_memrealtime(); }
    Unit cur, nxt; int ui = 0;
    if (!S.next(0, cur)) return;
    f32x4 acc[2][2][4][2];
#pragma unroll
    for (int a = 0; a < 2; ++a)
#pragma unroll
        for (int b = 0; b < 2; ++b)
#pragma unroll
            for (int m = 0; m < 4; ++m)
#pragma unroll
                for (int n = 0; n < 2; ++n) acc[a][b][m][n] = (f32x4){0.f, 0.f, 0.f, 0.f};
    bf16x8 At[4][2], B0[2][2], B1[2][2];
    v8i_t At8[4], B08[2], B18[2];
    const char* cA = (const char*)g.A + (size_t)cur.pm * tstep; const char* cB = (const char*)g.Bt + (size_t)cur.pn * tstep;
    S.a_ready(cur);
    if constexpr (SP2) {
        PG8_STAGE(PG8_SB(0, 0), cB, voffB); PG8_STAGE(PG8_SB(0, 1), cB + hstep, voffB); PG8_STAGE(PG8_SA(0, 0), cA, voffA); PG8_STAGE(PG8_SA(0, 1), cA + hstep, voffA);
        if (wr == 1) PG8_BAR;
        PG8_WAIT_V(2); PG8_BAR;
        PG8_STAGE(PG8_SB(1, 0), cB + kstep, voffB); PG8_STAGE(PG8_SA(1, 0), cA + kstep, voffA); PG8_STAGE(PG8_SB(1, 1), cB + hstep + kstep, voffB);
        PG8_WAIT_V(6); PG8_BAR;
    } else {
        PG8_STAGE(PG8_SB(0, 0), cB, voffB); PG8_STAGE(PG8_SA(0, 0), cA, voffA); PG8_STAGE(PG8_SB(0, 1), cB + hstep, voffB); PG8_STAGE(PG8_SA(0, 1), cA + hstep, voffA);
        if (wr == 1) PG8_BAR;
        PG8_WAIT_V(4); PG8_BAR;
        PG8_STAGE(PG8_SB(1, 0), cB + kstep, voffB); PG8_STAGE(PG8_SA(1, 0), cA + kstep, voffA); PG8_STAGE(PG8_SB(1, 1), cB + hstep + kstep, voffB);
        PG8_WAIT_V(6); PG8_BAR;
    }
    for (;;) {
        S.tick(ui, tid == 0);
        const bool has_next = S.next(ui + 1, nxt);
        const char* nA = has_next ? (const char*)g.A + (size_t)nxt.pm * tstep : cA; const char* nB = has_next ? (const char*)g.Bt + (size_t)nxt.pn * tstep : cB;
        unsigned long long pk0 = 0, pk1 = 0; if (PROBE && PROBE_TIMER) pk0 = PROBE_NOW();
        for (int t = 0; t < nt; t += 2) {
            const bool last = (t == nt - 2);
            const char* a1 = cA + (size_t)(t + 1) * kstep;
            const char* a2 = last ? nA : cA + (size_t)(t + 2) * kstep; const char* b2 = last ? nB : cB + (size_t)(t + 2) * kstep;
            const char* a3 = a2 + kstep; const char* b3 = b2 + kstep;
            if (last && has_next) S.a_ready(nxt);
            if constexpr (Epi::CONVTAB) { if (last && wid == 1) { int lane; asm volatile("v_mbcnt_lo_u32_b32 %0, -1, 0\n\tv_mbcnt_hi_u32_b32 %0, -1, %0" : "=v"(lane));
                const int cho = (cur.pn + E.pn0) * HALF + (lane & 31) * 4;
                __builtin_amdgcn_global_load_lds((const unsigned*)(E.cw + (lane >> 5) * 11008 + cho), (PG8_LAS unsigned*)(lds + ROWTAB_OFF + 1024), 16, 0, 0);
                __builtin_amdgcn_global_load_lds((const unsigned*)((lane >> 5) ? E.cb + cho : E.cw + 2 * 11008 + cho), (PG8_LAS unsigned*)(lds + ROWTAB_OFF + 2048), 16, 0, 0); } }
            if constexpr (Epi::ROWTAB) { if (last && wid == 0) { int lane; asm volatile("v_mbcnt_lo_u32_b32 %0, -1, 0\n\tv_mbcnt_hi_u32_b32 %0, -1, %0" : "=v"(lane)); __builtin_amdgcn_global_load_lds((const unsigned*)(E.rstd + cur.pm * BM + lane * 4), (PG8_LAS unsigned*)(lds + ROWTAB_OFF), 16, 0, 0); } }
            if constexpr (SP2 && F8) {
            PG8_LDB8(B08, 0, 0); PG8_LDB8(B18, 0, 1); PG8_SCHED; PG8_LDA8(At8, 0, 0); PG8_STAGE(PG8_SA(1, 1), a1 + hstep, voffA);
            PG8_WAIT_V(8); PG8_WAIT_L(0); PG8_BAR; PG8_MMA(0, 0, At, B0); PG8_MMA(0, 1, At, B1); PG8_BAR; PG8_SCHED;
            PG8_LDA8(At8, 0, 1); PG8_STAGE(PG8_SB(0, 0), b2, voffB); PG8_STAGE(PG8_SB(0, 1), b2 + hstep, voffB); PG8_STAGE(PG8_SA(0, 0), a2, voffA);
            PG8_WAIT_V(8); PG8_WAIT_L(0); PG8_BAR; PG8_MMA(1, 0, At, B0); PG8_MMA(1, 1, At, B1); PG8_BAR; PG8_SCHED;
            PG8_LDB8(B08, 1, 0); PG8_LDB8(B18, 1, 1); PG8_SCHED; PG8_LDA8(At8, 1, 0); PG8_STAGE(PG8_SA(0, 1), a2 + hstep, voffA);
            PG8_WAIT_V(8); PG8_WAIT_L(0); PG8_BAR; PG8_MMA(0, 0, At, B0); PG8_MMA(0, 1, At, B1); PG8_BAR; PG8_SCHED;
            PG8_LDA8(At8, 1, 1); PG8_STAGE(PG8_SB(1, 0), b3, voffB); PG8_STAGE(PG8_SB(1, 1), b3 + hstep, voffB); PG8_STAGE(PG8_SA(1, 0), a3, voffA);
            PG8_WAIT_V(8); PG8_WAIT_L(0); PG8_BAR; PG8_MMA(1, 0, At, B0); PG8_MMA(1, 1, At, B1); PG8_BAR; PG8_SCHED;
            } else if constexpr (SP2) {
            PG8_LDB(B0, 0, 0); PG8_LDB(B1, 0, 1); PG8_SCHED; PG8_LDA(At, 0, 0); PG8_STAGE(PG8_SA(1, 1), a1 + hstep, voffA);
            PG8_WAIT_V(8); PG8_WAIT_L(0); PG8_BAR; PG8_MMA(0, 0, At, B0); PG8_MMA(0, 1, At, B1); PG8_BAR; PG8_SCHED;
            PG8_LDA(At, 0, 1); PG8_STAGE(PG8_SB(0, 0), b2, voffB); PG8_STAGE(PG8_SB(0, 1), b2 + hstep, voffB); PG8_STAGE(PG8_SA(0, 0), a2, voffA);
            PG8_WAIT_V(8); PG8_WAIT_L(0); PG8_BAR; PG8_MMA(1, 0, At, B0); PG8_MMA(1, 1, At, B1); PG8_BAR; PG8_SCHED;
            PG8_LDB(B0, 1, 0); PG8_LDB(B1, 1, 1); PG8_SCHED; PG8_LDA(At, 1, 0); PG8_STAGE(PG8_SA(0, 1), a2 + hstep, voffA);
            PG8_WAIT_V(8); PG8_WAIT_L(0); PG8_BAR; PG8_MMA(0, 0, At, B0); PG8_MMA(0, 1, At, B1); PG8_BAR; PG8_SCHED;
            PG8_LDA(At, 1, 1); PG8_STAGE(PG8_SB(1, 0), b3, voffB); PG8_STAGE(PG8_SB(1, 1), b3 + hstep, voffB); PG8_STAGE(PG8_SA(1, 0), a3, voffA);
            PG8_WAIT_V(8); PG8_WAIT_L(0); PG8_BAR; PG8_MMA(1, 0, At, B0); PG8_MMA(1, 1, At, B1); PG8_BAR; PG8_SCHED;
            } else {
            PG8_LDB(B0, 0, 0); PG8_SCHED; PG8_LDA(At, 0, 0); PG8_STAGE(PG8_SA(1, 1), a1 + hstep, voffA);
            PG8_WAIT_L(8); PG8_BAR; PG8_WAIT_L(0); PG8_MMA(0, 0, At, B0); PG8_BAR; PG8_SCHED;
            PG8_LDB(B1, 0, 1); PG8_STAGE(PG8_SB(0, 0), b2, voffB);
            PG8_BAR; PG8_WAIT_L(0); PG8_MMA(0, 1, At, B1); PG8_BAR;
            PG8_LDA(At, 0, 1); PG8_STAGE(PG8_SA(0, 0), a2, voffA);
            PG8_BAR; PG8_WAIT_L(0); PG8_MMA(1, 0, At, B0); PG8_BAR; PG8_SCHED;
            PG8_STAGE(PG8_SB(0, 1), b2 + hstep, voffB);
            PG8_WAIT_V(6); PG8_BAR; PG8_MMA(1, 1, At, B1); PG8_BAR;
            PG8_LDB(B0, 1, 0); PG8_SCHED; PG8_LDA(At, 1, 0); PG8_STAGE(PG8_SA(0, 1), a2 + hstep, voffA);
            PG8_WAIT_L(8); PG8_BAR; PG8_WAIT_L(0); PG8_MMA(0, 0, At, B0); PG8_BAR; PG8_SCHED;
            PG8_LDB(B1, 1, 1); PG8_STAGE(PG8_SB(1, 0), b3, voffB);
            PG8_BAR; PG8_WAIT_L(0); PG8_MMA(0, 1, At, B1); PG8_BAR;
            PG8_LDA(At, 1, 1); PG8_STAGE(PG8_SA(1, 0), a3, voffA);
            PG8_BAR; PG8_WAIT_L(0); PG8_MMA(1, 0, At, B0); PG8_BAR; PG8_SCHED;
            PG8_STAGE(PG8_SB(1, 1), b3 + hstep, voffB);
            PG8_WAIT_V(6); PG8_BAR; PG8_MMA(1, 1, At, B1); PG8_BAR;
            }
        }
        if (PROBE && PROBE_TIMER) pk1 = PROBE_NOW();
        if constexpr (ALIGN_EPI) { if (wr == 0) PG8_BAR; }
        if constexpr (I8) {
#pragma unroll
            for (int a = 0; a < 2; ++a)
#pragma unroll
                for (int b = 0; b < 2; ++b)
#pragma unroll
                    for (int m = 0; m < 4; ++m)
#pragma unroll
                        for (int n = 0; n < 2; ++n) acc[a][b][m][n] = __builtin_convertvector(__builtin_bit_cast(v4i_t, acc[a][b][m][n]), f32x4); }
        if constexpr (!Epi::AFTER_DRAIN) { int l2_; asm volatile("v_mbcnt_lo_u32_b32 %0, -1, 0\n\tv_mbcnt_hi_u32_b32 %0, -1, %0" : "=v"(l2_)); E(acc, cur, wr, wc, l2_ & 15, l2_ >> 4); S.done(cur); }
        if (PROBE && PROBE_TIMER && PROBE_TIMER != 6) { const unsigned long long pk2 = PROBE_NOW(); if (tid == 0 && blockIdx.x == 0) { volatile PG8_LAS unsigned* pm = (volatile PG8_LAS unsigned*)(lds + 139264 + 320 + 64);
            pm[0] += (unsigned)((PROBE_TIMER <= 2) ? (pk1 - pk0) : (pk2 - pk1)); pm[1] += 1u; } }
        if (!has_next) break;
#pragma unroll
        for (int a = 0; a < 2; ++a)
#pragma unroll
            for (int b = 0; b < 2; ++b)
#pragma unroll
                for (int m = 0; m < 4; ++m)
#pragma unroll
                    for (int n = 0; n < 2; ++n) acc[a][b][m][n] = (f32x4){0.f, 0.f, 0.f, 0.f};
        cur = nxt; cA = nA; cB = nB; ++ui;
        if constexpr (ALIGN_EPI) { if (wr == 1) PG8_BAR; }
    }
    if (PROBE && PROBE_TIMER == 6 && wid == 0 && blockIdx.x == 0) { int l0; asm volatile("v_mbcnt_lo_u32_b32 %0, -1, 0\n\tv_mbcnt_hi_u32_b32 %0, -1, %0" : "=v"(l0)); if (l0 == 0) { volatile PG8_LAS unsigned* pm = (volatile PG8_LAS unsigned*)(lds + 139264 + 320 + 64); pm[0] += (unsigned)__builtin_amdgcn_s_memrealtime() - pm[2]; pm[1] += (unsigned)(ui + 1); } }
    PG8_WAIT_V(0);
    if constexpr (!ALIGN_EPI) { if (wr == 0) PG8_BAR; }
    PG8_BAR;
#undef PG8_SA
#undef PG8_SB
#undef PG8_STAGE
#undef PG8_LDA
#undef PG8_LDB
#undef PG8_MMA
#undef PG8_WAIT_V
#undef PG8_WAIT_L
#undef PG8_BAR
#undef PG8_SCHED
}
}

#ifndef PG8_SP2
#define PG8_SP2 true
#endif
#ifndef PG8_ALIGN
#define PG8_ALIGN true
#endif

constexpr int NWAVES = 8;
constexpr int BATCH = 4, SEQ = 4096, D = 4096, M = BATCH * SEQ, DEPTH = 2;
constexpr int CW = 2048, RW = 2048, RH = 8, HD = 256, CHUNK = 128, NCH = SEQ / CHUNK;
constexpr int IN_COLS = 14336, N1 = 12288  , FF = 11008, NGU = 2 * FF;
constexpr int COL_AB = 0, COL_AC = 2048, COL_AX = 4096, COL_Q = 6144, COL_G = 8192, COL_K = 10240;
constexpr float EPS = 1e-6f;
#ifndef F8_K0
#define F8_K0 0
#endif
static_assert(F8_K0 % 256 == 0 && F8_K0 <= FF && (FF - F8_K0) % 128 == 0 && FF % 256 == 0, "fp8 / bf16 K split: whole pairs of K-tiles on both sides");
__device__ __forceinline__ int k8_of(int l) { return (l == DEPTH - 1) ? FF : F8_K0; }
#ifndef GU8_TILES_L0
#define GU8_TILES_L0 86
#endif
#ifndef GU8_TILES_L1
#define GU8_TILES_L1 86
#endif
static_assert(GU8_TILES_L0 >= 0 && GU8_TILES_L0 <= NGU / 256 && GU8_TILES_L1 >= 0 && GU8_TILES_L1 <= NGU / 256, "int8 column tiles");
__device__ __forceinline__ int gu8_of(int l) { return (l == DEPTH - 1) ? GU8_TILES_L1 : GU8_TILES_L0; }
#ifndef IN8_TILES_L1
#define IN8_TILES_L1 16
#endif
__device__ __forceinline__ int in8_of(int l) { return (l == DEPTH - 1) ? IN8_TILES_L1 : 0; }
static_assert(IN8_TILES_L1 >= 0 && IN8_TILES_L1 <= 32 && IN8_TILES_L1 % 4 == 0, "int8 in-projection tiles: whole rounds, inside the blocks whose source and destination columns coincide");
constexpr int WABS_WORD = 3000;

constexpr size_t MiB = 1u << 20;
constexpr size_t WS_CTL = 0, CTL_ZERO_BYTES = 1 * MiB;
constexpr size_t WS_RSTD1 = 1 * MiB;
constexpr size_t WS_RSTD2 = WS_RSTD1 + 256 * 1024;
constexpr size_t WS_LGAM = WS_RSTD2 + 256 * 1024;
constexpr size_t WS_WSQ = WS_LGAM + 64 * 1024;
constexpr size_t WS_RS8 = WS_LGAM + 128 * 1024;
constexpr size_t WS_PART = 2 * MiB;
constexpr size_t WS_COS = 6 * MiB, WS_SIN = 14 * MiB;
constexpr size_t WS_WIN = 38 * MiB;
constexpr size_t WS_WOUT = WS_WIN + 112 * MiB;
constexpr size_t WS_WGU = WS_WOUT + 32 * MiB;
constexpr size_t WS_WDN = WS_WGU + 172 * MiB;
constexpr size_t WS_XB = WS_WDN + 86 * MiB;
constexpr size_t WS_R = WS_XB + 128 * MiB;
constexpr size_t WS_PROJ = WS_R;
constexpr size_t WS_KFT = WS_PROJ + 384 * MiB, WS_KBT = WS_KFT + 64 * MiB, WS_VT = WS_KBT + 64 * MiB;
constexpr size_t WS_SFT = WS_VT + 64 * MiB, WS_SBT = WS_SFT + 128 * MiB;
constexpr size_t WS_YCAT = WS_SBT + 128 * MiB;
constexpr size_t WS_MIX_END = WS_YCAT + 128 * MiB;
constexpr size_t WS_GU = WS_R;
constexpr size_t WS_ACT = WS_GU + 688 * MiB;
constexpr size_t WS_HG = 22 * MiB;
constexpr size_t WS_HU = WS_ACT + 344 * MiB;
constexpr size_t WS_END = WS_HU + 6 * MiB;
static_assert(WS_MIX_END <= WS_END, "overlay");
static_assert((size_t)M * N1 * 2 == 384 * MiB && (size_t)M * NGU * 2 == 688 * MiB && (size_t)M * FF * 2 == 344 * MiB && (size_t)IN_COLS * D * 2 == 112 * MiB && (size_t)NGU * D * 2 == 172 * MiB && (size_t)D * FF * 2 == 86 * MiB, "sizes");
constexpr int CW_BAR = 4096;

constexpr int RING_OFF = 0, RING_BYTES = 136 * 1024;
constexpr int LDSCTL_OFF = RING_BYTES, MISC_OFF = LDSCTL_OFF + 320;
constexpr int LDS_BYTES = 147456;
static_assert(MISC_OFF + 128 <= LDS_BYTES && 8 * 16640 <= RING_BYTES, "LDS map");

#define GAS __attribute__((address_space(1)))
#define LAS __attribute__((address_space(3)))
typedef unsigned short bf16;
typedef unsigned v4u __attribute__((ext_vector_type(4)));
typedef unsigned v2u __attribute__((ext_vector_type(2)));
typedef float f32x4 __attribute__((ext_vector_type(4)));
typedef float f32x16 __attribute__((ext_vector_type(16)));
typedef short bf16x8 __attribute__((ext_vector_type(8)));
typedef GAS unsigned gu32;
#define RLX_AGENT __ATOMIC_RELAXED, __HIP_MEMORY_SCOPE_AGENT
#define LDS_WAIT() asm volatile("s_waitcnt lgkmcnt(0)" ::: "memory")
#define VM_WAIT() asm volatile("s_waitcnt vmcnt(0)" ::: "memory")
__device__ __forceinline__ unsigned pk2(float lo, float hi) { return pg8::cvt_pk_bf16(lo, hi); }
__device__ __forceinline__ float bflo(unsigned w) { return __uint_as_float(w << 16); }
__device__ __forceinline__ float bfhi(unsigned w) { return __uint_as_float(w & 0xffff0000u); }
__device__ __forceinline__ void unpack8(const v4u w, float (&f)[8]) { f[0] = bflo(w.x); f[1] = bfhi(w.x); f[2] = bflo(w.y); f[3] = bfhi(w.y); f[4] = bflo(w.z); f[5] = bfhi(w.z); f[6] = bflo(w.w); f[7] = bfhi(w.w); }

#define XB_TMO      128
#define XB_XCNT(j)  (256  + 64 * (j))
#define XB_XSUB(j)  (1280 + 64 * (j))
#define XB_XGEN(j)  (2304 + 64 * (j))
#define XB_TOP      3328
#define XB_TOPGEN   3392
#define XCD_BAR_WORDS 3456
#define XB_SPIN_CAP (1u << 18)

__device__ __forceinline__ unsigned xb_ld(unsigned* p)              { return __hip_atomic_load(p, __ATOMIC_RELAXED, __HIP_MEMORY_SCOPE_AGENT); }
__device__ __forceinline__ unsigned xb_add(unsigned* p, unsigned v) { return __hip_atomic_fetch_add(p, v, __ATOMIC_RELAXED, __HIP_MEMORY_SCOPE_AGENT); }
__device__ __forceinline__ unsigned xb_xcc_id() { return (unsigned)__builtin_amdgcn_s_getreg((3 << 11) | 20) & 0xFu; }
#define XB_SPIN(cond, bar) do { unsigned _sp = 0; while (cond) { __builtin_amdgcn_s_sleep(1); \
    if ((++_sp & 255u) == 0u) { if (xb_ld(&(bar)[XB_TMO])) break; if (_sp > XB_SPIN_CAP) { atomicAdd(&(bar)[XB_TMO], 1u); break; } } } } while (0)

struct XcdBarrier {
    unsigned* bar; unsigned x;
    volatile LAS unsigned* st;
};
__device__ __forceinline__ XcdBarrier xcd_barrier_post(unsigned* bar, volatile LAS unsigned* st, bool is_t0) {
    XcdBarrier b; b.bar = bar; b.x = xb_xcc_id(); b.st = st;
    if (is_t0) (void)xb_add(&bar[XB_XCNT(b.x)], 1u);
    return b;
}
__device__ __forceinline__ void xcd_barrier_complete(unsigned* bar, unsigned x, unsigned& nloc, unsigned& nx) {
    const unsigned G = gridDim.x * gridDim.y * gridDim.z;
    unsigned sum, cnt, mine, sp = 0u;
    for (;;) {
        sum = 0u; cnt = 0u; mine = 0u;
#pragma unroll
        for (unsigned j = 0; j < 16; ++j) { const unsigned c = xb_ld(&bar[XB_XCNT(j)]); sum += c; cnt += (c > 0u) ? 1u : 0u; mine = (j == x) ? c : mine; }
        if (sum == G) break;
        __builtin_amdgcn_s_sleep(1);
        if ((++sp & 255u) == 0u) { if (xb_ld(&bar[XB_TMO])) break; if (sp > XB_SPIN_CAP) { atomicAdd(&bar[XB_TMO], 1u); break; } }
    }
    nloc = mine > 0u ? mine : 1u; nx = cnt > 0u ? cnt : 1u;
}
__device__ __forceinline__ void xcd_barrier(const XcdBarrier& b, bool is_t0) {
    asm volatile("s_waitcnt vmcnt(0)" ::: "memory");
    __syncthreads();
    if (is_t0) {
        unsigned* bar = b.bar;
        __builtin_amdgcn_s_waitcnt(0);
        unsigned nloc = b.st[0], nx = b.st[1];
        if (nloc == 0u) { xcd_barrier_complete(bar, b.x, nloc, nx); b.st[0] = nloc; b.st[1] = nx; }
        const unsigned old = xb_add(&bar[XB_XSUB(b.x)], 1u);
        const unsigned gen = old / nloc;
        if (old + 1u == (gen + 1u) * nloc) {
            __builtin_amdgcn_fence(__ATOMIC_RELEASE, "agent");
            asm volatile("s_waitcnt vmcnt(0)" ::: "memory");
            const unsigned og = xb_add(&bar[XB_TOP], 1u);
            const unsigned tg = og / nx;
            if (og + 1u == (tg + 1u) * nx) xb_add(&bar[XB_TOPGEN], 1u);
            else XB_SPIN(xb_ld(&bar[XB_TOPGEN]) == tg, bar);
            __builtin_amdgcn_fence(__ATOMIC_ACQUIRE, "agent");
            xb_add(&bar[XB_XGEN(b.x)], 1u);
            asm volatile("s_waitcnt vmcnt(0)" ::: "memory");
        } else {
            XB_SPIN(xb_ld(&bar[XB_XGEN(b.x)]) == gen, bar);
            __builtin_amdgcn_fence(__ATOMIC_ACQUIRE, "agent");
            asm volatile("s_waitcnt vmcnt(0)" ::: "memory");
        }
    }
    __syncthreads();
}

struct Args { const void* in[17]; float* out; unsigned char* ws; int ph_lo, ph_hi; };
static_assert(sizeof(Args) == 17 * 8 + 8 + 8 + 8, "Args has no padding");
struct Frame {
    LAS unsigned char* lds;
    int tid, lane, wave;
    int vcu, G;
    const __attribute__((address_space(4))) Args* ap;
};
#define F_x ((const float*)(const GAS float*)F.ap->in[0])
#define F_pos ((const int*)(const GAS int*)F.ap->in[1])
#define F_norm1_g ((const float*)(const GAS float*)F.ap->in[2])
#define F_w_in ((const float*)(const GAS float*)F.ap->in[3])
#define F_conv_a_w ((const float*)(const GAS float*)F.ap->in[4])
#define F_conv_a_b ((const float*)(const GAS float*)F.ap->in[5])
#define F_beta_a ((const float*)(const GAS float*)F.ap->in[6])
#define F_dlogit ((const float*)(const GAS float*)F.ap->in[7])
#define F_gn_g ((const float*)(const GAS float*)F.ap->in[8])
#define F_w_out ((const float*)(const GAS float*)F.ap->in[9])
#define F_norm2_g ((const float*)(const GAS float*)F.ap->in[10])
#define F_w_gate ((const float*)(const GAS float*)F.ap->in[11])
#define F_w_up ((const float*)(const GAS float*)F.ap->in[12])
#define F_ffn_w ((const float*)(const GAS float*)F.ap->in[13])
#define F_ffn_b ((const float*)(const GAS float*)F.ap->in[14])
#define F_w_down ((const float*)(const GAS float*)F.ap->in[15])
#define F_norm_f ((const float*)(const GAS float*)F.ap->in[16])
#define F_out ((float*)(GAS float*)F.ap->out)
#define F_rstd1 ((float*)(GAS float*)(F.ap->ws + WS_RSTD1))
#define F_rstd2 ((float*)(GAS float*)(F.ap->ws + WS_RSTD2))
#define F_lgam ((float*)(GAS float*)(F.ap->ws + WS_LGAM))
#define F_part ((float*)(GAS float*)(F.ap->ws + WS_PART))
#define F_rs8 ((float*)(GAS float*)(F.ap->ws + WS_RS8))
#define F_rs8p ((float*)(GAS float*)(F.ap->ws + WS_RS8 + 64 * 1024))
#define F_xq8p ((unsigned char*)(GAS unsigned char*)(F.ap->ws + WS_YCAT))
#define F_wsq ((float*)(GAS float*)(F.ap->ws + WS_WSQ))
#define F_xq8 ((unsigned char*)(GAS unsigned char*)(F.ap->ws + WS_GU))
#define F_wabs ((unsigned*)(GAS unsigned*)(F.ap->ws) + WABS_WORD)
#define F_cosb ((float*)(GAS float*)(F.ap->ws + WS_COS))
#define F_sinb ((float*)(GAS float*)(F.ap->ws + WS_SIN))
#define F_WIN ((bf16*)(GAS bf16*)(F.ap->ws + WS_WIN))
#define F_WOUT ((bf16*)(GAS bf16*)(F.ap->ws + WS_WOUT))
#define F_WGU ((bf16*)(GAS bf16*)(F.ap->ws + WS_WGU))
#define F_WDN ((bf16*)(GAS bf16*)(F.ap->ws + WS_WDN))
#define F_XB ((bf16*)(GAS bf16*)(F.ap->ws + WS_XB))
#define F_PROJ ((bf16*)(GAS bf16*)(F.ap->ws + WS_PROJ))
#define F_KFT ((bf16*)(GAS bf16*)(F.ap->ws + WS_KFT))
#define F_KBT ((bf16*)(GAS bf16*)(F.ap->ws + WS_KBT))
#define F_VT ((bf16*)(GAS bf16*)(F.ap->ws + WS_VT))
#define F_SFT ((bf16*)(GAS bf16*)(F.ap->ws + WS_SFT))
#define F_SBT ((bf16*)(GAS bf16*)(F.ap->ws + WS_SBT))
#define F_YCAT ((bf16*)(GAS bf16*)(F.ap->ws + WS_YCAT))
#define F_GU ((bf16*)(GAS bf16*)(F.ap->ws + WS_GU))
#define F_HG ((float*)(GAS float*)(F.ap->ws + WS_HG))
#define F_HU ((float*)(GAS float*)(F.ap->ws + WS_HU))
#define F_ACT ((bf16*)(GAS bf16*)(F.ap->ws + WS_ACT))
__device__ __forceinline__ float wave_sum(float v) {
    int ln; asm volatile("v_mbcnt_lo_u32_b32 %0, -1, 0\n\tv_mbcnt_hi_u32_b32 %0, -1, %0" : "=v"(ln));
#pragma unroll
    for (int o = 1; o < 64; o <<= 1) v += __builtin_bit_cast(float, __builtin_amdgcn_ds_bpermute((ln ^ o) << 2, __builtin_bit_cast(int, v)));
    return v;
}

__device__ __forceinline__ void cvt_item(const float* __restrict__ W, int N, const float* __restrict__ gain, bf16* WT, int K, int k0, int n0s, int n0d, LAS float* scr, int lane, bool f8 = false, int kd = -1, float qs = 0.f) {
    if (kd < 0) kd = k0;
    const int r4 = lane >> 4, c4 = (lane & 15) * 4;
    f32x4 v[16];
#pragma unroll
    for (int i = 0; i < 16; ++i) v[i] = *(const f32x4*)(W + (size_t)(k0 + 4 * i + r4) * N + n0s + c4);
#pragma unroll
    for (int i = 0; i < 16; ++i) { const int kk = 4 * i + r4; const float g = gain ? gain[k0 + kk] : 1.0f; LAS float* s = scr + kk * 65 + c4;
        s[0] = v[i].x * g; s[1] = v[i].y * g; s[2] = v[i].z * g; s[3] = v[i].w * g;
        }
    LDS_WAIT(); asm volatile("" ::: "memory");
    const int c = lane & 7;
#pragma unroll
    for (int it = 0; it < 8; ++it) { const int n = (lane >> 3) + 8 * it; const LAS float* s = scr + (8 * c) * 65 + n;
        if (qs > 0.f) {
#define Q8(i) ((int)__builtin_rintf(__builtin_fminf(__builtin_fmaxf(s[(i) * 65] * qs, -127.0f), 127.0f)) & 255)
            v2u o8; o8.x = (unsigned)(Q8(0) | (Q8(1) << 8) | (Q8(2) << 16) | (Q8(3) << 24)); o8.y = (unsigned)(Q8(4) | (Q8(5) << 8) | (Q8(6) << 16) | (Q8(7) << 24));
#undef Q8
            *(v2u*)((unsigned char*)WT + (size_t)(n0d + n) * K + kd + 8 * c) = o8;
        } else if (f8) {
#define W8(i) __builtin_fminf(__builtin_fmaxf(s[(i) * 65] * pg8::F8_WSCALE, -440.0f), 440.0f)
            int t = __builtin_amdgcn_cvt_pk_fp8_f32(W8(0), W8(1), 0, false); t = __builtin_amdgcn_cvt_pk_fp8_f32(W8(2), W8(3), t, true);
            int q = __builtin_amdgcn_cvt_pk_fp8_f32(W8(4), W8(5), 0, false); q = __builtin_amdgcn_cvt_pk_fp8_f32(W8(6), W8(7), q, true);
#undef W8
            v2u o8; o8.x = (unsigned)t; o8.y = (unsigned)q; *(v2u*)((unsigned char*)WT + (size_t)(n0d + n) * K + kd + 8 * c) = o8;
        } else {
        v4u o; o.x = pk2(s[0 * 65], s[1 * 65]); o.y = pk2(s[2 * 65], s[3 * 65]); o.z = pk2(s[4 * 65], s[5 * 65]); o.w = pk2(s[6 * 65], s[7 * 65]);
        *(v4u*)(WT + (size_t)(n0d + n) * K + kd + 8 * c) = o; } }
    LDS_WAIT(); asm volatile("" ::: "memory");
}
__device__ __forceinline__ void cvt_matrix(Frame& F, const float* W, int K, int N, const float* gain, bf16* WT, int dst_row0, bool in_perm, int& it, int it_end_prev, LAS float* scr, int k8 = 0, int n8rows = 0, float qs = 0.f) {
    const int nnb = N / 64, nitems = (K / 64) * nnb, NGW = F.G * NWAVES;
    for (; it < it_end_prev + nitems; it += NGW) {
        const int r = it - it_end_prev, kb = r / nnb, nb = r % nnb; const int n0s = nb * 64; int n0d = dst_row0 + n0s;
        if (dst_row0 < 0) { n0d = (n0s >> 7) * 256 + (dst_row0 == -2 ? 128 : 0) + (n0s & 127); }
        if (in_perm) { const int blk = n0s >> 11, dblk = (blk < 4) ? blk : (blk == 4 ? 5 : (blk == 5 ? 6 : 4)); n0d = dblk * 2048 + (n0s & 2047); }
        const bool f8 = kb * 64 < k8;
        if (n0d < n8rows) cvt_item(W, N, gain, WT, K, kb * 64, n0s, n0d, scr, F.lane, false, -1, qs);
        else if (f8) cvt_item(W, N, gain, WT, k8, kb * 64, n0s, n0d, scr, F.lane, true);
        else cvt_item(W, N, gain, (bf16*)((unsigned char*)WT + (size_t)N * k8), K - k8, kb * 64, n0s, n0d, scr, F.lane, false, kb * 64 - k8);
    }
}

constexpr int WQ_KBLOCKS = 4;
__device__ __forceinline__ float wave_max(float v) {
    int ln; asm volatile("v_mbcnt_lo_u32_b32 %0, -1, 0\n\tv_mbcnt_hi_u32_b32 %0, -1, %0" : "=v"(ln));
#pragma unroll
    for (int o = 1; o < 64; o <<= 1) v = __builtin_fmaxf(v, __builtin_bit_cast(float, __builtin_amdgcn_ds_bpermute((ln ^ o) << 2, __builtin_bit_cast(int, v))));
    return v;
}
__device__ __forceinline__ void wabs_phase(Frame& F) {
    const int gw = F.vcu * NWAVES + F.wave, NGW = F.G * NWAVES, r4 = F.lane >> 4, c4 = (F.lane & 15) * 4;
    for (int l = 0; l < DEPTH; ++l)
        for (int mat = 0; mat < 3; ++mat) {
            const int nnb = (mat == 2) ? in8_of(l) * 4 : gu8_of(l) * 2; if (nnb == 0) continue;
            const int N = (mat == 2) ? IN_COLS : FF; const float* W = (mat == 2) ? F_w_in + (size_t)l * D * IN_COLS : (mat ? F_w_up : F_w_gate) + (size_t)l * D * FF; const float* gain = ((mat == 2) ? F_norm1_g : F_norm2_g) + l * D; float mx = 0.f, sq = 0.f;
            for (int it = gw; it < WQ_KBLOCKS * nnb; it += NGW) { const int kbi = it / nnb, nb = it - kbi * nnb, kb = kbi * ((D / 64) / WQ_KBLOCKS); f32x4 v[16];
#pragma unroll
                for (int i = 0; i < 16; ++i) v[i] = *(const f32x4*)(W + (size_t)(kb * 64 + 4 * i + r4) * N + nb * 64 + c4);
#pragma unroll
                for (int i = 0; i < 16; ++i) { const float g = gain[kb * 64 + 4 * i + r4]; const f32x4 p = v[i] * g; mx = __builtin_fmaxf(mx, __builtin_fmaxf(__builtin_fmaxf(__builtin_fabsf(p.x), __builtin_fabsf(p.y)), __builtin_fmaxf(__builtin_fabsf(p.z), __builtin_fabsf(p.w)))); sq += (p.x * p.x + p.y * p.y) + (p.z * p.z + p.w * p.w); } }
            mx = wave_max(mx); sq = wave_sum(sq); if (F.lane == 0) { __hip_atomic_fetch_max(F_wabs + 4 * l + mat, __float_as_uint(mx), RLX_AGENT); if (gw < 2048) F_wsq[(4 * l + mat) * 2048 + gw] = sq; } }
}
__device__ __forceinline__ float wq_range(Frame& F, int l, int mat) {
    const int NGW = F.G * NWAVES; float s = 0.f;
    for (int i = F.lane; i < NGW && i < 2048; i += 64) s += F_wsq[(4 * l + mat) * 2048 + i];
    s = wave_sum(s); const float cnt = (float)(WQ_KBLOCKS * 64) * (float)((mat == 2) ? in8_of(l) * 256 : gu8_of(l) * 128);
    return __builtin_fmaxf(__builtin_fminf(__uint_as_float(__hip_atomic_load(F_wabs + 4 * l + mat, RLX_AGENT)), 4.25f * sqrtf(s / cnt)), 1e-30f);
}
__device__ __forceinline__ void p5_i8_phase(Frame& F, float* rstd_out, unsigned char* q_out, float* tab_out, float tsc) {
    const int gw = F.vcu * NWAVES + F.wave, NGW = F.G * NWAVES;
    for (int row = gw; row < M; row += NGW) {
        const float s = wave_sum(F_part[(size_t)row * 64 + F.lane]); const float rstd = 1.0f / sqrtf(s * (1.0f / D) + EPS);
        const bf16* xr = F_XB + (size_t)row * D + 8 * F.lane; v4u w[8]; float mx = 0.f;
#pragma unroll
        for (int j = 0; j < 8; ++j) w[j] = *(const v4u*)(xr + 512 * j);
#pragma unroll
        for (int j = 0; j < 8; ++j) { float v[8]; unpack8(w[j], v);
#pragma unroll
            for (int e = 0; e < 8; ++e) mx = __builtin_fmaxf(mx, __builtin_fabsf(v[e])); }
        mx = wave_max(mx); const float qs = mx > 0.f ? 127.0f / mx : 0.f;
        unsigned char* qr = q_out + (size_t)row * D + 8 * F.lane;
#pragma unroll
        for (int j = 0; j < 8; ++j) { float v[8]; unpack8(w[j], v);
#define Q8(i) ((int)__builtin_rintf(v[i] * qs) & 255)
            v2u o; o.x = (unsigned)(Q8(0) | (Q8(1) << 8) | (Q8(2) << 16) | (Q8(3) << 24)); o.y = (unsigned)(Q8(4) | (Q8(5) << 8) | (Q8(6) << 16) | (Q8(7) << 24));
#undef Q8
            *(v2u*)(qr + 512 * j) = o; }
        if (F.lane == 0) { rstd_out[row] = rstd; tab_out[row] = rstd * mx * (1.0f / 127.0f) * tsc; } }
}
__device__ __forceinline__ void rstd_from_part(Frame& F, float* rstd) {
    const int gw = F.vcu * NWAVES + F.wave, NGW = F.G * NWAVES;
    for (int row = gw; row < M; row += NGW) { const float s = wave_sum(F_part[(size_t)row * 64 + F.lane]); if (F.lane == 0) rstd[row] = 1.0f / sqrtf(s * (1.0f / D) + EPS); }
}
__device__ __forceinline__ void p0_phase(Frame& F, int l) {
    LAS float* scr = (LAS float*)(F.lds + RING_OFF + F.wave * 16640);
    const int gw = F.vcu * NWAVES + F.wave, NGW = F.G * NWAVES;
    int it = gw, base = 0;
    cvt_matrix(F, F_w_in + (size_t)l * D * IN_COLS, D, IN_COLS, F_norm1_g + l * D, F_WIN, 0, true, it, base, scr, 0, in8_of(l) * 256, in8_of(l) > 0 ? 127.0f / wq_range(F, l, 2) : 0.f); base += (D / 64) * (IN_COLS / 64);
    cvt_matrix(F, F_w_out + (size_t)l * D * D, D, D, nullptr, F_WOUT, 0, false, it, base, scr); base += (D / 64) * (D / 64);
    cvt_matrix(F, F_w_gate + (size_t)l * D * FF, D, FF, F_norm2_g + l * D, F_WGU, -1, false, it, base, scr, 0, gu8_of(l) * 256, gu8_of(l) > 0 ? 127.0f / __builtin_fmaxf(wq_range(F, l, 0), 1e-30f) : 0.f); base += (D / 64) * (FF / 64);
    cvt_matrix(F, F_w_up + (size_t)l * D * FF, D, FF, F_norm2_g + l * D, F_WGU, -2, false, it, base, scr, 0, gu8_of(l) * 256, gu8_of(l) > 0 ? 127.0f / __builtin_fmaxf(wq_range(F, l, 1), 1e-30f) : 0.f); base += (D / 64) * (FF / 64);
    cvt_matrix(F, F_w_down + (size_t)l * FF * D, FF, D, nullptr, F_WDN, 0, false, it, base, scr, k8_of(l));
    if (l == 0) {
        for (int m = gw; m < M; m += NGW) { const float* xr = F_x + (size_t)m * D + 8 * F.lane; f32x4 v[16]; float ss = 0.f;
#pragma unroll
            for (int j = 0; j < 8; ++j) { v[2 * j] = *(const f32x4*)(xr + 512 * j); v[2 * j + 1] = *(const f32x4*)(xr + 512 * j + 4); }
#pragma unroll
            for (int j = 0; j < 16; ++j) ss += (v[j].x * v[j].x + v[j].y * v[j].y) + (v[j].z * v[j].z + v[j].w * v[j].w);
            ss = wave_sum(ss); if (F.lane == 0) F_rstd1[m] = 1.0f / sqrtf(ss * (1.0f / D) + EPS);
            bf16* o = F_XB + (size_t)m * D + 8 * F.lane;
#pragma unroll
            for (int j = 0; j < 8; ++j) *(v4u*)(o + 512 * j) = pg8::pack8(v[2 * j], v[2 * j + 1]); }
        { const int gt = gw * 64 + F.lane, NT = NGW * 64; const int j = gt & 127;
          const float inv = exp2f(-(float)j * (13.287712379549449f / 128.0f));
          for (int idx = gt; idx < M * 128; idx += NT) { const int m = idx >> 7; const float ang = (float)F_pos[m] * inv;
              const double a = (double)ang, k = rint(a * 0.15915494309189535), r = a - k * 6.283185307179586; const float rf = (float)r;
              const float c = cosf(rf), s = sinf(rf);
              F_cosb[idx] = c; F_sinb[idx] = s; } }
        if (blockIdx.x == 0 && F.tid < DEPTH * 2 * RH) { const float xl = F_dlogit[F.tid]; const float t = __expf(-xl);
            const float ser = t * (1.0f - t * (0.5f - t * (0.33333334f - t * (0.25f - t * 0.2f)))); F_lgam[F.tid] = -((t < 0.04f) ? ser : __logf(1.0f + t)); }
    } else if (in8_of(l) > 0) p5_i8_phase(F, F_rstd1, F_xq8p, F_rs8p, wq_range(F, l, 2) * (1.0f / 127.0f));
    else rstd_from_part(F, F_rstd1);
}

__device__ __forceinline__ void mixer_a(Frame& F, int l) {
    const int gw = F.vcu * NWAVES + F.wave, NGW = F.G * NWAVES;
    for (int item = gw; item < (M / 32) * 4; item += NGW) {
        const int t0 = (item >> 2) * 32, c0 = (item & 3) * 512 + F.lane * 8;
        float w0[8], w1[8], w2[8], bb[8], be[8];
        { const float* cw = F_conv_a_w + (size_t)l * 3 * CW + c0; const float* cb = F_conv_a_b + (size_t)l * CW + c0; const float* bt = F_beta_a + (size_t)l * CW + c0;
#pragma unroll
          for (int j = 0; j < 8; ++j) { w0[j] = cw[j]; w1[j] = cw[CW + j]; w2[j] = cw[2 * CW + j]; bb[j] = cb[j]; be[j] = bt[j]; } }
        const bf16* pbase = F_PROJ + c0;
        float pp[8], pc[8];
        if ((t0 & (SEQ - 1)) == 0) {
#pragma unroll
            for (int j = 0; j < 8; ++j) pp[j] = 0.f;
        } else { float a[8], b[8]; unpack8(*(const v4u*)(pbase + (size_t)(t0 - 1) * N1 + COL_AC), a); unpack8(*(const v4u*)(pbase + (size_t)(t0 - 1) * N1 + COL_AX), b);
#pragma unroll
            for (int j = 0; j < 8; ++j) pp[j] = a[j] * b[j]; }
        { float a[8], b[8]; unpack8(*(const v4u*)(pbase + (size_t)t0 * N1 + COL_AC), a); unpack8(*(const v4u*)(pbase + (size_t)t0 * N1 + COL_AX), b);
#pragma unroll
          for (int j = 0; j < 8; ++j) pc[j] = a[j] * b[j]; }
        for (int t = t0; t < t0 + 32; t += 4) {
            v4u ac[4], ax[4], ab[4];
#pragma unroll
            for (int k = 0; k < 4; ++k) { const int tn = t + k + 1; const bool z = (tn & (SEQ - 1)) == 0;
                ac[k] = z ? (v4u){0u, 0u, 0u, 0u} : *(const v4u*)(pbase + (size_t)tn * N1 + COL_AC); ax[k] = z ? (v4u){0u, 0u, 0u, 0u} : *(const v4u*)(pbase + (size_t)tn * N1 + COL_AX);
                ab[k] = *(const v4u*)(pbase + (size_t)(t + k) * N1 + COL_AB); }
#pragma unroll
            for (int k = 0; k < 4; ++k) {
                float pn[8], fa[8], fx[8], fb[8], y[8]; unpack8(ac[k], fa); unpack8(ax[k], fx); unpack8(ab[k], fb); float ss = 0.f;
#pragma unroll
                for (int j = 0; j < 8; ++j) { pn[j] = fa[j] * fx[j]; y[j] = fb[j] * (w0[j] * pp[j] + w1[j] * pc[j] + w2[j] * pn[j] + bb[j]); ss += y[j] * y[j]; }
                ss += __shfl_xor(ss, 1); ss += __shfl_xor(ss, 2); ss += __shfl_xor(ss, 4); ss += __shfl_xor(ss, 8);
                const float r = 1.0f / sqrtf(ss * (1.0f / 128.0f) + EPS);
                v4u o; o.x = pk2(y[0] * r * be[0], y[1] * r * be[1]); o.y = pk2(y[2] * r * be[2], y[3] * r * be[3]); o.z = pk2(y[4] * r * be[4], y[5] * r * be[5]); o.w = pk2(y[6] * r * be[6], y[7] * r * be[7]);
                *(v4u*)(F_YCAT + (size_t)(t + k) * D + c0) = o;
#pragma unroll
                for (int j = 0; j < 8; ++j) { pp[j] = pc[j]; pc[j] = pn[j]; } }
        }
    }
}

#define MFMA32(a, b, c) __builtin_amdgcn_mfma_f32_32x32x16_bf16((a), (b), (c), 0, 0, 0)
__device__ __forceinline__ void scan_dma(const char* kt, const char* vt, LAS unsigned char* dst, int w, int lane) {
#pragma unroll
    for (int q = 0; q < 4; ++q) { __builtin_amdgcn_global_load_lds((const unsigned*)(kt + q * 8192), (LAS unsigned*)(dst + q * 8192 + w * 1024), 16, 0, 0);
        __builtin_amdgcn_global_load_lds((const unsigned*)(vt + q * 8192), (LAS unsigned*)(dst + 32768 + q * 8192 + w * 1024), 16, 0, 0); }
}
__device__ __forceinline__ void scan_phase(Frame& F, int l) {
    LAS unsigned char* BUF = F.lds + RING_OFF;
    const int w = F.wave, dbl = w & 3, eql = w >> 2;
    for (int unit = F.vcu; unit < BATCH * RH * 2 * 2 * 2; unit += F.G) {
        const int eh2 = unit & 1, dq = (unit >> 1) & 1, dir = (unit >> 2) & 1, h = (unit >> 3) & 7, b = unit >> 6;
        const size_t blk0 = (size_t)(b * RH + h) * NCH * (HD * CHUNK);
        const char* KT = (const char*)((dir ? F_KBT : F_KFT) + blk0) + (size_t)((4 * dq * 8 + w) * 64 + F.lane) * 16;
        const char* VT = (const char*)(F_VT + blk0) + (size_t)((4 * eh2 * 8 + w) * 64 + F.lane) * 16;
        const int eq = 2 * eh2 + eql, dblk = 4 * dq + dbl;
        bf16* ST = (dir ? F_SBT : F_SFT) + (size_t)(b * RH + h) * NCH * (HD * HD) + (size_t)(((2 * eq) * 16 + 2 * dblk) * 64 + F.lane) * 8;
        const float g128 = __expf(128.0f * F_lgam[l * 16 + dir * 8 + h]);
        f32x16 s0, s1;
#pragma unroll
        for (int r = 0; r < 16; ++r) { s0[r] = 0.f; s1[r] = 0.f; }
        __syncthreads();
        { const int n0 = dir ? (NCH - 1) : 0; scan_dma(KT + (size_t)n0 * HD * CHUNK * 2, VT + (size_t)n0 * HD * CHUNK * 2, BUF, w, F.lane); }
        for (int step = 0; step < NCH; ++step) {
            const int n = dir ? (NCH - 1 - step) : step, nn = dir ? (n - 1) : (n + 1);
            VM_WAIT(); __syncthreads();
            if (step + 1 < NCH) scan_dma(KT + (size_t)nn * HD * CHUNK * 2, VT + (size_t)nn * HD * CHUNK * 2, BUF + ((step + 1) & 1) * 65536, w, F.lane);
            bf16* st = ST + (size_t)n * HD * HD;
#pragma unroll
            for (int sp = 0; sp < 2; ++sp) {
                v4u a; a.x = pk2(s0[8 * sp], s0[8 * sp + 1]); a.y = pk2(s0[8 * sp + 2], s0[8 * sp + 3]); a.z = pk2(s0[8 * sp + 4], s0[8 * sp + 5]); a.w = pk2(s0[8 * sp + 6], s0[8 * sp + 7]);
                *(v4u*)(st + sp * 512) = a;
                v4u c; c.x = pk2(s1[8 * sp], s1[8 * sp + 1]); c.y = pk2(s1[8 * sp + 2], s1[8 * sp + 3]); c.z = pk2(s1[8 * sp + 4], s1[8 * sp + 5]); c.w = pk2(s1[8 * sp + 6], s1[8 * sp + 7]);
                *(v4u*)(st + 16 * 512 + sp * 512) = c; }
#pragma unroll
            for (int r = 0; r < 16; ++r) { s0[r] *= g128; s1[r] *= g128; }
            const LAS unsigned char* kb = BUF + (step & 1) * 65536 + (dbl * 8 * 64 + F.lane) * 16; const LAS unsigned char* vb = BUF + (step & 1) * 65536 + 32768 + (2 * eql * 8 * 64 + F.lane) * 16;
#pragma unroll
            for (int ks = 0; ks < 8; ++ks) { const bf16x8 a = *(const LAS bf16x8*)(kb + ks * 1024), b0 = *(const LAS bf16x8*)(vb + ks * 1024), b1 = *(const LAS bf16x8*)(vb + 8192 + ks * 1024);
                s0 = MFMA32(a, b0, s0); s1 = MFMA32(a, b1, s1); }
        }
    }
    VM_WAIT(); __syncthreads();
}

__device__ __forceinline__ void dma16(const char* g, LAS unsigned char* l) { __builtin_amdgcn_global_load_lds((const unsigned*)g, (LAS unsigned*)l, 16, 0, 0); }
__device__ __forceinline__ void intra_dma(Frame& F, const int kind, const int p, LAS unsigned char* dst, int b, int h, int n, int w, int lane) {
    const int tok0 = b * SEQ + n * CHUNK;
    if (kind == 4) {
        const char* g0 = (const char*)F_VT + (((size_t)(b * RH + h) * NCH + n) * (HD * CHUNK)) * 2 + (size_t)(w * 64 + lane) * 16;
#pragma unroll
        for (int q = 0; q < 4; ++q) dma16(g0 + (size_t)(4 * (q >> 1) + 2 * p + (q & 1)) * 8192, dst + q * 8192 + w * 1024);
    } else if (kind == 2 || kind == 3) {
        const char* g0 = (const char*)(kind == 2 ? F_SFT : F_SBT) + ((size_t)(b * RH + h) * NCH + n) * HD * HD * 2 + (size_t)lane * 16;
#pragma unroll
        for (int q = 0; q < 4; ++q) { const int idx = q * 8 + w, ehl = idx >> 4, sx = idx & 15; dma16(g0 + (size_t)(((4 * ehl + p) * 16 + sx) * 1024), dst + q * 8192 + w * 1024); }
    } else {
        const int r0 = w * 2 + (lane >> 5), c = (lane & 31) ^ (r0 & 15);
        const char* g0 = (const char*)F_PROJ + ((size_t)(tok0 + (kind == 1 ? 64 * p : 0) + r0) * N1 + (kind == 0 ? COL_Q : COL_K) + h * HD) * 2 + c * 16;
#pragma unroll
        for (int q = 0; q < (kind == 0 ? 8 : 4); ++q) dma16(g0 + (size_t)q * 16 * N1 * 2, dst + q * 8192 + w * 1024);
    }
}
__device__ __forceinline__ void intra_phase(Frame& F, int l) {
    LAS unsigned char* QS = F.lds + RING_OFF; LAS unsigned char* BUF = QS + 65536; LAS float* red1 = (LAS float*)(QS + 131072); LAS float* red2 = red1 + 256;
    const int w = F.wave, ib = w & 3, eh = w >> 2, li = F.lane & 31, hh = F.lane >> 5, sw = li & 15, yx = hh ^ sw;
    const float L2E = 1.4426950408889634f;
    const int nun = BATCH * RH * NCH;
    if (F.vcu < nun) { const int u0 = F.vcu; intra_dma(F, 0, 0, QS, u0 >> 8, (u0 >> 5) & 7, u0 & 31, w, F.lane); intra_dma(F, 1, 0, BUF, u0 >> 8, (u0 >> 5) & 7, u0 & 31, w, F.lane); }
    for (int unit = F.vcu; unit < nun; unit += F.G) {
        const int n = unit & 31, h = (unit >> 5) & 7, b = unit >> 8;
        const int nxt = unit + F.G; const bool has_next = nxt < nun; const int n2 = nxt & 31, h2 = (nxt >> 5) & 7, b2 = nxt >> 8;
        int i = 32 * ib + li; asm volatile("" : "+v"(i));
        const int tok0 = b * SEQ + n * CHUNK, tok = tok0 + i;
        const float lf = F_lgam[l * 16 + h], lb = F_lgam[l * 16 + 8 + h];
        const float lf2 = lf * L2E, lb2 = lb * L2E;
        const LAS unsigned char* qrow = QS + (32 * ib + li) * 512;
#define QF(s) (*(const LAS bf16x8*)(qrow + (((2 * (s)) ^ yx) << 4)))
        bf16x8 pf[4][2];
        f32x16 acc[4];
#pragma unroll
        for (int et = 0; et < 4; ++et)
#pragma unroll
            for (int r = 0; r < 16; ++r) acc[et][r] = 0.f;
#pragma unroll
        for (int t = 0; t < 12; ++t) {
            VM_WAIT(); __syncthreads();
            LAS unsigned char* nb = BUF + ((t + 1) & 1) * 32768; const LAS unsigned char* cb = BUF + (t & 1) * 32768;
            int ln = F.lane; asm volatile("" : "+v"(ln));
            if (t < 11) { const int t1 = t + 1; intra_dma(F, t1 < 2 ? 1 : (t1 < 6 ? 2 : (t1 < 10 ? 3 : 4)), t1 < 2 ? t1 : (t1 < 6 ? t1 - 2 : (t1 < 10 ? t1 - 6 : t1 - 10)), nb, b, h, n, w, ln); }
            else if (has_next) intra_dma(F, 1, 0, nb, b2, h2, n2, w, ln);
            if (t == 10 && has_next) intra_dma(F, 0, 0, QS, b2, h2, n2, w, ln);
            if (t < 2) {
#pragma unroll
                for (int jtl = 0; jtl < 2; ++jtl) { const int jt = 2 * t + jtl; const LAS unsigned char* krow = cb + (32 * jtl + li) * 512;
                    f32x16 sc;
#pragma unroll
                    for (int r = 0; r < 16; ++r) sc[r] = 0.f;
#pragma unroll
                    for (int s = 0; s < 16; ++s) { const bf16x8 a = *(const LAS bf16x8*)(krow + (((2 * s) ^ yx) << 4)); sc = MFMA32(a, QF(s), sc); }
#pragma unroll
                    for (int s2 = 0; s2 < 2; ++s2) {
                        float pv[8];
#pragma unroll
                        for (int jj = 0; jj < 8; ++jj) { const int r = 8 * s2 + jj; const int j = 32 * jt + (r & 3) + 8 * (r >> 2) + 4 * hh; const int dd = i - j;
                            const float e = (dd >= 0) ? lf2 * (float)dd : lb2 * (float)(-dd); pv[jj] = sc[r] * exp2f(e); }
                        v4u pw; pw.x = pk2(pv[0], pv[1]); pw.y = pk2(pv[2], pv[3]); pw.z = pk2(pv[4], pv[5]); pw.w = pk2(pv[6], pv[7]);
                        pf[jt][s2] = __builtin_bit_cast(bf16x8, pw); } }
            } else if (t < 10) {
                const int et = (t - 2) & 3; const LAS unsigned char* srow = cb + (eh * 16 * 64 + F.lane) * 16;
#pragma unroll
                for (int s = 0; s < 16; ++s) { const bf16x8 a = *(const LAS bf16x8*)(srow + s * 1024); acc[et] = MFMA32(a, QF(s), acc[et]); }
                if (t == 5) { const float ratio = __expf(lf * (float)(i + 1) - lb * (float)(CHUNK - i));
#pragma unroll
                    for (int e2 = 0; e2 < 4; ++e2)
#pragma unroll
                        for (int r = 0; r < 16; ++r) acc[e2][r] *= ratio; }
                if (t == 9) { const float wb = __expf(lb * (float)(CHUNK - i));
#pragma unroll
                    for (int e2 = 0; e2 < 4; ++e2)
#pragma unroll
                        for (int r = 0; r < 16; ++r) acc[e2][r] *= wb; }
            } else {
                const int p = t - 10;
#pragma unroll
                for (int etl = 0; etl < 2; ++etl) { const int et = 2 * p + etl; const LAS unsigned char* vrow = cb + ((2 * eh + etl) * 8 * 64 + F.lane) * 16;
#pragma unroll
                    for (int jt = 0; jt < 4; ++jt)
#pragma unroll
                        for (int s2 = 0; s2 < 2; ++s2) { const bf16x8 a = *(const LAS bf16x8*)(vrow + (2 * jt + s2) * 1024); acc[et] = MFMA32(a, pf[jt][s2], acc[et]); } }
            }
        }
#undef QF
        float s = 0.f;
#pragma unroll
        for (int et = 0; et < 4; ++et)
#pragma unroll
            for (int r = 0; r < 16; ++r) s += acc[et][r];
        s += __shfl_xor(s, 32);
        if (hh == 0) red1[w * 32 + li] = s;
        LDS_WAIT(); __syncthreads();
        const float mean = (red1[ib * 32 + li] + red1[(ib + 4) * 32 + li]) * (1.0f / HD);
        float q = 0.f;
#pragma unroll
        for (int et = 0; et < 4; ++et)
#pragma unroll
            for (int r = 0; r < 16; ++r) { const float dlt = acc[et][r] - mean; q += dlt * dlt; }
        q += __shfl_xor(q, 32);
        if (hh == 0) red2[w * 32 + li] = q;
        LDS_WAIT(); __syncthreads();
        const float rstd = 1.0f / sqrtf((red2[ib * 32 + li] + red2[(ib + 4) * 32 + li]) * (1.0f / HD) + EPS);
        { const float* gn = F_gn_g + (size_t)l * RW + h * HD; const bf16* gp = F_PROJ + (size_t)tok * N1 + COL_G + h * HD; bf16* yp = F_YCAT + (size_t)tok * D + CW + h * HD;
          f32x4 gv[4][4]; v2u gw2[4][4];
#pragma unroll
          for (int et = 0; et < 4; ++et)
#pragma unroll
              for (int g = 0; g < 4; ++g) { const int e4 = 128 * eh + 32 * et + 8 * g + 4 * hh; gv[et][g] = *(const f32x4*)(gn + e4); gw2[et][g] = *(const v2u*)(gp + e4); }
          asm volatile("" : "+v"(gv[0][0]), "+v"(gv[0][1]), "+v"(gv[0][2]), "+v"(gv[0][3]), "+v"(gv[1][0]), "+v"(gv[1][1]), "+v"(gv[1][2]), "+v"(gv[1][3]),
                            "+v"(gv[2][0]), "+v"(gv[2][1]), "+v"(gv[2][2]), "+v"(gv[2][3]), "+v"(gv[3][0]), "+v"(gv[3][1]), "+v"(gv[3][2]), "+v"(gv[3][3]));
          asm volatile("" : "+v"(gw2[0][0]), "+v"(gw2[0][1]), "+v"(gw2[0][2]), "+v"(gw2[0][3]), "+v"(gw2[1][0]), "+v"(gw2[1][1]), "+v"(gw2[1][2]), "+v"(gw2[1][3]),
                            "+v"(gw2[2][0]), "+v"(gw2[2][1]), "+v"(gw2[2][2]), "+v"(gw2[2][3]), "+v"(gw2[3][0]), "+v"(gw2[3][1]), "+v"(gw2[3][2]), "+v"(gw2[3][3]));
#pragma unroll
          for (int et = 0; et < 4; ++et)
#pragma unroll
              for (int g = 0; g < 4; ++g) { const int e4 = 128 * eh + 32 * et + 8 * g + 4 * hh; const f32x4 gvv = gv[et][g]; const v2u gw = gw2[et][g];
                  const float gt[4] = {bflo(gw.x), bfhi(gw.x), bflo(gw.y), bfhi(gw.y)}; float y[4];
#pragma unroll
                  for (int j = 0; j < 4; ++j) { const float sg = gt[j] * __builtin_amdgcn_rcpf(1.0f + __expf(-gt[j])); y[j] = (acc[et][4 * g + j] - mean) * rstd * gvv[j] * sg; }
                  v2u o; o.x = pk2(y[0], y[1]); o.y = pk2(y[2], y[3]); *(v2u*)(yp + e4) = o; } }
    }
    VM_WAIT(); __syncthreads();
}

__device__ __forceinline__ void act_fix_phase(Frame& F, int l) {
    const int gt = (F.vcu * NWAVES + F.wave) * 64 + F.lane, NT = F.G * NWAVES * 64;
    for (int idx = gt; idx < (M / 256) * 2 * (FF / 8); idx += NT) {
        const int rs = idx / (FF / 8), c0 = (idx - rs * (FF / 8)) * 8, pm = rs >> 1, lastr = rs & 1, r = pm * 256 + (lastr ? 255 : 0);
        const float* hg = F_HG + (size_t)pm * 4 * FF + c0; const float* hu = F_HU + (size_t)(pm * 2 + lastr) * FF + c0;
        const bool zprev = !lastr && (r & (SEQ - 1)) == 0, znext = lastr && ((r + 1) & (SEQ - 1)) == 0;
        const float* gm = lastr ? hg + 2 * FF : hg - FF;
        const float* g0 = lastr ? hg + 3 * FF : hg;
        const float* gp = lastr ? hg + 4 * FF : hg + FF;
        const float* cw = F_ffn_w + (size_t)l * 3 * FF + c0; const float* cb = F_ffn_b + (size_t)l * FF + c0;
        float y[8];
#pragma unroll
        for (int j = 0; j < 8; ++j) { const float a = zprev ? 0.f : gm[j], c = znext ? 0.f : gp[j]; const float z = cw[j] * a + cw[FF + j] * g0[j] + cw[2 * FF + j] * c + cb[j]; y[j] = z / (1.0f + __expf(-z)) * hu[j]; }
        const int k8 = k8_of(l);
        if (c0 < k8) *(v2u*)((unsigned char*)F_ACT + (size_t)r * k8 + c0) = __builtin_bit_cast(v2u, pg8::pack8_fp8((f32x4){y[0], y[1], y[2], y[3]}, (f32x4){y[4], y[5], y[6], y[7]}));
        else { v4u o; o.x = pk2(y[0], y[1]); o.y = pk2(y[2], y[3]); o.z = pk2(y[4], y[5]); o.w = pk2(y[6], y[7]); *(v4u*)((unsigned char*)F_ACT + (size_t)M * k8 + ((size_t)r * (FF - k8) + (c0 - k8)) * 2) = o; }
    }
}

__device__ __forceinline__ void final_phase(Frame& F) {
    const int gw = F.vcu * NWAVES + F.wave, NGW = F.G * NWAVES;
    f32x4 gg[8][2];
    { const float* gr0 = F_norm_f + 8 * F.lane;
#pragma unroll
      for (int j = 0; j < 8; ++j) { gg[j][0] = *(const f32x4*)(gr0 + 512 * j); gg[j][1] = *(const f32x4*)(gr0 + 512 * j + 4); } }
    for (int m = gw; m < M; m += NGW) {
        const float s = wave_sum(F_part[(size_t)m * 64 + F.lane]); const float rs = 1.0f / sqrtf(s * (1.0f / D) + EPS);
        const bf16* xr = F_XB + (size_t)m * D + 8 * F.lane; float* orow = F_out + (size_t)m * D + 8 * F.lane;
        v4u xv[8];
#pragma unroll
        for (int j = 0; j < 8; ++j) xv[j] = *(const v4u*)(xr + 512 * j);
        asm volatile("" : "+v"(xv[0]), "+v"(xv[1]), "+v"(xv[2]), "+v"(xv[3]), "+v"(xv[4]), "+v"(xv[5]), "+v"(xv[6]), "+v"(xv[7]));
#pragma unroll
        for (int j = 0; j < 8; ++j) { float v[8]; unpack8(xv[j], v); const f32x4 g0 = gg[j][0], g1 = gg[j][1];
            *(f32x4*)(orow + 512 * j) = (f32x4){v[0] * rs * g0[0], v[1] * rs * g0[1], v[2] * rs * g0[2], v[3] * rs * g0[3]};
            *(f32x4*)(orow + 512 * j + 4) = (f32x4){v[4] * rs * g1[0], v[5] * rs * g1[1], v[6] * rs * g1[2], v[7] * rs * g1[3]}; }
    }
}

constexpr int PH_PER_LAYER = 9, N_PHASES = DEPTH * PH_PER_LAYER + 1;

__global__ void __launch_bounds__(NWAVES * 64, 2) enc_fwd(Args args) {
    extern __shared__ __attribute__((aligned(16))) unsigned char lds[];
    Frame F;
    F.lds = (LAS unsigned char*)lds;
    volatile LAS unsigned* MISC = (volatile LAS unsigned*)(F.lds + MISC_OFF);
    { int wv = __builtin_amdgcn_readfirstlane((int)threadIdx.x >> 6); asm volatile("" : "+s"(wv)); F.wave = wv; }
    { int ln_; asm volatile("v_mbcnt_lo_u32_b32 %0, -1, 0\n\tv_mbcnt_hi_u32_b32 %0, -1, %0" : "=v"(ln_)); F.lane = ln_; F.tid = F.wave * 64 + ln_; }
    F.G = gridDim.x; { const int bx = blockIdx.x; F.vcu = (F.G % 8 == 0) ? (bx % 8) * (F.G / 8) + bx / 8 : bx; }
    F.ap = (const __attribute__((address_space(4))) Args*)__builtin_amdgcn_kernarg_segment_ptr();
    unsigned char* ws = args.ws;
    for (int u = F.tid; u < (LDS_BYTES - LDSCTL_OFF) / 4; u += NWAVES * 64) ((LAS unsigned*)(F.lds + LDSCTL_OFF))[u] = 0u;
    __syncthreads();
    XcdBarrier bar; bar.bar = (unsigned*)(ws + WS_CTL) + CW_BAR; bar.x = 0; bar.st = nullptr;
#define LAUNDER() do { int ln_; asm volatile("v_mbcnt_lo_u32_b32 %0, -1, 0\n\tv_mbcnt_hi_u32_b32 %0, -1, %0" : "=v"(ln_)); asm volatile("" : "+s"(F.ap)); F.lane = ln_; F.tid = F.wave * 64 + ln_; } while (0)
#if !MK_SPLIT
    bar = xcd_barrier_post((unsigned*)(ws + WS_CTL) + CW_BAR, MISC + 8, F.tid == 0);
#define GRID_BAR() do { asm volatile("" : "+s"(bar.bar));     LAUNDER(); xcd_barrier(bar, F.tid == 0); } while (0)
#else
#define GRID_BAR() do {} while (0)
#endif
    const int lo = args.ph_lo, hi = args.ph_hi;
#define IN(k) (lo <= (k) && (k) < hi)
#define SEAM(k) do { if (IN(k) && IN((k) + 1)) GRID_BAR(); } while (0)
    using namespace pg8;
    if (IN(0) && (GU8_TILES_L0 > 0 || GU8_TILES_L1 > 0 || IN8_TILES_L1 > 0)) { LAUNDER(); wabs_phase(F); GRID_BAR(); }
    for (int l = 0; l < DEPTH; ++l) {
        const int pb = l * PH_PER_LAYER;
#define PT0(k) unsigned long long pt_##k = 0; if (PROBE_PHTIME == (k)) pt_##k = __builtin_amdgcn_s_memrealtime()
#define PT1(k) if (PROBE_PHTIME == (k) && blockIdx.x == 0 && F.tid == 0) MISC[18] += (unsigned)(__builtin_amdgcn_s_memrealtime() - pt_##k)
#define SP0(k) if (PROBE_SPREAD == (k) && F.tid == 0) { const unsigned t = (unsigned)__builtin_amdgcn_s_memrealtime(); gu32* cw = (gu32*)(F.ap->ws) + 2048 + l * 128; __hip_atomic_fetch_max(cw, t, RLX_AGENT); __hip_atomic_fetch_max(cw + 64, 0xFFFFFFFFu - t, RLX_AGENT); }
#define SP1(k) if (PROBE_SPREAD == (k) && blockIdx.x == 0 && F.tid == 0) { gu32* cw = (gu32*)(F.ap->ws) + 2048 + l * 128; const unsigned mx = __hip_atomic_load(cw, RLX_AGENT), mn = 0xFFFFFFFFu - __hip_atomic_load(cw + 64, RLX_AGENT); MISC[19] += mx - mn; }
#define BW0(k) unsigned long long bw_##k = 0; if (PROBE_BWAIT == (k)) bw_##k = __builtin_amdgcn_s_memrealtime()
#define BW1(k) if (PROBE_BWAIT == (k) && blockIdx.x == 0 && F.tid == 0) MISC[20] += (unsigned)(__builtin_amdgcn_s_memrealtime() - bw_##k)
        PT0(0); if (PHON(0) && IN(pb + 0)) { for (int rp = 0; rp < PHREP(0); ++rp) { LAUNDER(); p0_phase(F, l); } } SP0(0); BW0(0); SEAM(pb + 0); BW1(0); PT1(0); SP1(0);
        PT0(1); if (PHON(1) && IN(pb + 1)) for (int rp = 0; rp < PHREP(1); ++rp) { LAUNDER();
            const int ni = in8_of(l);
            if (ni > 0) { Gemm g{(const bf16*)F_xq8p, F_WIN, M, ni * 256, D / 2}; StaticOrder S; S.init(M, ni * 256, F.G, (int)blockIdx.x);
              EpiIn E{F_PROJ, N1, F_rs8p, (PG8_LAS const float*)(F.lds + RING_OFF + ROWTAB_OFF), F_cosb, F_sinb, F_KFT, F_KBT, F_VT, F_lgam + l * 16, 0};
              gemm_phase<EpiIn, StaticOrder, PG8_ALIGN, PG8_SP2, 0, false, true>(F.lds + RING_OFF, g, S, E, F.tid); LAUNDER(); }
            { Gemm g{F_XB, F_WIN + (size_t)ni * 256 * D, M, IN_COLS - ni * 256, D}; StaticOrder S; S.init(M, IN_COLS - ni * 256, F.G, (int)blockIdx.x); EpiIn E{F_PROJ, N1, F_rstd1, (PG8_LAS const float*)(F.lds + RING_OFF + ROWTAB_OFF), F_cosb, F_sinb, F_KFT, F_KBT, F_VT, F_lgam + l * 16, ni};
              gemm_phase<EpiIn, StaticOrder, PG8_ALIGN, PG8_SP2, PROBE_PHASE == 1>(F.lds + RING_OFF, g, S, E, F.tid); }
        } SP0(1); BW0(1); SEAM(pb + 1); BW1(1); PT1(1); SP1(1);
        PT0(2); if (PHON(2) && IN(pb + 2)) { for (int rp = 0; rp < PHREP(2); ++rp) { LAUNDER(); for (int r2 = 0; r2 < PHREP(10); ++r2) mixer_a(F, l); for (int r2 = 0; r2 < PHREP(11); ++r2) scan_phase(F, l); } } SP0(2); BW0(2); SEAM(pb + 2); BW1(2); PT1(2); SP1(2);
        PT0(3); if (PHON(3) && IN(pb + 3)) { for (int rp = 0; rp < PHREP(3); ++rp) { LAUNDER(); intra_phase(F, l); } } SP0(3); BW0(3); SEAM(pb + 3); BW1(3); PT1(3); SP1(3);
        PT0(4); if (PHON(4) && IN(pb + 4)) for (int rp = 0; rp < PHREP(4); ++rp) { LAUNDER(); Gemm g{F_YCAT, F_WOUT, M, D, D}; StaticOrder S; S.init(M, D, F.G, (int)blockIdx.x); EpiRes E{l == 0 ? F_x : nullptr, F_XB, F_part, D, 1.0f};
            gemm_phase<EpiRes, StaticOrder, PG8_ALIGN, PG8_SP2, PROBE_PHASE == 4>(F.lds + RING_OFF, g, S, E, F.tid); } SP0(4); BW0(4); SEAM(pb + 4); BW1(4); PT1(4); SP1(4);
        PT0(5); if (PHON(5) && IN(pb + 5)) { for (int rp = 0; rp < PHREP(5); ++rp) { LAUNDER(); if (gu8_of(l) > 0) p5_i8_phase(F, F_rstd2, F_xq8, F_rs8, 1.0f); else rstd_from_part(F, F_rstd2); } } SP0(5); BW0(5); SEAM(pb + 5); BW1(5); PT1(5); SP1(5);
        PT0(6); if (PHON(6) && IN(pb + 6)) for (int rp = 0; rp < PHREP(6); ++rp) { const int n8 = gu8_of(l);
            if (n8 > 0) { LAUNDER(); Gemm g{(const bf16*)F_xq8, F_WGU, M, n8 * 256, D / 2}; TailOrder S; S.init(M, n8 * 256, F.G, (int)blockIdx.x); S.init2((unsigned*)(F.ap->ws) + 1024 + 64 * l + 32, (volatile PG8_LAS int*)(MISC + 24)); if (F.tid == 0) MISC[24] = 0xffffffffu;
                const float sg = __builtin_fmaxf(wq_range(F, l, 0), 1e-30f) * (1.0f / 127.0f), su = __builtin_fmaxf(wq_range(F, l, 1), 1e-30f) * (1.0f / 127.0f);
                EpiAct E{F_ACT, FF, F_rs8, (PG8_LAS float*)(F.lds + RING_OFF + ROWTAB_OFF), sg, su, 0, k8_of(l), (size_t)M * k8_of(l), F_ffn_w + (size_t)l * 3 * FF, F_ffn_b + (size_t)l * FF, F_HG, F_HU};
                gemm_phase<EpiAct, TailOrder, PG8_ALIGN, PG8_SP2, 0, false, true>(F.lds + RING_OFF, g, S, E, F.tid); }
            if (n8 < NGU / 256) { LAUNDER(); Gemm g{F_XB, F_WGU + (size_t)n8 * 256 * D, M, NGU - n8 * 256, D}; TailOrder S; S.init(M, NGU - n8 * 256, F.G, (int)blockIdx.x); S.init2((unsigned*)(F.ap->ws) + 1024 + 64 * l, (volatile PG8_LAS int*)(MISC + 24)); if (F.tid == 0) MISC[24] = 0xffffffffu;
              EpiAct E{F_ACT, FF, F_rstd2, (PG8_LAS float*)(F.lds + RING_OFF + ROWTAB_OFF), 1.0f, 1.0f, n8, k8_of(l), (size_t)M * k8_of(l), F_ffn_w + (size_t)l * 3 * FF, F_ffn_b + (size_t)l * FF, F_HG, F_HU};
              gemm_phase<EpiAct, TailOrder, PG8_ALIGN, PG8_SP2, PROBE_PHASE == 6>(F.lds + RING_OFF, g, S, E, F.tid); } } SP0(6); BW0(6); SEAM(pb + 6); BW1(6); PT1(6); SP1(6);
#if PROBE_GEMM
        if (IN(pb + 6)) { GRID_BAR(); LAUNDER(); Gemm g{F_XB, F_WGU, M, FF, D}; ProbeOrder S; S.init(M, FF, F.G, (int)blockIdx.x); EpiScale E{F_ACT, FF, F_rstd2, (PG8_LAS const float*)(F.lds + RING_OFF + ROWTAB_OFF)};
            gemm_phase<EpiScale, ProbeOrder, PG8_ALIGN, PG8_SP2>(F.lds + RING_OFF, g, S, E, F.tid); GRID_BAR(); }
#endif
        PT0(7); if (PHON(7) && IN(pb + 7)) { for (int rp = 0; rp < PHREP(7); ++rp) { LAUNDER(); act_fix_phase(F, l); } } SP0(7); BW0(7); SEAM(pb + 7); BW1(7); PT1(7); SP1(7);
        PT0(8); if (PHON(8) && IN(pb + 8)) { LAUNDER(); StaticOrder S; S.init(M, D, F.G, (int)blockIdx.x);
            const int k8 = k8_of(l);
            if (k8 > 0) { Gemm g{F_ACT, F_WDN, M, D, k8 / 2}; EpiRes E{nullptr, F_XB, F_part, D, 1.0f / (F8_ASCALE * F8_WSCALE)};
                gemm_phase<EpiRes, StaticOrder, PG8_ALIGN, PG8_SP2, 0, true>(F.lds + RING_OFF, g, S, E, F.tid); }
            if (k8 < FF) { LAUNDER(); Gemm g{(const bf16*)((const unsigned char*)F_ACT + (size_t)M * k8), (const bf16*)((const unsigned char*)F_WDN + (size_t)D * k8), M, D, FF - k8}; EpiRes E{nullptr, F_XB, F_part, D, 1.0f};
                gemm_phase<EpiRes, StaticOrder, PG8_ALIGN, PG8_SP2, PROBE_PHASE == 8>(F.lds + RING_OFF, g, S, E, F.tid); } } SP0(8); BW0(8); SEAM(pb + 8); BW1(8); PT1(8); SP1(8);
    }
    PT0(9); if (PHON(9) && IN(N_PHASES - 1)) { LAUNDER(); final_phase(F); }
#if PROBE_PHTIME == 9
    GRID_BAR(); PT1(9);
#endif
#if PROBE_BARS
    for (int i = 0; i < PROBE_BARS; ++i) GRID_BAR();
#endif
#if PROBE_SPREAD >= 0
    if (blockIdx.x == 0 && F.tid == 0) { const unsigned long long ticks = 4ull * MISC[19]; const unsigned long long t0 = __builtin_amdgcn_s_memrealtime(); while (__builtin_amdgcn_s_memrealtime() - t0 < ticks) __builtin_amdgcn_s_sleep(8); }
#endif
#if PROBE_BWAIT >= 0
    if (blockIdx.x == 0 && F.tid == 0) { const unsigned long long ticks = 2ull * MISC[20]; const unsigned long long t0 = __builtin_amdgcn_s_memrealtime(); while (__builtin_amdgcn_s_memrealtime() - t0 < ticks) __builtin_amdgcn_s_sleep(8); }
#endif
#if PROBE_PHTIME >= 0
    if (blockIdx.x == 0 && F.tid == 0) { const unsigned long long ticks = MISC[18]; const unsigned long long t0 = __builtin_amdgcn_s_memrealtime(); while (__builtin_amdgcn_s_memrealtime() - t0 < ticks) __builtin_amdgcn_s_sleep(8); }
#endif
#if PROBE_TIMER
    if (blockIdx.x == 0 && F.tid == 0) { const unsigned v = MISC[16] / (MISC[17] ? MISC[17] : 1u);
        const unsigned long long ticks = (PROBE_TIMER & 1) ? (unsigned long long)v / 2ull : (unsigned long long)v * 10ull;
        const unsigned long long t0 = __builtin_amdgcn_s_memrealtime(); while (__builtin_amdgcn_s_memrealtime() - t0 < ticks) __builtin_amdgcn_s_sleep(8); }
#endif
#undef IN
#undef SEAM
}

extern "C" void kernel_launch(void* const* d_in, const int* in_sizes, int n_in, void* d_out, int out_size, void* d_ws, size_t ws_size, hipStream_t stream) {
    static int grid = 0;
    if (grid == 0) {
        if (n_in != 17 || in_sizes[0] != M * D || out_size != M * D || ws_size < WS_END) { fprintf(stderr, "kernel_launch: unexpected shapes (n_in %d, in0 %d, out %d, ws %zu < %zu?)\n", n_in, n_in > 0 ? in_sizes[0] : -1, out_size, ws_size, (size_t)WS_END); grid = -1; return; }
        int dev = 0, cus = 0, per_cu = 0;
        if (hipGetDevice(&dev) != hipSuccess || hipDeviceGetAttribute(&cus, hipDeviceAttributeMultiprocessorCount, dev) != hipSuccess) { grid = -1; return; }
        if (hipFuncSetAttribute((const void*)enc_fwd, hipFuncAttributeMaxDynamicSharedMemorySize, LDS_BYTES) != hipSuccess) { fprintf(stderr, "kernel_launch: hipFuncSetAttribute failed\n"); grid = -1; return; }
        if (hipOccupancyMaxActiveBlocksPerMultiprocessor(&per_cu, (const void*)enc_fwd, NWAVES * 64, LDS_BYTES) != hipSuccess || per_cu < 1) fprintf(stderr, "kernel_launch: occupancy query reports %d\n", per_cu);
        (void)hipGetLastError();
        grid = cus;
    }
    if (grid < 0) return;
    if (hipMemsetAsync((char*)d_ws + WS_CTL, 0, CTL_ZERO_BYTES, stream) != hipSuccess) { fprintf(stderr, "kernel_launch: memset failed\n"); return; }
    Args a{};
    for (int i = 0; i < 17; ++i) a.in[i] = d_in[i];
    a.out = (float*)d_out; a.ws = (unsigned char*)d_ws;
#if MK_SPLIT
    for (int p = 0; p < N_PHASES; ++p) { a.ph_lo = p; a.ph_hi = p + 1; hipLaunchKernelGGL(enc_fwd, dim3(grid), dim3(NWAVES * 64), LDS_BYTES, stream, a); }
#else
    a.ph_lo = 0; a.ph_hi = N_PHASES;
    hipLaunchKernelGGL(enc_fwd, dim3(grid), dim3(NWAVES * 64), LDS_BYTES, stream, a);
#endif
    const hipError_t le = hipPeekAtLastError();
    if (le != hipSuccess) fprintf(stderr, "kernel_launch: launch failed: %s\n", hipGetErrorName(le));
}
```

```cpp
#include <hip/hip_runtime.h>
#include <cstdio>
#include <cstdint>

#ifndef PH_MASK
#define PH_MASK 0x3ff
#endif
#define PHON(k) ((PH_MASK >> (k)) & 1)
#ifndef PH_REPEAT
#define PH_REPEAT 0
#endif
#define PHREP(k) (((PH_REPEAT >> (k)) & 1) ? 2 : 1)
#ifndef MK_SPLIT
#define MK_SPLIT 0
#endif

namespace pg8 {
#define PG8_LAS __attribute__((address_space(3)))
typedef unsigned short bf16_t;
typedef short bf16x8 __attribute__((ext_vector_type(8)));
typedef float f32x4 __attribute__((ext_vector_type(4)));
typedef unsigned u32x4 __attribute__((ext_vector_type(4)));
constexpr int ROWTAB_OFF = 131072;
constexpr int BM = 256, BK = 64, HALF = 128, HTB = HALF * BK * 2  , STAGE_BYTES = 8 * HTB, NXCD = 8, WGM = 8;

__host__ __device__ __forceinline__ int lds_byte(int r, int c) { const int st = (r >> 4) * 2 + (c >> 5), rr = r & 15, cc = c & 31, ob = rr * 64 + cc * 2; return st * 1024 + (ob ^ (((ob >> 9) & 1) << 5)); }
__host__ __device__ __forceinline__ void stage_rc(int b, int& R, int& C) { const int st = b / 1024, sb = b % 1024, swz = sb ^ (((sb >> 9) & 1) << 5); R = (st >> 1) * 16 + swz / 64; C = (st & 1) * 32 + (swz % 64) / 2; }
__host__ __device__ __forceinline__ int perm32(int rho) { const int n = rho >> 4, i = rho & 15; return 8 * (i >> 2) + 4 * n + (i & 3); }

struct Unit { int pm, pn; };
struct Gemm { const bf16_t* A; const bf16_t* Bt; int M, N, K; };

struct StaticOrder {
    int nM, nN, nwg, G, c;
    __host__ __device__ void init(int M, int N, int G_, int c_) { nM = M / BM; nN = N / BM; nwg = nM * nN; G = G_; c = c_; }
    __host__ __device__ bool next(int i, Unit& u) const {
        const long L = (long)i * G + c; if (L >= nwg) return false;
        int wgid = (int)L; { const int q = nwg / NXCD, r = nwg % NXCD, xcd = wgid % NXCD, off = wgid / NXCD; wgid = (xcd < r ? xcd * (q + 1) : r * (q + 1) + (xcd - r) * q) + off; }
        const int nig = WGM * nN, gid = wgid / nig, fm = gid * WGM, gsz = (nM - fm) < WGM ? (nM - fm) : WGM;
        u.pm = fm + ((wgid % nig) % gsz); u.pn = (wgid % nig) / gsz; return true;
    }
    __device__ __forceinline__ void a_ready(const Unit&) const {}
    __device__ __forceinline__ void done(const Unit&) const {}
    __device__ __forceinline__ void tick(int, bool) const {}
};

struct TailOrder : StaticOrder {
    unsigned* ctr; volatile PG8_LAS int* slot; int full, rem;
    __device__ __forceinline__ void init2(unsigned* c_, volatile PG8_LAS int* s_) { ctr = c_; slot = s_; full = nwg / G; rem = nwg - full * G; }
    __device__ __forceinline__ bool next(int i, Unit& u) const {
        if (i < full || full < 2) return StaticOrder::next(i, u);
        if (i > full || rem == 0) return false;
        const int t = *slot; if (t < 0 || t >= rem) return false;
        TailOrder tmp = *this; tmp.c = t; return tmp.StaticOrder::next(full, u);
    }
    __device__ __forceinline__ void tick(int ui, bool t0) const {
        if (rem != 0 && ui == full - 2 && t0) { const int t = (int)__hip_atomic_fetch_add(ctr, 1u, __ATOMIC_RELAXED, __HIP_MEMORY_SCOPE_AGENT); *slot = t; }
    }
};
#ifndef PROBE_GEMM
#define PROBE_GEMM 0
#endif
struct ProbeOrder : StaticOrder {
    __host__ __device__ bool next(int i, Unit& u) const { const bool ok = StaticOrder::next(i, u); if (PROBE_GEMM == 2) { u.pm = 0; u.pn = 0; } return ok; }
};
__device__ __forceinline__ unsigned cvt_pk_bf16(float lo, float hi) { unsigned r; asm volatile("v_cvt_pk_bf16_f32 %0, %1, %2" : "=v"(r) : "v"(lo), "v"(hi)); return r; }
typedef unsigned u32x2 __attribute__((ext_vector_type(2)));
constexpr float F8_ASCALE = 4.0f, F8_WSCALE = 64.0f;
__device__ __forceinline__ float f8clamp(float v) { return __builtin_fminf(__builtin_fmaxf(v * F8_ASCALE, -440.0f), 440.0f); }
__device__ __forceinline__ u32x2 pack8_fp8(const f32x4 a, const f32x4 b) { u32x2 w; int t = __builtin_amdgcn_cvt_pk_fp8_f32(f8clamp(a[0]), f8clamp(a[1]), 0, false); t = __builtin_amdgcn_cvt_pk_fp8_f32(f8clamp(a[2]), f8clamp(a[3]), t, true); w.x = (unsigned)t;
    int q = __builtin_amdgcn_cvt_pk_fp8_f32(f8clamp(b[0]), f8clamp(b[1]), 0, false); q = __builtin_amdgcn_cvt_pk_fp8_f32(f8clamp(b[2]), f8clamp(b[3]), q, true); w.y = (unsigned)q; return w; }
__device__ __forceinline__ float dpp_qp(float v, const int ctrl) { const int x = __builtin_bit_cast(int, v); return __builtin_bit_cast(float, ctrl == 0xB1 ? __builtin_amdgcn_update_dpp(x, x, 0xB1, 0xF, 0xF, false) : __builtin_amdgcn_update_dpp(x, x, 0x4E, 0xF, 0xF, false)); }
__device__ __forceinline__ f32x4 quad_transpose(f32x4 a, int q) {
    { const bool odd = (q & 1) != 0; const float s0 = odd ? a[0] : a[1], s1 = odd ? a[2] : a[3]; const float r0 = dpp_qp(s0, 0xB1), r1 = dpp_qp(s1, 0xB1);
      if (odd) { a[0] = r0; a[2] = r1; } else { a[1] = r0; a[3] = r1; } }
    { const bool hi = (q & 2) != 0; const float s0 = hi ? a[0] : a[2], s1 = hi ? a[1] : a[3]; const float r0 = dpp_qp(s0, 0x4E), r1 = dpp_qp(s1, 0x4E);
      if (hi) { a[0] = r0; a[1] = r1; } else { a[2] = r0; a[3] = r1; } }
    return a;
}
__device__ __forceinline__ u32x2 pack4(const f32x4 a) { u32x2 w; w.x = cvt_pk_bf16(a[0], a[1]); w.y = cvt_pk_bf16(a[2], a[3]); return w; }
__device__ __forceinline__ u32x4 pack8(const f32x4 a, const f32x4 b) { u32x4 w; w.x = cvt_pk_bf16(a[0], a[1]); w.y = cvt_pk_bf16(a[2], a[3]); w.z = cvt_pk_bf16(b[0], b[1]); w.w = cvt_pk_bf16(b[2], b[3]); return w; }

struct EpiIn {
    static constexpr bool PERM = true, AFTER_DRAIN = false, ROWTAB = true, CONVTAB = false;
    bf16_t* O; int ldc; const float* rstd; PG8_LAS const float* tab; const float* cosb; const float* sinb;
    bf16_t* KFT; bf16_t* KBT; bf16_t* VT; const float* lgam;
    int pn0 = 0;
    __device__ __forceinline__ void operator()(const f32x4 (&acc)[2][2][4][2], const Unit& u, int wr, int wc, int fr, int fq) const {
        asm volatile("" : "+v"(fr), "+v"(fq));
        const int upn = u.pn + pn0; const int row0 = u.pm * BM + wr * 64 + fr, col0 = upn * BM + wc * 32 + 8 * fq, typ = upn >> 3;
        if (typ == 3 || typ == 5) {
            const float osc = (typ == 3) ? 0.0625f : 1.0f; const int h = upn & 7;
            float lf = 0.f, lb = 0.f; if (typ == 5) { lf = lgam[h]; lb = lgam[8 + h]; }
            const int tlane = ((((fr >> 2) & 1) * 32 + 8 * fq + (fr & 3)) * 8) + 4 * (fr >> 3);
#pragma unroll
            for (int ai = 0; ai < 2; ++ai) {
                const int tokb = u.pm * BM + ai * HALF; const size_t blk = ((size_t)((tokb >> 12) * 8 + h) * 32 + ((tokb >> 7) & 31)) * 32768 + (size_t)((wc * 8 + 4 * wr) * 512 + tlane);
#pragma unroll
              for (int mh = 0; mh < 2; ++mh) {
                float rsv[2]; f32x4 cv[2][2], sv[2][2];
#pragma unroll
                for (int m2 = 0; m2 < 2; ++m2) { const int row = row0 + ai * HALF + (2 * mh + m2) * 16; rsv[m2] = tab[row - u.pm * BM]; const float* cp = cosb + (size_t)row * 128 + wc * 32 + 8 * fq; const float* sp = sinb + (size_t)row * 128 + wc * 32 + 8 * fq;
                    cv[m2][0] = *(const f32x4*)cp; cv[m2][1] = *(const f32x4*)(cp + 4); sv[m2][0] = *(const f32x4*)sp; sv[m2][1] = *(const f32x4*)(sp + 4); }
                asm volatile("" : "+v"(rsv[0]), "+v"(rsv[1]), "+v"(cv[0][0]), "+v"(cv[0][1]), "+v"(cv[1][0]), "+v"(cv[1][1]), "+v"(sv[0][0]), "+v"(sv[0][1]), "+v"(sv[1][0]), "+v"(sv[1][1]));
#pragma unroll
                for (int m2 = 0; m2 < 2; ++m2) { const int m = 2 * mh + m2; const int row = row0 + ai * HALF + m * 16; const float rs = rsv[m2];
                    const float sc = rs * osc;
                    const f32x4 c0 = cv[m2][0], c1 = cv[m2][1], s0 = sv[m2][0], s1 = sv[m2][1];
                    const f32x4 a0 = acc[ai][0][m][0] * sc, a1 = acc[ai][0][m][1] * sc, b0 = acc[ai][1][m][0] * sc, b1 = acc[ai][1][m][1] * sc;
                    bf16_t* rp2 = O + (size_t)row * ldc + upn * BM + 16 * (2 * wc + (fq >> 1)) + 4 * (fq & 1);
                    const f32x4 o10 = a0 * c0 - b0 * s0, o11 = a1 * c1 - b1 * s1, o20 = b0 * c0 + a0 * s0, o21 = b1 * c1 + a1 * s1;
                    *(u32x2*)(rp2) = pack4(o10); *(u32x2*)(rp2 + 8) = pack4(o11);
                    *(u32x2*)(rp2 + HALF) = pack4(o20); *(u32x2*)(rp2 + HALF + 8) = pack4(o21);
                    if (typ == 5) {
                        const int c = wr * 64 + m * 16 + fr; const float wf = __expf(lf * (float)(127 - c)), wb = __expf(lb * (float)c); const int q = fr & 3;
                        bf16_t* pf = KFT + blk + m * 512; bf16_t* pb = KBT + blk + m * 512;
                        *(u32x2*)(pf) = pack4(quad_transpose(o10 * wf, q)); *(u32x2*)(pf + 32) = pack4(quad_transpose(o11 * wf, q)); *(u32x2*)(pf + 16384) = pack4(quad_transpose(o20 * wf, q)); *(u32x2*)(pf + 16384 + 32) = pack4(quad_transpose(o21 * wf, q));
                        *(u32x2*)(pb) = pack4(quad_transpose(o10 * wb, q)); *(u32x2*)(pb + 32) = pack4(quad_transpose(o11 * wb, q)); *(u32x2*)(pb + 16384) = pack4(quad_transpose(o20 * wb, q)); *(u32x2*)(pb + 16384 + 32) = pack4(quad_transpose(o21 * wb, q));
                    } } } }
        } else if (typ == 6) {
            const int h = upn & 7; const int tlane = ((((fr >> 2) & 1) * 32 + 8 * fq + (fr & 3)) * 8) + 4 * (fr >> 3), q = fr & 3;
            float rs8[8];
#pragma unroll
            for (int i = 0; i < 8; ++i) rs8[i] = tab[row0 - u.pm * BM + (i >> 2) * HALF + (i & 3) * 16];
            asm volatile("" : "+v"(rs8[0]), "+v"(rs8[1]), "+v"(rs8[2]), "+v"(rs8[3]), "+v"(rs8[4]), "+v"(rs8[5]), "+v"(rs8[6]), "+v"(rs8[7]));
#pragma unroll
            for (int ai = 0; ai < 2; ++ai) {
                const int tokb = u.pm * BM + ai * HALF; const size_t blk = ((size_t)((tokb >> 12) * 8 + h) * 32 + ((tokb >> 7) & 31)) * 32768 + (size_t)((wc * 8 + 4 * wr) * 512 + tlane);
#pragma unroll
                for (int m = 0; m < 4; ++m) { const float rs = rs8[ai * 4 + m]; bf16_t* pv = VT + blk + m * 512;
#pragma unroll
                    for (int bj = 0; bj < 2; ++bj)
#pragma unroll
                        for (int n = 0; n < 2; ++n) *(u32x2*)(pv + bj * 16384 + n * 32) = pack4(quad_transpose(acc[ai][bj][m][n] * rs, q)); } }
        } else {
            float rs8[8];
#pragma unroll
            for (int i = 0; i < 8; ++i) rs8[i] = tab[row0 - u.pm * BM + (i >> 2) * HALF + (i & 3) * 16];
            asm volatile("" : "+v"(rs8[0]), "+v"(rs8[1]), "+v"(rs8[2]), "+v"(rs8[3]), "+v"(rs8[4]), "+v"(rs8[5]), "+v"(rs8[6]), "+v"(rs8[7]));
#pragma unroll
            for (int ai = 0; ai < 2; ++ai)
#pragma unroll
                for (int m = 0; m < 4; ++m) { const int row = row0 + ai * HALF + m * 16; const float rs = rs8[ai * 4 + m]; bf16_t* rowp = O + (size_t)row * ldc + col0;
#pragma unroll
                    for (int bj = 0; bj < 2; ++bj) *(u32x4*)(rowp + bj * HALF) = pack8(acc[ai][bj][m][0] * rs, acc[ai][bj][m][1] * rs); }
        }
    }
};
struct EpiScale {
    static constexpr bool PERM = true, AFTER_DRAIN = false, ROWTAB = true, CONVTAB = false;
    bf16_t* O; int ldc; const float* rstd; PG8_LAS const float* tab;
    __device__ __forceinline__ void operator()(const f32x4 (&acc)[2][2][4][2], const Unit& u, int wr, int wc, int fr, int fq) const {
        asm volatile("" : "+v"(fr), "+v"(fq));
        const int rl0 = wr * 64 + fr, row0 = u.pm * BM + rl0, col0 = u.pn * BM + wc * 32 + 8 * fq;
#pragma unroll
        for (int ai = 0; ai < 2; ++ai)
#pragma unroll
            for (int m = 0; m < 4; ++m) { const int row = row0 + ai * HALF + m * 16; const float r = tab[rl0 + ai * HALF + m * 16]; bf16_t* rowp = O + (size_t)row * ldc + col0;
#pragma unroll
                for (int bj = 0; bj < 2; ++bj) *(u32x4*)(rowp + bj * HALF) = pack8(acc[ai][bj][m][0] * r, acc[ai][bj][m][1] * r); }
    }
};
__device__ __forceinline__ float dpp_row(float oldv, float v, const int ctrl) { const int o = __builtin_bit_cast(int, oldv), x = __builtin_bit_cast(int, v);
    return __builtin_bit_cast(float, ctrl == 0x111 ? __builtin_amdgcn_update_dpp(o, x, 0x111, 0xF, 0xF, false) : ctrl == 0x101 ? __builtin_amdgcn_update_dpp(o, x, 0x101, 0xF, 0xF, false)
                                   : ctrl == 0x10F ? __builtin_amdgcn_update_dpp(o, x, 0x10F, 0xF, 0xF, false) : __builtin_amdgcn_update_dpp(o, x, 0x11F, 0xF, 0xF, false)); }
__device__ __forceinline__ float dpp_in(float v, const int ctrl) { const int x = __builtin_bit_cast(int, v);
    return __builtin_bit_cast(float, ctrl == 0x10F ? __builtin_amdgcn_mov_dpp(x, 0x10F, 0xF, 0xF, true) : __builtin_amdgcn_mov_dpp(x, 0x11F, 0xF, 0xF, true)); }
struct EpiAct {
    static constexpr bool PERM = true, AFTER_DRAIN = false, ROWTAB = true, CONVTAB = true;
    bf16_t* ACT; int ldc; const float* rstd; PG8_LAS float* tab;
    float scg, scu; int pn0;
    int k8; size_t a16off;
    const float* cw; const float* cb; float* HG; float* HU;
    __device__ __forceinline__ void operator()(const f32x4 (&acc)[2][2][4][2], const Unit& u, int wr, int wc, int fr, int fq) const {
        asm volatile("" : "+v"(fr), "+v"(fq));
        const int rl0 = wr * 64 + fr, ch0 = wc * 32 + 8 * fq;
        f32x4 G[2][4][2], U[2][4][2];
#pragma unroll
        for (int ai = 0; ai < 2; ++ai)
#pragma unroll
            for (int m = 0; m < 4; ++m) { const float r = tab[rl0 + ai * HALF + m * 16]; const float rg = r * scg, ru = r * scu;
#pragma unroll
                for (int n = 0; n < 2; ++n) { G[ai][m][n] = acc[ai][0][m][n] * rg; U[ai][m][n] = acc[ai][1][m][n] * ru; } }
        PG8_LAS float* hb = tab + 768;
#define EPA_H(wr_, ai_, fl_) (((((wr_) * 4 + wc) * 2 + (ai_)) * 2 + (fl_)) * 32 + 8 * fq)
        if (fr == 0) {
#pragma unroll
            for (int ai = 0; ai < 2; ++ai) { *(PG8_LAS f32x4*)(hb + EPA_H(wr, ai, 0)) = G[ai][0][0]; *(PG8_LAS f32x4*)(hb + EPA_H(wr, ai, 0) + 4) = G[ai][0][1]; } }
        if (fr == 15) {
#pragma unroll
            for (int ai = 0; ai < 2; ++ai) { *(PG8_LAS f32x4*)(hb + EPA_H(wr, ai, 1)) = G[ai][3][0]; *(PG8_LAS f32x4*)(hb + EPA_H(wr, ai, 1) + 4) = G[ai][3][1]; } }
        asm volatile("s_waitcnt lgkmcnt(0)" ::: "memory"); __builtin_amdgcn_s_barrier(); asm volatile("" ::: "memory");
        f32x4 top[2][2], bot[2][2];
#pragma unroll
        for (int ai = 0; ai < 2; ++ai) {
            const int to = (wr == 1) ? EPA_H(0, ai, 1) : EPA_H(1, 0, 1);
            const int bo = (wr == 0) ? EPA_H(1, ai, 0) : EPA_H(0, 1, 0);
            top[ai][0] = *(PG8_LAS const f32x4*)(hb + to); top[ai][1] = *(PG8_LAS const f32x4*)(hb + to + 4); bot[ai][0] = *(PG8_LAS const f32x4*)(hb + bo); bot[ai][1] = *(PG8_LAS const f32x4*)(hb + bo + 4); }
#undef EPA_H
        f32x4 w0[2], w1[2], w2[2], bb[2];
#pragma unroll
        for (int n = 0; n < 2; ++n) { w0[n] = *(PG8_LAS const f32x4*)(tab + 256 + ch0 + 4 * n); w1[n] = *(PG8_LAS const f32x4*)(tab + 384 + ch0 + 4 * n); w2[n] = *(PG8_LAS const f32x4*)(tab + 512 + ch0 + 4 * n); bb[n] = *(PG8_LAS const f32x4*)(tab + 640 + ch0 + 4 * n); }
        const int chg = (u.pn + pn0) * HALF + ch0;
        const bool f8 = (u.pn + pn0) * HALF < k8;
        unsigned char* const ab = f8 ? (unsigned char*)ACT + chg : (unsigned char*)ACT + a16off + (size_t)(chg - k8) * 2; const size_t ap = f8 ? (size_t)k8 : (size_t)(ldc - k8) * 2;
#pragma unroll
        for (int ai = 0; ai < 2; ++ai)
#pragma unroll
            for (int m = 0; m < 4; ++m) {
                f32x4 o[2];
#pragma unroll
                for (int n = 0; n < 2; ++n)
#pragma unroll
                    for (int j = 0; j < 4; ++j) {
                        const float g = G[ai][m][n][j];
                        const float xo = (m > 0) ? dpp_in(G[ai][m > 0 ? m - 1 : 0][n][j], 0x10F) : top[ai][n][j];
                        const float gp = dpp_row(xo, g, 0x111);
                        const float yo = (m < 3) ? dpp_in(G[ai][m < 3 ? m + 1 : 3][n][j], 0x11F) : bot[ai][n][j];
                        const float gn = dpp_row(yo, g, 0x101);
                        const float z = __builtin_fmaf(w0[n][j], gp, __builtin_fmaf(w1[n][j], g, __builtin_fmaf(w2[n][j], gn, bb[n][j])));
                        o[n][j] = z * __builtin_amdgcn_rcpf(1.0f + __builtin_amdgcn_exp2f(z * -1.4426950408889634f)) * U[ai][m][n][j]; }
                const int tr = ai * HALF + wr * 64 + m * 16 + fr;
                const bool first = (ai == 0 && m == 0 && wr == 0 && fr == 0), lastr = (ai == 1 && m == 3 && wr == 1 && fr == 15);
                if (!first && !lastr) { if (f8) *(u32x2*)(ab + (size_t)(u.pm * BM + tr) * ap) = pack8_fp8(o[0], o[1]); else *(u32x4*)(ab + (size_t)(u.pm * BM + tr) * ap) = pack8(o[0], o[1]); }
                if (ai == 0 && m == 0 && wr == 0 && fr <= 1) { float* hg = HG + (size_t)(u.pm * 4 + fr) * ldc + chg; *(f32x4*)hg = G[0][0][0]; *(f32x4*)(hg + 4) = G[0][0][1];
                    if (fr == 0) { float* hu = HU + (size_t)(u.pm * 2) * ldc + chg; *(f32x4*)hu = U[0][0][0]; *(f32x4*)(hu + 4) = U[0][0][1]; } }
                if (ai == 1 && m == 3 && wr == 1 && fr >= 14) { float* hg = HG + (size_t)(u.pm * 4 + 2 + (fr - 14)) * ldc + chg; *(f32x4*)hg = G[1][3][0]; *(f32x4*)(hg + 4) = G[1][3][1];
                    if (fr == 15) { float* hu = HU + (size_t)(u.pm * 2 + 1) * ldc + chg; *(f32x4*)hu = U[1][3][0]; *(f32x4*)(hu + 4) = U[1][3][1]; } }
            }
    }
};
struct EpiRes {
    static constexpr bool PERM = true, AFTER_DRAIN = false, ROWTAB = false, CONVTAB = false;
    const float* xin32; bf16_t* xb; float* part; int ldc; float sc;
    __device__ __forceinline__ void operator()(const f32x4 (&acc)[2][2][4][2], const Unit& u, int wr, int wc, int fr, int fq) const {
        asm volatile("" : "+v"(fr), "+v"(fq));
        const int row0 = u.pm * BM + wr * 64 + fr, col0 = u.pn * BM + wc * 32 + 8 * fq;
        float ssv[8];
        if (xin32) {
#pragma unroll
            for (int q = 0; q < 4; ++q) {
                const int ai = q >> 1, mh = q & 1;
                f32x4 xv[2][2][2];
#pragma unroll
                for (int m2 = 0; m2 < 2; ++m2)
#pragma unroll
                    for (int bj = 0; bj < 2; ++bj) { const float* p = xin32 + (size_t)(row0 + ai * HALF + (2 * mh + m2) * 16) * ldc + col0 + bj * HALF; xv[m2][bj][0] = *(const f32x4*)p; xv[m2][bj][1] = *(const f32x4*)(p + 4); }
                asm volatile("" : "+v"(xv[0][0][0]), "+v"(xv[0][0][1]), "+v"(xv[0][1][0]), "+v"(xv[0][1][1]), "+v"(xv[1][0][0]), "+v"(xv[1][0][1]), "+v"(xv[1][1][0]), "+v"(xv[1][1][1]));
#pragma unroll
                for (int m2 = 0; m2 < 2; ++m2) { const int m = 2 * mh + m2; const size_t off = (size_t)(row0 + ai * HALF + m * 16) * ldc + col0; float ss = 0.f;
#pragma unroll
                    for (int bj = 0; bj < 2; ++bj) { const f32x4 v0 = xv[m2][bj][0] + acc[ai][bj][m][0] * sc, v1 = xv[m2][bj][1] + acc[ai][bj][m][1] * sc;
                        *(u32x4*)(xb + off + bj * HALF) = pack8(v0, v1);
                        ss += (v0[0] * v0[0] + v0[1] * v0[1]) + (v0[2] * v0[2] + v0[3] * v0[3]) + (v1[0] * v1[0] + v1[1] * v1[1]) + (v1[2] * v1[2] + v1[3] * v1[3]); }
                    ss += __shfl_xor(ss, 16); ss += __shfl_xor(ss, 32); ssv[ai * 4 + m] = ss; } }
        } else {
#pragma unroll
            for (int q = 0; q < 4; ++q) {
                const int ai = q >> 1, mh = q & 1;
                u32x4 xo[2][2];
#pragma unroll
                for (int m2 = 0; m2 < 2; ++m2)
#pragma unroll
                    for (int bj = 0; bj < 2; ++bj) xo[m2][bj] = *(const u32x4*)(xb + (size_t)(row0 + ai * HALF + (2 * mh + m2) * 16) * ldc + col0 + bj * HALF);
                asm volatile("" : "+v"(xo[0][0]), "+v"(xo[0][1]), "+v"(xo[1][0]), "+v"(xo[1][1]));
#pragma unroll
                for (int m2 = 0; m2 < 2; ++m2) { const int m = 2 * mh + m2; const size_t off = (size_t)(row0 + ai * HALF + m * 16) * ldc + col0; float ss = 0.f;
#pragma unroll
                    for (int bj = 0; bj < 2; ++bj) { const u32x4 w = xo[m2][bj];
                        const f32x4 x0 = (f32x4){__uint_as_float(w.x << 16), __uint_as_float(w.x & 0xffff0000u), __uint_as_float(w.y << 16), __uint_as_float(w.y & 0xffff0000u)};
                        const f32x4 x1 = (f32x4){__uint_as_float(w.z << 16), __uint_as_float(w.z & 0xffff0000u), __uint_as_float(w.w << 16), __uint_as_float(w.w & 0xffff0000u)};
                        const f32x4 v0 = x0 + acc[ai][bj][m][0] * sc, v1 = x1 + acc[ai][bj][m][1] * sc;
                        *(u32x4*)(xb + off + bj * HALF) = pack8(v0, v1);
                        ss += (v0[0] * v0[0] + v0[1] * v0[1]) + (v0[2] * v0[2] + v0[3] * v0[3]) + (v1[0] * v1[0] + v1[1] * v1[1]) + (v1[2] * v1[2] + v1[3] * v1[3]); }
                    ss += __shfl_xor(ss, 16); ss += __shfl_xor(ss, 32); ssv[ai * 4 + m] = ss; } }
        }
        if (fq == 0) {
#pragma unroll
            for (int i = 0; i < 8; ++i) part[(size_t)(row0 + (i >> 2) * HALF + (i & 3) * 16) * 64 + u.pn * 4 + wc] = ssv[i]; }
    }
};

#ifndef PROBE_PHTIME
#define PROBE_PHTIME (-1)
#endif
#ifndef PROBE_SPREAD
#define PROBE_SPREAD (-1)
#endif
#ifndef PROBE_BWAIT
#define PROBE_BWAIT (-1)
#endif
#ifndef PROBE_BARS
#define PROBE_BARS 0
#endif
#ifndef PROBE_TIMER
#define PROBE_TIMER 0
#endif
#ifndef PROBE_PHASE
#define PROBE_PHASE 6
#endif
#define PROBE_NOW() ((PROBE_TIMER & 1) ? __builtin_amdgcn_s_memtime() : __builtin_amdgcn_s_memrealtime())
typedef int v8i_t __attribute__((ext_vector_type(8)));
typedef int v4i_t __attribute__((ext_vector_type(4)));
__device__ __forceinline__ v8i_t cat8(const bf16x8 lo, const bf16x8 hi) { const u32x4 a = __builtin_bit_cast(u32x4, lo), b = __builtin_bit_cast(u32x4, hi); return (v8i_t){(int)a.x, (int)a.y, (int)a.z, (int)a.w, (int)b.x, (int)b.y, (int)b.z, (int)b.w}; }
template <class Epi, class Sched, bool ALIGN_EPI = false, bool SP2 = false, int PROBE = 0, bool F8 = false, bool I8 = false>
__device__ __forceinline__ void gemm_phase(PG8_LAS unsigned char* lds, const Gemm g, const Sched& S, const Epi& E, int tid_) {
    asm volatile("" : "+v"(tid_));
    const int tid = tid_, wid = __builtin_amdgcn_readfirstlane(tid >> 6), lane = tid & 63, wr = wid >> 2, wc = wid & 3, fr = lane & 15, fq = lane >> 4;
    const int K = g.K, nt = K / BK;
    unsigned voffA[2], voffB[2];
#pragma unroll
    for (int i = 0; i < 2; ++i) { int R, C; stage_rc(tid * 16 + i * 8192, R, C); const int Rb = Epi::PERM ? ((R & ~31) + perm32(R & 31)) : R;
        voffA[i] = (unsigned)(R * K + C) * 2u; voffB[i] = (unsigned)(Rb * K + C) * 2u; }
    const size_t kstep = (size_t)(BK * 2);
    const size_t hstep = (size_t)HALF * K * 2;
    const size_t tstep = 2 * hstep;
    const unsigned ldsw = (unsigned)wid * 1024u;
    const int aoff = lds_byte(wr * 64 + fr, fq * 8), boff = lds_byte(wc * 32 + fr, fq * 8);
#define PG8_SA(b, h) (((b) * 2 + (h)) * HTB)
#define PG8_SB(b, h) ((4 + (b) * 2 + (h)) * HTB)
#define PG8_STAGE(bufoff, gbase, voff) do { _Pragma("unroll") for (int _i = 0; _i < 2; ++_i) { unsigned _v = (voff)[_i]; if constexpr (F8) asm volatile("" : "+v"(_v));     \
        __builtin_amdgcn_global_load_lds((const unsigned*)((const char*)(gbase) + _v), (PG8_LAS unsigned*)(lds + (bufoff) + ldsw + _i * 8192), 16, 0, 0); } } while (0)
#define PG8_LDA8(dst, b, h) do { _Pragma("unroll") for (int m = 0; m < 4; ++m) dst[m] = cat8(*(const PG8_LAS bf16x8*)(lds + PG8_SA(b, h) + aoff + m * 2048), *(const PG8_LAS bf16x8*)(lds + PG8_SA(b, h) + aoff + m * 2048 + 1024)); } while (0)
#define PG8_LDB8(dst, b, h) do { _Pragma("unroll") for (int n = 0; n < 2; ++n) dst[n] = cat8(*(const PG8_LAS bf16x8*)(lds + PG8_SB(b, h) + boff + n * 2048), *(const PG8_LAS bf16x8*)(lds + PG8_SB(b, h) + boff + n * 2048 + 1024)); } while (0)
#define PG8_LDA(dst, b, h) do { _Pragma("unroll") for (int m = 0; m < 4; ++m) _Pragma("unroll") for (int k = 0; k < 2; ++k) dst[m][k] = *(const PG8_LAS bf16x8*)(lds + PG8_SA(b, h) + aoff + m * 2048 + k * 1024); } while (0)
#define PG8_LDB(dst, b, h) do { _Pragma("unroll") for (int n = 0; n < 2; ++n) _Pragma("unroll") for (int k = 0; k < 2; ++k) dst[n][k] = *(const PG8_LAS bf16x8*)(lds + PG8_SB(b, h) + boff + n * 2048 + k * 1024); } while (0)
#define PG8_MMA(ai, bj, At, Bt) do { __builtin_amdgcn_s_setprio(1); if constexpr (F8) { _Pragma("unroll") for (int m = 0; m < 4; ++m) _Pragma("unroll") for (int n = 0; n < 2; ++n) \
        acc[ai][bj][m][n] = __builtin_amdgcn_mfma_scale_f32_16x16x128_f8f6f4(Bt##8[n], At##8[m], acc[ai][bj][m][n], 0, 0, 0, 0, 0, 0); } \
        else { _Pragma("unroll") for (int m = 0; m < 4; ++m) _Pragma("unroll") for (int n = 0; n < 2; ++n) _Pragma("unroll") for (int k = 0; k < 2; ++k) \
        { if constexpr (I8) acc[ai][bj][m][n] = __builtin_bit_cast(f32x4, __builtin_amdgcn_mfma_i32_16x16x64_i8(__builtin_bit_cast(v4i_t, Bt[n][k]), __builtin_bit_cast(v4i_t, At[m][k]), __builtin_bit_cast(v4i_t, acc[ai][bj][m][n]), 0, 0, 0)); \
          else acc[ai][bj][m][n] = __builtin_amdgcn_mfma_f32_16x16x32_bf16(Bt[n][k], At[m][k], acc[ai][bj][m][n], 0, 0, 0); } } __builtin_amdgcn_s_setprio(0); } while (0)
#define PG8_WAIT_V(n) asm volatile("s_waitcnt vmcnt(" #n ")" ::: "memory")
#define PG8_WAIT_L(n) asm volatile("s_waitcnt lgkmcnt(" #n ")" ::: "memory")
#define PG8_BAR __builtin_amdgcn_s_barrier()
#define PG8_SCHED __builtin_amdgcn_sched_barrier(0)
    if (PROBE && PROBE_TIMER == 6 && tid == 0 && blockIdx.x == 0) { volatile PG8_LAS unsigned* pm = (volatile PG8_LAS unsigned*)(lds + 139264 + 320 + 64); pm[2] = (unsigned)__builtin_amdgcn_s_memrealtime(); }
    Unit cur, nxt; int ui = 0;
    if (!S.next(0, cur)) return;
    f32x4 acc[2][2][4][2];
#pragma unroll
    for (int a = 0; a < 2; ++a)
#pragma unroll
        for (int b = 0; b < 2; ++b)
#pragma unroll
            for (int m = 0; m < 4; ++m)
#pragma unroll
                for (int n = 0; n < 2; ++n) acc[a][b][m][n] = (f32x4){0.f, 0.f, 0.f, 0.f};
    bf16x8 At[4][2], B0[2][2], B1[2][2];
    v8i_t At8[4], B08[2], B18[2];
    const char* cA = (const char*)g.A + (size_t)cur.pm * tstep; const char* cB = (const char*)g.Bt + (size_t)cur.pn * tstep;
    S.a_ready(cur);
    if constexpr (SP2) {
        PG8_STAGE(PG8_SB(0, 0), cB, voffB); PG8_STAGE(PG8_SB(0, 1), cB + hstep, voffB); PG8_STAGE(PG8_SA(0, 0), cA, voffA); PG8_STAGE(PG8_SA(0, 1), cA + hstep, voffA);
        if (wr == 1) PG8_BAR;
        PG8_WAIT_V(2); PG8_BAR;
        PG8_STAGE(PG8_SB(1, 0), cB + kstep, voffB); PG8_STAGE(PG8_SA(1, 0), cA + kstep, voffA); PG8_STAGE(PG8_SB(1, 1), cB + hstep + kstep, voffB);
        PG8_WAIT_V(6); PG8_BAR;
    } else {
        PG8_STAGE(PG8_SB(0, 0), cB, voffB); PG8_STAGE(PG8_SA(0, 0), cA, voffA); PG8_STAGE(PG8_SB(0, 1), cB + hstep, voffB); PG8_STAGE(PG8_SA(0, 1), cA + hstep, voffA);
        if (wr == 1) PG8_BAR;
        PG8_WAIT_V(4); PG8_BAR;
        PG8_STAGE(PG8_SB(1, 0), cB + kstep, voffB); PG8_STAGE(PG8_SA(1, 0), cA + kstep, voffA); PG8_STAGE(PG8_SB(1, 1), cB + hstep + kstep, voffB);
        PG8_WAIT_V(6); PG8_BAR;
    }
    for (;;) {
        S.tick(ui, tid == 0);
        const bool has_next = S.next(ui + 1, nxt);
        const char* nA = has_next ? (const char*)g.A + (size_t)nxt.pm * tstep : cA; const char* nB = has_next ? (const char*)g.Bt + (size_t)nxt.pn * tstep : cB;
        unsigned long long pk0 = 0, pk1 = 0; if (PROBE && PROBE_TIMER) pk0 = PROBE_NOW();
        for (int t = 0; t < nt; t += 2) {
            const bool last = (t == nt - 2);
            const char* a1 = cA + (size_t)(t + 1) * kstep;
            const char* a2 = last ? nA : cA + (size_t)(t + 2) * kstep; const char* b2 = last ? nB : cB + (size_t)(t + 2) * kstep;
            const char* a3 = a2 + kstep; const char* b3 = b2 + kstep;
            if (last && has_next) S.a_ready(nxt);
            if constexpr (Epi::CONVTAB) { if (last && wid == 1) { int lane; asm volatile("v_mbcnt_lo_u32_b32 %0, -1, 0\n\tv_mbcnt_hi_u32_b32 %0, -1, %0" : "=v"(lane));
                const int cho = (cur.pn + E.pn0) * HALF + (lane & 31) * 4;
                __builtin_amdgcn_global_load_lds((const unsigned*)(E.cw + (lane >> 5) * 11008 + cho), (PG8_LAS unsigned*)(lds + ROWTAB_OFF + 1024), 16, 0, 0);
                __builtin_amdgcn_global_load_lds((const unsigned*)((lane >> 5) ? E.cb + cho : E.cw + 2 * 11008 + cho), (PG8_LAS unsigned*)(lds + ROWTAB_OFF + 2048), 16, 0, 0); } }
            if constexpr (Epi::ROWTAB) { if (last && wid == 0) { int lane; asm volatile("v_mbcnt_lo_u32_b32 %0, -1, 0\n\tv_mbcnt_hi_u32_b32 %0, -1, %0" : "=v"(lane)); __builtin_amdgcn_global_load_lds((const unsigned*)(E.rstd + cur.pm * BM + lane * 4), (PG8_LAS unsigned*)(lds + ROWTAB_OFF), 16, 0, 0); } }
            if constexpr (SP2 && F8) {
            PG8_LDB8(B08, 0, 0); PG8_LDB8(B18, 0, 1); PG8_SCHED; PG8_LDA8(At8, 0, 0); PG8_STAGE(PG8_SA(1, 1), a1 + hstep, voffA);
            PG8_WAIT_V(8); PG8_WAIT_L(0); PG8_BAR; PG8_MMA(0, 0, At, B0); PG8_MMA(0, 1, At, B1); PG8_BAR; PG8_SCHED;
            PG8_LDA8(At8, 0, 1); PG8_STAGE(PG8_SB(0, 0), b2, voffB); PG8_STAGE(PG8_SB(0, 1), b2 + hstep, voffB); PG8_STAGE(PG8_SA(0, 0), a2, voffA);
            PG8_WAIT_V(8); PG8_WAIT_L(0); PG8_BAR; PG8_MMA(1, 0, At, B0); PG8_MMA(1, 1, At, B1); PG8_BAR; PG8_SCHED;
            PG8_LDB8(B08, 1, 0); PG8_LDB8(B18, 1, 1); PG8_SCHED; PG8_LDA8(At8, 1, 0); PG8_STAGE(PG8_SA(0, 1), a2 + hstep, voffA);
            PG8_WAIT_V(8); PG8_WAIT_L(0); PG8_BAR; PG8_MMA(0, 0, At, B0); PG8_MMA(0, 1, At, B1); PG8_BAR; PG8_SCHED;
            PG8_LDA8(At8, 1, 1); PG8_STAGE(PG8_SB(1, 0), b3, voffB); PG8_STAGE(PG8_SB(1, 1), b3 + hstep, voffB); PG8_STAGE(PG8_SA(1, 0), a3, voffA);
            PG8_WAIT_V(8); PG8_WAIT_L(0); PG8_BAR; PG8_MMA(1, 0, At, B0); PG8_MMA(1, 1, At, B1); PG8_BAR; PG8_SCHED;
            } else if constexpr (SP2) {
            PG8_LDB(B0, 0, 0); PG8_LDB(B1, 0, 1); PG8_SCHED; PG8_LDA(At, 0, 0); PG8_STAGE(PG8_SA(1, 1), a1 + hstep, voffA);
            PG8_WAIT_V(8); PG8_WAIT_L(0); PG8_BAR; PG8_MMA(0, 0, At, B0); PG8_MMA(0, 1, At, B1); PG8_BAR; PG8_SCHED;
            PG8_LDA(At, 0, 1); PG8_STAGE(PG8_SB(0, 0), b2, voffB); PG8_STAGE(PG8_SB(0, 1), b2 + hstep, voffB); PG8_STAGE(PG8_SA(0, 0), a2, voffA);
            PG8_WAIT_V(8); PG8_WAIT_L(0); PG8_BAR; PG8_MMA(1, 0, At, B0); PG8_MMA(1, 1, At, B1); PG8_BAR; PG8_SCHED;
            PG8_LDB(B0, 1, 0); PG8_LDB(B1, 1, 1); PG8_SCHED; PG8_LDA(At, 1, 0); PG8_STAGE(PG8_SA(0, 1), a2 + hstep, voffA);
            PG8_WAIT_V(8); PG8_WAIT_L(0); PG8_BAR; PG8_MMA(0, 0, At, B0); PG8_MMA(0, 1, At, B1); PG8_BAR; PG8_SCHED;
            PG8_LDA(At, 1, 1); PG8_STAGE(PG8_SB(1, 0), b3, voffB); PG8_STAGE(PG8_SB(1, 1), b3 + hstep, voffB); PG8_STAGE(PG8_SA(1, 0), a3, voffA);
            PG8_WAIT_V(8); PG8_WAIT_L(0); PG8_BAR; PG8_MMA(1, 0, At, B0); PG8_MMA(1, 1, At, B1); PG8_BAR; PG8_SCHED;
            } else {
            PG8_LDB(B0, 0, 0); PG8_SCHED; PG8_LDA(At, 0, 0); PG8_STAGE(PG8_SA(1, 1), a1 + hstep, voffA);
            PG8_WAIT_L(8); PG8_BAR; PG8_WAIT_L(0); PG8_MMA(0, 0, At, B0); PG8_BAR; PG8_SCHED;
            PG8_LDB(B1, 0, 1); PG8_STAGE(PG8_SB(0, 0), b2, voffB);
            PG8_BAR; PG8_WAIT_L(0); PG8_MMA(0, 1, At, B1); PG8_BAR;
            PG8_LDA(At, 0, 1); PG8_STAGE(PG8_SA(0, 0), a2, voffA);
            PG8_BAR; PG8_WAIT_L(0); PG8_MMA(1, 0, At, B0); PG8_BAR; PG8_SCHED;
            PG8_STAGE(PG8_SB(0, 1), b2 + hstep, voffB);
            PG8_WAIT_V(6); PG8_BAR; PG8_MMA(1, 1, At, B1); PG8_BAR;
            PG8_LDB(B0, 1, 0); PG8_SCHED; PG8_LDA(At, 1, 0); PG8_STAGE(PG8_SA(0, 1), a2 + hstep, voffA);
            PG8_WAIT_L(8); PG8_BAR; PG8_WAIT_L(0); PG8_MMA(0, 0, At, B0); PG8_BAR; PG8_SCHED;
            PG8_LDB(B1, 1, 1); PG8_STAGE(PG8_SB(1, 0), b3, voffB);
            PG8_BAR; PG8_WAIT_L(0); PG8_MMA(0, 1, At, B1); PG8_BAR;
            PG8_LDA(At, 1, 1); PG8_STAGE(PG8_SA(1, 0), a3, voffA);
            PG8_BAR; PG8_WAIT_L(0); PG8_MMA(1, 0, At, B0); PG8_BAR; PG8_SCHED;
            PG8_STAGE(PG8_SB(1, 1), b3 + hstep, voffB);
            PG8_WAIT_V(6); PG8_BAR; PG8_MMA(1, 1, At, B1); PG8_BAR;
            }
        }
        if (PROBE && PROBE_TIMER) pk1 = PROBE_NOW();
        if constexpr (ALIGN_EPI) { if (wr == 0) PG8_BAR; }
        if constexpr (I8) {
#pragma unroll
            for (int a = 0; a < 2; ++a)
#pragma unroll
                for (int b = 0; b < 2; ++b)
#pragma unroll
                    for (int m = 0; m < 4; ++m)
#pragma unroll
                        for (int n = 0; n < 2; ++n) acc[a][b][m][n] = __builtin_convertvector(__builtin_bit_cast(v4i_t, acc[a][b][m][n]), f32x4); }
        if constexpr (!Epi::AFTER_DRAIN) { int l2_; asm volatile("v_mbcnt_lo_u32_b32 %0, -1, 0\n\tv_mbcnt_hi_u32_b32 %0, -1, %0" : "=v"(l2_)); E(acc, cur, wr, wc, l2_ & 15, l2_ >> 4); S.done(cur); }
        if (PROBE && PROBE_TIMER && PROBE_TIMER != 6) { const unsigned long long pk2 = PROBE_NOW(); if (tid == 0 && blockIdx.x == 0) { volatile PG8_LAS unsigned* pm = (volatile PG8_LAS unsigned*)(lds + 139264 + 320 + 64);
            pm[0] += (unsigned)((PROBE_TIMER <= 2) ? (pk1 - pk0) : (pk2 - pk1)); pm[1] += 1u; } }
        if (!has_next) break;
#pragma unroll
        for (int a = 0; a < 2; ++a)
#pragma unroll
            for (int b = 0; b < 2; ++b)
#pragma unroll
                for (int m = 0; m < 4; ++m)
#pragma unroll
                    for (int n = 0; n < 2; ++n) acc[a][b][m][n] = (f32x4){0.f, 0.f, 0.f, 0.f};
        cur = nxt; cA = nA; cB = nB; ++ui;
        if constexpr (ALIGN_EPI) { if (wr == 1) PG8_BAR; }
    }
    if (PROBE && PROBE_TIMER == 6 && wid == 0 && blockIdx.x == 0) { int l0; asm volatile("v_mbcnt_lo_u32_b32 %0, -1, 0\n\tv_mbcnt_hi_u32_b32 %0, -1, %0" : "=v"(l0)); if (l0 == 0) { volatile PG8_LAS unsigned* pm = (volatile PG8_LAS unsigned*)(lds + 139264 + 320 + 64); pm[0] += (unsigned)__builtin_amdgcn_s_memrealtime() - pm[2]; pm[1] += (unsigned)(ui + 1); } }
    PG8_WAIT_V(0);
    if constexpr (!ALIGN_EPI) { if (wr == 0) PG8_BAR; }
    PG8_BAR;
#undef PG8_SA
#undef PG8_SB
#undef PG8_STAGE
#undef PG8_LDA
#undef PG8_LDB
#undef PG8_MMA
#undef PG8_WAIT_V
#undef PG8_WAIT_L
#undef PG8_BAR
#undef PG8_SCHED
}
}

#ifndef PG8_SP2
#define PG8_SP2 true
#endif
#ifndef PG8_ALIGN
#define PG8_ALIGN true
#endif

constexpr int NWAVES = 8;
constexpr int BATCH = 4, SEQ = 4096, D = 4096, M = BATCH * SEQ, DEPTH = 2;
constexpr int CW = 2048, RW = 2048, RH = 8, HD = 256, CHUNK = 128, NCH = SEQ / CHUNK;
constexpr int IN_COLS = 14336, N1 = 12288  , FF = 11008, NGU = 2 * FF;
constexpr int COL_AB = 0, COL_AC = 2048, COL_AX = 4096, COL_Q = 6144, COL_G = 8192, COL_K = 10240;
constexpr float EPS = 1e-6f;
#ifndef F8_K0
#define F8_K0 0
#endif
static_assert(F8_K0 % 256 == 0 && F8_K0 <= FF && (FF - F8_K0) % 128 == 0 && FF % 256 == 0, "fp8 / bf16 K split: whole pairs of K-tiles on both sides");
__device__ __forceinline__ int k8_of(int l) { return (l == DEPTH - 1) ? FF : F8_K0; }
#ifndef GU8_TILES_L0
#define GU8_TILES_L0 86
#endif
#ifndef GU8_TILES_L1
#define GU8_TILES_L1 86
#endif
static_assert(GU8_TILES_L0 >= 0 && GU8_TILES_L0 <= NGU / 256 && GU8_TILES_L1 >= 0 && GU8_TILES_L1 <= NGU / 256, "int8 column tiles");
__device__ __forceinline__ int gu8_of(int l) { return (l == DEPTH - 1) ? GU8_TILES_L1 : GU8_TILES_L0; }
#ifndef IN8_TILES_L1
#define IN8_TILES_L1 16
#endif
__device__ __forceinline__ int in8_of(int l) { return (l == DEPTH - 1) ? IN8_TILES_L1 : 0; }
static_assert(IN8_TILES_L1 >= 0 && IN8_TILES_L1 <= 32 && IN8_TILES_L1 % 4 == 0, "int8 in-projection tiles: whole rounds, inside the blocks whose source and destination columns coincide");
constexpr int WABS_WORD = 3000;

constexpr size_t MiB = 1u << 20;
constexpr size_t WS_CTL = 0, CTL_ZERO_BYTES = 1 * MiB;
constexpr size_t WS_RSTD1 = 1 * MiB;
constexpr size_t WS_RSTD2 = WS_RSTD1 + 256 * 1024;
constexpr size_t WS_LGAM = WS_RSTD2 + 256 * 1024;
constexpr size_t WS_WSQ = WS_LGAM + 64 * 1024;
constexpr size_t WS_RS8 = WS_LGAM + 128 * 1024;
constexpr size_t WS_PART = 2 * MiB;
constexpr size_t WS_COS = 6 * MiB, WS_SIN = 14 * MiB;
constexpr size_t WS_WIN = 38 * MiB;
constexpr size_t WS_WOUT = WS_WIN + 112 * MiB;
constexpr size_t WS_WGU = WS_WOUT + 32 * MiB;
constexpr size_t WS_WDN = WS_WGU + 172 * MiB;
constexpr size_t WS_XB = WS_WDN + 86 * MiB;
constexpr size_t WS_R = WS_XB + 128 * MiB;
constexpr size_t WS_PROJ = WS_R;
constexpr size_t WS_KFT = WS_PROJ + 384 * MiB, WS_KBT = WS_KFT + 64 * MiB, WS_VT = WS_KBT + 64 * MiB;
constexpr size_t WS_SFT = WS_VT + 64 * MiB, WS_SBT = WS_SFT + 128 * MiB;
constexpr size_t WS_YCAT = WS_SBT + 128 * MiB;
constexpr size_t WS_MIX_END = WS_YCAT + 128 * MiB;
constexpr size_t WS_GU = WS_R;
constexpr size_t WS_ACT = WS_GU + 688 * MiB;
constexpr size_t WS_HG = 22 * MiB;
constexpr size_t WS_HU = WS_ACT + 344 * MiB;
constexpr size_t WS_END = WS_HU + 6 * MiB;
static_assert(WS_MIX_END <= WS_END, "overlay");
static_assert((size_t)M * N1 * 2 == 384 * MiB && (size_t)M * NGU * 2 == 688 * MiB && (size_t)M * FF * 2 == 344 * MiB && (size_t)IN_COLS * D * 2 == 112 * MiB && (size_t)NGU * D * 2 == 172 * MiB && (size_t)D * FF * 2 == 86 * MiB, "sizes");
constexpr int CW_BAR = 4096;

constexpr int RING_OFF = 0, RING_BYTES = 136 * 1024;
constexpr int LDSCTL_OFF = RING_BYTES, MISC_OFF = LDSCTL_OFF + 320;
constexpr int LDS_BYTES = 147456;
static_assert(MISC_OFF + 128 <= LDS_BYTES && 8 * 16640 <= RING_BYTES, "LDS map");

#define GAS __attribute__((address_space(1)))
#define LAS __attribute__((address_space(3)))
typedef unsigned short bf16;
typedef unsigned v4u __attribute__((ext_vector_type(4)));
typedef unsigned v2u __attribute__((ext_vector_type(2)));
typedef float f32x4 __attribute__((ext_vector_type(4)));
typedef float f32x16 __attribute__((ext_vector_type(16)));
typedef short bf16x8 __attribute__((ext_vector_type(8)));
typedef GAS unsigned gu32;
#define RLX_AGENT __ATOMIC_RELAXED, __HIP_MEMORY_SCOPE_AGENT
#define LDS_WAIT() asm volatile("s_waitcnt lgkmcnt(0)" ::: "memory")
#define VM_WAIT() asm volatile("s_waitcnt vmcnt(0)" ::: "memory")
__device__ __forceinline__ unsigned pk2(float lo, float hi) { return pg8::cvt_pk_bf16(lo, hi); }
__device__ __forceinline__ float bflo(unsigned w) { return __uint_as_float(w << 16); }
__device__ __forceinline__ float bfhi(unsigned w) { return __uint_as_float(w & 0xffff0000u); }
__device__ __forceinline__ void unpack8(const v4u w, float (&f)[8]) { f[0] = bflo(w.x); f[1] = bfhi(w.x); f[2] = bflo(w.y); f[3] = bfhi(w.y); f[4] = bflo(w.z); f[5] = bfhi(w.z); f[6] = bflo(w.w); f[7] = bfhi(w.w); }

#define XB_TMO      128
#define XB_XCNT(j)  (256  + 64 * (j))
#define XB_XSUB(j)  (1280 + 64 * (j))
#define XB_XGEN(j)  (2304 + 64 * (j))
#define XB_TOP      3328
#define XB_TOPGEN   3392
#define XCD_BAR_WORDS 3456
#define XB_SPIN_CAP (1u << 18)

__device__ __forceinline__ unsigned xb_ld(unsigned* p)              { return __hip_atomic_load(p, __ATOMIC_RELAXED, __HIP_MEMORY_SCOPE_AGENT); }
__device__ __forceinline__ unsigned xb_add(unsigned* p, unsigned v) { return __hip_atomic_fetch_add(p, v, __ATOMIC_RELAXED, __HIP_MEMORY_SCOPE_AGENT); }
__device__ __forceinline__ unsigned xb_xcc_id() { return (unsigned)__builtin_amdgcn_s_getreg((3 << 11) | 20) & 0xFu; }
#define XB_SPIN(cond, bar) do { unsigned _sp = 0; while (cond) { __builtin_amdgcn_s_sleep(1); \
    if ((++_sp & 255u) == 0u) { if (xb_ld(&(bar)[XB_TMO])) break; if (_sp > XB_SPIN_CAP) { atomicAdd(&(bar)[XB_TMO], 1u); break; } } } } while (0)

struct XcdBarrier {
    unsigned* bar; unsigned x;
    volatile LAS unsigned* st;
};
__device__ __forceinline__ XcdBarrier xcd_barrier_post(unsigned* bar, volatile LAS unsigned* st, bool is_t0) {
    XcdBarrier b; b.bar = bar; b.x = xb_xcc_id(); b.st = st;
    if (is_t0) (void)xb_add(&bar[XB_XCNT(b.x)], 1u);
    return b;
}
__device__ __forceinline__ void xcd_barrier_complete(unsigned* bar, unsigned x, unsigned& nloc, unsigned& nx) {
    const unsigned G = gridDim.x * gridDim.y * gridDim.z;
    unsigned sum, cnt, mine, sp = 0u;
    for (;;) {
        sum = 0u; cnt = 0u; mine = 0u;
#pragma unroll
        for (unsigned j = 0; j < 16; ++j) { const unsigned c = xb_ld(&bar[XB_XCNT(j)]); sum += c; cnt += (c > 0u) ? 1u : 0u; mine = (j == x) ? c : mine; }
        if (sum == G) break;
        __builtin_amdgcn_s_sleep(1);
        if ((++sp & 255u) == 0u) { if (xb_ld(&bar[XB_TMO])) break; if (sp > XB_SPIN_CAP) { atomicAdd(&bar[XB_TMO], 1u); break; } }
    }
    nloc = mine > 0u ? mine : 1u; nx = cnt > 0u ? cnt : 1u;
}
__device__ __forceinline__ void xcd_barrier(const XcdBarrier& b, bool is_t0) {
    asm volatile("s_waitcnt vmcnt(0)" ::: "memory");
    __syncthreads();
    if (is_t0) {
        unsigned* bar = b.bar;
        __builtin_amdgcn_s_waitcnt(0);
        unsigned nloc = b.st[0], nx = b.st[1];
        if (nloc == 0u) { xcd_barrier_complete(bar, b.x, nloc, nx); b.st[0] = nloc; b.st[1] = nx; }
        const unsigned old = xb_add(&bar[XB_XSUB(b.x)], 1u);
        const unsigned gen = old / nloc;
        if (old + 1u == (gen + 1u) * nloc) {
            __builtin_amdgcn_fence(__ATOMIC_RELEASE, "agent");
            asm volatile("s_waitcnt vmcnt(0)" ::: "memory");
            const unsigned og = xb_add(&bar[XB_TOP], 1u);
            const unsigned tg = og / nx;
            if (og + 1u == (tg + 1u) * nx) xb_add(&bar[XB_TOPGEN], 1u);
            else XB_SPIN(xb_ld(&bar[XB_TOPGEN]) == tg, bar);
            __builtin_amdgcn_fence(__ATOMIC_ACQUIRE, "agent");
            xb_add(&bar[XB_XGEN(b.x)], 1u);
            asm volatile("s_waitcnt vmcnt(0)" ::: "memory");
        } else {
            XB_SPIN(xb_ld(&bar[XB_XGEN(b.x)]) == gen, bar);
            __builtin_amdgcn_fence(__ATOMIC_ACQUIRE, "agent");
            asm volatile("s_waitcnt vmcnt(0)" ::: "memory");
        }
    }
    __syncthreads();
}

struct Args { const void* in[17]; float* out; unsigned char* ws; int ph_lo, ph_hi; };
static_assert(sizeof(Args) == 17 * 8 + 8 + 8 + 8, "Args has no padding");
struct Frame {
    LAS unsigned char* lds;
    int tid, lane, wave;
    int vcu, G;
    const __attribute__((address_space(4))) Args* ap;
};
#define F_x ((const float*)(const GAS float*)F.ap->in[0])
#define F_pos ((const int*)(const GAS int*)F.ap->in[1])
#define F_norm1_g ((const float*)(const GAS float*)F.ap->in[2])
#define F_w_in ((const float*)(const GAS float*)F.ap->in[3])
#define F_conv_a_w ((const float*)(const GAS float*)F.ap->in[4])
#define F_conv_a_b ((const float*)(const GAS float*)F.ap->in[5])
#define F_beta_a ((const float*)(const GAS float*)F.ap->in[6])
#define F_dlogit ((const float*)(const GAS float*)F.ap->in[7])
#define F_gn_g ((const float*)(const GAS float*)F.ap->in[8])
#define F_w_out ((const float*)(const GAS float*)F.ap->in[9])
#define F_norm2_g ((const float*)(const GAS float*)F.ap->in[10])
#define F_w_gate ((const float*)(const GAS float*)F.ap->in[11])
#define F_w_up ((const float*)(const GAS float*)F.ap->in[12])
#define F_ffn_w ((const float*)(const GAS float*)F.ap->in[13])
#define F_ffn_b ((const float*)(const GAS float*)F.ap->in[14])
#define F_w_down ((const float*)(const GAS float*)F.ap->in[15])
#define F_norm_f ((const float*)(const GAS float*)F.ap->in[16])
#define F_out ((float*)(GAS float*)F.ap->out)
#define F_rstd1 ((float*)(GAS float*)(F.ap->ws + WS_RSTD1))
#define F_rstd2 ((float*)(GAS float*)(F.ap->ws + WS_RSTD2))
#define F_lgam ((float*)(GAS float*)(F.ap->ws + WS_LGAM))
#define F_part ((float*)(GAS float*)(F.ap->ws + WS_PART))
#define F_rs8 ((float*)(GAS float*)(F.ap->ws + WS_RS8))
#define F_rs8p ((float*)(GAS float*)(F.ap->ws + WS_RS8 + 64 * 1024))
#define F_xq8p ((unsigned char*)(GAS unsigned char*)(F.ap->ws + WS_YCAT))
#define F_wsq ((float*)(GAS float*)(F.ap->ws + WS_WSQ))
#define F_xq8 ((unsigned char*)(GAS unsigned char*)(F.ap->ws + WS_GU))
#define F_wabs ((unsigned*)(GAS unsigned*)(F.ap->ws) + WABS_WORD)
#define F_cosb ((float*)(GAS float*)(F.ap->ws + WS_COS))
#define F_sinb ((float*)(GAS float*)(F.ap->ws + WS_SIN))
#define F_WIN ((bf16*)(GAS bf16*)(F.ap->ws + WS_WIN))
#define F_WOUT ((bf16*)(GAS bf16*)(F.ap->ws + WS_WOUT))
#define F_WGU ((bf16*)(GAS bf16*)(F.ap->ws + WS_WGU))
#define F_WDN ((bf16*)(GAS bf16*)(F.ap->ws + WS_WDN))
#define F_XB ((bf16*)(GAS bf16*)(F.ap->ws + WS_XB))
#define F_PROJ ((bf16*)(GAS bf16*)(F.ap->ws + WS_PROJ))
#define F_KFT ((bf16*)(GAS bf16*)(F.ap->ws + WS_KFT))
#define F_KBT ((bf16*)(GAS bf16*)(F.ap->ws + WS_KBT))
#define F_VT ((bf16*)(GAS bf16*)(F.ap->ws + WS_VT))
#define F_SFT ((bf16*)(GAS bf16*)(F.ap->ws + WS_SFT))
#define F_SBT ((bf16*)(GAS bf16*)(F.ap->ws + WS_SBT))
#define F_YCAT ((bf16*)(GAS bf16*)(F.ap->ws + WS_YCAT))
#define F_GU ((bf16*)(GAS bf16*)(F.ap->ws + WS_GU))
#define F_HG ((float*)(GAS float*)(F.ap->ws + WS_HG))
#define F_HU ((float*)(GAS float*)(F.ap->ws + WS_HU))
#define F_ACT ((bf16*)(GAS bf16*)(F.ap->ws + WS_ACT))
__device__ __forceinline__ float wave_sum(float v) {
    int ln; asm volatile("v_mbcnt_lo_u32_b32 %0, -1, 0\n\tv_mbcnt_hi_u32_b32 %0, -1, %0" : "=v"(ln));
#pragma unroll
    for (int o = 1; o < 64; o <<= 1) v += __builtin_bit_cast(float, __builtin_amdgcn_ds_bpermute((ln ^ o) << 2, __builtin_bit_cast(int, v)));
    return v;
}

__device__ __forceinline__ void cvt_item(const float* __restrict__ W, int N, const float* __restrict__ gain, bf16* WT, int K, int k0, int n0s, int n0d, LAS float* scr, int lane, bool f8 = false, int kd = -1, float qs = 0.f) {
    if (kd < 0) kd = k0;
    const int r4 = lane >> 4, c4 = (lane & 15) * 4;
    f32x4 v[16];
#pragma unroll
    for (int i = 0; i < 16; ++i) v[i] = *(const f32x4*)(W + (size_t)(k0 + 4 * i + r4) * N + n0s + c4);
#pragma unroll
    for (int i = 0; i < 16; ++i) { const int kk = 4 * i + r4; const float g = gain ? gain[k0 + kk] : 1.0f; LAS float* s = scr + kk * 65 + c4;
        s[0] = v[i].x * g; s[1] = v[i].y * g; s[2] = v[i].z * g; s[3] = v[i].w * g;
        }
    LDS_WAIT(); asm volatile("" ::: "memory");
    const int c = lane & 7;
#pragma unroll
    for (int it = 0; it < 8; ++it) { const int n = (lane >> 3) + 8 * it; const LAS float* s = scr + (8 * c) * 65 + n;
        if (qs > 0.f) {
#define Q8(i) ((int)__builtin_rintf(__builtin_fminf(__builtin_fmaxf(s[(i) * 65] * qs, -127.0f), 127.0f)) & 255)
            v2u o8; o8.x = (unsigned)(Q8(0) | (Q8(1) << 8) | (Q8(2) << 16) | (Q8(3) << 24)); o8.y = (unsigned)(Q8(4) | (Q8(5) << 8) | (Q8(6) << 16) | (Q8(7) << 24));
#undef Q8
            *(v2u*)((unsigned char*)WT + (size_t)(n0d + n) * K + kd + 8 * c) = o8;
        } else if (f8) {
#define W8(i) __builtin_fminf(__builtin_fmaxf(s[(i) * 65] * pg8::F8_WSCALE, -440.0f), 440.0f)
            int t = __builtin_amdgcn_cvt_pk_fp8_f32(W8(0), W8(1), 0, false); t = __builtin_amdgcn_cvt_pk_fp8_f32(W8(2), W8(3), t, true);
            int q = __builtin_amdgcn_cvt_pk_fp8_f32(W8(4), W8(5), 0, false); q = __builtin_amdgcn_cvt_pk_fp8_f32(W8(6), W8(7), q, true);
#undef W8
            v2u o8; o8.x = (unsigned)t; o8.y = (unsigned)q; *(v2u*)((unsigned char*)WT + (size_t)(n0d + n) * K + kd + 8 * c) = o8;
        } else {
        v4u o; o.x = pk2(s[0 * 65], s[1 * 65]); o.y = pk2(s[2 * 65], s[3 * 65]); o.z = pk2(s[4 * 65], s[5 * 65]); o.w = pk2(s[6 * 65], s[7 * 65]);
        *(v4u*)(WT + (size_t)(n0d + n) * K + kd + 8 * c) = o; } }
    LDS_WAIT(); asm volatile("" ::: "memory");
}
__device__ __forceinline__ void cvt_matrix(Frame& F, const float* W, int K, int N, const float* gain, bf16* WT, int dst_row0, bool in_perm, int& it, int it_end_prev, LAS float* scr, int k8 = 0, int n8rows = 0, float qs = 0.f) {
    const int nnb = N / 64, nitems = (K / 64) * nnb, NGW = F.G * NWAVES;
    for (; it < it_end_prev + nitems; it += NGW) {
        const int r = it - it_end_prev, kb = r / nnb, nb = r % nnb; const int n0s = nb * 64; int n0d = dst_row0 + n0s;
        if (dst_row0 < 0) { n0d = (n0s >> 7) * 256 + (dst_row0 == -2 ? 128 : 0) + (n0s & 127); }
        if (in_perm) { const int blk = n0s >> 11, dblk = (blk < 4) ? blk : (blk == 4 ? 5 : (blk == 5 ? 6 : 4)); n0d = dblk * 2048 + (n0s & 2047); }
        const bool f8 = kb * 64 < k8;
        if (n0d < n8rows) cvt_item(W, N, gain, WT, K, kb * 64, n0s, n0d, scr, F.lane, false, -1, qs);
        else if (f8) cvt_item(W, N, gain, WT, k8, kb * 64, n0s, n0d, scr, F.lane, true);
        else cvt_item(W, N, gain, (bf16*)((unsigned char*)WT + (size_t)N * k8), K - k8, kb * 64, n0s, n0d, scr, F.lane, false, kb * 64 - k8);
    }
}

constexpr int WQ_KBLOCKS = 4;
__device__ __forceinline__ float wave_max(float v) {
    int ln; asm volatile("v_mbcnt_lo_u32_b32 %0, -1, 0\n\tv_mbcnt_hi_u32_b32 %0, -1, %0" : "=v"(ln));
#pragma unroll
    for (int o = 1; o < 64; o <<= 1) v = __builtin_fmaxf(v, __builtin_bit_cast(float, __builtin_amdgcn_ds_bpermute((ln ^ o) << 2, __builtin_bit_cast(int, v))));
    return v;
}
__device__ __forceinline__ void wabs_phase(Frame& F) {
    const int gw = F.vcu * NWAVES + F.wave, NGW = F.G * NWAVES, r4 = F.lane >> 4, c4 = (F.lane & 15) * 4;
    for (int l = 0; l < DEPTH; ++l)
        for (int mat = 0; mat < 3; ++mat) {
            const int nnb = (mat == 2) ? in8_of(l) * 4 : gu8_of(l) * 2; if (nnb == 0) continue;
            const int N = (mat == 2) ? IN_COLS : FF; const float* W = (mat == 2) ? F_w_in + (size_t)l * D * IN_COLS : (mat ? F_w_up : F_w_gate) + (size_t)l * D * FF; const float* gain = ((mat == 2) ? F_norm1_g : F_norm2_g) + l * D; float mx = 0.f, sq = 0.f;
            for (int it = gw; it < WQ_KBLOCKS * nnb; it += NGW) { const int kbi = it / nnb, nb = it - kbi * nnb, kb = kbi * ((D / 64) / WQ_KBLOCKS); f32x4 v[16];
#pragma unroll
                for (int i = 0; i < 16; ++i) v[i] = *(const f32x4*)(W + (size_t)(kb * 64 + 4 * i + r4) * N + nb * 64 + c4);
#pragma unroll
                for (int i = 0; i < 16; ++i) { const float g = gain[kb * 64 + 4 * i + r4]; const f32x4 p = v[i] * g; mx = __builtin_fmaxf(mx, __builtin_fmaxf(__builtin_fmaxf(__builtin_fabsf(p.x), __builtin_fabsf(p.y)), __builtin_fmaxf(__builtin_fabsf(p.z), __builtin_fabsf(p.w)))); sq += (p.x * p.x + p.y * p.y) + (p.z * p.z + p.w * p.w); } }
            mx = wave_max(mx); sq = wave_sum(sq); if (F.lane == 0) { __hip_atomic_fetch_max(F_wabs + 4 * l + mat, __float_as_uint(mx), RLX_AGENT); if (gw < 2048) F_wsq[(4 * l + mat) * 2048 + gw] = sq; } }
}
__device__ __forceinline__ float wq_range(Frame& F, int l, int mat) {
    const int NGW = F.G * NWAVES; float s = 0.f;
    for (int i = F.lane; i < NGW && i < 2048; i += 64) s += F_wsq[(4 * l + mat) * 2048 + i];
    s = wave_sum(s); const float cnt = (float)(WQ_KBLOCKS * 64) * (float)((mat == 2) ? in8_of(l) * 256 : gu8_of(l) * 128);
    return __builtin_fmaxf(__builtin_fminf(__uint_as_float(__hip_atomic_load(F_wabs + 4 * l + mat, RLX_AGENT)), 4.25f * sqrtf(s / cnt)), 1e-30f);
}
__device__ __forceinline__ void p5_i8_phase(Frame& F, float* rstd_out, unsigned char* q_out, float* tab_out, float tsc) {
    const int gw = F.vcu * NWAVES + F.wave, NGW = F.G * NWAVES;
    float pcur = 0.f; v4u w[8];
    if (gw < M) { pcur = F_part[(size_t)gw * 64 + F.lane]; const bf16* xr = F_XB + (size_t)gw * D + 8 * F.lane;
#pragma unroll
        for (int j = 0; j < 8; ++j) w[j] = *(const v4u*)(xr + 512 * j); }
    for (int row = gw; row < M; row += NGW) {
        const int nrow = row + NGW; const bool hasn = nrow < M; float pnext = 0.f; v4u wn[8];
        if (hasn) { pnext = F_part[(size_t)nrow * 64 + F.lane]; const bf16* xn = F_XB + (size_t)nrow * D + 8 * F.lane;
#pragma unroll
            for (int j = 0; j < 8; ++j) wn[j] = *(const v4u*)(xn + 512 * j); }
        const float s = wave_sum(pcur); const float rstd = 1.0f / sqrtf(s * (1.0f / D) + EPS);
        float mx = 0.f;
#pragma unroll
        for (int j = 0; j < 8; ++j) { float v[8]; unpack8(w[j], v);
#pragma unroll
            for (int e = 0; e < 8; ++e) mx = __builtin_fmaxf(mx, __builtin_fabsf(v[e])); }
        mx = wave_max(mx); const float qs = mx > 0.f ? 127.0f / mx : 0.f;
        unsigned char* qr = q_out + (size_t)row * D + 8 * F.lane;
#pragma unroll
        for (int j = 0; j < 8; ++j) { float v[8]; unpack8(w[j], v);
#define Q8(i) ((int)__builtin_rintf(v[i] * qs) & 255)
            v2u o; o.x = (unsigned)(Q8(0) | (Q8(1) << 8) | (Q8(2) << 16) | (Q8(3) << 24)); o.y = (unsigned)(Q8(4) | (Q8(5) << 8) | (Q8(6) << 16) | (Q8(7) << 24));
#undef Q8
            *(v2u*)(qr + 512 * j) = o; }
        if (F.lane == 0) { rstd_out[row] = rstd; tab_out[row] = rstd * mx * (1.0f / 127.0f) * tsc; }
        if (hasn) { pcur = pnext;
#pragma unroll
            for (int j = 0; j < 8; ++j) w[j] = wn[j]; } }
}
__device__ __forceinline__ void rstd_from_part(Frame& F, float* rstd) {
    const int gw = F.vcu * NWAVES + F.wave, NGW = F.G * NWAVES;
    for (int row = gw; row < M; row += NGW) { const float s = wave_sum(F_part[(size_t)row * 64 + F.lane]); if (F.lane == 0) rstd[row] = 1.0f / sqrtf(s * (1.0f / D) + EPS); }
}
__device__ __forceinline__ void p0_phase(Frame& F, int l) {
    LAS float* scr = (LAS float*)(F.lds + RING_OFF + F.wave * 16640);
    const int gw = F.vcu * NWAVES + F.wave, NGW = F.G * NWAVES;
    int it = gw, base = 0;
    cvt_matrix(F, F_w_in + (size_t)l * D * IN_COLS, D, IN_COLS, F_norm1_g + l * D, F_WIN, 0, true, it, base, scr, 0, in8_of(l) * 256, in8_of(l) > 0 ? 127.0f / wq_range(F, l, 2) : 0.f); base += (D / 64) * (IN_COLS / 64);
    cvt_matrix(F, F_w_out + (size_t)l * D * D, D, D, nullptr, F_WOUT, 0, false, it, base, scr); base += (D / 64) * (D / 64);
    cvt_matrix(F, F_w_gate + (size_t)l * D * FF, D, FF, F_norm2_g + l * D, F_WGU, -1, false, it, base, scr, 0, gu8_of(l) * 256, gu8_of(l) > 0 ? 127.0f / __builtin_fmaxf(wq_range(F, l, 0), 1e-30f) : 0.f); base += (D / 64) * (FF / 64);
    cvt_matrix(F, F_w_up + (size_t)l * D * FF, D, FF, F_norm2_g + l * D, F_WGU, -2, false, it, base, scr, 0, gu8_of(l) * 256, gu8_of(l) > 0 ? 127.0f / __builtin_fmaxf(wq_range(F, l, 1), 1e-30f) : 0.f); base += (D / 64) * (FF / 64);
    cvt_matrix(F, F_w_down + (size_t)l * FF * D, FF, D, nullptr, F_WDN, 0, false, it, base, scr, k8_of(l));
    if (l == 0) {
        for (int m = gw; m < M; m += NGW) { const float* xr = F_x + (size_t)m * D + 8 * F.lane; f32x4 v[16]; float ss = 0.f;
#pragma unroll
            for (int j = 0; j < 8; ++j) { v[2 * j] = *(const f32x4*)(xr + 512 * j); v[2 * j + 1] = *(const f32x4*)(xr + 512 * j + 4); }
#pragma unroll
            for (int j = 0; j < 16; ++j) ss += (v[j].x * v[j].x + v[j].y * v[j].y) + (v[j].z * v[j].z + v[j].w * v[j].w);
            ss = wave_sum(ss); if (F.lane == 0) F_rstd1[m] = 1.0f / sqrtf(ss * (1.0f / D) + EPS);
            bf16* o = F_XB + (size_t)m * D + 8 * F.lane;
#pragma unroll
            for (int j = 0; j < 8; ++j) *(v4u*)(o + 512 * j) = pg8::pack8(v[2 * j], v[2 * j + 1]); }
        { const int gt = gw * 64 + F.lane, NT = NGW * 64; const int j = gt & 127;
          const float inv = exp2f(-(float)j * (13.287712379549449f / 128.0f));
          for (int idx = gt; idx < M * 128; idx += NT) { const int m = idx >> 7; const float ang = (float)F_pos[m] * inv;
              const double a = (double)ang, k = rint(a * 0.15915494309189535), r = a - k * 6.283185307179586; const float rf = (float)r;
              const float c = cosf(rf), s = sinf(rf);
              F_cosb[idx] = c; F_sinb[idx] = s; } }
        if (blockIdx.x == 0 && F.tid < DEPTH * 2 * RH) { const float xl = F_dlogit[F.tid]; const float t = __expf(-xl);
            const float ser = t * (1.0f - t * (0.5f - t * (0.33333334f - t * (0.25f - t * 0.2f)))); F_lgam[F.tid] = -((t < 0.04f) ? ser : __logf(1.0f + t)); }
    } else if (in8_of(l) > 0) p5_i8_phase(F, F_rstd1, F_xq8p, F_rs8p, wq_range(F, l, 2) * (1.0f / 127.0f));
    else rstd_from_part(F, F_rstd1);
}

__device__ __forceinline__ void mixer_a(Frame& F, int l) {
    const int gw = F.vcu * NWAVES + F.wave, NGW = F.G * NWAVES;
    for (int item = gw; item < (M / 32) * 4; item += NGW) {
        const int t0 = (item >> 2) * 32, c0 = (item & 3) * 512 + F.lane * 8;
        float w0[8], w1[8], w2[8], bb[8], be[8];
        { const float* cw = F_conv_a_w + (size_t)l * 3 * CW + c0; const float* cb = F_conv_a_b + (size_t)l * CW + c0; const float* bt = F_beta_a + (size_t)l * CW + c0;
#pragma unroll
          for (int j = 0; j < 8; ++j) { w0[j] = cw[j]; w1[j] = cw[CW + j]; w2[j] = cw[2 * CW + j]; bb[j] = cb[j]; be[j] = bt[j]; } }
        const bf16* pbase = F_PROJ + c0;
        float pp[8], pc[8];
        if ((t0 & (SEQ - 1)) == 0) {
#pragma unroll
            for (int j = 0; j < 8; ++j) pp[j] = 0.f;
        } else { float a[8], b[8]; unpack8(*(const v4u*)(pbase + (size_t)(t0 - 1) * N1 + COL_AC), a); unpack8(*(const v4u*)(pbase + (size_t)(t0 - 1) * N1 + COL_AX), b);
#pragma unroll
            for (int j = 0; j < 8; ++j) pp[j] = a[j] * b[j]; }
        { float a[8], b[8]; unpack8(*(const v4u*)(pbase + (size_t)t0 * N1 + COL_AC), a); unpack8(*(const v4u*)(pbase + (size_t)t0 * N1 + COL_AX), b);
#pragma unroll
          for (int j = 0; j < 8; ++j) pc[j] = a[j] * b[j]; }
        for (int t = t0; t < t0 + 32; t += 4) {
            v4u ac[4], ax[4], ab[4];
#pragma unroll
            for (int k = 0; k < 4; ++k) { const int tn = t + k + 1; const bool z = (tn & (SEQ - 1)) == 0;
                ac[k] = z ? (v4u){0u, 0u, 0u, 0u} : *(const v4u*)(pbase + (size_t)tn * N1 + COL_AC); ax[k] = z ? (v4u){0u, 0u, 0u, 0u} : *(const v4u*)(pbase + (size_t)tn * N1 + COL_AX);
                ab[k] = *(const v4u*)(pbase + (size_t)(t + k) * N1 + COL_AB); }
#pragma unroll
            for (int k = 0; k < 4; ++k) {
                float pn[8], fa[8], fx[8], fb[8], y[8]; unpack8(ac[k], fa); unpack8(ax[k], fx); unpack8(ab[k], fb); float ss = 0.f;
#pragma unroll
                for (int j = 0; j < 8; ++j) { pn[j] = fa[j] * fx[j]; y[j] = fb[j] * (w0[j] * pp[j] + w1[j] * pc[j] + w2[j] * pn[j] + bb[j]); ss += y[j] * y[j]; }
                ss += __shfl_xor(ss, 1); ss += __shfl_xor(ss, 2); ss += __shfl_xor(ss, 4); ss += __shfl_xor(ss, 8);
                const float r = 1.0f / sqrtf(ss * (1.0f / 128.0f) + EPS);
                v4u o; o.x = pk2(y[0] * r * be[0], y[1] * r * be[1]); o.y = pk2(y[2] * r * be[2], y[3] * r * be[3]); o.z = pk2(y[4] * r * be[4], y[5] * r * be[5]); o.w = pk2(y[6] * r * be[6], y[7] * r * be[7]);
                *(v4u*)(F_YCAT + (size_t)(t + k) * D + c0) = o;
#pragma unroll
                for (int j = 0; j < 8; ++j) { pp[j] = pc[j]; pc[j] = pn[j]; } }
        }
    }
}

#define MFMA32(a, b, c) __builtin_amdgcn_mfma_f32_32x32x16_bf16((a), (b), (c), 0, 0, 0)
__device__ __forceinline__ void scan_dma(const char* kt, const char* vt, LAS unsigned char* dst, int w, int lane) {
#pragma unroll
    for (int q = 0; q < 4; ++q) { __builtin_amdgcn_global_load_lds((const unsigned*)(kt + q * 8192), (LAS unsigned*)(dst + q * 8192 + w * 1024), 16, 0, 0);
        __builtin_amdgcn_global_load_lds((const unsigned*)(vt + q * 8192), (LAS unsigned*)(dst + 32768 + q * 8192 + w * 1024), 16, 0, 0); }
}
__device__ __forceinline__ void scan_phase(Frame& F, int l) {
    LAS unsigned char* BUF = F.lds + RING_OFF;
    const int w = F.wave, dbl = w & 3, eql = w >> 2;
    for (int unit = F.vcu; unit < BATCH * RH * 2 * 2 * 2; unit += F.G) {
        const int eh2 = unit & 1, dq = (unit >> 1) & 1, dir = (unit >> 2) & 1, h = (unit >> 3) & 7, b = unit >> 6;
        const size_t blk0 = (size_t)(b * RH + h) * NCH * (HD * CHUNK);
        const char* KT = (const char*)((dir ? F_KBT : F_KFT) + blk0) + (size_t)((4 * dq * 8 + w) * 64 + F.lane) * 16;
        const char* VT = (const char*)(F_VT + blk0) + (size_t)((4 * eh2 * 8 + w) * 64 + F.lane) * 16;
        const int eq = 2 * eh2 + eql, dblk = 4 * dq + dbl;
        bf16* ST = (dir ? F_SBT : F_SFT) + (size_t)(b * RH + h) * NCH * (HD * HD) + (size_t)(((2 * eq) * 16 + 2 * dblk) * 64 + F.lane) * 8;
        const float g128 = __expf(128.0f * F_lgam[l * 16 + dir * 8 + h]);
        f32x16 s0, s1;
#pragma unroll
        for (int r = 0; r < 16; ++r) { s0[r] = 0.f; s1[r] = 0.f; }
        __syncthreads();
        { const int n0 = dir ? (NCH - 1) : 0; scan_dma(KT + (size_t)n0 * HD * CHUNK * 2, VT + (size_t)n0 * HD * CHUNK * 2, BUF, w, F.lane); }
        for (int step = 0; step < NCH; ++step) {
            const int n = dir ? (NCH - 1 - step) : step, nn = dir ? (n - 1) : (n + 1);
            VM_WAIT(); __syncthreads();
            if (step + 1 < NCH) scan_dma(KT + (size_t)nn * HD * CHUNK * 2, VT + (size_t)nn * HD * CHUNK * 2, BUF + ((step + 1) & 1) * 65536, w, F.lane);
            bf16* st = ST + (size_t)n * HD * HD;
#pragma unroll
            for (int sp = 0; sp < 2; ++sp) {
                v4u a; a.x = pk2(s0[8 * sp], s0[8 * sp + 1]); a.y = pk2(s0[8 * sp + 2], s0[8 * sp + 3]); a.z = pk2(s0[8 * sp + 4], s0[8 * sp + 5]); a.w = pk2(s0[8 * sp + 6], s0[8 * sp + 7]);
                *(v4u*)(st + sp * 512) = a;
                v4u c; c.x = pk2(s1[8 * sp], s1[8 * sp + 1]); c.y = pk2(s1[8 * sp + 2], s1[8 * sp + 3]); c.z = pk2(s1[8 * sp + 4], s1[8 * sp + 5]); c.w = pk2(s1[8 * sp + 6], s1[8 * sp + 7]);
                *(v4u*)(st + 16 * 512 + sp * 512) = c; }
#pragma unroll
            for (int r = 0; r < 16; ++r) { s0[r] *= g128; s1[r] *= g128; }
            const LAS unsigned char* kb = BUF + (step & 1) * 65536 + (dbl * 8 * 64 + F.lane) * 16; const LAS unsigned char* vb = BUF + (step & 1) * 65536 + 32768 + (2 * eql * 8 * 64 + F.lane) * 16;
#pragma unroll
            for (int ks = 0; ks < 8; ++ks) { const bf16x8 a = *(const LAS bf16x8*)(kb + ks * 1024), b0 = *(const LAS bf16x8*)(vb + ks * 1024), b1 = *(const LAS bf16x8*)(vb + 8192 + ks * 1024);
                s0 = MFMA32(a, b0, s0); s1 = MFMA32(a, b1, s1); }
        }
    }
    VM_WAIT(); __syncthreads();
}

__device__ __forceinline__ void dma16(const char* g, LAS unsigned char* l) { __builtin_amdgcn_global_load_lds((const unsigned*)g, (LAS unsigned*)l, 16, 0, 0); }
__device__ __forceinline__ void intra_dma(Frame& F, const int kind, const int p, LAS unsigned char* dst, int b, int h, int n, int w, int lane) {
    const int tok0 = b * SEQ + n * CHUNK;
    if (kind == 4) {
        const char* g0 = (const char*)F_VT + (((size_t)(b * RH + h) * NCH + n) * (HD * CHUNK)) * 2 + (size_t)(w * 64 + lane) * 16;
#pragma unroll
        for (int q = 0; q < 4; ++q) dma16(g0 + (size_t)(4 * (q >> 1) + 2 * p + (q & 1)) * 8192, dst + q * 8192 + w * 1024);
    } else if (kind == 2 || kind == 3) {
        const char* g0 = (const char*)(kind == 2 ? F_SFT : F_SBT) + ((size_t)(b * RH + h) * NCH + n) * HD * HD * 2 + (size_t)lane * 16;
#pragma unroll
        for (int q = 0; q < 4; ++q) { const int idx = q * 8 + w, ehl = idx >> 4, sx = idx & 15; dma16(g0 + (size_t)(((4 * ehl + p) * 16 + sx) * 1024), dst + q * 8192 + w * 1024); }
    } else {
        const int r0 = w * 2 + (lane >> 5), c = (lane & 31) ^ (r0 & 15);
        const char* g0 = (const char*)F_PROJ + ((size_t)(tok0 + (kind == 1 ? 64 * p : 0) + r0) * N1 + (kind == 0 ? COL_Q : COL_K) + h * HD) * 2 + c * 16;
#pragma unroll
        for (int q = 0; q < (kind == 0 ? 8 : 4); ++q) dma16(g0 + (size_t)q * 16 * N1 * 2, dst + q * 8192 + w * 1024);
    }
}
__device__ __forceinline__ void intra_phase(Frame& F, int l) {
    LAS unsigned char* QS = F.lds + RING_OFF; LAS unsigned char* BUF = QS + 65536; LAS float* red1 = (LAS float*)(QS + 131072); LAS float* red2 = red1 + 256;
    const int w = F.wave, ib = w & 3, eh = w >> 2, li = F.lane & 31, hh = F.lane >> 5, sw = li & 15, yx = hh ^ sw;
    const float L2E = 1.4426950408889634f;
    const int nun = BATCH * RH * NCH;
    if (F.vcu < nun) { const int u0 = F.vcu; intra_dma(F, 0, 0, QS, u0 >> 8, (u0 >> 5) & 7, u0 & 31, w, F.lane); intra_dma(F, 1, 0, BUF, u0 >> 8, (u0 >> 5) & 7, u0 & 31, w, F.lane); }
    for (int unit = F.vcu; unit < nun; unit += F.G) {
        const int n = unit & 31, h = (unit >> 5) & 7, b = unit >> 8;
        const int nxt = unit + F.G; const bool has_next = nxt < nun; const int n2 = nxt & 31, h2 = (nxt >> 5) & 7, b2 = nxt >> 8;
        int i = 32 * ib + li; asm volatile("" : "+v"(i));
        const int tok0 = b * SEQ + n * CHUNK, tok = tok0 + i;
        const float lf = F_lgam[l * 16 + h], lb = F_lgam[l * 16 + 8 + h];
        const float lf2 = lf * L2E, lb2 = lb * L2E;
        const LAS unsigned char* qrow = QS + (32 * ib + li) * 512;
#define QF(s) (*(const LAS bf16x8*)(qrow + (((2 * (s)) ^ yx) << 4)))
        bf16x8 pf[4][2];
        f32x16 acc[4];
#pragma unroll
        for (int et = 0; et < 4; ++et)
#pragma unroll
            for (int r = 0; r < 16; ++r) acc[et][r] = 0.f;
#pragma unroll
        for (int t = 0; t < 12; ++t) {
            VM_WAIT(); __syncthreads();
            LAS unsigned char* nb = BUF + ((t + 1) & 1) * 32768; const LAS unsigned char* cb = BUF + (t & 1) * 32768;
            int ln = F.lane; asm volatile("" : "+v"(ln));
            if (t < 11) { const int t1 = t + 1; intra_dma(F, t1 < 2 ? 1 : (t1 < 6 ? 2 : (t1 < 10 ? 3 : 4)), t1 < 2 ? t1 : (t1 < 6 ? t1 - 2 : (t1 < 10 ? t1 - 6 : t1 - 10)), nb, b, h, n, w, ln); }
            else if (has_next) intra_dma(F, 1, 0, nb, b2, h2, n2, w, ln);
            if (t == 10 && has_next) intra_dma(F, 0, 0, QS, b2, h2, n2, w, ln);
            if (t < 2) {
#pragma unroll
                for (int jtl = 0; jtl < 2; ++jtl) { const int jt = 2 * t + jtl; const LAS unsigned char* krow = cb + (32 * jtl + li) * 512;
                    f32x16 sc;
#pragma unroll
                    for (int r = 0; r < 16; ++r) sc[r] = 0.f;
#pragma unroll
                    for (int s = 0; s < 16; ++s) { const bf16x8 a = *(const LAS bf16x8*)(krow + (((2 * s) ^ yx) << 4)); sc = MFMA32(a, QF(s), sc); }
#pragma unroll
                    for (int s2 = 0; s2 < 2; ++s2) {
                        float pv[8];
#pragma unroll
                        for (int jj = 0; jj < 8; ++jj) { const int r = 8 * s2 + jj; const int j = 32 * jt + (r & 3) + 8 * (r >> 2) + 4 * hh; const int dd = i - j;
                            const float e = (dd >= 0) ? lf2 * (float)dd : lb2 * (float)(-dd); pv[jj] = sc[r] * exp2f(e); }
                        v4u pw; pw.x = pk2(pv[0], pv[1]); pw.y = pk2(pv[2], pv[3]); pw.z = pk2(pv[4], pv[5]); pw.w = pk2(pv[6], pv[7]);
                        pf[jt][s2] = __builtin_bit_cast(bf16x8, pw); } }
            } else if (t < 10) {
                const int et = (t - 2) & 3; const LAS unsigned char* srow = cb + (eh * 16 * 64 + F.lane) * 16;
#pragma unroll
                for (int s = 0; s < 16; ++s) { const bf16x8 a = *(const LAS bf16x8*)(srow + s * 1024); acc[et] = MFMA32(a, QF(s), acc[et]); }
                if (t == 5) { const float ratio = __expf(lf * (float)(i + 1) - lb * (float)(CHUNK - i));
#pragma unroll
                    for (int e2 = 0; e2 < 4; ++e2)
#pragma unroll
                        for (int r = 0; r < 16; ++r) acc[e2][r] *= ratio; }
                if (t == 9) { const float wb = __expf(lb * (float)(CHUNK - i));
#pragma unroll
                    for (int e2 = 0; e2 < 4; ++e2)
#pragma unroll
                        for (int r = 0; r < 16; ++r) acc[e2][r] *= wb; }
            } else {
                const int p = t - 10;
#pragma unroll
                for (int etl = 0; etl < 2; ++etl) { const int et = 2 * p + etl; const LAS unsigned char* vrow = cb + ((2 * eh + etl) * 8 * 64 + F.lane) * 16;
#pragma unroll
                    for (int jt = 0; jt < 4; ++jt)
#pragma unroll
                        for (int s2 = 0; s2 < 2; ++s2) { const bf16x8 a = *(const LAS bf16x8*)(vrow + (2 * jt + s2) * 1024); acc[et] = MFMA32(a, pf[jt][s2], acc[et]); } }
            }
        }
#undef QF
        float s = 0.f;
#pragma unroll
        for (int et = 0; et < 4; ++et)
#pragma unroll
            for (int r = 0; r < 16; ++r) s += acc[et][r];
        s += __shfl_xor(s, 32);
        if (hh == 0) red1[w * 32 + li] = s;
        LDS_WAIT(); __syncthreads();
        const float mean = (red1[ib * 32 + li] + red1[(ib + 4) * 32 + li]) * (1.0f / HD);
        float q = 0.f;
#pragma unroll
        for (int et = 0; et < 4; ++et)
#pragma unroll
            for (int r = 0; r < 16; ++r) { const float dlt = acc[et][r] - mean; q += dlt * dlt; }
        q += __shfl_xor(q, 32);
        if (hh == 0) red2[w * 32 + li] = q;
        LDS_WAIT(); __syncthreads();
        const float rstd = 1.0f / sqrtf((red2[ib * 32 + li] + red2[(ib + 4) * 32 + li]) * (1.0f / HD) + EPS);
        { const float* gn = F_gn_g + (size_t)l * RW + h * HD; const bf16* gp = F_PROJ + (size_t)tok * N1 + COL_G + h * HD; bf16* yp = F_YCAT + (size_t)tok * D + CW + h * HD;
          f32x4 gv[4][4]; v2u gw2[4][4];
#pragma unroll
          for (int et = 0; et < 4; ++et)
#pragma unroll
              for (int g = 0; g < 4; ++g) { const int e4 = 128 * eh + 32 * et + 8 * g + 4 * hh; gv[et][g] = *(const f32x4*)(gn + e4); gw2[et][g] = *(const v2u*)(gp + e4); }
          asm volatile("" : "+v"(gv[0][0]), "+v"(gv[0][1]), "+v"(gv[0][2]), "+v"(gv[0][3]), "+v"(gv[1][0]), "+v"(gv[1][1]), "+v"(gv[1][2]), "+v"(gv[1][3]),
                            "+v"(gv[2][0]), "+v"(gv[2][1]), "+v"(gv[2][2]), "+v"(gv[2][3]), "+v"(gv[3][0]), "+v"(gv[3][1]), "+v"(gv[3][2]), "+v"(gv[3][3]));
          asm volatile("" : "+v"(gw2[0][0]), "+v"(gw2[0][1]), "+v"(gw2[0][2]), "+v"(gw2[0][3]), "+v"(gw2[1][0]), "+v"(gw2[1][1]), "+v"(gw2[1][2]), "+v"(gw2[1][3]),
                            "+v"(gw2[2][0]), "+v"(gw2[2][1]), "+v"(gw2[2][2]), "+v"(gw2[2][3]), "+v"(gw2[3][0]), "+v"(gw2[3][1]), "+v"(gw2[3][2]), "+v"(gw2[3][3]));
#pragma unroll
          for (int et = 0; et < 4; ++et)
#pragma unroll
              for (int g = 0; g < 4; ++g) { const int e4 = 128 * eh + 32 * et + 8 * g + 4 * hh; const f32x4 gvv = gv[et][g]; const v2u gw = gw2[et][g];
                  const float gt[4] = {bflo(gw.x), bfhi(gw.x), bflo(gw.y), bfhi(gw.y)}; float y[4];
#pragma unroll
                  for (int j = 0; j < 4; ++j) { const float sg = gt[j] * __builtin_amdgcn_rcpf(1.0f + __expf(-gt[j])); y[j] = (acc[et][4 * g + j] - mean) * rstd * gvv[j] * sg; }
                  v2u o; o.x = pk2(y[0], y[1]); o.y = pk2(y[2], y[3]); *(v2u*)(yp + e4) = o; } }
    }
    VM_WAIT(); __syncthreads();
}

__device__ __forceinline__ void act_fix_phase(Frame& F, int l) {
    const int gt = (F.vcu * NWAVES + F.wave) * 64 + F.lane, NT = F.G * NWAVES * 64;
    for (int idx = gt; idx < (M / 256) * 2 * (FF / 8); idx += NT) {
        const int rs = idx / (FF / 8), c0 = (idx - rs * (FF / 8)) * 8, pm = rs >> 1, lastr = rs & 1, r = pm * 256 + (lastr ? 255 : 0);
        const float* hg = F_HG + (size_t)pm * 4 * FF + c0; const float* hu = F_HU + (size_t)(pm * 2 + lastr) * FF + c0;
        const bool zprev = !lastr && (r & (SEQ - 1)) == 0, znext = lastr && ((r + 1) & (SEQ - 1)) == 0;
        const float* gm = lastr ? hg + 2 * FF : hg - FF;
        const float* g0 = lastr ? hg + 3 * FF : hg;
        const float* gp = lastr ? hg + 4 * FF : hg + FF;
        const float* cw = F_ffn_w + (size_t)l * 3 * FF + c0; const float* cb = F_ffn_b + (size_t)l * FF + c0;
        float y[8];
#pragma unroll
        for (int j = 0; j < 8; ++j) { const float a = zprev ? 0.f : gm[j], c = znext ? 0.f : gp[j]; const float z = cw[j] * a + cw[FF + j] * g0[j] + cw[2 * FF + j] * c + cb[j]; y[j] = z / (1.0f + __expf(-z)) * hu[j]; }
        const int k8 = k8_of(l);
        if (c0 < k8) *(v2u*)((unsigned char*)F_ACT + (size_t)r * k8 + c0) = __builtin_bit_cast(v2u, pg8::pack8_fp8((f32x4){y[0], y[1], y[2], y[3]}, (f32x4){y[4], y[5], y[6], y[7]}));
        else { v4u o; o.x = pk2(y[0], y[1]); o.y = pk2(y[2], y[3]); o.z = pk2(y[4], y[5]); o.w = pk2(y[6], y[7]); *(v4u*)((unsigned char*)F_ACT + (size_t)M * k8 + ((size_t)r * (FF - k8) + (c0 - k8)) * 2) = o; }
    }
}

__device__ __forceinline__ void final_phase(Frame& F) {
    const int gw = F.vcu * NWAVES + F.wave, NGW = F.G * NWAVES;
    f32x4 gg[8][2];
    { const float* gr0 = F_norm_f + 8 * F.lane;
#pragma unroll
      for (int j = 0; j < 8; ++j) { gg[j][0] = *(const f32x4*)(gr0 + 512 * j); gg[j][1] = *(const f32x4*)(gr0 + 512 * j + 4); } }
    for (int m = gw; m < M; m += NGW) {
        const float s = wave_sum(F_part[(size_t)m * 64 + F.lane]); const float rs = 1.0f / sqrtf(s * (1.0f / D) + EPS);
        const bf16* xr = F_XB + (size_t)m * D + 8 * F.lane; float* orow = F_out + (size_t)m * D + 8 * F.lane;
        v4u xv[8];
#pragma unroll
        for (int j = 0; j < 8; ++j) xv[j] = *(const v4u*)(xr + 512 * j);
        asm volatile("" : "+v"(xv[0]), "+v"(xv[1]), "+v"(xv[2]), "+v"(xv[3]), "+v"(xv[4]), "+v"(xv[5]), "+v"(xv[6]), "+v"(xv[7]));
#pragma unroll
        for (int j = 0; j < 8; ++j) { float v[8]; unpack8(xv[j], v); const f32x4 g0 = gg[j][0], g1 = gg[j][1];
            *(f32x4*)(orow + 512 * j) = (f32x4){v[0] * rs * g0[0], v[1] * rs * g0[1], v[2] * rs * g0[2], v[3] * rs * g0[3]};
            *(f32x4*)(orow + 512 * j + 4) = (f32x4){v[4] * rs * g1[0], v[5] * rs * g1[1], v[6] * rs * g1[2], v[7] * rs * g1[3]}; }
    }
}

constexpr int PH_PER_LAYER = 9, N_PHASES = DEPTH * PH_PER_LAYER + 1;

__global__ void __launch_bounds__(NWAVES * 64, 2) enc_fwd(Args args) {
    extern __shared__ __attribute__((aligned(16))) unsigned char lds[];
    Frame F;
    F.lds = (LAS unsigned char*)lds;
    volatile LAS unsigned* MISC = (volatile LAS unsigned*)(F.lds + MISC_OFF);
    { int wv = __builtin_amdgcn_readfirstlane((int)threadIdx.x >> 6); asm volatile("" : "+s"(wv)); F.wave = wv; }
    { int ln_; asm volatile("v_mbcnt_lo_u32_b32 %0, -1, 0\n\tv_mbcnt_hi_u32_b32 %0, -1, %0" : "=v"(ln_)); F.lane = ln_; F.tid = F.wave * 64 + ln_; }
    F.G = gridDim.x; { const int bx = blockIdx.x; F.vcu = (F.G % 8 == 0) ? (bx % 8) * (F.G / 8) + bx / 8 : bx; }
    F.ap = (const __attribute__((address_space(4))) Args*)__builtin_amdgcn_kernarg_segment_ptr();
    unsigned char* ws = args.ws;
    for (int u = F.tid; u < (LDS_BYTES - LDSCTL_OFF) / 4; u += NWAVES * 64) ((LAS unsigned*)(F.lds + LDSCTL_OFF))[u] = 0u;
    __syncthreads();
    XcdBarrier bar; bar.bar = (unsigned*)(ws + WS_CTL) + CW_BAR; bar.x = 0; bar.st = nullptr;
#define LAUNDER() do { int ln_; asm volatile("v_mbcnt_lo_u32_b32 %0, -1, 0\n\tv_mbcnt_hi_u32_b32 %0, -1, %0" : "=v"(ln_)); asm volatile("" : "+s"(F.ap)); F.lane = ln_; F.tid = F.wave * 64 + ln_; } while (0)
#if !MK_SPLIT
    bar = xcd_barrier_post((unsigned*)(ws + WS_CTL) + CW_BAR, MISC + 8, F.tid == 0);
#define GRID_BAR() do { asm volatile("" : "+s"(bar.bar));     LAUNDER(); xcd_barrier(bar, F.tid == 0); } while (0)
#else
#define GRID_BAR() do {} while (0)
#endif
    const int lo = args.ph_lo, hi = args.ph_hi;
#define IN(k) (lo <= (k) && (k) < hi)
#define SEAM(k) do { if (IN(k) && IN((k) + 1)) GRID_BAR(); } while (0)
    using namespace pg8;
    if (IN(0) && (GU8_TILES_L0 > 0 || GU8_TILES_L1 > 0 || IN8_TILES_L1 > 0)) { LAUNDER(); wabs_phase(F); GRID_BAR(); }
    for (int l = 0; l < DEPTH; ++l) {
        const int pb = l * PH_PER_LAYER;
#define PT0(k) unsigned long long pt_##k = 0; if (PROBE_PHTIME == (k)) pt_##k = __builtin_amdgcn_s_memrealtime()
#define PT1(k) if (PROBE_PHTIME == (k) && blockIdx.x == 0 && F.tid == 0) MISC[18] += (unsigned)(__builtin_amdgcn_s_memrealtime() - pt_##k)
#define SP0(k) if (PROBE_SPREAD == (k) && F.tid == 0) { const unsigned t = (unsigned)__builtin_amdgcn_s_memrealtime(); gu32* cw = (gu32*)(F.ap->ws) + 2048 + l * 128; __hip_atomic_fetch_max(cw, t, RLX_AGENT); __hip_atomic_fetch_max(cw + 64, 0xFFFFFFFFu - t, RLX_AGENT); }
#define SP1(k) if (PROBE_SPREAD == (k) && blockIdx.x == 0 && F.tid == 0) { gu32* cw = (gu32*)(F.ap->ws) + 2048 + l * 128; const unsigned mx = __hip_atomic_load(cw, RLX_AGENT), mn = 0xFFFFFFFFu - __hip_atomic_load(cw + 64, RLX_AGENT); MISC[19] += mx - mn; }
#define BW0(k) unsigned long long bw_##k = 0; if (PROBE_BWAIT == (k)) bw_##k = __builtin_amdgcn_s_memrealtime()
#define BW1(k) if (PROBE_BWAIT == (k) && blockIdx.x == 0 && F.tid == 0) MISC[20] += (unsigned)(__builtin_amdgcn_s_memrealtime() - bw_##k)
        PT0(0); if (PHON(0) && IN(pb + 0)) { for (int rp = 0; rp < PHREP(0); ++rp) { LAUNDER(); p0_phase(F, l); } } SP0(0); BW0(0); SEAM(pb + 0); BW1(0); PT1(0); SP1(0);
        PT0(1); if (PHON(1) && IN(pb + 1)) for (int rp = 0; rp < PHREP(1); ++rp) { LAUNDER();
            const int ni = in8_of(l);
            if (ni > 0) { Gemm g{(const bf16*)F_xq8p, F_WIN, M, ni * 256, D / 2}; StaticOrder S; S.init(M, ni * 256, F.G, (int)blockIdx.x);
              EpiIn E{F_PROJ, N1, F_rs8p, (PG8_LAS const float*)(F.lds + RING_OFF + ROWTAB_OFF), F_cosb, F_sinb, F_KFT, F_KBT, F_VT, F_lgam + l * 16, 0};
              gemm_phase<EpiIn, StaticOrder, PG8_ALIGN, PG8_SP2, 0, false, true>(F.lds + RING_OFF, g, S, E, F.tid); LAUNDER(); }
            { Gemm g{F_XB, F_WIN + (size_t)ni * 256 * D, M, IN_COLS - ni * 256, D}; StaticOrder S; S.init(M, IN_COLS - ni * 256, F.G, (int)blockIdx.x); EpiIn E{F_PROJ, N1, F_rstd1, (PG8_LAS const float*)(F.lds + RING_OFF + ROWTAB_OFF), F_cosb, F_sinb, F_KFT, F_KBT, F_VT, F_lgam + l * 16, ni};
              gemm_phase<EpiIn, StaticOrder, PG8_ALIGN, PG8_SP2, PROBE_PHASE == 1>(F.lds + RING_OFF, g, S, E, F.tid); }
        } SP0(1); BW0(1); SEAM(pb + 1); BW1(1); PT1(1); SP1(1);
        PT0(2); if (PHON(2) && IN(pb + 2)) { for (int rp = 0; rp < PHREP(2); ++rp) { LAUNDER(); for (int r2 = 0; r2 < PHREP(10); ++r2) mixer_a(F, l); for (int r2 = 0; r2 < PHREP(11); ++r2) scan_phase(F, l); } } SP0(2); BW0(2); SEAM(pb + 2); BW1(2); PT1(2); SP1(2);
        PT0(3); if (PHON(3) && IN(pb + 3)) { for (int rp = 0; rp < PHREP(3); ++rp) { LAUNDER(); intra_phase(F, l); } } SP0(3); BW0(3); SEAM(pb + 3); BW1(3); PT1(3); SP1(3);
        PT0(4); if (PHON(4) && IN(pb + 4)) for (int rp = 0; rp < PHREP(4); ++rp) { LAUNDER(); Gemm g{F_YCAT, F_WOUT, M, D, D}; StaticOrder S; S.init(M, D, F.G, (int)blockIdx.x); EpiRes E{l == 0 ? F_x : nullptr, F_XB, F_part, D, 1.0f};
            gemm_phase<EpiRes, StaticOrder, PG8_ALIGN, PG8_SP2, PROBE_PHASE == 4>(F.lds + RING_OFF, g, S, E, F.tid); } SP0(4); BW0(4); SEAM(pb + 4); BW1(4); PT1(4); SP1(4);
        PT0(5); if (PHON(5) && IN(pb + 5)) { for (int rp = 0; rp < PHREP(5); ++rp) { LAUNDER(); if (gu8_of(l) > 0) p5_i8_phase(F, F_rstd2, F_xq8, F_rs8, 1.0f); else rstd_from_part(F, F_rstd2); } } SP0(5); BW0(5); SEAM(pb + 5); BW1(5); PT1(5); SP1(5);
        PT0(6); if (PHON(6) && IN(pb + 6)) for (int rp = 0; rp < PHREP(6); ++rp) { const int n8 = gu8_of(l);
            if (n8 > 0) { LAUNDER(); Gemm g{(const bf16*)F_xq8, F_WGU, M, n8 * 256, D / 2}; TailOrder S; S.init(M, n8 * 256, F.G, (int)blockIdx.x); S.init2((unsigned*)(F.ap->ws) + 1024 + 64 * l + 32, (volatile PG8_LAS int*)(MISC + 24)); if (F.tid == 0) MISC[24] = 0xffffffffu;
                const float sg = __builtin_fmaxf(wq_range(F, l, 0), 1e-30f) * (1.0f / 127.0f), su = __builtin_fmaxf(wq_range(F, l, 1), 1e-30f) * (1.0f / 127.0f);
                EpiAct E{F_ACT, FF, F_rs8, (PG8_LAS float*)(F.lds + RING_OFF + ROWTAB_OFF), sg, su, 0, k8_of(l), (size_t)M * k8_of(l), F_ffn_w + (size_t)l * 3 * FF, F_ffn_b + (size_t)l * FF, F_HG, F_HU};
                gemm_phase<EpiAct, TailOrder, PG8_ALIGN, PG8_SP2, 0, false, true>(F.lds + RING_OFF, g, S, E, F.tid); }
            if (n8 < NGU / 256) { LAUNDER(); Gemm g{F_XB, F_WGU + (size_t)n8 * 256 * D, M, NGU - n8 * 256, D}; TailOrder S; S.init(M, NGU - n8 * 256, F.G, (int)blockIdx.x); S.init2((unsigned*)(F.ap->ws) + 1024 + 64 * l, (volatile PG8_LAS int*)(MISC + 24)); if (F.tid == 0) MISC[24] = 0xffffffffu;
              EpiAct E{F_ACT, FF, F_rstd2, (PG8_LAS float*)(F.lds + RING_OFF + ROWTAB_OFF), 1.0f, 1.0f, n8, k8_of(l), (size_t)M * k8_of(l), F_ffn_w + (size_t)l * 3 * FF, F_ffn_b + (size_t)l * FF, F_HG, F_HU};
              gemm_phase<EpiAct, TailOrder, PG8_ALIGN, PG8_SP2, PROBE_PHASE == 6>(F.lds + RING_OFF, g, S, E, F.tid); } } SP0(6); BW0(6); SEAM(pb + 6); BW1(6); PT1(6); SP1(6);
#if PROBE_GEMM
        if (IN(pb + 6)) { GRID_BAR(); LAUNDER(); Gemm g{F_XB, F_WGU, M, FF, D}; ProbeOrder S; S.init(M, FF, F.G, (int)blockIdx.x); EpiScale E{F_ACT, FF, F_rstd2, (PG8_LAS const float*)(F.lds + RING_OFF + ROWTAB_OFF)};
            gemm_phase<EpiScale, ProbeOrder, PG8_ALIGN, PG8_SP2>(F.lds + RING_OFF, g, S, E, F.tid); GRID_BAR(); }
#endif
        PT0(7); if (PHON(7) && IN(pb + 7)) { for (int rp = 0; rp < PHREP(7); ++rp) { LAUNDER(); act_fix_phase(F, l); } } SP0(7); BW0(7); SEAM(pb + 7); BW1(7); PT1(7); SP1(7);
        PT0(8); if (PHON(8) && IN(pb + 8)) { LAUNDER(); StaticOrder S; S.init(M, D, F.G, (int)blockIdx.x);
            const int k8 = k8_of(l);
            if (k8 > 0) { Gemm g{F_ACT, F_WDN, M, D, k8 / 2}; EpiRes E{nullptr, F_XB, F_part, D, 1.0f / (F8_ASCALE * F8_WSCALE)};
                gemm_phase<EpiRes, StaticOrder, PG8_ALIGN, PG8_SP2, 0, true>(F.lds + RING_OFF, g, S, E, F.tid); }
            if (k8 < FF) { LAUNDER(); Gemm g{(const bf16*)((const unsigned char*)F_ACT + (size_t)M * k8), (const bf16*)((const unsigned char*)F_WDN + (size_t)D * k8), M, D, FF - k8}; EpiRes E{nullptr, F_XB, F_part, D, 1.0f};
                gemm_phase<EpiRes, StaticOrder, PG8_ALIGN, PG8_SP2, PROBE_PHASE == 8>(F.lds + RING_OFF, g, S, E, F.tid); } } SP0(8); BW0(8); SEAM(pb + 8); BW1(8); PT1(8); SP1(8);
    }
    PT0(9); if (PHON(9) && IN(N_PHASES - 1)) { LAUNDER(); final_phase(F); }
#if PROBE_PHTIME == 9
    GRID_BAR(); PT1(9);
#endif
#if PROBE_BARS
    for (int i = 0; i < PROBE_BARS; ++i) GRID_BAR();
#endif
#if PROBE_SPREAD >= 0
    if (blockIdx.x == 0 && F.tid == 0) { const unsigned long long ticks = 4ull * MISC[19]; const unsigned long long t0 = __builtin_amdgcn_s_memrealtime(); while (__builtin_amdgcn_s_memrealtime() - t0 < ticks) __builtin_amdgcn_s_sleep(8); }
#endif
#if PROBE_BWAIT >= 0
    if (blockIdx.x == 0 && F.tid == 0) { const unsigned long long ticks = 2ull * MISC[20]; const unsigned long long t0 = __builtin_amdgcn_s_memrealtime(); while (__builtin_amdgcn_s_memrealtime() - t0 < ticks) __builtin_amdgcn_s_sleep(8); }
#endif
#if PROBE_PHTIME >= 0
    if (blockIdx.x == 0 && F.tid == 0) { const unsigned long long ticks = MISC[18]; const unsigned long long t0 = __builtin_amdgcn_s_memrealtime(); while (__builtin_amdgcn_s_memrealtime() - t0 < ticks) __builtin_amdgcn_s_sleep(8); }
#endif
#if PROBE_TIMER
    if (blockIdx.x == 0 && F.tid == 0) { const unsigned v = MISC[16] / (MISC[17] ? MISC[17] : 1u);
        const unsigned long long ticks = (PROBE_TIMER & 1) ? (unsigned long long)v / 2ull : (unsigned long long)v * 10ull;
        const unsigned long long t0 = __builtin_amdgcn_s_memrealtime(); while (__builtin_amdgcn_s_memrealtime() - t0 < ticks) __builtin_amdgcn_s_sleep(8); }
#endif
#undef IN
#undef SEAM
}

extern "C" void kernel_launch(void* const* d_in, const int* in_sizes, int n_in, void* d_out, int out_size, void* d_ws, size_t ws_size, hipStream_t stream) {
    static int grid = 0;
    if (grid == 0) {
        if (n_in != 17 || in_sizes[0] != M * D || out_size != M * D || ws_size < WS_END) { fprintf(stderr, "kernel_launch: unexpected shapes (n_in %d, in0 %d, out %d, ws %zu < %zu?)\n", n_in, n_in > 0 ? in_sizes[0] : -1, out_size, ws_size, (size_t)WS_END); grid = -1; return; }
        int dev = 0, cus = 0, per_cu = 0;
        if (hipGetDevice(&dev) != hipSuccess || hipDeviceGetAttribute(&cus, hipDeviceAttributeMultiprocessorCount, dev) != hipSuccess) { grid = -1; return; }
        if (hipFuncSetAttribute((const void*)enc_fwd, hipFuncAttributeMaxDynamicSharedMemorySize, LDS_BYTES) != hipSuccess) { fprintf(stderr, "kernel_launch: hipFuncSetAttribute failed\n"); grid = -1; return; }
        if (hipOccupancyMaxActiveBlocksPerMultiprocessor(&per_cu, (const void*)enc_fwd, NWAVES * 64, LDS_BYTES) != hipSuccess || per_cu < 1) fprintf(stderr, "kernel_launch: occupancy query reports %d\n", per_cu);
        (void)hipGetLastError();
        grid = cus;
    }
    if (grid < 0) return;
    if (hipMemsetAsync((char*)d_ws + WS_CTL, 0, CTL_ZERO_BYTES, stream) != hipSuccess) { fprintf(stderr, "kernel_launch: memset failed\n"); return; }
    Args a{};
    for (int i = 0; i < 17; ++i) a.in[i] = d_in[i];
    a.out = (float*)d_out; a.ws = (unsigned char*)d_ws;
#if MK_SPLIT
    for (int p = 0; p < N_PHASES; ++p) { a.ph_lo = p; a.ph_hi = p + 1; hipLaunchKernelGGL(enc_fwd, dim3(grid), dim3(NWAVES * 64), LDS_BYTES, stream, a); }
#else
    a.ph_lo = 0; a.ph_hi = N_PHASES;
    hipLaunchKernelGGL(enc_fwd, dim3(grid), dim3(NWAVES * 64), LDS_BYTES, stream, a);
#endif
    const hipError_t le = hipPeekAtLastError();
    if (le != hipSuccess) fprintf(stderr, "kernel_launch: launch failed: %s\n", hipGetErrorName(le));
}
```

```cpp
#include <hip/hip_runtime.h>
#include <cstdio>
#include <cstdint>

#ifndef PH_MASK
#define PH_MASK 0x3ff
#endif
#define PHON(k) ((PH_MASK >> (k)) & 1)
#ifndef PH_REPEAT
#define PH_REPEAT 0
#endif
#define PHREP(k) (((PH_REPEAT >> (k)) & 1) ? 2 : 1)
#ifndef MK_SPLIT
#define MK_SPLIT 0
#endif

namespace pg8 {
#define PG8_LAS __attribute__((address_space(3)))
typedef unsigned short bf16_t;
typedef short bf16x8 __attribute__((ext_vector_type(8)));
typedef float f32x4 __attribute__((ext_vector_type(4)));
typedef unsigned u32x4 __attribute__((ext_vector_type(4)));
constexpr int ROWTAB_OFF = 131072;
constexpr int BM = 256, BK = 64, HALF = 128, HTB = HALF * BK * 2  , STAGE_BYTES = 8 * HTB, NXCD = 8, WGM = 8;

__host__ __device__ __forceinline__ int lds_byte(int r, int c) { const int st = (r >> 4) * 2 + (c >> 5), rr = r & 15, cc = c & 31, ob = rr * 64 + cc * 2; return st * 1024 + (ob ^ (((ob >> 9) & 1) << 5)); }
__host__ __device__ __forceinline__ void stage_rc(int b, int& R, int& C) { const int st = b / 1024, sb = b % 1024, swz = sb ^ (((sb >> 9) & 1) << 5); R = (st >> 1) * 16 + swz / 64; C = (st & 1) * 32 + (swz % 64) / 2; }
__host__ __device__ __forceinline__ int perm32(int rho) { const int n = rho >> 4, i = rho & 15; return 8 * (i >> 2) + 4 * n + (i & 3); }

struct Unit { int pm, pn; };
struct Gemm { const bf16_t* A; const bf16_t* Bt; int M, N, K; };

struct StaticOrder {
    int nM, nN, nwg, G, c;
    __host__ __device__ void init(int M, int N, int G_, int c_) { nM = M / BM; nN = N / BM; nwg = nM * nN; G = G_; c = c_; }
    __host__ __device__ bool next(int i, Unit& u) const {
        const long L = (long)i * G + c; if (L >= nwg) return false;
        int wgid = (int)L; { const int q = nwg / NXCD, r = nwg % NXCD, xcd = wgid % NXCD, off = wgid / NXCD; wgid = (xcd < r ? xcd * (q + 1) : r * (q + 1) + (xcd - r) * q) + off; }
        const int nig = WGM * nN, gid = wgid / nig, fm = gid * WGM, gsz = (nM - fm) < WGM ? (nM - fm) : WGM;
        u.pm = fm + ((wgid % nig) % gsz); u.pn = (wgid % nig) / gsz; return true;
    }
    __device__ __forceinline__ void a_ready(const Unit&) const {}
    __device__ __forceinline__ void done(const Unit&) const {}
    __device__ __forceinline__ void tick(int, bool) const {}
};

struct TailOrder : StaticOrder {
    unsigned* ctr; volatile PG8_LAS int* slot; int full, rem;
    __device__ __forceinline__ void init2(unsigned* c_, volatile PG8_LAS int* s_) { ctr = c_; slot = s_; full = nwg / G; rem = nwg - full * G; }
    __device__ __forceinline__ bool next(int i, Unit& u) const {
        if (i < full || full < 2) return StaticOrder::next(i, u);
        if (i > full || rem == 0) return false;
        const int t = *slot; if (t < 0 || t >= rem) return false;
        TailOrder tmp = *this; tmp.c = t; return tmp.StaticOrder::next(full, u);
    }
    __device__ __forceinline__ void tick(int ui, bool t0) const {
        if (rem != 0 && ui == full - 2 && t0) { const int t = (int)__hip_atomic_fetch_add(ctr, 1u, __ATOMIC_RELAXED, __HIP_MEMORY_SCOPE_AGENT); *slot = t; }
    }
};
#ifndef PROBE_GEMM
#define PROBE_GEMM 0
#endif
struct ProbeOrder : StaticOrder {
    __host__ __device__ bool next(int i, Unit& u) const { const bool ok = StaticOrder::next(i, u); if (PROBE_GEMM == 2) { u.pm = 0; u.pn = 0; } return ok; }
};
__device__ __forceinline__ unsigned cvt_pk_bf16(float lo, float hi) { unsigned r; asm volatile("v_cvt_pk_bf16_f32 %0, %1, %2" : "=v"(r) : "v"(lo), "v"(hi)); return r; }
typedef unsigned u32x2 __attribute__((ext_vector_type(2)));
constexpr float F8_ASCALE = 4.0f, F8_WSCALE = 64.0f;
__device__ __forceinline__ float f8clamp(float v) { return __builtin_fminf(__builtin_fmaxf(v * F8_ASCALE, -440.0f), 440.0f); }
__device__ __forceinline__ u32x2 pack8_fp8(const f32x4 a, const f32x4 b) { u32x2 w; int t = __builtin_amdgcn_cvt_pk_fp8_f32(f8clamp(a[0]), f8clamp(a[1]), 0, false); t = __builtin_amdgcn_cvt_pk_fp8_f32(f8clamp(a[2]), f8clamp(a[3]), t, true); w.x = (unsigned)t;
    int q = __builtin_amdgcn_cvt_pk_fp8_f32(f8clamp(b[0]), f8clamp(b[1]), 0, false); q = __builtin_amdgcn_cvt_pk_fp8_f32(f8clamp(b[2]), f8clamp(b[3]), q, true); w.y = (unsigned)q; return w; }
__device__ __forceinline__ float dpp_qp(float v, const int ctrl) { const int x = __builtin_bit_cast(int, v); return __builtin_bit_cast(float, ctrl == 0xB1 ? __builtin_amdgcn_update_dpp(x, x, 0xB1, 0xF, 0xF, false) : __builtin_amdgcn_update_dpp(x, x, 0x4E, 0xF, 0xF, false)); }
__device__ __forceinline__ f32x4 quad_transpose(f32x4 a, int q) {
    { const bool odd = (q & 1) != 0; const float s0 = odd ? a[0] : a[1], s1 = odd ? a[2] : a[3]; const float r0 = dpp_qp(s0, 0xB1), r1 = dpp_qp(s1, 0xB1);
      if (odd) { a[0] = r0; a[2] = r1; } else { a[1] = r0; a[3] = r1; } }
    { const bool hi = (q & 2) != 0; const float s0 = hi ? a[0] : a[2], s1 = hi ? a[1] : a[3]; const float r0 = dpp_qp(s0, 0x4E), r1 = dpp_qp(s1, 0x4E);
      if (hi) { a[0] = r0; a[1] = r1; } else { a[2] = r0; a[3] = r1; } }
    return a;
}
__device__ __forceinline__ u32x2 pack4(const f32x4 a) { u32x2 w; w.x = cvt_pk_bf16(a[0], a[1]); w.y = cvt_pk_bf16(a[2], a[3]); return w; }
__device__ __forceinline__ u32x4 pack8(const f32x4 a, const f32x4 b) { u32x4 w; w.x = cvt_pk_bf16(a[0], a[1]); w.y = cvt_pk_bf16(a[2], a[3]); w.z = cvt_pk_bf16(b[0], b[1]); w.w = cvt_pk_bf16(b[2], b[3]); return w; }

struct EpiIn {
    static constexpr bool PERM = true, AFTER_DRAIN = false, ROWTAB = true, CONVTAB = false;
    bf16_t* O; int ldc; const float* rstd; PG8_LAS const float* tab; const float* cosb; const float* sinb;
    bf16_t* KFT; bf16_t* KBT; bf16_t* VT; const float* lgam;
    int pn0 = 0;
    __device__ __forceinline__ void operator()(const f32x4 (&acc)[2][2][4][2], const Unit& u, int wr, int wc, int fr, int fq) const {
        asm volatile("" : "+v"(fr), "+v"(fq));
        const int upn = u.pn + pn0; const int row0 = u.pm * BM + wr * 64 + fr, col0 = upn * BM + wc * 32 + 8 * fq, typ = upn >> 3;
        if (typ == 3 || typ == 5) {
            const float osc = (typ == 3) ? 0.0625f : 1.0f; const int h = upn & 7;
            float lf = 0.f, lb = 0.f; if (typ == 5) { lf = lgam[h]; lb = lgam[8 + h]; }
            const int tlane = ((((fr >> 2) & 1) * 32 + 8 * fq + (fr & 3)) * 8) + 4 * (fr >> 3);
#pragma unroll
            for (int ai = 0; ai < 2; ++ai) {
                const int tokb = u.pm * BM + ai * HALF; const size_t blk = ((size_t)((tokb >> 12) * 8 + h) * 32 + ((tokb >> 7) & 31)) * 32768 + (size_t)((wc * 8 + 4 * wr) * 512 + tlane);
#pragma unroll
              for (int mh = 0; mh < 2; ++mh) {
                float rsv[2]; f32x4 cv[2][2], sv[2][2];
#pragma unroll
                for (int m2 = 0; m2 < 2; ++m2) { const int row = row0 + ai * HALF + (2 * mh + m2) * 16; rsv[m2] = tab[row - u.pm * BM]; const float* cp = cosb + (size_t)row * 128 + wc * 32 + 8 * fq; const float* sp = sinb + (size_t)row * 128 + wc * 32 + 8 * fq;
                    cv[m2][0] = *(const f32x4*)cp; cv[m2][1] = *(const f32x4*)(cp + 4); sv[m2][0] = *(const f32x4*)sp; sv[m2][1] = *(const f32x4*)(sp + 4); }
                asm volatile("" : "+v"(rsv[0]), "+v"(rsv[1]), "+v"(cv[0][0]), "+v"(cv[0][1]), "+v"(cv[1][0]), "+v"(cv[1][1]), "+v"(sv[0][0]), "+v"(sv[0][1]), "+v"(sv[1][0]), "+v"(sv[1][1]));
#pragma unroll
                for (int m2 = 0; m2 < 2; ++m2) { const int m = 2 * mh + m2; const int row = row0 + ai * HALF + m * 16; const float rs = rsv[m2];
                    const float sc = rs * osc;
                    const f32x4 c0 = cv[m2][0], c1 = cv[m2][1], s0 = sv[m2][0], s1 = sv[m2][1];
                    const f32x4 a0 = acc[ai][0][m][0] * sc, a1 = acc[ai][0][m][1] * sc, b0 = acc[ai][1][m][0] * sc, b1 = acc[ai][1][m][1] * sc;
                    bf16_t* rp2 = O + (size_t)row * ldc + upn * BM + 16 * (2 * wc + (fq >> 1)) + 4 * (fq & 1);
                    const f32x4 o10 = a0 * c0 - b0 * s0, o11 = a1 * c1 - b1 * s1, o20 = b0 * c0 + a0 * s0, o21 = b1 * c1 + a1 * s1;
                    *(u32x2*)(rp2) = pack4(o10); *(u32x2*)(rp2 + 8) = pack4(o11);
                    *(u32x2*)(rp2 + HALF) = pack4(o20); *(u32x2*)(rp2 + HALF + 8) = pack4(o21);
                    if (typ == 5) {
                        const int c = wr * 64 + m * 16 + fr; const float wf = __expf(lf * (float)(127 - c)), wb = __expf(lb * (float)c); const int q = fr & 3;
                        bf16_t* pf = KFT + blk + m * 512; bf16_t* pb = KBT + blk + m * 512;
                        *(u32x2*)(pf) = pack4(quad_transpose(o10 * wf, q)); *(u32x2*)(pf + 32) = pack4(quad_transpose(o11 * wf, q)); *(u32x2*)(pf + 16384) = pack4(quad_transpose(o20 * wf, q)); *(u32x2*)(pf + 16384 + 32) = pack4(quad_transpose(o21 * wf, q));
                        *(u32x2*)(pb) = pack4(quad_transpose(o10 * wb, q)); *(u32x2*)(pb + 32) = pack4(quad_transpose(o11 * wb, q)); *(u32x2*)(pb + 16384) = pack4(quad_transpose(o20 * wb, q)); *(u32x2*)(pb + 16384 + 32) = pack4(quad_transpose(o21 * wb, q));
                    } } } }
        } else if (typ == 6) {
            const int h = upn & 7; const int tlane = ((((fr >> 2) & 1) * 32 + 8 * fq + (fr & 3)) * 8) + 4 * (fr >> 3), q = fr & 3;
            float rs8[8];
#pragma unroll
            for (int i = 0; i < 8; ++i) rs8[i] = tab[row0 - u.pm * BM + (i >> 2) * HALF + (i & 3) * 16];
            asm volatile("" : "+v"(rs8[0]), "+v"(rs8[1]), "+v"(rs8[2]), "+v"(rs8[3]), "+v"(rs8[4]), "+v"(rs8[5]), "+v"(rs8[6]), "+v"(rs8[7]));
#pragma unroll
            for (int ai = 0; ai < 2; ++ai) {
                const int tokb = u.pm * BM + ai * HALF; const size_t blk = ((size_t)((tokb >> 12) * 8 + h) * 32 + ((tokb >> 7) & 31)) * 32768 + (size_t)((wc * 8 + 4 * wr) * 512 + tlane);
#pragma unroll
                for (int m = 0; m < 4; ++m) { const float rs = rs8[ai * 4 + m]; bf16_t* pv = VT + blk + m * 512;
#pragma unroll
                    for (int bj = 0; bj < 2; ++bj)
#pragma unroll
                        for (int n = 0; n < 2; ++n) *(u32x2*)(pv + bj * 16384 + n * 32) = pack4(quad_transpose(acc[ai][bj][m][n] * rs, q)); } }
        } else {
            float rs8[8];
#pragma unroll
            for (int i = 0; i < 8; ++i) rs8[i] = tab[row0 - u.pm * BM + (i >> 2) * HALF + (i & 3) * 16];
            asm volatile("" : "+v"(rs8[0]), "+v"(rs8[1]), "+v"(rs8[2]), "+v"(rs8[3]), "+v"(rs8[4]), "+v"(rs8[5]), "+v"(rs8[6]), "+v"(rs8[7]));
#pragma unroll
            for (int ai = 0; ai < 2; ++ai)
#pragma unroll
                for (int m = 0; m < 4; ++m) { const int row = row0 + ai * HALF + m * 16; const float rs = rs8[ai * 4 + m]; bf16_t* rowp = O + (size_t)row * ldc + col0;
#pragma unroll
                    for (int bj = 0; bj < 2; ++bj) *(u32x4*)(rowp + bj * HALF) = pack8(acc[ai][bj][m][0] * rs, acc[ai][bj][m][1] * rs); }
        }
    }
};
struct EpiScale {
    static constexpr bool PERM = true, AFTER_DRAIN = false, ROWTAB = true, CONVTAB = false;
    bf16_t* O; int ldc; const float* rstd; PG8_LAS const float* tab;
    __device__ __forceinline__ void operator()(const f32x4 (&acc)[2][2][4][2], const Unit& u, int wr, int wc, int fr, int fq) const {
        asm volatile("" : "+v"(fr), "+v"(fq));
        const int rl0 = wr * 64 + fr, row0 = u.pm * BM + rl0, col0 = u.pn * BM + wc * 32 + 8 * fq;
#pragma unroll
        for (int ai = 0; ai < 2; ++ai)
#pragma unroll
            for (int m = 0; m < 4; ++m) { const int row = row0 + ai * HALF + m * 16; const float r = tab[rl0 + ai * HALF + m * 16]; bf16_t* rowp = O + (size_t)row * ldc + col0;
#pragma unroll
                for (int bj = 0; bj < 2; ++bj) *(u32x4*)(rowp + bj * HALF) = pack8(acc[ai][bj][m][0] * r, acc[ai][bj][m][1] * r); }
    }
};
__device__ __forceinline__ float dpp_row(float oldv, float v, const int ctrl) { const int o = __builtin_bit_cast(int, oldv), x = __builtin_bit_cast(int, v);
    return __builtin_bit_cast(float, ctrl == 0x111 ? __builtin_amdgcn_update_dpp(o, x, 0x111, 0xF, 0xF, false) : ctrl == 0x101 ? __builtin_amdgcn_update_dpp(o, x, 0x101, 0xF, 0xF, false)
                                   : ctrl == 0x10F ? __builtin_amdgcn_update_dpp(o, x, 0x10F, 0xF, 0xF, false) : __builtin_amdgcn_update_dpp(o, x, 0x11F, 0xF, 0xF, false)); }
__device__ __forceinline__ float dpp_in(float v, const int ctrl) { const int x = __builtin_bit_cast(int, v);
    return __builtin_bit_cast(float, ctrl == 0x10F ? __builtin_amdgcn_mov_dpp(x, 0x10F, 0xF, 0xF, true) : __builtin_amdgcn_mov_dpp(x, 0x11F, 0xF, 0xF, true)); }
struct EpiAct {
    static constexpr bool PERM = true, AFTER_DRAIN = false, ROWTAB = true, CONVTAB = true;
    bf16_t* ACT; int ldc; const float* rstd; PG8_LAS float* tab;
    float scg, scu; int pn0;
    int k8; size_t a16off;
    const float* cw; const float* cb; float* HG; float* HU;
    __device__ __forceinline__ void operator()(const f32x4 (&acc)[2][2][4][2], const Unit& u, int wr, int wc, int fr, int fq) const {
        asm volatile("" : "+v"(fr), "+v"(fq));
        const int rl0 = wr * 64 + fr, ch0 = wc * 32 + 8 * fq;
        f32x4 G[2][4][2], U[2][4][2];
#pragma unroll
        for (int ai = 0; ai < 2; ++ai)
#pragma unroll
            for (int m = 0; m < 4; ++m) { const float r = tab[rl0 + ai * HALF + m * 16]; const float rg = r * scg, ru = r * scu;
#pragma unroll
                for (int n = 0; n < 2; ++n) { G[ai][m][n] = acc[ai][0][m][n] * rg; U[ai][m][n] = acc[ai][1][m][n] * ru; } }
        PG8_LAS float* hb = tab + 768;
#define EPA_H(wr_, ai_, fl_) (((((wr_) * 4 + wc) * 2 + (ai_)) * 2 + (fl_)) * 32 + 8 * fq)
        if (fr == 0) {
#pragma unroll
            for (int ai = 0; ai < 2; ++ai) { *(PG8_LAS f32x4*)(hb + EPA_H(wr, ai, 0)) = G[ai][0][0]; *(PG8_LAS f32x4*)(hb + EPA_H(wr, ai, 0) + 4) = G[ai][0][1]; } }
        if (fr == 15) {
#pragma unroll
            for (int ai = 0; ai < 2; ++ai) { *(PG8_LAS f32x4*)(hb + EPA_H(wr, ai, 1)) = G[ai][3][0]; *(PG8_LAS f32x4*)(hb + EPA_H(wr, ai, 1) + 4) = G[ai][3][1]; } }
        asm volatile("s_waitcnt lgkmcnt(0)" ::: "memory"); __builtin_amdgcn_s_barrier(); asm volatile("" ::: "memory");
        f32x4 top[2][2], bot[2][2];
#pragma unroll
        for (int ai = 0; ai < 2; ++ai) {
            const int to = (wr == 1) ? EPA_H(0, ai, 1) : EPA_H(1, 0, 1);
            const int bo = (wr == 0) ? EPA_H(1, ai, 0) : EPA_H(0, 1, 0);
            top[ai][0] = *(PG8_LAS const f32x4*)(hb + to); top[ai][1] = *(PG8_LAS const f32x4*)(hb + to + 4); bot[ai][0] = *(PG8_LAS const f32x4*)(hb + bo); bot[ai][1] = *(PG8_LAS const f32x4*)(hb + bo + 4); }
#undef EPA_H
        f32x4 w0[2], w1[2], w2[2], bb[2];
#pragma unroll
        for (int n = 0; n < 2; ++n) { w0[n] = *(PG8_LAS const f32x4*)(tab + 256 + ch0 + 4 * n); w1[n] = *(PG8_LAS const f32x4*)(tab + 384 + ch0 + 4 * n); w2[n] = *(PG8_LAS const f32x4*)(tab + 512 + ch0 + 4 * n); bb[n] = *(PG8_LAS const f32x4*)(tab + 640 + ch0 + 4 * n); }
        const int chg = (u.pn + pn0) * HALF + ch0;
        const bool f8 = (u.pn + pn0) * HALF < k8;
        unsigned char* const ab = f8 ? (unsigned char*)ACT + chg : (unsigned char*)ACT + a16off + (size_t)(chg - k8) * 2; const size_t ap = f8 ? (size_t)k8 : (size_t)(ldc - k8) * 2;
#pragma unroll
        for (int ai = 0; ai < 2; ++ai)
#pragma unroll
            for (int m = 0; m < 4; ++m) {
                f32x4 o[2];
#pragma unroll
                for (int n = 0; n < 2; ++n)
#pragma unroll
                    for (int j = 0; j < 4; ++j) {
                        const float g = G[ai][m][n][j];
                        const float xo = (m > 0) ? dpp_in(G[ai][m > 0 ? m - 1 : 0][n][j], 0x10F) : top[ai][n][j];
                        const float gp = dpp_row(xo, g, 0x111);
                        const float yo = (m < 3) ? dpp_in(G[ai][m < 3 ? m + 1 : 3][n][j], 0x11F) : bot[ai][n][j];
                        const float gn = dpp_row(yo, g, 0x101);
                        const float z = __builtin_fmaf(w0[n][j], gp, __builtin_fmaf(w1[n][j], g, __builtin_fmaf(w2[n][j], gn, bb[n][j])));
                        o[n][j] = z * __builtin_amdgcn_rcpf(1.0f + __builtin_amdgcn_exp2f(z * -1.4426950408889634f)) * U[ai][m][n][j]; }
                const int tr = ai * HALF + wr * 64 + m * 16 + fr;
                const bool first = (ai == 0 && m == 0 && wr == 0 && fr == 0), lastr = (ai == 1 && m == 3 && wr == 1 && fr == 15);
                if (!first && !lastr) { if (f8) *(u32x2*)(ab + (size_t)(u.pm * BM + tr) * ap) = pack8_fp8(o[0], o[1]); else *(u32x4*)(ab + (size_t)(u.pm * BM + tr) * ap) = pack8(o[0], o[1]); }
                if (ai == 0 && m == 0 && wr == 0 && fr <= 1) { float* hg = HG + (size_t)(u.pm * 4 + fr) * ldc + chg; *(f32x4*)hg = G[0][0][0]; *(f32x4*)(hg + 4) = G[0][0][1];
                    if (fr == 0) { float* hu = HU + (size_t)(u.pm * 2) * ldc + chg; *(f32x4*)hu = U[0][0][0]; *(f32x4*)(hu + 4) = U[0][0][1]; } }
                if (ai == 1 && m == 3 && wr == 1 && fr >= 14) { float* hg = HG + (size_t)(u.pm * 4 + 2 + (fr - 14)) * ldc + chg; *(f32x4*)hg = G[1][3][0]; *(f32x4*)(hg + 4) = G[1][3][1];
                    if (fr == 15) { float* hu = HU + (size_t)(u.pm * 2 + 1) * ldc + chg; *(f32x4*)hu = U[1][3][0]; *(f32x4*)(hu + 4) = U[1][3][1]; } }
            }
    }
};
struct EpiRes {
    static constexpr bool PERM = true, AFTER_DRAIN = false, ROWTAB = false, CONVTAB = false;
    const float* xin32; bf16_t* xb; float* part; int ldc; float sc;
    __device__ __forceinline__ void operator()(const f32x4 (&acc)[2][2][4][2], const Unit& u, int wr, int wc, int fr, int fq) const {
        asm volatile("" : "+v"(fr), "+v"(fq));
        const int row0 = u.pm * BM + wr * 64 + fr, col0 = u.pn * BM + wc * 32 + 8 * fq;
        float ssv[8];
        if (xin32) {
#pragma unroll
            for (int q = 0; q < 4; ++q) {
                const int ai = q >> 1, mh = q & 1;
                f32x4 xv[2][2][2];
#pragma unroll
                for (int m2 = 0; m2 < 2; ++m2)
#pragma unroll
                    for (int bj = 0; bj < 2; ++bj) { const float* p = xin32 + (size_t)(row0 + ai * HALF + (2 * mh + m2) * 16) * ldc + col0 + bj * HALF; xv[m2][bj][0] = *(const f32x4*)p; xv[m2][bj][1] = *(const f32x4*)(p + 4); }
                asm volatile("" : "+v"(xv[0][0][0]), "+v"(xv[0][0][1]), "+v"(xv[0][1][0]), "+v"(xv[0][1][1]), "+v"(xv[1][0][0]), "+v"(xv[1][0][1]), "+v"(xv[1][1][0]), "+v"(xv[1][1][1]));
#pragma unroll
                for (int m2 = 0; m2 < 2; ++m2) { const int m = 2 * mh + m2; const size_t off = (size_t)(row0 + ai * HALF + m * 16) * ldc + col0; float ss = 0.f;
#pragma unroll
                    for (int bj = 0; bj < 2; ++bj) { const f32x4 v0 = xv[m2][bj][0] + acc[ai][bj][m][0] * sc, v1 = xv[m2][bj][1] + acc[ai][bj][m][1] * sc;
                        *(u32x4*)(xb + off + bj * HALF) = pack8(v0, v1);
                        ss += (v0[0] * v0[0] + v0[1] * v0[1]) + (v0[2] * v0[2] + v0[3] * v0[3]) + (v1[0] * v1[0] + v1[1] * v1[1]) + (v1[2] * v1[2] + v1[3] * v1[3]); }
                    ss += __shfl_xor(ss, 16); ss += __shfl_xor(ss, 32); ssv[ai * 4 + m] = ss; } }
        } else {
#pragma unroll
            for (int q = 0; q < 4; ++q) {
                const int ai = q >> 1, mh = q & 1;
                u32x4 xo[2][2];
#pragma unroll
                for (int m2 = 0; m2 < 2; ++m2)
#pragma unroll
                    for (int bj = 0; bj < 2; ++bj) xo[m2][bj] = *(const u32x4*)(xb + (size_t)(row0 + ai * HALF + (2 * mh + m2) * 16) * ldc + col0 + bj * HALF);
                asm volatile("" : "+v"(xo[0][0]), "+v"(xo[0][1]), "+v"(xo[1][0]), "+v"(xo[1][1]));
#pragma unroll
                for (int m2 = 0; m2 < 2; ++m2) { const int m = 2 * mh + m2; const size_t off = (size_t)(row0 + ai * HALF + m * 16) * ldc + col0; float ss = 0.f;
#pragma unroll
                    for (int bj = 0; bj < 2; ++bj) { const u32x4 w = xo[m2][bj];
                        const f32x4 x0 = (f32x4){__uint_as_float(w.x << 16), __uint_as_float(w.x & 0xffff0000u), __uint_as_float(w.y << 16), __uint_as_float(w.y & 0xffff0000u)};
                        const f32x4 x1 = (f32x4){__uint_as_float(w.z << 16), __uint_as_float(w.z & 0xffff0000u), __uint_as_float(w.w << 16), __uint_as_float(w.w & 0xffff0000u)};
                        const f32x4 v0 = x0 + acc[ai][bj][m][0] * sc, v1 = x1 + acc[ai][bj][m][1] * sc;
                        *(u32x4*)(xb + off + bj * HALF) = pack8(v0, v1);
                        ss += (v0[0] * v0[0] + v0[1] * v0[1]) + (v0[2] * v0[2] + v0[3] * v0[3]) + (v1[0] * v1[0] + v1[1] * v1[1]) + (v1[2] * v1[2] + v1[3] * v1[3]); }
                    ss += __shfl_xor(ss, 16); ss += __shfl_xor(ss, 32); ssv[ai * 4 + m] = ss; } }
        }
        if (fq == 0) {
#pragma unroll
            for (int i = 0; i < 8; ++i) part[(size_t)(row0 + (i >> 2) * HALF + (i & 3) * 16) * 64 + u.pn * 4 + wc] = ssv[i]; }
    }
};

#ifndef PROBE_PHTIME
#define PROBE_PHTIME (-1)
#endif
#ifndef PROBE_SPREAD
#define PROBE_SPREAD (-1)
#endif
#ifndef PROBE_BWAIT
#define PROBE_BWAIT (-1)
#endif
#ifndef PROBE_BARS
#define PROBE_BARS 0
#endif
#ifndef PROBE_TIMER
#define PROBE_TIMER 0
#endif
#ifndef PROBE_PHASE
#define PROBE_PHASE 6
#endif
#define PROBE_NOW() ((PROBE_TIMER & 1) ? __builtin_amdgcn_s_memtime() : __builtin_amdgcn_s_memrealtime())
typedef int v8i_t __attribute__((ext_vector_type(8)));
typedef int v4i_t __attribute__((ext_vector_type(4)));
__device__ __forceinline__ v8i_t cat8(const bf16x8 lo, const bf16x8 hi) { const u32x4 a = __builtin_bit_cast(u32x4, lo), b = __builtin_bit_cast(u32x4, hi); return (v8i_t){(int)a.x, (int)a.y, (int)a.z, (int)a.w, (int)b.x, (int)b.y, (int)b.z, (int)b.w}; }
template <class Epi, class Sched, bool ALIGN_EPI = false, bool SP2 = false, int PROBE = 0, bool F8 = false, bool I8 = false>
__device__ __forceinline__ void gemm_phase(PG8_LAS unsigned char* lds, const Gemm g, const Sched& S, const Epi& E, int tid_) {
    asm volatile("" : "+v"(tid_));
    const int tid = tid_, wid = __builtin_amdgcn_readfirstlane(tid >> 6), lane = tid & 63, wr = wid >> 2, wc = wid & 3, fr = lane & 15, fq = lane >> 4;
    const int K = g.K, nt = K / BK;
    unsigned voffA[2], voffB[2];
#pragma unroll
    for (int i = 0; i < 2; ++i) { int R, C; stage_rc(tid * 16 + i * 8192, R, C); const int Rb = Epi::PERM ? ((R & ~31) + perm32(R & 31)) : R;
        voffA[i] = (unsigned)(R * K + C) * 2u; voffB[i] = (unsigned)(Rb * K + C) * 2u; }
    const size_t kstep = (size_t)(BK * 2);
    const size_t hstep = (size_t)HALF * K * 2;
    const size_t tstep = 2 * hstep;
    const unsigned ldsw = (unsigned)wid * 1024u;
    const int aoff = lds_byte(wr * 64 + fr, fq * 8), boff = lds_byte(wc * 32 + fr, fq * 8);
#define PG8_SA(b, h) (((b) * 2 + (h)) * HTB)
#define PG8_SB(b, h) ((4 + (b) * 2 + (h)) * HTB)
#define PG8_STAGE(bufoff, gbase, voff) do { _Pragma("unroll") for (int _i = 0; _i < 2; ++_i) { unsigned _v = (voff)[_i]; if constexpr (F8) asm volatile("" : "+v"(_v));     \
        __builtin_amdgcn_global_load_lds((const unsigned*)((const char*)(gbase) + _v), (PG8_LAS unsigned*)(lds + (bufoff) + ldsw + _i * 8192), 16, 0, 0); } } while (0)
#define PG8_LDA8(dst, b, h) do { _Pragma("unroll") for (int m = 0; m < 4; ++m) dst[m] = cat8(*(const PG8_LAS bf16x8*)(lds + PG8_SA(b, h) + aoff + m * 2048), *(const PG8_LAS bf16x8*)(lds + PG8_SA(b, h) + aoff + m * 2048 + 1024)); } while (0)
#define PG8_LDB8(dst, b, h) do { _Pragma("unroll") for (int n = 0; n < 2; ++n) dst[n] = cat8(*(const PG8_LAS bf16x8*)(lds + PG8_SB(b, h) + boff + n * 2048), *(const PG8_LAS bf16x8*)(lds + PG8_SB(b, h) + boff + n * 2048 + 1024)); } while (0)
#define PG8_LDA(dst, b, h) do { _Pragma("unroll") for (int m = 0; m < 4; ++m) _Pragma("unroll") for (int k = 0; k < 2; ++k) dst[m][k] = *(const PG8_LAS bf16x8*)(lds + PG8_SA(b, h) + aoff + m * 2048 + k * 1024); } while (0)
#define PG8_LDB(dst, b, h) do { _Pragma("unroll") for (int n = 0; n < 2; ++n) _Pragma("unroll") for (int k = 0; k < 2; ++k) dst[n][k] = *(const PG8_LAS bf16x8*)(lds + PG8_SB(b, h) + boff + n * 2048 + k * 1024); } while (0)
#define PG8_MMA(ai, bj, At, Bt) do { __builtin_amdgcn_s_setprio(1); if constexpr (F8) { _Pragma("unroll") for (int m = 0; m < 4; ++m) _Pragma("unroll") for (int n = 0; n < 2; ++n) \
        acc[ai][bj][m][n] = __builtin_amdgcn_mfma_scale_f32_16x16x128_f8f6f4(Bt##8[n], At##8[m], acc[ai][bj][m][n], 0, 0, 0, 0, 0, 0); } \
        else { _Pragma("unroll") for (int m = 0; m < 4; ++m) _Pragma("unroll") for (int n = 0; n < 2; ++n) _Pragma("unroll") for (int k = 0; k < 2; ++k) \
        { if constexpr (I8) acc[ai][bj][m][n] = __builtin_bit_cast(f32x4, __builtin_amdgcn_mfma_i32_16x16x64_i8(__builtin_bit_cast(v4i_t, Bt[n][k]), __builtin_bit_cast(v4i_t, At[m][k]), __builtin_bit_cast(v4i_t, acc[ai][bj][m][n]), 0, 0, 0)); \
          else acc[ai][bj][m][n] = __builtin_amdgcn_mfma_f32_16x16x32_bf16(Bt[n][k], At[m][k], acc[ai][bj][m][n], 0, 0, 0); } } __builtin_amdgcn_s_setprio(0); } while (0)
#define PG8_WAIT_V(n) asm volatile("s_waitcnt vmcnt(" #n ")" ::: "memory")
#define PG8_WAIT_L(n) asm volatile("s_waitcnt lgkmcnt(" #n ")" ::: "memory")
#define PG8_BAR __builtin_amdgcn_s_barrier()
#define PG8_SCHED __builtin_amdgcn_sched_barrier(0)
    if (PROBE && PROBE_TIMER == 6 && tid == 0 && blockIdx.x == 0) { volatile PG8_LAS unsigned* pm = (volatile PG8_LAS unsigned*)(lds + 139264 + 320 + 64); pm[2] = (unsigned)__builtin_amdgcn_s_memrealtime(); }
    Unit cur, nxt; int ui = 0;
    if (!S.next(0, cur)) return;
    f32x4 acc[2][2][4][2];
#pragma unroll
    for (int a = 0; a < 2; ++a)
#pragma unroll
        for (int b = 0; b < 2; ++b)
#pragma unroll
            for (int m = 0; m < 4; ++m)
#pragma unroll
                for (int n = 0; n < 2; ++n) acc[a][b][m][n] = (f32x4){0.f, 0.f, 0.f, 0.f};
    bf16x8 At[4][2], B0[2][2], B1[2][2];
    v8i_t At8[4], B08[2], B18[2];
    const char* cA = (const char*)g.A + (size_t)cur.pm * tstep; const char* cB = (const char*)g.Bt + (size_t)cur.pn * tstep;
    S.a_ready(cur);
    if constexpr (SP2) {
        PG8_STAGE(PG8_SB(0, 0), cB, voffB); PG8_STAGE(PG8_SB(0, 1), cB + hstep, voffB); PG8_STAGE(PG8_SA(0, 0), cA, voffA); PG8_STAGE(PG8_SA(0, 1), cA + hstep, voffA);
        if (wr == 1) PG8_BAR;
        PG8_WAIT_V(2); PG8_BAR;
        PG8_STAGE(PG8_SB(1, 0), cB + kstep, voffB); PG8_STAGE(PG8_SA(1, 0), cA + kstep, voffA); PG8_STAGE(PG8_SB(1, 1), cB + hstep + kstep, voffB);
        PG8_WAIT_V(6); PG8_BAR;
    } else {
        PG8_STAGE(PG8_SB(0, 0), cB, voffB); PG8_STAGE(PG8_SA(0, 0), cA, voffA); PG8_STAGE(PG8_SB(0, 1), cB + hstep, voffB); PG8_STAGE(PG8_SA(0, 1), cA + hstep, voffA);
        if (wr == 1) PG8_BAR;
        PG8_WAIT_V(4); PG8_BAR;
        PG8_STAGE(PG8_SB(1, 0), cB + kstep, voffB); PG8_STAGE(PG8_SA(1, 0), cA + kstep, voffA); PG8_STAGE(PG8_SB(1, 1), cB + hstep + kstep, voffB);
        PG8_WAIT_V(6); PG8_BAR;
    }
    for (;;) {
        S.tick(ui, tid == 0);
        const bool has_next = S.next(ui + 1, nxt);
        const char* nA = has_next ? (const char*)g.A + (size_t)nxt.pm * tstep : cA; const char* nB = has_next ? (const char*)g.Bt + (size_t)nxt.pn * tstep : cB;
        unsigned long long pk0 = 0, pk1 = 0; if (PROBE && PROBE_TIMER) pk0 = PROBE_NOW();
        for (int t = 0; t < nt; t += 2) {
            const bool last = (t == nt - 2);
            const char* a1 = cA + (size_t)(t + 1) * kstep;
            const char* a2 = last ? nA : cA + (size_t)(t + 2) * kstep; const char* b2 = last ? nB : cB + (size_t)(t + 2) * kstep;
            const char* a3 = a2 + kstep; const char* b3 = b2 + kstep;
            if (last && has_next) S.a_ready(nxt);
            if constexpr (Epi::CONVTAB) { if (last && wid == 1) { int lane; asm volatile("v_mbcnt_lo_u32_b32 %0, -1, 0\n\tv_mbcnt_hi_u32_b32 %0, -1, %0" : "=v"(lane));
                const int cho = (cur.pn + E.pn0) * HALF + (lane & 31) * 4;
                __builtin_amdgcn_global_load_lds((const unsigned*)(E.cw + (lane >> 5) * 11008 + cho), (PG8_LAS unsigned*)(lds + ROWTAB_OFF + 1024), 16, 0, 0);
                __builtin_amdgcn_global_load_lds((const unsigned*)((lane >> 5) ? E.cb + cho : E.cw + 2 * 11008 + cho), (PG8_LAS unsigned*)(lds + ROWTAB_OFF + 2048), 16, 0, 0); } }
            if constexpr (Epi::ROWTAB) { if (last && wid == 0) { int lane; asm volatile("v_mbcnt_lo_u32_b32 %0, -1, 0\n\tv_mbcnt_hi_u32_b32 %0, -1, %0" : "=v"(lane)); __builtin_amdgcn_global_load_lds((const unsigned*)(E.rstd + cur.pm * BM + lane * 4), (PG8_LAS unsigned*)(lds + ROWTAB_OFF), 16, 0, 0); } }
            if constexpr (SP2 && F8) {
            PG8_LDB8(B08, 0, 0); PG8_LDB8(B18, 0, 1); PG8_SCHED; PG8_LDA8(At8, 0, 0); PG8_STAGE(PG8_SA(1, 1), a1 + hstep, voffA);
            PG8_WAIT_V(8); PG8_WAIT_L(0); PG8_BAR; PG8_MMA(0, 0, At, B0); PG8_MMA(0, 1, At, B1); PG8_BAR; PG8_SCHED;
            PG8_LDA8(At8, 0, 1); PG8_STAGE(PG8_SB(0, 0), b2, voffB); PG8_STAGE(PG8_SB(0, 1), b2 + hstep, voffB); PG8_STAGE(PG8_SA(0, 0), a2, voffA);
            PG8_WAIT_V(8); PG8_WAIT_L(0); PG8_BAR; PG8_MMA(1, 0, At, B0); PG8_MMA(1, 1, At, B1); PG8_BAR; PG8_SCHED;
            PG8_LDB8(B08, 1, 0); PG8_LDB8(B18, 1, 1); PG8_SCHED; PG8_LDA8(At8, 1, 0); PG8_STAGE(PG8_SA(0, 1), a2 + hstep, voffA);
            PG8_WAIT_V(8); PG8_WAIT_L(0); PG8_BAR; PG8_MMA(0, 0, At, B0); PG8_MMA(0, 1, At, B1); PG8_BAR; PG8_SCHED;
            PG8_LDA8(At8, 1, 1); PG8_STAGE(PG8_SB(1, 0), b3, voffB); PG8_STAGE(PG8_SB(1, 1), b3 + hstep, voffB); PG8_STAGE(PG8_SA(1, 0), a3, voffA);
            PG8_WAIT_V(8); PG8_WAIT_L(0); PG8_BAR; PG8_MMA(1, 0, At, B0); PG8_MMA(1, 1, At, B1); PG8_BAR; PG8_SCHED;
            } else if constexpr (SP2) {
            PG8_LDB(B0, 0, 0); PG8_LDB(B1, 0, 1); PG8_SCHED; PG8_LDA(At, 0, 0); PG8_STAGE(PG8_SA(1, 1), a1 + hstep, voffA);
            PG8_WAIT_V(8); PG8_WAIT_L(0); PG8_BAR; PG8_MMA(0, 0, At, B0); PG8_MMA(0, 1, At, B1); PG8_BAR; PG8_SCHED;
            PG8_LDA(At, 0, 1); PG8_STAGE(PG8_SB(0, 0), b2, voffB); PG8_STAGE(PG8_SB(0, 1), b2 + hstep, voffB); PG8_STAGE(PG8_SA(0, 0), a2, voffA);
            PG8_WAIT_V(8); PG8_WAIT_L(0); PG8_BAR; PG8_MMA(1, 0, At, B0); PG8_MMA(1, 1, At, B1); PG8_BAR; PG8_SCHED;
            PG8_LDB(B0, 1, 0); PG8_LDB(B1, 1, 1); PG8_SCHED; PG8_LDA(At, 1, 0); PG8_STAGE(PG8_SA(0, 1), a2 + hstep, voffA);
            PG8_WAIT_V(8); PG8_WAIT_L(0); PG8_BAR; PG8_MMA(0, 0, At, B0); PG8_MMA(0, 1, At, B1); PG8_BAR; PG8_SCHED;
            PG8_LDA(At, 1, 1); PG8_STAGE(PG8_SB(1, 0), b3, voffB); PG8_STAGE(PG8_SB(1, 1), b3 + hstep, voffB); PG8_STAGE(PG8_SA(1, 0), a3, voffA);
            PG8_WAIT_V(8); PG8_WAIT_L(0); PG8_BAR; PG8_MMA(1, 0, At, B0); PG8_MMA(1, 1, At, B1); PG8_BAR; PG8_SCHED;
            } else {
            PG8_LDB(B0, 0, 0); PG8_SCHED; PG8_LDA(At, 0, 0); PG8_STAGE(PG8_SA(1, 1), a1 + hstep, voffA);
            PG8_WAIT_L(8); PG8_BAR; PG8_WAIT_L(0); PG8_MMA(0, 0, At, B0); PG8_BAR; PG8_SCHED;
            PG8_LDB(B1, 0, 1); PG8_STAGE(PG8_SB(0, 0), b2, voffB);
            PG8_BAR; PG8_WAIT_L(0); PG8_MMA(0, 1, At, B1); PG8_BAR;
            PG8_LDA(At, 0, 1); PG8_STAGE(PG8_SA(0, 0), a2, voffA);
            PG8_BAR; PG8_WAIT_L(0); PG8_MMA(1, 0, At, B0); PG8_BAR; PG8_SCHED;
            PG8_STAGE(PG8_SB(0, 1), b2 + hstep, voffB);
            PG8_WAIT_V(6); PG8_BAR; PG8_MMA(1, 1, At, B1); PG8_BAR;
            PG8_LDB(B0, 1, 0); PG8_SCHED; PG8_LDA(At, 1, 0); PG8_STAGE(PG8_SA(0, 1), a2 + hstep, voffA);
            PG8_WAIT_L(8); PG8_BAR; PG8_WAIT_L(0); PG8_MMA(0, 0, At, B0); PG8_BAR; PG8_SCHED;
            PG8_LDB(B1, 1, 1); PG8_STAGE(PG8_SB(1, 0), b3, voffB);
            PG8_BAR; PG8_WAIT_L(0); PG8_MMA(0, 1, At, B1); PG8_BAR;
            PG8_LDA(At, 1, 1); PG8_STAGE(PG8_SA(1, 0), a3, voffA);
            PG8_BAR; PG8_WAIT_L(0); PG8_MMA(1, 0, At, B0); PG8_BAR; PG8_SCHED;
            PG8_STAGE(PG8_SB(1, 1), b3 + hstep, voffB);
            PG8_WAIT_V(6); PG8_BAR; PG8_MMA(1, 1, At, B1); PG8_BAR;
            }
        }
        if (PROBE && PROBE_TIMER) pk1 = PROBE_NOW();
        if constexpr (ALIGN_EPI) { if (wr == 0) PG8_BAR; }
        if constexpr (I8) {
#pragma unroll
            for (int a = 0; a < 2; ++a)
#pragma unroll
                for (int b = 0; b < 2; ++b)
#pragma unroll
                    for (int m = 0; m < 4; ++m)
#pragma unroll
                        for (int n = 0; n < 2; ++n) acc[a][b][m][n] = __builtin_convertvector(__builtin_bit_cast(v4i_t, acc[a][b][m][n]), f32x4); }
        if constexpr (!Epi::AFTER_DRAIN) { int l2_; asm volatile("v_mbcnt_lo_u32_b32 %0, -1, 0\n\tv_mbcnt_hi_u32_b32 %0, -1, %0" : "=v"(l2_)); E(acc, cur, wr, wc, l2_ & 15, l2_ >> 4); S.done(cur); }
        if (PROBE && PROBE_TIMER && PROBE_TIMER != 6) { const unsigned long long pk2 = PROBE_NOW(); if (tid == 0 && blockIdx.x == 0) { volatile PG8_LAS unsigned* pm = (volatile PG8_LAS unsigned*)(lds + 139264 + 320 + 64);
            pm[0] += (unsigned)((PROBE_TIMER <= 2) ? (pk1 - pk0) : (pk2 - pk1)); pm[1] += 1u; } }
        if (!has_next) break;
#pragma unroll
        for (int a = 0; a < 2; ++a)
#pragma unroll
            for (int b = 0; b < 2; ++b)
#pragma unroll
                for (int m = 0; m < 4; ++m)
#pragma unroll
                    for (int n = 0; n < 2; ++n) acc[a][b][m][n] = (f32x4){0.f, 0.f, 0.f, 0.f};
        cur = nxt; cA = nA; cB = nB; ++ui;
        if constexpr (ALIGN_EPI) { if (wr == 1) PG8_BAR; }
    }
    if (PROBE && PROBE_TIMER == 6 && wid == 0 && blockIdx.x == 0) { int l0; asm volatile("v_mbcnt_lo_u32_b32 %0, -1, 0\n\tv_mbcnt_hi_u32_b32 %0, -1, %0" : "=v"(l0)); if (l0 == 0) { volatile PG8_LAS unsigned* pm = (volatile PG8_LAS unsigned*)(lds + 139264 + 320 + 64); pm[0] += (unsigned)__builtin_amdgcn_s_memrealtime() - pm[2]; pm[1] += (unsigned)(ui + 1); } }
    PG8_WAIT_V(0);
    if constexpr (!ALIGN_EPI) { if (wr == 0) PG8_BAR; }
    PG8_BAR;
#undef PG8_SA
#undef PG8_SB
#undef PG8_STAGE
#undef PG8_LDA
#undef PG8_LDB
#undef PG8_MMA
#undef PG8_WAIT_V
#undef PG8_WAIT_L
#undef PG8_BAR
#undef PG8_SCHED
}
}

#ifndef PG8_SP2
#define PG8_SP2 true
#endif
#ifndef PG8_ALIGN
#define PG8_ALIGN true
#endif

constexpr int NWAVES = 8;
constexpr int BATCH = 4, SEQ = 4096, D = 4096, M = BATCH * SEQ, DEPTH = 2;
constexpr int CW = 2048, RW = 2048, RH = 8, HD = 256, CHUNK = 128, NCH = SEQ / CHUNK;
constexpr int IN_COLS = 14336, N1 = 12288  , FF = 11008, NGU = 2 * FF;
constexpr int COL_AB = 0, COL_AC = 2048, COL_AX = 4096, COL_Q = 6144, COL_G = 8192, COL_K = 10240;
constexpr float EPS = 1e-6f;
#ifndef F8_K0
#define F8_K0 0
#endif
static_assert(F8_K0 % 256 == 0 && F8_K0 <= FF && (FF - F8_K0) % 128 == 0 && FF % 256 == 0, "fp8 / bf16 K split: whole pairs of K-tiles on both sides");
__device__ __forceinline__ int k8_of(int l) { return (l == DEPTH - 1) ? FF : F8_K0; }
#ifndef GU8_TILES_L0
#define GU8_TILES_L0 86
#endif
#ifndef GU8_TILES_L1
#define GU8_TILES_L1 86
#endif
static_assert(GU8_TILES_L0 >= 0 && GU8_TILES_L0 <= NGU / 256 && GU8_TILES_L1 >= 0 && GU8_TILES_L1 <= NGU / 256, "int8 column tiles");
__device__ __forceinline__ int gu8_of(int l) { return (l == DEPTH - 1) ? GU8_TILES_L1 : GU8_TILES_L0; }
#ifndef IN8_TILES_L1
#define IN8_TILES_L1 16
#endif
__device__ __forceinline__ int in8_of(int l) { return (l == DEPTH - 1) ? IN8_TILES_L1 : 0; }
static_assert(IN8_TILES_L1 >= 0 && IN8_TILES_L1 <= 32 && IN8_TILES_L1 % 4 == 0, "int8 in-projection tiles: whole rounds, inside the blocks whose source and destination columns coincide");
constexpr int WABS_WORD = 3000;

constexpr size_t MiB = 1u << 20;
constexpr size_t WS_CTL = 0, CTL_ZERO_BYTES = 1 * MiB;
constexpr size_t WS_RSTD1 = 1 * MiB;
constexpr size_t WS_RSTD2 = WS_RSTD1 + 256 * 1024;
constexpr size_t WS_LGAM = WS_RSTD2 + 256 * 1024;
constexpr size_t WS_WSQ = WS_LGAM + 64 * 1024;
constexpr size_t WS_RS8 = WS_LGAM + 128 * 1024;
constexpr size_t WS_PART = 2 * MiB;
constexpr size_t WS_COS = 6 * MiB, WS_SIN = 14 * MiB;
constexpr size_t WS_WIN = 38 * MiB;
constexpr size_t WS_WOUT = WS_WIN + 112 * MiB;
constexpr size_t WS_WGU = WS_WOUT + 32 * MiB;
constexpr size_t WS_WDN = WS_WGU + 172 * MiB;
constexpr size_t WS_XB = WS_WDN + 86 * MiB;
constexpr size_t WS_R = WS_XB + 128 * MiB;
constexpr size_t WS_PROJ = WS_R;
constexpr size_t WS_KFT = WS_PROJ + 384 * MiB, WS_KBT = WS_KFT + 64 * MiB, WS_VT = WS_KBT + 64 * MiB;
constexpr size_t WS_SFT = WS_VT + 64 * MiB, WS_SBT = WS_SFT + 128 * MiB;
constexpr size_t WS_YCAT = WS_SBT + 128 * MiB;
constexpr size_t WS_MIX_END = WS_YCAT + 128 * MiB;
constexpr size_t WS_GU = WS_R;
constexpr size_t WS_ACT = WS_GU + 688 * MiB;
constexpr size_t WS_HG = 22 * MiB;
constexpr size_t WS_HU = WS_ACT + 344 * MiB;
constexpr size_t WS_END = WS_HU + 6 * MiB;
static_assert(WS_MIX_END <= WS_END, "overlay");
static_assert((size_t)M * N1 * 2 == 384 * MiB && (size_t)M * NGU * 2 == 688 * MiB && (size_t)M * FF * 2 == 344 * MiB && (size_t)IN_COLS * D * 2 == 112 * MiB && (size_t)NGU * D * 2 == 172 * MiB && (size_t)D * FF * 2 == 86 * MiB, "sizes");
constexpr int CW_BAR = 4096;

constexpr int RING_OFF = 0, RING_BYTES = 136 * 1024;
constexpr int LDSCTL_OFF = RING_BYTES, MISC_OFF = LDSCTL_OFF + 320;
constexpr int LDS_BYTES = 147456;
static_assert(MISC_OFF + 128 <= LDS_BYTES && 8 * 16640 <= RING_BYTES, "LDS map");

#define GAS __attribute__((address_space(1)))
#define LAS __attribute__((address_space(3)))
typedef unsigned short bf16;
typedef unsigned v4u __attribute__((ext_vector_type(4)));
typedef unsigned v2u __attribute__((ext_vector_type(2)));
typedef float f32x4 __attribute__((ext_vector_type(4)));
typedef float f32x16 __attribute__((ext_vector_type(16)));
typedef short bf16x8 __attribute__((ext_vector_type(8)));
typedef GAS unsigned gu32;
#define RLX_AGENT __ATOMIC_RELAXED, __HIP_MEMORY_SCOPE_AGENT
#define LDS_WAIT() asm volatile("s_waitcnt lgkmcnt(0)" ::: "memory")
#define VM_WAIT() asm volatile("s_waitcnt vmcnt(0)" ::: "memory")
__device__ __forceinline__ unsigned pk2(float lo, float hi) { return pg8::cvt_pk_bf16(lo, hi); }
__device__ __forceinline__ float bflo(unsigned w) { return __uint_as_float(w << 16); }
__device__ __forceinline__ float bfhi(unsigned w) { return __uint_as_float(w & 0xffff0000u); }
__device__ __forceinline__ void unpack8(const v4u w, float (&f)[8]) { f[0] = bflo(w.x); f[1] = bfhi(w.x); f[2] = bflo(w.y); f[3] = bfhi(w.y); f[4] = bflo(w.z); f[5] = bfhi(w.z); f[6] = bflo(w.w); f[7] = bfhi(w.w); }

#define XB_TMO      128
#define XB_XCNT(j)  (256  + 64 * (j))
#define XB_XSUB(j)  (1280 + 64 * (j))
#define XB_XGEN(j)  (2304 + 64 * (j))
#define XB_TOP      3328
#define XB_TOPGEN   3392
#define XCD_BAR_WORDS 3456
#define XB_SPIN_CAP (1u << 18)

__device__ __forceinline__ unsigned xb_ld(unsigned* p)              { return __hip_atomic_load(p, __ATOMIC_RELAXED, __HIP_MEMORY_SCOPE_AGENT); }
__device__ __forceinline__ unsigned xb_add(unsigned* p, unsigned v) { return __hip_atomic_fetch_add(p, v, __ATOMIC_RELAXED, __HIP_MEMORY_SCOPE_AGENT); }
__device__ __forceinline__ unsigned xb_xcc_id() { return (unsigned)__builtin_amdgcn_s_getreg((3 << 11) | 20) & 0xFu; }
#define XB_SPIN(cond, bar) do { unsigned _sp = 0; while (cond) { __builtin_amdgcn_s_sleep(1); \
    if ((++_sp & 255u) == 0u) { if (xb_ld(&(bar)[XB_TMO])) break; if (_sp > XB_SPIN_CAP) { atomicAdd(&(bar)[XB_TMO], 1u); break; } } } } while (0)

struct XcdBarrier {
    unsigned* bar; unsigned x;
    volatile LAS unsigned* st;
};
__device__ __forceinline__ XcdBarrier xcd_barrier_post(unsigned* bar, volatile LAS unsigned* st, bool is_t0) {
    XcdBarrier b; b.bar = bar; b.x = xb_xcc_id(); b.st = st;
    if (is_t0) (void)xb_add(&bar[XB_XCNT(b.x)], 1u);
    return b;
}
__device__ __forceinline__ void xcd_barrier_complete(unsigned* bar, unsigned x, unsigned& nloc, unsigned& nx) {
    const unsigned G = gridDim.x * gridDim.y * gridDim.z;
    unsigned sum, cnt, mine, sp = 0u;
    for (;;) {
        sum = 0u; cnt = 0u; mine = 0u;
#pragma unroll
        for (unsigned j = 0; j < 16; ++j) { const unsigned c = xb_ld(&bar[XB_XCNT(j)]); sum += c; cnt += (c > 0u) ? 1u : 0u; mine = (j == x) ? c : mine; }
        if (sum == G) break;
        __builtin_amdgcn_s_sleep(1);
        if ((++sp & 255u) == 0u) { if (xb_ld(&bar[XB_TMO])) break; if (sp > XB_SPIN_CAP) { atomicAdd(&bar[XB_TMO], 1u); break; } }
    }
    nloc = mine > 0u ? mine : 1u; nx = cnt > 0u ? cnt : 1u;
}
__device__ __forceinline__ void xcd_barrier(const XcdBarrier& b, bool is_t0) {
    asm volatile("s_waitcnt vmcnt(0)" ::: "memory");
    __syncthreads();
    if (is_t0) {
        unsigned* bar = b.bar;
        __builtin_amdgcn_s_waitcnt(0);
        unsigned nloc = b.st[0], nx = b.st[1];
        if (nloc == 0u) { xcd_barrier_complete(bar, b.x, nloc, nx); b.st[0] = nloc; b.st[1] = nx; }
        const unsigned old = xb_add(&bar[XB_XSUB(b.x)], 1u);
        const unsigned gen = old / nloc;
        if (old + 1u == (gen + 1u) * nloc) {
            __builtin_amdgcn_fence(__ATOMIC_RELEASE, "agent");
            asm volatile("s_waitcnt vmcnt(0)" ::: "memory");
            const unsigned og = xb_add(&bar[XB_TOP], 1u);
            const unsigned tg = og / nx;
            if (og + 1u == (tg + 1u) * nx) xb_add(&bar[XB_TOPGEN], 1u);
            else XB_SPIN(xb_ld(&bar[XB_TOPGEN]) == tg, bar);
            __builtin_amdgcn_fence(__ATOMIC_ACQUIRE, "agent");
            xb_add(&bar[XB_XGEN(b.x)], 1u);
            asm volatile("s_waitcnt vmcnt(0)" ::: "memory");
        } else {
            XB_SPIN(xb_ld(&bar[XB_XGEN(b.x)]) == gen, bar);
            __builtin_amdgcn_fence(__ATOMIC_ACQUIRE, "agent");
            asm volatile("s_waitcnt vmcnt(0)" ::: "memory");
        }
    }
    __syncthreads();
}

struct Args { const void* in[17]; float* out; unsigned char* ws; int ph_lo, ph_hi; };
static_assert(sizeof(Args) == 17 * 8 + 8 + 8 + 8, "Args has no padding");
struct Frame {
    LAS unsigned char* lds;
    int tid, lane, wave;
    int vcu, G;
    const __attribute__((address_space(4))) Args* ap;
};
#define F_x ((const float*)(const GAS float*)F.ap->in[0])
#define F_pos ((const int*)(const GAS int*)F.ap->in[1])
#define F_norm1_g ((const float*)(const GAS float*)F.ap->in[2])
#define F_w_in ((const float*)(const GAS float*)F.ap->in[3])
#define F_conv_a_w ((const float*)(const GAS float*)F.ap->in[4])
#define F_conv_a_b ((const float*)(const GAS float*)F.ap->in[5])
#define F_beta_a ((const float*)(const GAS float*)F.ap->in[6])
#define F_dlogit ((const float*)(const GAS float*)F.ap->in[7])
#define F_gn_g ((const float*)(const GAS float*)F.ap->in[8])
#define F_w_out ((const float*)(const GAS float*)F.ap->in[9])
#define F_norm2_g ((const float*)(const GAS float*)F.ap->in[10])
#define F_w_gate ((const float*)(const GAS float*)F.ap->in[11])
#define F_w_up ((const float*)(const GAS float*)F.ap->in[12])
#define F_ffn_w ((const float*)(const GAS float*)F.ap->in[13])
#define F_ffn_b ((const float*)(const GAS float*)F.ap->in[14])
#define F_w_down ((const float*)(const GAS float*)F.ap->in[15])
#define F_norm_f ((const float*)(const GAS float*)F.ap->in[16])
#define F_out ((float*)(GAS float*)F.ap->out)
#define F_rstd1 ((float*)(GAS float*)(F.ap->ws + WS_RSTD1))
#define F_rstd2 ((float*)(GAS float*)(F.ap->ws + WS_RSTD2))
#define F_lgam ((float*)(GAS float*)(F.ap->ws + WS_LGAM))
#define F_part ((float*)(GAS float*)(F.ap->ws + WS_PART))
#define F_rs8 ((float*)(GAS float*)(F.ap->ws + WS_RS8))
#define F_rs8p ((float*)(GAS float*)(F.ap->ws + WS_RS8 + 64 * 1024))
#define F_xq8p ((unsigned char*)(GAS unsigned char*)(F.ap->ws + WS_YCAT))
#define F_wsq ((float*)(GAS float*)(F.ap->ws + WS_WSQ))
#define F_xq8 ((unsigned char*)(GAS unsigned char*)(F.ap->ws + WS_GU))
#define F_wabs ((unsigned*)(GAS unsigned*)(F.ap->ws) + WABS_WORD)
#define F_cosb ((float*)(GAS float*)(F.ap->ws + WS_COS))
#define F_sinb ((float*)(GAS float*)(F.ap->ws + WS_SIN))
#define F_WIN ((bf16*)(GAS bf16*)(F.ap->ws + WS_WIN))
#define F_WOUT ((bf16*)(GAS bf16*)(F.ap->ws + WS_WOUT))
#define F_WGU ((bf16*)(GAS bf16*)(F.ap->ws + WS_WGU))
#define F_WDN ((bf16*)(GAS bf16*)(F.ap->ws + WS_WDN))
#define F_XB ((bf16*)(GAS bf16*)(F.ap->ws + WS_XB))
#define F_PROJ ((bf16*)(GAS bf16*)(F.ap->ws + WS_PROJ))
#define F_KFT ((bf16*)(GAS bf16*)(F.ap->ws + WS_KFT))
#define F_KBT ((bf16*)(GAS bf16*)(F.ap->ws + WS_KBT))
#define F_VT ((bf16*)(GAS bf16*)(F.ap->ws + WS_VT))
#define F_SFT ((bf16*)(GAS bf16*)(F.ap->ws + WS_SFT))
#define F_SBT ((bf16*)(GAS bf16*)(F.ap->ws + WS_SBT))
#define F_YCAT ((bf16*)(GAS bf16*)(F.ap->ws + WS_YCAT))
#define F_GU ((bf16*)(GAS bf16*)(F.ap->ws + WS_GU))
#define F_HG ((float*)(GAS float*)(F.ap->ws + WS_HG))
#define F_HU ((float*)(GAS float*)(F.ap->ws + WS_HU))
#define F_ACT ((bf16*)(GAS bf16*)(F.ap->ws + WS_ACT))
__device__ __forceinline__ float wave_sum(float v) {
    int ln; asm volatile("v_mbcnt_lo_u32_b32 %0, -1, 0\n\tv_mbcnt_hi_u32_b32 %0, -1, %0" : "=v"(ln));
#pragma unroll
    for (int o = 1; o < 64; o <<= 1) v += __builtin_bit_cast(float, __builtin_amdgcn_ds_bpermute((ln ^ o) << 2, __builtin_bit_cast(int, v)));
    return v;
}

__device__ __forceinline__ void cvt_item(const float* __restrict__ W, int N, const float* __restrict__ gain, bf16* WT, int K, int k0, int n0s, int n0d, LAS float* scr, int lane, bool f8 = false, int kd = -1, float qs = 0.f) {
    if (kd < 0) kd = k0;
    const int r4 = lane >> 4, c4 = (lane & 15) * 4;
    f32x4 v[16];
#pragma unroll
    for (int i = 0; i < 16; ++i) v[i] = *(const f32x4*)(W + (size_t)(k0 + 4 * i + r4) * N + n0s + c4);
#pragma unroll
    for (int i = 0; i < 16; ++i) { const int kk = 4 * i + r4; const float g = gain ? gain[k0 + kk] : 1.0f; LAS float* s = scr + kk * 65 + c4;
        s[0] = v[i].x * g; s[1] = v[i].y * g; s[2] = v[i].z * g; s[3] = v[i].w * g;
        }
    LDS_WAIT(); asm volatile("" ::: "memory");
    const int c = lane & 7;
#pragma unroll
    for (int it = 0; it < 8; ++it) { const int n = (lane >> 3) + 8 * it; const LAS float* s = scr + (8 * c) * 65 + n;
        if (qs > 0.f) {
#define Q8(i) ((int)__builtin_rintf(__builtin_fminf(__builtin_fmaxf(s[(i) * 65] * qs, -127.0f), 127.0f)) & 255)
            v2u o8; o8.x = (unsigned)(Q8(0) | (Q8(1) << 8) | (Q8(2) << 16) | (Q8(3) << 24)); o8.y = (unsigned)(Q8(4) | (Q8(5) << 8) | (Q8(6) << 16) | (Q8(7) << 24));
#undef Q8
            *(v2u*)((unsigned char*)WT + (size_t)(n0d + n) * K + kd + 8 * c) = o8;
        } else if (f8) {
#define W8(i) __builtin_fminf(__builtin_fmaxf(s[(i) * 65] * pg8::F8_WSCALE, -440.0f), 440.0f)
            int t = __builtin_amdgcn_cvt_pk_fp8_f32(W8(0), W8(1), 0, false); t = __builtin_amdgcn_cvt_pk_fp8_f32(W8(2), W8(3), t, true);
            int q = __builtin_amdgcn_cvt_pk_fp8_f32(W8(4), W8(5), 0, false); q = __builtin_amdgcn_cvt_pk_fp8_f32(W8(6), W8(7), q, true);
#undef W8
            v2u o8; o8.x = (unsigned)t; o8.y = (unsigned)q; *(v2u*)((unsigned char*)WT + (size_t)(n0d + n) * K + kd + 8 * c) = o8;
        } else {
        v4u o; o.x = pk2(s[0 * 65], s[1 * 65]); o.y = pk2(s[2 * 65], s[3 * 65]); o.z = pk2(s[4 * 65], s[5 * 65]); o.w = pk2(s[6 * 65], s[7 * 65]);
        *(v4u*)(WT + (size_t)(n0d + n) * K + kd + 8 * c) = o; } }
    LDS_WAIT(); asm volatile("" ::: "memory");
}
__device__ __forceinline__ void cvt_matrix(Frame& F, const float* W, int K, int N, const float* gain, bf16* WT, int dst_row0, bool in_perm, int& it, int it_end_prev, LAS float* scr, int k8 = 0, int n8rows = 0, float qs = 0.f) {
    const int nnb = N / 64, nitems = (K / 64) * nnb, NGW = F.G * NWAVES;
    for (; it < it_end_prev + nitems; it += NGW) {
        const int r = it - it_end_prev, kb = r / nnb, nb = r % nnb; const int n0s = nb * 64; int n0d = dst_row0 + n0s;
        if (dst_row0 < 0) { n0d = (n0s >> 7) * 256 + (dst_row0 == -2 ? 128 : 0) + (n0s & 127); }
        if (in_perm) { const int blk = n0s >> 11, dblk = (blk < 4) ? blk : (blk == 4 ? 5 : (blk == 5 ? 6 : 4)); n0d = dblk * 2048 + (n0s & 2047); }
        const bool f8 = kb * 64 < k8;
        if (n0d < n8rows) cvt_item(W, N, gain, WT, K, kb * 64, n0s, n0d, scr, F.lane, false, -1, qs);
        else if (f8) cvt_item(W, N, gain, WT, k8, kb * 64, n0s, n0d, scr, F.lane, true);
        else cvt_item(W, N, gain, (bf16*)((unsigned char*)WT + (size_t)N * k8), K - k8, kb * 64, n0s, n0d, scr, F.lane, false, kb * 64 - k8);
    }
}

constexpr int WQ_KBLOCKS = 4;
__device__ __forceinline__ float wave_max(float v) {
    int ln; asm volatile("v_mbcnt_lo_u32_b32 %0, -1, 0\n\tv_mbcnt_hi_u32_b32 %0, -1, %0" : "=v"(ln));
#pragma unroll
    for (int o = 1; o < 64; o <<= 1) v = __builtin_fmaxf(v, __builtin_bit_cast(float, __builtin_amdgcn_ds_bpermute((ln ^ o) << 2, __builtin_bit_cast(int, v))));
    return v;
}
__device__ __forceinline__ void wabs_phase(Frame& F) {
    const int gw = F.vcu * NWAVES + F.wave, NGW = F.G * NWAVES, r4 = F.lane >> 4, c4 = (F.lane & 15) * 4;
    for (int l = 0; l < DEPTH; ++l)
        for (int mat = 0; mat < 3; ++mat) {
            const int nnb = (mat == 2) ? in8_of(l) * 4 : gu8_of(l) * 2; if (nnb == 0) continue;
            const int N = (mat == 2) ? IN_COLS : FF; const float* W = (mat == 2) ? F_w_in + (size_t)l * D * IN_COLS : (mat ? F_w_up : F_w_gate) + (size_t)l * D * FF; const float* gain = ((mat == 2) ? F_norm1_g : F_norm2_g) + l * D; float mx = 0.f, sq = 0.f;
            for (int it = gw; it < WQ_KBLOCKS * nnb; it += NGW) { const int kbi = it / nnb, nb = it - kbi * nnb, kb = kbi * ((D / 64) / WQ_KBLOCKS); f32x4 v[16];
#pragma unroll
                for (int i = 0; i < 16; ++i) v[i] = *(const f32x4*)(W + (size_t)(kb * 64 + 4 * i + r4) * N + nb * 64 + c4);
#pragma unroll
                for (int i = 0; i < 16; ++i) { const float g = gain[kb * 64 + 4 * i + r4]; const f32x4 p = v[i] * g; mx = __builtin_fmaxf(mx, __builtin_fmaxf(__builtin_fmaxf(__builtin_fabsf(p.x), __builtin_fabsf(p.y)), __builtin_fmaxf(__builtin_fabsf(p.z), __builtin_fabsf(p.w)))); sq += (p.x * p.x + p.y * p.y) + (p.z * p.z + p.w * p.w); } }
            mx = wave_max(mx); sq = wave_sum(sq); if (F.lane == 0) { __hip_atomic_fetch_max(F_wabs + 4 * l + mat, __float_as_uint(mx), RLX_AGENT); if (gw < 2048) F_wsq[(4 * l + mat) * 2048 + gw] = sq; } }
}
__device__ __forceinline__ float wq_range(Frame& F, int l, int mat) {
    const int NGW = F.G * NWAVES; float s = 0.f;
    for (int i = F.lane; i < NGW && i < 2048; i += 64) s += F_wsq[(4 * l + mat) * 2048 + i];
    s = wave_sum(s); const float cnt = (float)(WQ_KBLOCKS * 64) * (float)((mat == 2) ? in8_of(l) * 256 : gu8_of(l) * 128);
    return __builtin_fmaxf(__builtin_fminf(__uint_as_float(__hip_atomic_load(F_wabs + 4 * l + mat, RLX_AGENT)), 4.25f * sqrtf(s / cnt)), 1e-30f);
}
__device__ __forceinline__ void p5_i8_phase(Frame& F, float* rstd_out, unsigned char* q_out, float* tab_out, float tsc) {
    const int gw = F.vcu * NWAVES + F.wave, NGW = F.G * NWAVES;
    float pcur = 0.f; v4u w[8];
    if (gw < M) { pcur = F_part[(size_t)gw * 64 + F.lane]; const bf16* xr = F_XB + (size_t)gw * D + 8 * F.lane;
#pragma unroll
        for (int j = 0; j < 8; ++j) w[j] = *(const v4u*)(xr + 512 * j); }
    for (int row = gw; row < M; row += NGW) {
        const int nrow = row + NGW; const bool hasn = nrow < M; float pnext = 0.f; v4u wn[8];
        if (hasn) { pnext = F_part[(size_t)nrow * 64 + F.lane]; const bf16* xn = F_XB + (size_t)nrow * D + 8 * F.lane;
#pragma unroll
            for (int j = 0; j < 8; ++j) wn[j] = *(const v4u*)(xn + 512 * j); }
        const float s = wave_sum(pcur); const float rstd = 1.0f / sqrtf(s * (1.0f / D) + EPS);
        float mx = 0.f;
#pragma unroll
        for (int j = 0; j < 8; ++j) { float v[8]; unpack8(w[j], v);
#pragma unroll
            for (int e = 0; e < 8; ++e) mx = __builtin_fmaxf(mx, __builtin_fabsf(v[e])); }
        mx = wave_max(mx); const float qs = mx > 0.f ? 127.0f / mx : 0.f;
        unsigned char* qr = q_out + (size_t)row * D + 8 * F.lane;
#pragma unroll
        for (int j = 0; j < 8; ++j) { float v[8]; unpack8(w[j], v);
#define Q8(i) ((int)__builtin_rintf(v[i] * qs) & 255)
            v2u o; o.x = (unsigned)(Q8(0) | (Q8(1) << 8) | (Q8(2) << 16) | (Q8(3) << 24)); o.y = (unsigned)(Q8(4) | (Q8(5) << 8) | (Q8(6) << 16) | (Q8(7) << 24));
#undef Q8
            *(v2u*)(qr + 512 * j) = o; }
        if (F.lane == 0) { rstd_out[row] = rstd; tab_out[row] = rstd * mx * (1.0f / 127.0f) * tsc; }
        if (hasn) { pcur = pnext;
#pragma unroll
            for (int j = 0; j < 8; ++j) w[j] = wn[j]; } }
}
__device__ __forceinline__ void rstd_from_part(Frame& F, float* rstd) {
    const int gw = F.vcu * NWAVES + F.wave, NGW = F.G * NWAVES;
    for (int row = gw; row < M; row += NGW) { const float s = wave_sum(F_part[(size_t)row * 64 + F.lane]); if (F.lane == 0) rstd[row] = 1.0f / sqrtf(s * (1.0f / D) + EPS); }
}
__device__ __forceinline__ void p0_phase(Frame& F, int l) {
    LAS float* scr = (LAS float*)(F.lds + RING_OFF + F.wave * 16640);
    const int gw = F.vcu * NWAVES + F.wave, NGW = F.G * NWAVES;
    int it = gw, base = 0;
    cvt_matrix(F, F_w_in + (size_t)l * D * IN_COLS, D, IN_COLS, F_norm1_g + l * D, F_WIN, 0, true, it, base, scr, 0, in8_of(l) * 256, in8_of(l) > 0 ? 127.0f / wq_range(F, l, 2) : 0.f); base += (D / 64) * (IN_COLS / 64);
    cvt_matrix(F, F_w_out + (size_t)l * D * D, D, D, nullptr, F_WOUT, 0, false, it, base, scr); base += (D / 64) * (D / 64);
    cvt_matrix(F, F_w_gate + (size_t)l * D * FF, D, FF, F_norm2_g + l * D, F_WGU, -1, false, it, base, scr, 0, gu8_of(l) * 256, gu8_of(l) > 0 ? 127.0f / __builtin_fmaxf(wq_range(F, l, 0), 1e-30f) : 0.f); base += (D / 64) * (FF / 64);
    cvt_matrix(F, F_w_up + (size_t)l * D * FF, D, FF, F_norm2_g + l * D, F_WGU, -2, false, it, base, scr, 0, gu8_of(l) * 256, gu8_of(l) > 0 ? 127.0f / __builtin_fmaxf(wq_range(F, l, 1), 1e-30f) : 0.f); base += (D / 64) * (FF / 64);
    cvt_matrix(F, F_w_down + (size_t)l * FF * D, FF, D, nullptr, F_WDN, 0, false, it, base, scr, k8_of(l));
    if (l == 0) {
        { f32x4 v[16];
          if (gw < M) { const float* xr = F_x + (size_t)gw * D + 8 * F.lane;
#pragma unroll
              for (int j = 0; j < 8; ++j) { v[2 * j] = *(const f32x4*)(xr + 512 * j); v[2 * j + 1] = *(const f32x4*)(xr + 512 * j + 4); } }
          for (int m = gw; m < M; m += NGW) { const int mn = m + NGW; const bool hasn = mn < M; f32x4 vn[16]; float ss = 0.f;
            if (hasn) { const float* xn = F_x + (size_t)mn * D + 8 * F.lane;
#pragma unroll
                for (int j = 0; j < 8; ++j) { vn[2 * j] = *(const f32x4*)(xn + 512 * j); vn[2 * j + 1] = *(const f32x4*)(xn + 512 * j + 4); } }
#pragma unroll
            for (int j = 0; j < 16; ++j) ss += (v[j].x * v[j].x + v[j].y * v[j].y) + (v[j].z * v[j].z + v[j].w * v[j].w);
            ss = wave_sum(ss); if (F.lane == 0) F_rstd1[m] = 1.0f / sqrtf(ss * (1.0f / D) + EPS);
            bf16* o = F_XB + (size_t)m * D + 8 * F.lane;
#pragma unroll
            for (int j = 0; j < 8; ++j) *(v4u*)(o + 512 * j) = pg8::pack8(v[2 * j], v[2 * j + 1]);
            if (hasn) {
#pragma unroll
                for (int j = 0; j < 16; ++j) v[j] = vn[j]; } } }
        { const int gt = gw * 64 + F.lane, NT = NGW * 64; const int j = gt & 127;
          const float inv = exp2f(-(float)j * (13.287712379549449f / 128.0f));
          for (int idx = gt; idx < M * 128; idx += NT) { const int m = idx >> 7; const float ang = (float)F_pos[m] * inv;
              const double a = (double)ang, k = rint(a * 0.15915494309189535), r = a - k * 6.283185307179586; const float rf = (float)r;
              const float c = cosf(rf), s = sinf(rf);
              F_cosb[idx] = c; F_sinb[idx] = s; } }
        if (blockIdx.x == 0 && F.tid < DEPTH * 2 * RH) { const float xl = F_dlogit[F.tid]; const float t = __expf(-xl);
            const float ser = t * (1.0f - t * (0.5f - t * (0.33333334f - t * (0.25f - t * 0.2f)))); F_lgam[F.tid] = -((t < 0.04f) ? ser : __logf(1.0f + t)); }
    } else if (in8_of(l) > 0) p5_i8_phase(F, F_rstd1, F_xq8p, F_rs8p, wq_range(F, l, 2) * (1.0f / 127.0f));
    else rstd_from_part(F, F_rstd1);
}

__device__ __forceinline__ void mixer_a(Frame& F, int l) {
    const int gw = F.vcu * NWAVES + F.wave, NGW = F.G * NWAVES;
    for (int item = gw; item < (M / 32) * 4; item += NGW) {
        const int t0 = (item >> 2) * 32, c0 = (item & 3) * 512 + F.lane * 8;
        float w0[8], w1[8], w2[8], bb[8], be[8];
        { const float* cw = F_conv_a_w + (size_t)l * 3 * CW + c0; const float* cb = F_conv_a_b + (size_t)l * CW + c0; const float* bt = F_beta_a + (size_t)l * CW + c0;
#pragma unroll
          for (int j = 0; j < 8; ++j) { w0[j] = cw[j]; w1[j] = cw[CW + j]; w2[j] = cw[2 * CW + j]; bb[j] = cb[j]; be[j] = bt[j]; } }
        const bf16* pbase = F_PROJ + c0;
        float pp[8], pc[8];
        if ((t0 & (SEQ - 1)) == 0) {
#pragma unroll
            for (int j = 0; j < 8; ++j) pp[j] = 0.f;
        } else { float a[8], b[8]; unpack8(*(const v4u*)(pbase + (size_t)(t0 - 1) * N1 + COL_AC), a); unpack8(*(const v4u*)(pbase + (size_t)(t0 - 1) * N1 + COL_AX), b);
#pragma unroll
            for (int j = 0; j < 8; ++j) pp[j] = a[j] * b[j]; }
        { float a[8], b[8]; unpack8(*(const v4u*)(pbase + (size_t)t0 * N1 + COL_AC), a); unpack8(*(const v4u*)(pbase + (size_t)t0 * N1 + COL_AX), b);
#pragma unroll
          for (int j = 0; j < 8; ++j) pc[j] = a[j] * b[j]; }
        for (int t = t0; t < t0 + 32; t += 4) {
            v4u ac[4], ax[4], ab[4];
#pragma unroll
            for (int k = 0; k < 4; ++k) { const int tn = t + k + 1; const bool z = (tn & (SEQ - 1)) == 0;
                ac[k] = z ? (v4u){0u, 0u, 0u, 0u} : *(const v4u*)(pbase + (size_t)tn * N1 + COL_AC); ax[k] = z ? (v4u){0u, 0u, 0u, 0u} : *(const v4u*)(pbase + (size_t)tn * N1 + COL_AX);
                ab[k] = *(const v4u*)(pbase + (size_t)(t + k) * N1 + COL_AB); }
#pragma unroll
            for (int k = 0; k < 4; ++k) {
                float pn[8], fa[8], fx[8], fb[8], y[8]; unpack8(ac[k], fa); unpack8(ax[k], fx); unpack8(ab[k], fb); float ss = 0.f;
#pragma unroll
                for (int j = 0; j < 8; ++j) { pn[j] = fa[j] * fx[j]; y[j] = fb[j] * (w0[j] * pp[j] + w1[j] * pc[j] + w2[j] * pn[j] + bb[j]); ss += y[j] * y[j]; }
                ss += __shfl_xor(ss, 1); ss += __shfl_xor(ss, 2); ss += __shfl_xor(ss, 4); ss += __shfl_xor(ss, 8);
                const float r = 1.0f / sqrtf(ss * (1.0f / 128.0f) + EPS);
                v4u o; o.x = pk2(y[0] * r * be[0], y[1] * r * be[1]); o.y = pk2(y[2] * r * be[2], y[3] * r * be[3]); o.z = pk2(y[4] * r * be[4], y[5] * r * be[5]); o.w = pk2(y[6] * r * be[6], y[7] * r * be[7]);
                *(v4u*)(F_YCAT + (size_t)(t + k) * D + c0) = o;
#pragma unroll
                for (int j = 0; j < 8; ++j) { pp[j] = pc[j]; pc[j] = pn[j]; } }
        }
    }
}

#define MFMA32(a, b, c) __builtin_amdgcn_mfma_f32_32x32x16_bf16((a), (b), (c), 0, 0, 0)
__device__ __forceinline__ void scan_dma(const char* kt, const char* vt, LAS unsigned char* dst, int w, int lane) {
#pragma unroll
    for (int q = 0; q < 4; ++q) { __builtin_amdgcn_global_load_lds((const unsigned*)(kt + q * 8192), (LAS unsigned*)(dst + q * 8192 + w * 1024), 16, 0, 0);
        __builtin_amdgcn_global_load_lds((const unsigned*)(vt + q * 8192), (LAS unsigned*)(dst + 32768 + q * 8192 + w * 1024), 16, 0, 0); }
}
__device__ __forceinline__ void scan_phase(Frame& F, int l) {
    LAS unsigned char* BUF = F.lds + RING_OFF;
    const int w = F.wave, dbl = w & 3, eql = w >> 2;
    for (int unit = F.vcu; unit < BATCH * RH * 2 * 2 * 2; unit += F.G) {
        const int eh2 = unit & 1, dq = (unit >> 1) & 1, dir = (unit >> 2) & 1, h = (unit >> 3) & 7, b = unit >> 6;
        const size_t blk0 = (size_t)(b * RH + h) * NCH * (HD * CHUNK);
        const char* KT = (const char*)((dir ? F_KBT : F_KFT) + blk0) + (size_t)((4 * dq * 8 + w) * 64 + F.lane) * 16;
        const char* VT = (const char*)(F_VT + blk0) + (size_t)((4 * eh2 * 8 + w) * 64 + F.lane) * 16;
        const int eq = 2 * eh2 + eql, dblk = 4 * dq + dbl;
        bf16* ST = (dir ? F_SBT : F_SFT) + (size_t)(b * RH + h) * NCH * (HD * HD) + (size_t)(((2 * eq) * 16 + 2 * dblk) * 64 + F.lane) * 8;
        const float g128 = __expf(128.0f * F_lgam[l * 16 + dir * 8 + h]);
        f32x16 s0, s1;
#pragma unroll
        for (int r = 0; r < 16; ++r) { s0[r] = 0.f; s1[r] = 0.f; }
        __syncthreads();
        { const int n0 = dir ? (NCH - 1) : 0; scan_dma(KT + (size_t)n0 * HD * CHUNK * 2, VT + (size_t)n0 * HD * CHUNK * 2, BUF, w, F.lane); }
        for (int step = 0; step < NCH; ++step) {
            const int n = dir ? (NCH - 1 - step) : step, nn = dir ? (n - 1) : (n + 1);
            VM_WAIT(); __syncthreads();
            if (step + 1 < NCH) scan_dma(KT + (size_t)nn * HD * CHUNK * 2, VT + (size_t)nn * HD * CHUNK * 2, BUF + ((step + 1) & 1) * 65536, w, F.lane);
            bf16* st = ST + (size_t)n * HD * HD;
#pragma unroll
            for (int sp = 0; sp < 2; ++sp) {
                v4u a; a.x = pk2(s0[8 * sp], s0[8 * sp + 1]); a.y = pk2(s0[8 * sp + 2], s0[8 * sp + 3]); a.z = pk2(s0[8 * sp + 4], s0[8 * sp + 5]); a.w = pk2(s0[8 * sp + 6], s0[8 * sp + 7]);
                *(v4u*)(st + sp * 512) = a;
                v4u c; c.x = pk2(s1[8 * sp], s1[8 * sp + 1]); c.y = pk2(s1[8 * sp + 2], s1[8 * sp + 3]); c.z = pk2(s1[8 * sp + 4], s1[8 * sp + 5]); c.w = pk2(s1[8 * sp + 6], s1[8 * sp + 7]);
                *(v4u*)(st + 16 * 512 + sp * 512) = c; }
#pragma unroll
            for (int r = 0; r < 16; ++r) { s0[r] *= g128; s1[r] *= g128; }
            const LAS unsigned char* kb = BUF + (step & 1) * 65536 + (dbl * 8 * 64 + F.lane) * 16; const LAS unsigned char* vb = BUF + (step & 1) * 65536 + 32768 + (2 * eql * 8 * 64 + F.lane) * 16;
#pragma unroll
            for (int ks = 0; ks < 8; ++ks) { const bf16x8 a = *(const LAS bf16x8*)(kb + ks * 1024), b0 = *(const LAS bf16x8*)(vb + ks * 1024), b1 = *(const LAS bf16x8*)(vb + 8192 + ks * 1024);
                s0 = MFMA32(a, b0, s0); s1 = MFMA32(a, b1, s1); }
        }
    }
    VM_WAIT(); __syncthreads();
}

__device__ __forceinline__ void dma16(const char* g, LAS unsigned char* l) { __builtin_amdgcn_global_load_lds((const unsigned*)g, (LAS unsigned*)l, 16, 0, 0); }
__device__ __forceinline__ void intra_dma(Frame& F, const int kind, const int p, LAS unsigned char* dst, int b, int h, int n, int w, int lane) {
    const int tok0 = b * SEQ + n * CHUNK;
    if (kind == 4) {
        const char* g0 = (const char*)F_VT + (((size_t)(b * RH + h) * NCH + n) * (HD * CHUNK)) * 2 + (size_t)(w * 64 + lane) * 16;
#pragma unroll
        for (int q = 0; q < 4; ++q) dma16(g0 + (size_t)(4 * (q >> 1) + 2 * p + (q & 1)) * 8192, dst + q * 8192 + w * 1024);
    } else if (kind == 2 || kind == 3) {
        const char* g0 = (const char*)(kind == 2 ? F_SFT : F_SBT) + ((size_t)(b * RH + h) * NCH + n) * HD * HD * 2 + (size_t)lane * 16;
#pragma unroll
        for (int q = 0; q < 4; ++q) { const int idx = q * 8 + w, ehl = idx >> 4, sx = idx & 15; dma16(g0 + (size_t)(((4 * ehl + p) * 16 + sx) * 1024), dst + q * 8192 + w * 1024); }
    } else {
        const int r0 = w * 2 + (lane >> 5), c = (lane & 31) ^ (r0 & 15);
        const char* g0 = (const char*)F_PROJ + ((size_t)(tok0 + (kind == 1 ? 64 * p : 0) + r0) * N1 + (kind == 0 ? COL_Q : COL_K) + h * HD) * 2 + c * 16;
#pragma unroll
        for (int q = 0; q < (kind == 0 ? 8 : 4); ++q) dma16(g0 + (size_t)q * 16 * N1 * 2, dst + q * 8192 + w * 1024);
    }
}
__device__ __forceinline__ void intra_phase(Frame& F, int l) {
    LAS unsigned char* QS = F.lds + RING_OFF; LAS unsigned char* BUF = QS + 65536; LAS float* red1 = (LAS float*)(QS + 131072); LAS float* red2 = red1 + 256;
    const int w = F.wave, ib = w & 3, eh = w >> 2, li = F.lane & 31, hh = F.lane >> 5, sw = li & 15, yx = hh ^ sw;
    const float L2E = 1.4426950408889634f;
    const int nun = BATCH * RH * NCH;
    if (F.vcu < nun) { const int u0 = F.vcu; intra_dma(F, 0, 0, QS, u0 >> 8, (u0 >> 5) & 7, u0 & 31, w, F.lane); intra_dma(F, 1, 0, BUF, u0 >> 8, (u0 >> 5) & 7, u0 & 31, w, F.lane); }
    for (int unit = F.vcu; unit < nun; unit += F.G) {
        const int n = unit & 31, h = (unit >> 5) & 7, b = unit >> 8;
        const int nxt = unit + F.G; const bool has_next = nxt < nun; const int n2 = nxt & 31, h2 = (nxt >> 5) & 7, b2 = nxt >> 8;
        int i = 32 * ib + li; asm volatile("" : "+v"(i));
        const int tok0 = b * SEQ + n * CHUNK, tok = tok0 + i;
        const float lf = F_lgam[l * 16 + h], lb = F_lgam[l * 16 + 8 + h];
        const float lf2 = lf * L2E, lb2 = lb * L2E;
        const LAS unsigned char* qrow = QS + (32 * ib + li) * 512;
#define QF(s) (*(const LAS bf16x8*)(qrow + (((2 * (s)) ^ yx) << 4)))
        bf16x8 pf[4][2];
        f32x16 acc[4];
#pragma unroll
        for (int et = 0; et < 4; ++et)
#pragma unroll
            for (int r = 0; r < 16; ++r) acc[et][r] = 0.f;
#pragma unroll
        for (int t = 0; t < 12; ++t) {
            VM_WAIT(); __syncthreads();
            LAS unsigned char* nb = BUF + ((t + 1) & 1) * 32768; const LAS unsigned char* cb = BUF + (t & 1) * 32768;
            int ln = F.lane; asm volatile("" : "+v"(ln));
            if (t < 11) { const int t1 = t + 1; intra_dma(F, t1 < 2 ? 1 : (t1 < 6 ? 2 : (t1 < 10 ? 3 : 4)), t1 < 2 ? t1 : (t1 < 6 ? t1 - 2 : (t1 < 10 ? t1 - 6 : t1 - 10)), nb, b, h, n, w, ln); }
            else if (has_next) intra_dma(F, 1, 0, nb, b2, h2, n2, w, ln);
            if (t == 10 && has_next) intra_dma(F, 0, 0, QS, b2, h2, n2, w, ln);
            if (t < 2) {
#pragma unroll
                for (int jtl = 0; jtl < 2; ++jtl) { const int jt = 2 * t + jtl; const LAS unsigned char* krow = cb + (32 * jtl + li) * 512;
                    f32x16 sc;
#pragma unroll
                    for (int r = 0; r < 16; ++r) sc[r] = 0.f;
#pragma unroll
                    for (int s = 0; s < 16; ++s) { const bf16x8 a = *(const LAS bf16x8*)(krow + (((2 * s) ^ yx) << 4)); sc = MFMA32(a, QF(s), sc); }
#pragma unroll
                    for (int s2 = 0; s2 < 2; ++s2) {
                        float pv[8];
#pragma unroll
                        for (int jj = 0; jj < 8; ++jj) { const int r = 8 * s2 + jj; const int j = 32 * jt + (r & 3) + 8 * (r >> 2) + 4 * hh; const int dd = i - j;
                            const float e = (dd >= 0) ? lf2 * (float)dd : lb2 * (float)(-dd); pv[jj] = sc[r] * exp2f(e); }
                        v4u pw; pw.x = pk2(pv[0], pv[1]); pw.y = pk2(pv[2], pv[3]); pw.z = pk2(pv[4], pv[5]); pw.w = pk2(pv[6], pv[7]);
                        pf[jt][s2] = __builtin_bit_cast(bf16x8, pw); } }
            } else if (t < 10) {
                const int et = (t - 2) & 3; const LAS unsigned char* srow = cb + (eh * 16 * 64 + F.lane) * 16;
#pragma unroll
                for (int s = 0; s < 16; ++s) { const bf16x8 a = *(const LAS bf16x8*)(srow + s * 1024); acc[et] = MFMA32(a, QF(s), acc[et]); }
                if (t == 5) { const float ratio = __expf(lf * (float)(i + 1) - lb * (float)(CHUNK - i));
#pragma unroll
                    for (int e2 = 0; e2 < 4; ++e2)
#pragma unroll
                        for (int r = 0; r < 16; ++r) acc[e2][r] *= ratio; }
                if (t == 9) { const float wb = __expf(lb * (float)(CHUNK - i));
#pragma unroll
                    for (int e2 = 0; e2 < 4; ++e2)
#pragma unroll
                        for (int r = 0; r < 16; ++r) acc[e2][r] *= wb; }
            } else {
                const int p = t - 10;
#pragma unroll
                for (int etl = 0; etl < 2; ++etl) { const int et = 2 * p + etl; const LAS unsigned char* vrow = cb + ((2 * eh + etl) * 8 * 64 + F.lane) * 16;
#pragma unroll
                    for (int jt = 0; jt < 4; ++jt)
#pragma unroll
                        for (int s2 = 0; s2 < 2; ++s2) { const bf16x8 a = *(const LAS bf16x8*)(vrow + (2 * jt + s2) * 1024); acc[et] = MFMA32(a, pf[jt][s2], acc[et]); } }
            }
        }
#undef QF
        float s = 0.f;
#pragma unroll
        for (int et = 0; et < 4; ++et)
#pragma unroll
            for (int r = 0; r < 16; ++r) s += acc[et][r];
        s += __shfl_xor(s, 32);
        if (hh == 0) red1[w * 32 + li] = s;
        LDS_WAIT(); __syncthreads();
        const float mean = (red1[ib * 32 + li] + red1[(ib + 4) * 32 + li]) * (1.0f / HD);
        float q = 0.f;
#pragma unroll
        for (int et = 0; et < 4; ++et)
#pragma unroll
            for (int r = 0; r < 16; ++r) { const float dlt = acc[et][r] - mean; q += dlt * dlt; }
        q += __shfl_xor(q, 32);
        if (hh == 0) red2[w * 32 + li] = q;
        LDS_WAIT(); __syncthreads();
        const float rstd = 1.0f / sqrtf((red2[ib * 32 + li] + red2[(ib + 4) * 32 + li]) * (1.0f / HD) + EPS);
        { const float* gn = F_gn_g + (size_t)l * RW + h * HD; const bf16* gp = F_PROJ + (size_t)tok * N1 + COL_G + h * HD; bf16* yp = F_YCAT + (size_t)tok * D + CW + h * HD;
          f32x4 gv[4][4]; v2u gw2[4][4];
#pragma unroll
          for (int et = 0; et < 4; ++et)
#pragma unroll
              for (int g = 0; g < 4; ++g) { const int e4 = 128 * eh + 32 * et + 8 * g + 4 * hh; gv[et][g] = *(const f32x4*)(gn + e4); gw2[et][g] = *(const v2u*)(gp + e4); }
          asm volatile("" : "+v"(gv[0][0]), "+v"(gv[0][1]), "+v"(gv[0][2]), "+v"(gv[0][3]), "+v"(gv[1][0]), "+v"(gv[1][1]), "+v"(gv[1][2]), "+v"(gv[1][3]),
                            "+v"(gv[2][0]), "+v"(gv[2][1]), "+v"(gv[2][2]), "+v"(gv[2][3]), "+v"(gv[3][0]), "+v"(gv[3][1]), "+v"(gv[3][2]), "+v"(gv[3][3]));
          asm volatile("" : "+v"(gw2[0][0]), "+v"(gw2[0][1]), "+v"(gw2[0][2]), "+v"(gw2[0][3]), "+v"(gw2[1][0]), "+v"(gw2[1][1]), "+v"(gw2[1][2]), "+v"(gw2[1][3]),
                            "+v"(gw2[2][0]), "+v"(gw2[2][1]), "+v"(gw2[2][2]), "+v"(gw2[2][3]), "+v"(gw2[3][0]), "+v"(gw2[3][1]), "+v"(gw2[3][2]), "+v"(gw2[3][3]));
#pragma unroll
          for (int et = 0; et < 4; ++et)
#pragma unroll
              for (int g = 0; g < 4; ++g) { const int e4 = 128 * eh + 32 * et + 8 * g + 4 * hh; const f32x4 gvv = gv[et][g]; const v2u gw = gw2[et][g];
                  const float gt[4] = {bflo(gw.x), bfhi(gw.x), bflo(gw.y), bfhi(gw.y)}; float y[4];
#pragma unroll
                  for (int j = 0; j < 4; ++j) { const float sg = gt[j] * __builtin_amdgcn_rcpf(1.0f + __expf(-gt[j])); y[j] = (acc[et][4 * g + j] - mean) * rstd * gvv[j] * sg; }
                  v2u o; o.x = pk2(y[0], y[1]); o.y = pk2(y[2], y[3]); *(v2u*)(yp + e4) = o; } }
    }
    VM_WAIT(); __syncthreads();
}

__device__ __forceinline__ void act_fix_phase(Frame& F, int l) {
    const int gt = (F.vcu * NWAVES + F.wave) * 64 + F.lane, NT = F.G * NWAVES * 64;
    for (int idx = gt; idx < (M / 256) * 2 * (FF / 8); idx += NT) {
        const int rs = idx / (FF / 8), c0 = (idx - rs * (FF / 8)) * 8, pm = rs >> 1, lastr = rs & 1, r = pm * 256 + (lastr ? 255 : 0);
        const float* hg = F_HG + (size_t)pm * 4 * FF + c0; const float* hu = F_HU + (size_t)(pm * 2 + lastr) * FF + c0;
        const bool zprev = !lastr && (r & (SEQ - 1)) == 0, znext = lastr && ((r + 1) & (SEQ - 1)) == 0;
        const float* gm = lastr ? hg + 2 * FF : hg - FF;
        const float* g0 = lastr ? hg + 3 * FF : hg;
        const float* gp = lastr ? hg + 4 * FF : hg + FF;
        const float* cw = F_ffn_w + (size_t)l * 3 * FF + c0; const float* cb = F_ffn_b + (size_t)l * FF + c0;
        float y[8];
#pragma unroll
        for (int j = 0; j < 8; ++j) { const float a = zprev ? 0.f : gm[j], c = znext ? 0.f : gp[j]; const float z = cw[j] * a + cw[FF + j] * g0[j] + cw[2 * FF + j] * c + cb[j]; y[j] = z / (1.0f + __expf(-z)) * hu[j]; }
        const int k8 = k8_of(l);
        if (c0 < k8) *(v2u*)((unsigned char*)F_ACT + (size_t)r * k8 + c0) = __builtin_bit_cast(v2u, pg8::pack8_fp8((f32x4){y[0], y[1], y[2], y[3]}, (f32x4){y[4], y[5], y[6], y[7]}));
        else { v4u o; o.x = pk2(y[0], y[1]); o.y = pk2(y[2], y[3]); o.z = pk2(y[4], y[5]); o.w = pk2(y[6], y[7]); *(v4u*)((unsigned char*)F_ACT + (size_t)M * k8 + ((size_t)r * (FF - k8) + (c0 - k8)) * 2) = o; }
    }
}

__device__ __forceinline__ void final_phase(Frame& F) {
    const int gw = F.vcu * NWAVES + F.wave, NGW = F.G * NWAVES;
    f32x4 gg[8][2];
    { const float* gr0 = F_norm_f + 8 * F.lane;
#pragma unroll
      for (int j = 0; j < 8; ++j) { gg[j][0] = *(const f32x4*)(gr0 + 512 * j); gg[j][1] = *(const f32x4*)(gr0 + 512 * j + 4); } }
    for (int m = gw; m < M; m += NGW) {
        const float s = wave_sum(F_part[(size_t)m * 64 + F.lane]); const float rs = 1.0f / sqrtf(s * (1.0f / D) + EPS);
        const bf16* xr = F_XB + (size_t)m * D + 8 * F.lane; float* orow = F_out + (size_t)m * D + 8 * F.lane;
        v4u xv[8];
#pragma unroll
        for (int j = 0; j < 8; ++j) xv[j] = *(const v4u*)(xr + 512 * j);
        asm volatile("" : "+v"(xv[0]), "+v"(xv[1]), "+v"(xv[2]), "+v"(xv[3]), "+v"(xv[4]), "+v"(xv[5]), "+v"(xv[6]), "+v"(xv[7]));
#pragma unroll
        for (int j = 0; j < 8; ++j) { float v[8]; unpack8(xv[j], v); const f32x4 g0 = gg[j][0], g1 = gg[j][1];
            *(f32x4*)(orow + 512 * j) = (f32x4){v[0] * rs * g0[0], v[1] * rs * g0[1], v[2] * rs * g0[2], v[3] * rs * g0[3]};
            *(f32x4*)(orow + 512 * j + 4) = (f32x4){v[4] * rs * g1[0], v[5] * rs * g1[1], v[6] * rs * g1[2], v[7] * rs * g1[3]}; }
    }
}

constexpr int PH_PER_LAYER = 9, N_PHASES = DEPTH * PH_PER_LAYER + 1;

__global__ void __launch_bounds__(NWAVES * 64, 2) enc_fwd(Args args) {
    extern __shared__ __attribute__((aligned(16))) unsigned char lds[];
    Frame F;
    F.lds = (LAS unsigned char*)lds;
    volatile LAS unsigned* MISC = (volatile LAS unsigned*)(F.lds + MISC_OFF);
    { int wv = __builtin_amdgcn_readfirstlane((int)threadIdx.x >> 6); asm volatile("" : "+s"(wv)); F.wave = wv; }
    { int ln_; asm volatile("v_mbcnt_lo_u32_b32 %0, -1, 0\n\tv_mbcnt_hi_u32_b32 %0, -1, %0" : "=v"(ln_)); F.lane = ln_; F.tid = F.wave * 64 + ln_; }
    F.G = gridDim.x; { const int bx = blockIdx.x; F.vcu = (F.G % 8 == 0) ? (bx % 8) * (F.G / 8) + bx / 8 : bx; }
    F.ap = (const __attribute__((address_space(4))) Args*)__builtin_amdgcn_kernarg_segment_ptr();
    unsigned char* ws = args.ws;
    for (int u = F.tid; u < (LDS_BYTES - LDSCTL_OFF) / 4; u += NWAVES * 64) ((LAS unsigned*)(F.lds + LDSCTL_OFF))[u] = 0u;
    __syncthreads();
    XcdBarrier bar; bar.bar = (unsigned*)(ws + WS_CTL) + CW_BAR; bar.x = 0; bar.st = nullptr;
#define LAUNDER() do { int ln_; asm volatile("v_mbcnt_lo_u32_b32 %0, -1, 0\n\tv_mbcnt_hi_u32_b32 %0, -1, %0" : "=v"(ln_)); asm volatile("" : "+s"(F.ap)); F.lane = ln_; F.tid = F.wave * 64 + ln_; } while (0)
#if !MK_SPLIT
    bar = xcd_barrier_post((unsigned*)(ws + WS_CTL) + CW_BAR, MISC + 8, F.tid == 0);
#define GRID_BAR() do { asm volatile("" : "+s"(bar.bar));     LAUNDER(); xcd_barrier(bar, F.tid == 0); } while (0)
#else
#define GRID_BAR() do {} while (0)
#endif
    const int lo = args.ph_lo, hi = args.ph_hi;
#define IN(k) (lo <= (k) && (k) < hi)
#define SEAM(k) do { if (IN(k) && IN((k) + 1)) GRID_BAR(); } while (0)
    using namespace pg8;
    if (IN(0) && (GU8_TILES_L0 > 0 || GU8_TILES_L1 > 0 || IN8_TILES_L1 > 0)) { LAUNDER(); wabs_phase(F); GRID_BAR(); }
    for (int l = 0; l < DEPTH; ++l) {
        const int pb = l * PH_PER_LAYER;
#define PT0(k) unsigned long long pt_##k = 0; if (PROBE_PHTIME == (k)) pt_##k = __builtin_amdgcn_s_memrealtime()
#define PT1(k) if (PROBE_PHTIME == (k) && blockIdx.x == 0 && F.tid == 0) MISC[18] += (unsigned)(__builtin_amdgcn_s_memrealtime() - pt_##k)
#define SP0(k) if (PROBE_SPREAD == (k) && F.tid == 0) { const unsigned t = (unsigned)__builtin_amdgcn_s_memrealtime(); gu32* cw = (gu32*)(F.ap->ws) + 2048 + l * 128; __hip_atomic_fetch_max(cw, t, RLX_AGENT); __hip_atomic_fetch_max(cw + 64, 0xFFFFFFFFu - t, RLX_AGENT); }
#define SP1(k) if (PROBE_SPREAD == (k) && blockIdx.x == 0 && F.tid == 0) { gu32* cw = (gu32*)(F.ap->ws) + 2048 + l * 128; const unsigned mx = __hip_atomic_load(cw, RLX_AGENT), mn = 0xFFFFFFFFu - __hip_atomic_load(cw + 64, RLX_AGENT); MISC[19] += mx - mn; }
#define BW0(k) unsigned long long bw_##k = 0; if (PROBE_BWAIT == (k)) bw_##k = __builtin_amdgcn_s_memrealtime()
#define BW1(k) if (PROBE_BWAIT == (k) && blockIdx.x == 0 && F.tid == 0) MISC[20] += (unsigned)(__builtin_amdgcn_s_memrealtime() - bw_##k)
        PT0(0); if (PHON(0) && IN(pb + 0)) { for (int rp = 0; rp < PHREP(0); ++rp) { LAUNDER(); p0_phase(F, l); } } SP0(0); BW0(0); SEAM(pb + 0); BW1(0); PT1(0); SP1(0);
        PT0(1); if (PHON(1) && IN(pb + 1)) for (int rp = 0; rp < PHREP(1); ++rp) { LAUNDER();
            const int ni = in8_of(l);
            if (ni > 0) { Gemm g{(const bf16*)F_xq8p, F_WIN, M, ni * 256, D / 2}; StaticOrder S; S.init(M, ni * 256, F.G, (int)blockIdx.x);
              EpiIn E{F_PROJ, N1, F_rs8p, (PG8_LAS const float*)(F.lds + RING_OFF + ROWTAB_OFF), F_cosb, F_sinb, F_KFT, F_KBT, F_VT, F_lgam + l * 16, 0};
              gemm_phase<EpiIn, StaticOrder, PG8_ALIGN, PG8_SP2, 0, false, true>(F.lds + RING_OFF, g, S, E, F.tid); LAUNDER(); }
            { Gemm g{F_XB, F_WIN + (size_t)ni * 256 * D, M, IN_COLS - ni * 256, D}; StaticOrder S; S.init(M, IN_COLS - ni * 256, F.G, (int)blockIdx.x); EpiIn E{F_PROJ, N1, F_rstd1, (PG8_LAS const float*)(F.lds + RING_OFF + ROWTAB_OFF), F_cosb, F_sinb, F_KFT, F_KBT, F_VT, F_lgam + l * 16, ni};
              gemm_phase<EpiIn, StaticOrder, PG8_ALIGN, PG8_SP2, PROBE_PHASE == 1>(F.lds + RING_OFF, g, S, E, F.tid); }
        } SP0(1); BW0(1); SEAM(pb + 1); BW1(1); PT1(1); SP1(1);
        PT0(2); if (PHON(2) && IN(pb + 2)) { for (int rp = 0; rp < PHREP(2); ++rp) { LAUNDER(); for (int r2 = 0; r2 < PHREP(10); ++r2) mixer_a(F, l); for (int r2 = 0; r2 < PHREP(11); ++r2) scan_phase(F, l); } } SP0(2); BW0(2); SEAM(pb + 2); BW1(2); PT1(2); SP1(2);
        PT0(3); if (PHON(3) && IN(pb + 3)) { for (int rp = 0; rp < PHREP(3); ++rp) { LAUNDER(); intra_phase(F, l); } } SP0(3); BW0(3); SEAM(pb + 3); BW1(3); PT1(3); SP1(3);
        PT0(4); if (PHON(4) && IN(pb + 4)) for (int rp = 0; rp < PHREP(4); ++rp) { LAUNDER(); Gemm g{F_YCAT, F_WOUT, M, D, D}; StaticOrder S; S.init(M, D, F.G, (int)blockIdx.x); EpiRes E{l == 0 ? F_x : nullptr, F_XB, F_part, D, 1.0f};
            gemm_phase<EpiRes, StaticOrder, PG8_ALIGN, PG8_SP2, PROBE_PHASE == 4>(F.lds + RING_OFF, g, S, E, F.tid); } SP0(4); BW0(4); SEAM(pb + 4); BW1(4); PT1(4); SP1(4);
        PT0(5); if (PHON(5) && IN(pb + 5)) { for (int rp = 0; rp < PHREP(5); ++rp) { LAUNDER(); if (gu8_of(l) > 0) p5_i8_phase(F, F_rstd2, F_xq8, F_rs8, 1.0f); else rstd_from_part(F, F_rstd2); } } SP0(5); BW0(5); SEAM(pb + 5); BW1(5); PT1(5); SP1(5);
        PT0(6); if (PHON(6) && IN(pb + 6)) for (int rp = 0; rp < PHREP(6); ++rp) { const int n8 = gu8_of(l);
            if (n8 > 0) { LAUNDER(); Gemm g{(const bf16*)F_xq8, F_WGU, M, n8 * 256, D / 2}; TailOrder S; S.init(M, n8 * 256, F.G, (int)blockIdx.x); S.init2((unsigned*)(F.ap->ws) + 1024 + 64 * l + 32, (volatile PG8_LAS int*)(MISC + 24)); if (F.tid == 0) MISC[24] = 0xffffffffu;
                const float sg = __builtin_fmaxf(wq_range(F, l, 0), 1e-30f) * (1.0f / 127.0f), su = __builtin_fmaxf(wq_range(F, l, 1), 1e-30f) * (1.0f / 127.0f);
                EpiAct E{F_ACT, FF, F_rs8, (PG8_LAS float*)(F.lds + RING_OFF + ROWTAB_OFF), sg, su, 0, k8_of(l), (size_t)M * k8_of(l), F_ffn_w + (size_t)l * 3 * FF, F_ffn_b + (size_t)l * FF, F_HG, F_HU};
                gemm_phase<EpiAct, TailOrder, PG8_ALIGN, PG8_SP2, 0, false, true>(F.lds + RING_OFF, g, S, E, F.tid); }
            if (n8 < NGU / 256) { LAUNDER(); Gemm g{F_XB, F_WGU + (size_t)n8 * 256 * D, M, NGU - n8 * 256, D}; TailOrder S; S.init(M, NGU - n8 * 256, F.G, (int)blockIdx.x); S.init2((unsigned*)(F.ap->ws) + 1024 + 64 * l, (volatile PG8_LAS int*)(MISC + 24)); if (F.tid == 0) MISC[24] = 0xffffffffu;
              EpiAct E{F_ACT, FF, F_rstd2, (PG8_LAS float*)(F.lds + RING_OFF + ROWTAB_OFF), 1.0f, 1.0f, n8, k8_of(l), (size_t)M * k8_of(l), F_ffn_w + (size_t)l * 3 * FF, F_ffn_b + (size_t)l * FF, F_HG, F_HU};
              gemm_phase<EpiAct, TailOrder, PG8_ALIGN, PG8_SP2, PROBE_PHASE == 6>(F.lds + RING_OFF, g, S, E, F.tid); } } SP0(6); BW0(6); SEAM(pb + 6); BW1(6); PT1(6); SP1(6);
#if PROBE_GEMM
        if (IN(pb + 6)) { GRID_BAR(); LAUNDER(); Gemm g{F_XB, F_WGU, M, FF, D}; ProbeOrder S; S.init(M, FF, F.G, (int)blockIdx.x); EpiScale E{F_ACT, FF, F_rstd2, (PG8_LAS const float*)(F.lds + RING_OFF + ROWTAB_OFF)};
            gemm_phase<EpiScale, ProbeOrder, PG8_ALIGN, PG8_SP2>(F.lds + RING_OFF, g, S, E, F.tid); GRID_BAR(); }
#endif
        PT0(7); if (PHON(7) && IN(pb + 7)) { for (int rp = 0; rp < PHREP(7); ++rp) { LAUNDER(); act_fix_phase(F, l); } } SP0(7); BW0(7); SEAM(pb + 7); BW1(7); PT1(7); SP1(7);
        PT0(8); if (PHON(8) && IN(pb + 8)) { LAUNDER(); StaticOrder S; S.init(M, D, F.G, (int)blockIdx.x);
            const int k8 = k8_of(l);
            if (k8 > 0) { Gemm g{F_ACT, F_WDN, M, D, k8 / 2}; EpiRes E{nullptr, F_XB, F_part, D, 1.0f / (F8_ASCALE * F8_WSCALE)};
                gemm_phase<EpiRes, StaticOrder, PG8_ALIGN, PG8_SP2, 0, true>(F.lds + RING_OFF, g, S, E, F.tid); }
            if (k8 < FF) { LAUNDER(); Gemm g{(const bf16*)((const unsigned char*)F_ACT + (size_t)M * k8), (const bf16*)((const unsigned char*)F_WDN + (size_t)D * k8), M, D, FF - k8}; EpiRes E{nullptr, F_XB, F_part, D, 1.0f};
                gemm_phase<EpiRes, StaticOrder, PG8_ALIGN, PG8_SP2, PROBE_PHASE == 8>(F.lds + RING_OFF, g, S, E, F.tid); } } SP0(8); BW0(8); SEAM(pb + 8); BW1(8); PT1(8); SP1(8);
    }
    PT0(9); if (PHON(9) && IN(N_PHASES - 1)) { LAUNDER(); final_phase(F); }
#if PROBE_PHTIME == 9
    GRID_BAR(); PT1(9);
#endif
#if PROBE_BARS
    for (int i = 0; i < PROBE_BARS; ++i) GRID_BAR();
#endif
#if PROBE_SPREAD >= 0
    if (blockIdx.x == 0 && F.tid == 0) { const unsigned long long ticks = 4ull * MISC[19]; const unsigned long long t0 = __builtin_amdgcn_s_memrealtime(); while (__builtin_amdgcn_s_memrealtime() - t0 < ticks) __builtin_amdgcn_s_sleep(8); }
#endif
#if PROBE_BWAIT >= 0
    if (blockIdx.x == 0 && F.tid == 0) { const unsigned long long ticks = 2ull * MISC[20]; const unsigned long long t0 = __builtin_amdgcn_s_memrealtime(); while (__builtin_amdgcn_s_memrealtime() - t0 < ticks) __builtin_amdgcn_s_sleep(8); }
#endif
#if PROBE_PHTIME >= 0
    if (blockIdx.x == 0 && F.tid == 0) { const unsigned long long ticks = MISC[18]; const unsigned long long t0 = __builtin_amdgcn_s_memrealtime(); while (__builtin_amdgcn_s_memrealtime() - t0 < ticks) __builtin_amdgcn_s_sleep(8); }
#endif
#if PROBE_TIMER
    if (blockIdx.x == 0 && F.tid == 0) { const unsigned v = MISC[16] / (MISC[17] ? MISC[17] : 1u);
        const unsigned long long ticks = (PROBE_TIMER & 1) ? (unsigned long long)v / 2ull : (unsigned long long)v * 10ull;
        const unsigned long long t0 = __builtin_amdgcn_s_memrealtime(); while (__builtin_amdgcn_s_memrealtime() - t0 < ticks) __builtin_amdgcn_s_sleep(8); }
#endif
#undef IN
#undef SEAM
}

extern "C" void kernel_launch(void* const* d_in, const int* in_sizes, int n_in, void* d_out, int out_size, void* d_ws, size_t ws_size, hipStream_t stream) {
    static int grid = 0;
    if (grid == 0) {
        if (n_in != 17 || in_sizes[0] != M * D || out_size != M * D || ws_size < WS_END) { fprintf(stderr, "kernel_launch: unexpected shapes (n_in %d, in0 %d, out %d, ws %zu < %zu?)\n", n_in, n_in > 0 ? in_sizes[0] : -1, out_size, ws_size, (size_t)WS_END); grid = -1; return; }
        int dev = 0, cus = 0, per_cu = 0;
        if (hipGetDevice(&dev) != hipSuccess || hipDeviceGetAttribute(&cus, hipDeviceAttributeMultiprocessorCount, dev) != hipSuccess) { grid = -1; return; }
        if (hipFuncSetAttribute((const void*)enc_fwd, hipFuncAttributeMaxDynamicSharedMemorySize, LDS_BYTES) != hipSuccess) { fprintf(stderr, "kernel_launch: hipFuncSetAttribute failed\n"); grid = -1; return; }
        if (hipOccupancyMaxActiveBlocksPerMultiprocessor(&per_cu, (const void*)enc_fwd, NWAVES * 64, LDS_BYTES) != hipSuccess || per_cu < 1) fprintf(stderr, "kernel_launch: occupancy query reports %d\n", per_cu);
        (void)hipGetLastError();
        grid = cus;
    }
    if (grid < 0) return;
    if (hipMemsetAsync((char*)d_ws + WS_CTL, 0, CTL_ZERO_BYTES, stream) != hipSuccess) { fprintf(stderr, "kernel_launch: memset failed\n"); return; }
    Args a{};
    for (int i = 0; i < 17; ++i) a.in[i] = d_in[i];
    a.out = (float*)d_out; a.ws = (unsigned char*)d_ws;
#if MK_SPLIT
    for (int p = 0; p < N_PHASES; ++p) { a.ph_lo = p; a.ph_hi = p + 1; hipLaunchKernelGGL(enc_fwd, dim3(grid), dim3(NWAVES * 64), LDS_BYTES, stream, a); }
#else
    a.ph_lo = 0; a.ph_hi = N_PHASES;
    hipLaunchKernelGGL(enc_fwd, dim3(grid), dim3(NWAVES * 64), LDS_BYTES, stream, a);
#endif
    const hipError_t le = hipPeekAtLastError();
    if (le != hipSuccess) fprintf(stderr, "kernel_launch: launch failed: %s\n", hipGetErrorName(le));
}
```
